# Optimizing an MI355X kernel written in HIP

```python
import math
import functools
import jax
import jax.numpy as jnp
from jax import lax
import numpy as np

D_MODEL = 1024
BATCH = 8
SEQ = 4096
DEPTH = 2

CTX_LEN = 256
GRID_W = 64
ROPE_BASE = 10000.0
NORM_EPS = 1e-6
NEG_INF = -1e30
Q_BLOCK = 128
N_MOD = 6

CONV_WIDTH = 3
CONV_DIM = 512
DIFF_HEADS = 4
DIFF_HEAD_DIM = 64
DIFF_V_DIM = 2 * DIFF_HEAD_DIM
DIFF_QK_WIDTH = DIFF_HEADS * 2 * DIFF_HEAD_DIM
DIFF_WIDTH = DIFF_HEADS * DIFF_V_DIM
AB_IN_WIDTH = 3 * CONV_DIM + 2 * DIFF_QK_WIDTH + DIFF_WIDTH
AB_SPLITS = (CONV_DIM, 2 * CONV_DIM, 3 * CONV_DIM, 3 * CONV_DIM + DIFF_QK_WIDTH, 3 * CONV_DIM + 2 * DIFF_QK_WIDTH)
AB_OUT_WIDTH = CONV_DIM + DIFF_WIDTH

SWA_HEADS = 16
SWA_KV_HEADS = 4
SWA_GROUP = SWA_HEADS // SWA_KV_HEADS
SWA_HEAD_DIM = 64
SWA_WINDOW = 128
SWA_Q_WIDTH = SWA_HEADS * SWA_HEAD_DIM
SWA_KV_WIDTH = SWA_KV_HEADS * SWA_HEAD_DIM
SWA_SPLITS = (SWA_Q_WIDTH, SWA_Q_WIDTH + SWA_KV_WIDTH)

N_EXPERTS = 16
EXPERT_FF = 1024
CAPACITY_FACTOR = 2

kernel_name = 'hybrid_diffusion_conv_diffattn_swa_ecmoe'


def rms_norm(x, gain):
    xf = x.astype(jnp.float32)
    y = xf * lax.rsqrt(jnp.mean(xf * xf, axis=-1, keepdims=True) + NORM_EPS)
    return (y * gain.astype(jnp.float32)).astype(x.dtype)


def ada_params(cond, w, b):
    m = jax.nn.silu(cond) @ w + b
    return jnp.split(m[..., None, :], N_MOD, axis=-1)


def modulate(x, gain, shift, scale):
    return rms_norm(x, gain) * (1.0 + scale) + shift


def diff_lambda_init(layer_idx):
    return 0.8 - 0.6 * math.exp(-0.3 * layer_idx)


def axial_rope(rows, rot_dim):
    n_freq = rot_dim // 4
    inv_freq = ROPE_BASE ** (-jnp.arange(n_freq, dtype=jnp.float32) / n_freq)
    row = jnp.repeat(jnp.arange(rows, dtype=jnp.float32), GRID_W)
    col = jnp.tile(jnp.arange(GRID_W, dtype=jnp.float32), rows)
    ang = jnp.stack([row, col], axis=-1)[:, :, None] * inv_freq
    return jnp.cos(ang), jnp.sin(ang)


def apply_rope(x, cos, sin):
    n_freq = cos.shape[-1]
    bshape = (x.shape[1],) + (1,) * (x.ndim - 3) + (2, n_freq)
    cs = cos.reshape(bshape).astype(x.dtype)
    sn = sin.reshape(bshape).astype(x.dtype)
    xr = x.reshape(x.shape[:-1] + (2, 2, n_freq))
    x1, x2 = xr[..., 0, :], xr[..., 1, :]
    out = jnp.stack([x1 * cs - x2 * sn, x2 * cs + x1 * sn], axis=-2)
    return out.reshape(x.shape)


def short_conv(u, w):
    half = CONV_WIDTH // 2
    return lax.conv_general_dilated(
        u, w[:, None, :], window_strides=(1,), padding=[(half, half)],
        dimension_numbers=('NWC', 'WIO', 'NWC'), feature_group_count=u.shape[-1])


def blocked_queries(q, fn):
    b, t = q.shape[:2]
    nb = t // Q_BLOCK
    qb = jnp.moveaxis(q.reshape((b, nb, Q_BLOCK) + q.shape[2:]), 1, 0)
    out = lax.map(lambda args: fn(*args), (qb, jnp.arange(nb)))
    return jnp.moveaxis(out, 0, 1).reshape((b, t) + out.shape[3:])


def diff_attend(q, k, v, lam):
    s = jnp.einsum('bqhmd,bkhmd->bhmqk', q, k).astype(jnp.float32) * DIFF_HEAD_DIM ** -0.5
    p = jax.nn.softmax(s, axis=-1)
    a = (p[:, :, 0] - lam * p[:, :, 1]).astype(v.dtype)
    return jnp.einsum('bhqk,bkhe->bqhe', a, v)


def sink_attend(q, k, v, sink, mask):
    s = jnp.einsum('bqngd,bknd->bngqk', q, k).astype(jnp.float32) * SWA_HEAD_DIM ** -0.5
    s = jnp.where(mask, s, NEG_INF)
    sk = jnp.broadcast_to(sink.astype(jnp.float32)[None, :, :, None, None], s.shape[:-1] + (1,))
    p = jax.nn.softmax(jnp.concatenate([s, sk], axis=-1), axis=-1)[..., :-1]
    return jnp.einsum('bngqk,bknd->bqngd', p.astype(v.dtype), v)


def window_attend_latent(q, k_lat, v_lat, k_ctx, v_ctx, sink):
    t = q.shape[1]
    pad = ((0, 0), (SWA_WINDOW, SWA_WINDOW), (0, 0), (0, 0))
    k_pad = jnp.pad(k_lat, pad)
    v_pad = jnp.pad(v_lat, pad)
    span = Q_BLOCK + 2 * SWA_WINDOW
    qi = jnp.arange(Q_BLOCK)[:, None]
    kj = jnp.arange(span)[None, :]
    band = (kj >= qi) & (kj <= qi + 2 * SWA_WINDOW)
    ctx_ok = jnp.ones((Q_BLOCK, k_ctx.shape[1]), dtype=bool)

    def block(qb, blk):
        start = blk * Q_BLOCK
        kb = lax.dynamic_slice_in_dim(k_pad, start, span, axis=1)
        vb = lax.dynamic_slice_in_dim(v_pad, start, span, axis=1)
        pos = start - SWA_WINDOW + kj
        mask = jnp.concatenate([ctx_ok, band & (pos >= 0) & (pos < t)], axis=1)
        return sink_attend(qb, jnp.concatenate([k_ctx, kb], axis=1),
                           jnp.concatenate([v_ctx, vb], axis=1), sink, mask)

    return blocked_queries(q, block)


def mixer_conv_diff(h, h_ctx, w_in, conv_w, lam_q1, lam_k1, lam_q2, lam_k2, subln_g, w_out,
                    cos, sin, lam_init, ctx_out):
    f32 = jnp.float32
    lam = (jnp.exp(jnp.sum(lam_q1.astype(f32) * lam_k1.astype(f32)))
           - jnp.exp(jnp.sum(lam_q2.astype(f32) * lam_k2.astype(f32))) + lam_init)

    def project(u):
        b, t = u.shape[:2]
        bg, cg, xv, q, k, v = jnp.split(u @ w_in, AB_SPLITS, axis=-1)
        conv = bg * short_conv(cg * xv, conv_w)
        q = q.reshape(b, t, DIFF_HEADS, 2, DIFF_HEAD_DIM)
        k = k.reshape(b, t, DIFF_HEADS, 2, DIFF_HEAD_DIM)
        v = v.reshape(b, t, DIFF_HEADS, DIFF_V_DIM)
        return conv, q, k, v

    def merge(conv, o):
        b, t = o.shape[:2]
        o = rms_norm(o, subln_g) * (1.0 - lam_init)
        return jnp.concatenate([conv, o.reshape(b, t, DIFF_WIDTH)], axis=-1) @ w_out

    conv_c, q_c, k_c, v_c = project(h_ctx)
    conv_l, q_l, k_l, v_l = project(h)
    q_l = apply_rope(q_l, cos, sin)
    k_l = apply_rope(k_l, cos, sin)
    k_all = jnp.concatenate([k_c, k_l], axis=1)
    v_all = jnp.concatenate([v_c, v_l], axis=1)
    o_l = blocked_queries(q_l, lambda qb, blk: diff_attend(qb, k_all, v_all, lam))
    y = merge(conv_l, o_l)
    y_ctx = merge(conv_c, diff_attend(q_c, k_c, v_c, lam)) if ctx_out else None
    return y, y_ctx


def mixer_window_gqa(h, h_ctx, w_qkv, sink, w_out, cos, sin, ctx_out):
    sink = sink.reshape(SWA_KV_HEADS, SWA_GROUP)

    def project(u):
        b, t = u.shape[:2]
        q, k, v = jnp.split(u @ w_qkv, SWA_SPLITS, axis=-1)
        return (q.reshape(b, t, SWA_KV_HEADS, SWA_GROUP, SWA_HEAD_DIM),
                k.reshape(b, t, SWA_KV_HEADS, SWA_HEAD_DIM),
                v.reshape(b, t, SWA_KV_HEADS, SWA_HEAD_DIM))

    def out(o):
        b, t = o.shape[:2]
        return o.reshape(b, t, SWA_Q_WIDTH) @ w_out

    q_c, k_c, v_c = project(h_ctx)
    q_l, k_l, v_l = project(h)
    q_l = apply_rope(q_l, cos, sin)
    k_l = apply_rope(k_l, cos, sin)
    y = out(window_attend_latent(q_l, k_l, v_l, k_c, v_c, sink))
    n_ctx = h_ctx.shape[1]
    y_ctx = out(sink_attend(q_c, k_c, v_c, sink, jnp.ones((n_ctx, n_ctx), dtype=bool))) if ctx_out else None
    return y, y_ctx


def expert_choice_ffn(h, router_w, w_gate, w_up, w_down):
    n, d = h.shape[1], h.shape[2]
    cap = CAPACITY_FACTOR * n // N_EXPERTS
    aff = jax.nn.softmax((h @ router_w).astype(jnp.float32), axis=-1)
    g, idx = lax.top_k(jnp.swapaxes(aff, 1, 2), cap)
    hs = jax.vmap(lambda hb, ib: hb[ib])(h, idx)
    a = jnp.einsum('becd,edf->becf', hs, w_gate)
    u = jnp.einsum('becd,edf->becf', hs, w_up)
    y = jnp.einsum('becf,efd->becd', jax.nn.silu(a) * u, w_down) * g[..., None].astype(h.dtype)
    return jax.vmap(lambda yb, ib: jax.ops.segment_sum(
        yb.reshape(-1, d), ib.reshape(-1), num_segments=n))(y, idx)


def trunk_layer(x, ctx, c, c_ctx, ada_w, ada_b, norm1_g, norm2_g, mixer, moe, ctx_out):
    sh1, sc1, g1, sh2, sc2, g2 = ada_params(c, ada_w, ada_b)
    csh1, csc1, cg1, csh2, csc2, cg2 = ada_params(c_ctx, ada_w, ada_b)
    y, y_ctx = mixer(modulate(x, norm1_g, sh1, sc1), modulate(ctx, norm1_g, csh1, csc1), ctx_out=ctx_out)
    x = x + g1 * y
    x = x + g2 * expert_choice_ffn(modulate(x, norm2_g, sh2, sc2), *moe)
    if ctx_out:
        ctx = ctx + cg1 * y_ctx
        ctx = ctx + cg2 * expert_choice_ffn(modulate(ctx, norm2_g, csh2, csc2), *moe)
    return x, ctx


def setup_inputs(seed: int = 0) -> dict:
    key = jax.random.key(seed)
    keys = iter(jax.random.split(key, 64))

    def nrm(shape, scale):
        return jax.random.normal(next(keys), shape, jnp.float32) * scale

    def gain(n):
        return 1.0 + nrm((n,), 0.01)

    d = D_MODEL
    inp = {}
    inp['x'] = nrm((BATCH, SEQ, d), 1.0)
    inp['c'] = nrm((BATCH, d), 1.0)
    inp['ctx'] = nrm((BATCH, CTX_LEN, d), 1.0)
    inp['c_ctx'] = nrm((d,), 1.0)
    inp['l0_ada_w'] = nrm((d, N_MOD * d), 0.5 * d ** -0.5)
    inp['l0_ada_b'] = nrm((N_MOD * d,), 0.01)
    inp['l0_norm1_g'] = gain(d)
    inp['l0_w_in'] = nrm((d, AB_IN_WIDTH), d ** -0.5)
    inp['l0_conv_w'] = nrm((CONV_WIDTH, CONV_DIM), CONV_WIDTH ** -0.5)
    inp['l0_lambda_q1'] = nrm((DIFF_HEAD_DIM,), 0.1)
    inp['l0_lambda_k1'] = nrm((DIFF_HEAD_DIM,), 0.1)
    inp['l0_lambda_q2'] = nrm((DIFF_HEAD_DIM,), 0.1)
    inp['l0_lambda_k2'] = nrm((DIFF_HEAD_DIM,), 0.1)
    inp['l0_subln_g'] = gain(DIFF_V_DIM)
    inp['l0_w_out'] = nrm((AB_OUT_WIDTH, d), AB_OUT_WIDTH ** -0.5)
    inp['l0_norm2_g'] = gain(d)
    inp['l0_router_w'] = nrm((d, N_EXPERTS), d ** -0.5)
    inp['l0_exp_w_gate'] = nrm((N_EXPERTS, d, EXPERT_FF), d ** -0.5)
    inp['l0_exp_w_up'] = nrm((N_EXPERTS, d, EXPERT_FF), d ** -0.5)
    inp['l0_exp_w_down'] = nrm((N_EXPERTS, EXPERT_FF, d), EXPERT_FF ** -0.5)
    inp['l1_ada_w'] = nrm((d, N_MOD * d), 0.5 * d ** -0.5)
    inp['l1_ada_b'] = nrm((N_MOD * d,), 0.01)
    inp['l1_norm1_g'] = gain(d)
    inp['l1_w_qkv'] = nrm((d, SWA_Q_WIDTH + 2 * SWA_KV_WIDTH), d ** -0.5)
    inp['l1_sink'] = nrm((SWA_HEADS,), 1.0)
    inp['l1_w_out'] = nrm((SWA_Q_WIDTH, d), SWA_Q_WIDTH ** -0.5)
    inp['l1_norm2_g'] = gain(d)
    inp['l1_router_w'] = nrm((d, N_EXPERTS), d ** -0.5)
    inp['l1_exp_w_gate'] = nrm((N_EXPERTS, d, EXPERT_FF), d ** -0.5)
    inp['l1_exp_w_up'] = nrm((N_EXPERTS, d, EXPERT_FF), d ** -0.5)
    inp['l1_exp_w_down'] = nrm((N_EXPERTS, EXPERT_FF, d), EXPERT_FF ** -0.5)
    inp['final_norm_g'] = gain(d)
    return inp


def reference(x, c, ctx, c_ctx,
              l0_ada_w, l0_ada_b, l0_norm1_g, l0_w_in, l0_conv_w, l0_lambda_q1, l0_lambda_k1,
              l0_lambda_q2, l0_lambda_k2, l0_subln_g, l0_w_out, l0_norm2_g, l0_router_w,
              l0_exp_w_gate, l0_exp_w_up, l0_exp_w_down,
              l1_ada_w, l1_ada_b, l1_norm1_g, l1_w_qkv, l1_sink, l1_w_out, l1_norm2_g, l1_router_w,
              l1_exp_w_gate, l1_exp_w_up, l1_exp_w_down,
              final_norm_g):
    rows = x.shape[1] // GRID_W
    cos_d, sin_d = axial_rope(rows, DIFF_HEAD_DIM)
    cos_w, sin_w = axial_rope(rows, SWA_HEAD_DIM)
    layers = [
        (l0_ada_w, l0_ada_b, l0_norm1_g, l0_norm2_g,
         functools.partial(mixer_conv_diff, w_in=l0_w_in, conv_w=l0_conv_w,
                           lam_q1=l0_lambda_q1, lam_k1=l0_lambda_k1,
                           lam_q2=l0_lambda_q2, lam_k2=l0_lambda_k2,
                           subln_g=l0_subln_g, w_out=l0_w_out, cos=cos_d, sin=sin_d,
                           lam_init=diff_lambda_init(0)),
         (l0_router_w, l0_exp_w_gate, l0_exp_w_up, l0_exp_w_down)),
        (l1_ada_w, l1_ada_b, l1_norm1_g, l1_norm2_g,
         functools.partial(mixer_window_gqa, w_qkv=l1_w_qkv, sink=l1_sink, w_out=l1_w_out,
                           cos=cos_w, sin=sin_w),
         (l1_router_w, l1_exp_w_gate, l1_exp_w_up, l1_exp_w_down)),
    ]
    for i in range(DEPTH):
        ada_w, ada_b, n1, n2, mixer, moe = layers[i]
        x, ctx = trunk_layer(x, ctx, c, c_ctx, ada_w, ada_b, n1, n2, mixer, moe,
                             ctx_out=i < DEPTH - 1)
    return rms_norm(x, final_norm_g)
```

```cpp
#include <hip/hip_runtime.h>
#include <hip/hip_bf16.h>
#include <cstdio>
#include <cstdint>

#ifndef MK_N_LAUNCHES
#define MK_N_LAUNCHES 1
#endif

#define GAS __attribute__((address_space(1)))
#define LAS __attribute__((address_space(3)))
typedef unsigned short bf16_t;
typedef short bf16x8 __attribute__((ext_vector_type(8)));
typedef short s16x4 __attribute__((ext_vector_type(4)));
typedef float f32x2 __attribute__((ext_vector_type(2)));
typedef float f32x4 __attribute__((ext_vector_type(4)));
typedef float f32x16 __attribute__((ext_vector_type(16)));
typedef unsigned u32x2 __attribute__((ext_vector_type(2)));
typedef unsigned u32x4 __attribute__((ext_vector_type(4)));
typedef GAS unsigned gu32;

constexpr int DM = 1024, NB = 8, SEQ = 4096, CTX = 256;
constexpr int NLAT = NB * SEQ;
constexpr int NCTX = NB * CTX;
constexpr int MALL = NLAT + NCTX;
constexpr int NE = 16, FF = 1024;
constexpr int CAP_L = 512, CAP_C = 32;
constexpr int EROWS0 = NB * CAP_L + NB * CAP_C;
constexpr int EROWS1 = NB * CAP_L;
constexpr int NWIN = 3072, NQKV1 = 1536;
constexpr float NORM_EPS = 1e-6f;
constexpr float LAM_INIT = 0.2f;
constexpr int NWAVES = 8, NTHREADS = 512;

constexpr size_t KiB = 1024, MiB = 1024 * 1024;
constexpr size_t WS_CTL = 0, CTL_ZERO_BYTES = 1 * MiB;
constexpr int CW_BAR = 4096;
constexpr size_t WS_MOD = 64 * KiB;
constexpr size_t MOD_BYTES = 2 * 9 * 6144 * 4;
static_assert(WS_MOD + MOD_BYTES <= 640 * KiB, "mod");
constexpr size_t WS_ROPE = 1 * MiB;
constexpr size_t WS_AFF = WS_ROPE + 16 * KiB;
constexpr size_t WS_POS = WS_AFF + (size_t)MALL * 16 * 4;
constexpr size_t WS_IDX = WS_POS + (size_t)MALL * 16 * 4;
constexpr size_t WS_XCTX = WS_IDX + (size_t)NE * EROWS0 * 4 + 4096;
constexpr size_t WS_W = (WS_XCTX + (size_t)NCTX * DM * 4 + 4095) / 4096 * 4096;
constexpr size_t W_IN = WS_W;
constexpr size_t W_OUT0 = W_IN + (size_t)NWIN * DM * 2;
constexpr size_t W_GU0 = W_OUT0 + (size_t)DM * DM * 2;
constexpr size_t W_D0 = W_GU0 + (size_t)NE * 2 * FF * DM * 2;
constexpr size_t W_QKV = W_D0 + (size_t)NE * DM * FF * 2;
constexpr size_t W_OUT1 = W_QKV + (size_t)NQKV1 * DM * 2;
constexpr size_t W_GU1 = W_OUT1 + (size_t)DM * DM * 2;
constexpr size_t W_D1 = W_GU1 + (size_t)NE * 2 * FF * DM * 2;
constexpr size_t WS_ARENA = W_D1 + (size_t)NE * DM * FF * 2;
constexpr size_t SZ_XN = (size_t)MALL * DM * 2;
constexpr size_t SZ_H5 = (size_t)MALL * 512 * 2;
constexpr size_t SZ_E = (size_t)NE * EROWS0 * DM * 2;
constexpr size_t A_XN = WS_ARENA;
constexpr size_t A_BG = A_XN + SZ_XN, A_CX = A_BG + SZ_H5, A_Q0 = A_CX + SZ_H5, A_K0 = A_Q0 + SZ_H5, A_V0 = A_K0 + SZ_H5;
constexpr size_t A_OH = A_V0 + SZ_H5;
constexpr size_t A_HS = A_XN + SZ_XN;
constexpr size_t A_ACT = A_HS + SZ_E;
constexpr size_t A_Q1 = A_XN + SZ_XN;
constexpr size_t A_K1 = A_Q1 + SZ_XN;
constexpr size_t A_V1 = A_K1 + (size_t)MALL * 256 * 2;
constexpr size_t WS_END = A_ACT + SZ_E;
static_assert(A_OH + SZ_XN <= WS_END && A_V1 + (size_t)MALL * 256 * 2 <= WS_END, "arena");
static_assert(WS_END <= 600000000ull, "workspace budget");

constexpr int RING_BYTES = 131072;
constexpr int MISC_OFF = RING_BYTES + 320;
constexpr int LDS_BYTES = 147456;

#define RLX_AGENT __ATOMIC_RELAXED, __HIP_MEMORY_SCOPE_AGENT
#define LDS_WAIT() asm volatile("s_waitcnt lgkmcnt(0)" ::: "memory")
#define VM_WAIT() asm volatile("s_waitcnt vmcnt(0)" ::: "memory")

__device__ __forceinline__ unsigned f2bf(float f) { unsigned u = __builtin_bit_cast(unsigned, f); return (u + 0x7fffu + ((u >> 16) & 1u)) >> 16; }
__device__ __forceinline__ unsigned pk2(float lo, float hi) { return f2bf(lo) | (f2bf(hi) << 16); }
__device__ __forceinline__ unsigned cvt_pk_bf16(float lo, float hi) { unsigned r; asm volatile("v_cvt_pk_bf16_f32 %0, %1, %2" : "=v"(r) : "v"(lo), "v"(hi)); return r; }
__device__ __forceinline__ float bf_lo(unsigned w) { return __builtin_bit_cast(float, w << 16); }
__device__ __forceinline__ float bf_hi(unsigned w) { return __builtin_bit_cast(float, w & 0xffff0000u); }
__device__ __forceinline__ float wave_sum(float v) {
#pragma unroll
    for (int o = 1; o < 64; o <<= 1) v += __shfl_xor(v, o);
    return v;
}

#define XB_TMO      128
#define XB_XCNT(j)  (256  + 64 * (j))
#define XB_XSUB(j)  (1280 + 64 * (j))
#define XB_XGEN(j)  (2304 + 64 * (j))
#define XB_TOP      3328
#define XB_TOPGEN   3392
#define XCD_BAR_WORDS 3456
#define XB_SPIN_CAP (1u << 20)
__device__ __forceinline__ unsigned xb_ld(unsigned* p)              { return __hip_atomic_load(p, __ATOMIC_RELAXED, __HIP_MEMORY_SCOPE_AGENT); }
__device__ __forceinline__ unsigned xb_add(unsigned* p, unsigned v) { return __hip_atomic_fetch_add(p, v, __ATOMIC_RELAXED, __HIP_MEMORY_SCOPE_AGENT); }
__device__ __forceinline__ unsigned xb_xcc_id() { return (unsigned)__builtin_amdgcn_s_getreg((3 << 11) | 20) & 0xFu; }
#define XB_SPIN(cond, bar) do { unsigned _sp = 0; while (cond) { __builtin_amdgcn_s_sleep(1); \
    if ((++_sp & 255u) == 0u) { if (xb_ld(&(bar)[XB_TMO])) break; if (_sp > XB_SPIN_CAP) { atomicAdd(&(bar)[XB_TMO], 1u); break; } } } } while (0)
struct XcdBarrier { unsigned* bar; unsigned x; volatile LAS unsigned* st; };
__device__ __forceinline__ XcdBarrier xcd_barrier_post(unsigned* bar, volatile LAS unsigned* st) {
    XcdBarrier b; b.bar = bar; b.x = xb_xcc_id(); b.st = st;
    if (threadIdx.x == 0) (void)xb_add(&bar[XB_XCNT(b.x)], 1u);
    return b;
}
__device__ __forceinline__ void xcd_barrier_complete(unsigned* bar, unsigned x, unsigned& nloc, unsigned& nx) {
    const unsigned G = gridDim.x * gridDim.y * gridDim.z;
    unsigned sum, cnt, mine, sp = 0u;
    for (;;) {
        sum = 0u; cnt = 0u; mine = 0u;
#pragma unroll
        for (unsigned j = 0; j < 16; ++j) { const unsigned c = xb_ld(&bar[XB_XCNT(j)]); sum += c; cnt += (c > 0u) ? 1u : 0u; mine = (j == x) ? c : mine; }
        if (sum == G) break;
        __builtin_amdgcn_s_sleep(1);
        if ((++sp & 255u) == 0u) { if (xb_ld(&bar[XB_TMO])) break; if (sp > XB_SPIN_CAP) { atomicAdd(&bar[XB_TMO], 1u); break; } }
    }
    nloc = mine > 0u ? mine : 1u; nx = cnt > 0u ? cnt : 1u;
}
__device__ __forceinline__ void xcd_barrier(const XcdBarrier& b) {
    asm volatile("s_waitcnt vmcnt(0)" ::: "memory");
    __syncthreads();
    if (threadIdx.x == 0) {
        unsigned* bar = b.bar;
        __builtin_amdgcn_s_waitcnt(0);
        unsigned nloc = b.st[0], nx = b.st[1];
        if (nloc == 0u) { xcd_barrier_complete(bar, b.x, nloc, nx); b.st[0] = nloc; b.st[1] = nx; }
        const unsigned old = xb_add(&bar[XB_XSUB(b.x)], 1u);
        const unsigned gen = old / nloc;
        if (old + 1u == (gen + 1u) * nloc) {
            __builtin_amdgcn_fence(__ATOMIC_RELEASE, "agent");
            asm volatile("s_waitcnt vmcnt(0)" ::: "memory");
            const unsigned og = xb_add(&bar[XB_TOP], 1u);
            const unsigned tg = og / nx;
            if (og + 1u == (tg + 1u) * nx) xb_add(&bar[XB_TOPGEN], 1u);
            else XB_SPIN(xb_ld(&bar[XB_TOPGEN]) == tg, bar);
            __builtin_amdgcn_fence(__ATOMIC_ACQUIRE, "agent");
            xb_add(&bar[XB_XGEN(b.x)], 1u);
            asm volatile("s_waitcnt vmcnt(0)" ::: "memory");
        } else {
            XB_SPIN(xb_ld(&bar[XB_XGEN(b.x)]) == gen, bar);
            __builtin_amdgcn_fence(__ATOMIC_ACQUIRE, "agent");
            asm volatile("s_waitcnt vmcnt(0)" ::: "memory");
        }
    }
    __syncthreads();
}

namespace pg8 {
constexpr int BM = 256, BK = 64, HALF = 128, HTB = HALF * BK * 2, NXCD = 8, WGM = 8;
__device__ __forceinline__ int lds_byte(int r, int c) { const int st = (r >> 4) * 2 + (c >> 5), rr = r & 15, cc = c & 31, ob = rr * 64 + cc * 2; return st * 1024 + (ob ^ (((ob >> 9) & 1) << 5)); }
__device__ __forceinline__ void stage_rc(int b, int& R, int& C) { const int st = b / 1024, sb = b % 1024, swz = sb ^ (((sb >> 9) & 1) << 5); R = (st >> 1) * 16 + swz / 64; C = (st & 1) * 32 + (swz % 64) / 2; }
__device__ __forceinline__ int perm32(int rho) { const int n = rho >> 4, i = rho & 15; return 8 * (i >> 2) + 4 * n + (i & 3); }

struct Unit { int pm, pn; const char* a; const char* b; };
struct Sched {
    const char* A; const char* B; int nM, nN, tpe, G, c;
    __device__ __forceinline__ bool next(int i, Unit& u) const {
        const int nwg = nM * nN; const long L = (long)i * G + c; if (L >= nwg) return false;
        int wgid = (int)L; { const int q = nwg / NXCD, r = nwg % NXCD, xcd = wgid % NXCD, off = wgid / NXCD; wgid = (xcd < r ? xcd * (q + 1) : r * (q + 1) + (xcd - r) * q) + off; }
        const int nig = WGM * nN, gid = wgid / nig, fm = gid * WGM, gsz = (nM - fm) < WGM ? (nM - fm) : WGM;
        u.pm = fm + ((wgid % nig) % gsz); u.pn = (wgid % nig) / gsz;
        const size_t tstep = (size_t)BM * DM * 2;
        u.a = A + (size_t)u.pm * tstep; u.b = B + (size_t)((u.pm / tpe) * nN + u.pn) * tstep;
        return true;
    }
};

enum EpiKind { EK_IN0 = 0, EK_OUT = 1, EK_GU = 2, EK_DOWN = 3, EK_QKV1 = 4 };
struct Epi {
    int kind, layer; unsigned char* ws; const float* xin_lat; const float* xin_ctx; float* out_lat;
    __device__ __forceinline__ void store8(bf16_t* p, const f32x4 a, const f32x4 b) const {
        u32x4 w; w.x = cvt_pk_bf16(a[0], a[1]); w.y = cvt_pk_bf16(a[2], a[3]); w.z = cvt_pk_bf16(b[0], b[1]); w.w = cvt_pk_bf16(b[2], b[3]);
        *(u32x4*)p = w;
    }
    __device__ __forceinline__ void operator()(const f32x4 (&acc)[2][2][4][2], const Unit& u, int wr, int wc, int fr, int fq) const {
        const int row0 = u.pm * BM + wr * 64 + fr;
        if (kind == EK_OUT) {
            const bool lat = row0 < NLAT;
            const int col0 = u.pn * BM + wc * 32 + 4 * fq;
            f32x4 gv[2][2];
            const int gb = lat ? (row0 >> 12) : 8;
#pragma unroll
            for (int bj = 0; bj < 2; ++bj)
#pragma unroll
                for (int n = 0; n < 2; ++n) gv[bj][n] = *(const f32x4*)((const float*)(ws + WS_MOD) + (size_t)(layer * 9 + gb) * 6144 + 2 * 1024 + col0 + bj * HALF + n * 16);
            const float* xi = lat ? xin_lat : xin_ctx - (size_t)NLAT * DM;
            float* xo = lat ? out_lat : (float*)(ws + WS_XCTX) - (size_t)NLAT * DM;
#pragma unroll
            for (int ai = 0; ai < 2; ++ai)
#pragma unroll
                for (int m = 0; m < 4; ++m) { const size_t off = (size_t)(row0 + ai * HALF + m * 16) * DM + col0;
#pragma unroll
                    for (int bj = 0; bj < 2; ++bj)
#pragma unroll
                        for (int n = 0; n < 2; ++n) { const f32x4 bs = *(const f32x4*)(xi + off + bj * HALF + n * 16);
                            *(f32x4*)(xo + off + bj * HALF + n * 16) = bs + gv[bj][n] * acc[ai][bj][m][n]; }
                    if (m & 1) asm volatile("" ::: "memory"); }
            return;
        }
        const int cw = wc * 32 + 8 * fq;
        if (kind == EK_GU) {
#pragma unroll
            for (int ai = 0; ai < 2; ++ai)
#pragma unroll
                for (int m = 0; m < 4; ++m) { f32x4 v[2];
#pragma unroll
                    for (int n = 0; n < 2; ++n) { const f32x4 g = acc[ai][0][m][n], up = acc[ai][1][m][n];
#pragma unroll
                        for (int j = 0; j < 4; ++j) v[n][j] = g[j] * __builtin_amdgcn_rcpf(1.f + __expf(-g[j])) * up[j]; }
                    store8((bf16_t*)(ws + A_ACT) + (size_t)(row0 + ai * HALF + m * 16) * FF + u.pn * HALF + cw, v[0], v[1]); }
            return;
        }
        if (kind == EK_DOWN) {
#pragma unroll
            for (int ai = 0; ai < 2; ++ai)
#pragma unroll
                for (int m = 0; m < 4; ++m)
#pragma unroll
                    for (int bj = 0; bj < 2; ++bj)
                        store8((bf16_t*)(ws + A_HS) + (size_t)(row0 + ai * HALF + m * 16) * DM + u.pn * BM + bj * HALF + cw, acc[ai][bj][m][0], acc[ai][bj][m][1]);
            return;
        }
        int mode; size_t doff; int ld, cb;
        if (kind == EK_IN0) {
            if (u.pn < 2)       { mode = 0; doff = A_BG; ld = 512; cb = u.pn * 256; }
            else if (u.pn < 6)  { mode = 1; doff = A_CX; ld = 512; cb = (u.pn - 2) * 128; }
            else if (u.pn < 8)  { mode = 2; doff = A_Q0; ld = 512; cb = (u.pn - 6) * 256; }
            else if (u.pn < 10) { mode = 2; doff = A_K0; ld = 512; cb = (u.pn - 8) * 256; }
            else                { mode = 0; doff = A_V0; ld = 512; cb = (u.pn - 10) * 256; }
        } else {
            if (u.pn < 4)       { mode = 2; doff = A_Q1; ld = 1024; cb = u.pn * 256; }
            else if (u.pn == 4) { mode = 2; doff = A_K1; ld = 256; cb = 0; }
            else                { mode = 0; doff = A_V1; ld = 256; cb = 0; }
        }
        bf16_t* dst = (bf16_t*)(ws + doff); const float* rope = (const float*)(ws + WS_ROPE);
        if (mode == 2 && row0 >= NLAT) mode = 0;
        if (mode == 1) {
#pragma unroll
            for (int ai = 0; ai < 2; ++ai)
#pragma unroll
                for (int m = 0; m < 4; ++m)
                    store8(dst + (size_t)(row0 + ai * HALF + m * 16) * ld + cb + cw, acc[ai][0][m][0] * acc[ai][1][m][0], acc[ai][0][m][1] * acc[ai][1][m][1]);
        } else if (mode == 0) {
#pragma unroll
            for (int ai = 0; ai < 2; ++ai)
#pragma unroll
                for (int m = 0; m < 4; ++m)
#pragma unroll
                    for (int bj = 0; bj < 2; ++bj)
                        store8(dst + (size_t)(row0 + ai * HALF + m * 16) * ld + cb + bj * HALF + cw, acc[ai][bj][m][0], acc[ai][bj][m][1]);
        } else {
#pragma unroll
            for (int ai = 0; ai < 2; ++ai)
#pragma unroll
                for (int m = 0; m < 4; ++m) { const int row = row0 + ai * HALF + m * 16; const int t = row & (SEQ - 1);
                    const int pos = (wc & 1) ? (t & 63) : (t >> 6);
                    const f32x4 cs = *(const f32x4*)(rope + pos * 16 + 4 * fq), sn = *(const f32x4*)(rope + 1024 + pos * 16 + 4 * fq);
#pragma unroll
                    for (int bj = 0; bj < 2; ++bj) { const f32x4 x1 = acc[ai][bj][m][0], x2 = acc[ai][bj][m][1];
                        store8(dst + (size_t)row * ld + cb + bj * HALF + cw, x1 * cs - x2 * sn, x2 * cs + x1 * sn); } }
        }
    }
};

__device__ __forceinline__ void gemm_phase(LAS unsigned char* lds, const int tid, const bool perm, const Sched& S, const Epi& E) {
    const int wid = __builtin_amdgcn_readfirstlane(tid >> 6), lane = tid & 63, wr = wid >> 2, wc = wid & 3, fr = lane & 15, fq = lane >> 4;
    constexpr int K = DM, nt = K / BK;
    unsigned voffA[2], voffB[2];
#pragma unroll
    for (int i = 0; i < 2; ++i) { int R, C; stage_rc(tid * 16 + i * 8192, R, C); const int Rb = perm ? ((R & ~31) + perm32(R & 31)) : R;
        voffA[i] = (unsigned)(R * K + C) * 2u; voffB[i] = (unsigned)(Rb * K + C) * 2u; }
    constexpr size_t kstep = (size_t)(BK * 2);
    constexpr size_t hstep = (size_t)HALF * K * 2;
    const unsigned ldsw = (unsigned)wid * 1024u;
    const int aoff = lds_byte(wr * 64 + fr, fq * 8), boff = lds_byte(wc * 32 + fr, fq * 8);
#define PG8_SA(b, h) (((b) * 2 + (h)) * HTB)
#define PG8_SB(b, h) ((4 + (b) * 2 + (h)) * HTB)
#define PG8_STAGE(bufoff, gbase, voff) do { _Pragma("unroll") for (int _i = 0; _i < 2; ++_i) \
        __builtin_amdgcn_global_load_lds((const unsigned*)((const char*)(gbase) + (voff)[_i]), (LAS unsigned*)(lds + (bufoff) + ldsw + _i * 8192), 16, 0, 0); } while (0)
#define PG8_LDA(dst, b, h) do { _Pragma("unroll") for (int m = 0; m < 4; ++m) _Pragma("unroll") for (int k = 0; k < 2; ++k) dst[m][k] = *(const LAS bf16x8*)(lds + PG8_SA(b, h) + aoff + m * 2048 + k * 1024); } while (0)
#define PG8_LDB(dst, b, h) do { _Pragma("unroll") for (int n = 0; n < 2; ++n) _Pragma("unroll") for (int k = 0; k < 2; ++k) dst[n][k] = *(const LAS bf16x8*)(lds + PG8_SB(b, h) + boff + n * 2048 + k * 1024); } while (0)
#define PG8_MMA(ai, bj, At, Bt) do { __builtin_amdgcn_s_setprio(1); _Pragma("unroll") for (int m = 0; m < 4; ++m) _Pragma("unroll") for (int n = 0; n < 2; ++n) _Pragma("unroll") for (int k = 0; k < 2; ++k) \
        acc[ai][bj][m][n] = __builtin_amdgcn_mfma_f32_16x16x32_bf16(Bt[n][k], At[m][k], acc[ai][bj][m][n], 0, 0, 0); __builtin_amdgcn_s_setprio(0); } while (0)
#define PG8_WAIT_V(n) asm volatile("s_waitcnt vmcnt(" #n ")" ::: "memory")
#define PG8_WAIT_L(n) asm volatile("s_waitcnt lgkmcnt(" #n ")" ::: "memory")
#define PG8_BAR __builtin_amdgcn_s_barrier()
#define PG8_SCHED __builtin_amdgcn_sched_barrier(0)
    Unit cur, nxt; int ui = 0;
    if (!S.next(0, cur)) return;
    f32x4 acc[2][2][4][2];
#pragma unroll
    for (int a = 0; a < 2; ++a)
#pragma unroll
        for (int b = 0; b < 2; ++b)
#pragma unroll
            for (int m = 0; m < 4; ++m)
#pragma unroll
                for (int n = 0; n < 2; ++n) acc[a][b][m][n] = (f32x4){0.f, 0.f, 0.f, 0.f};
    bf16x8 At[4][2], B0[2][2], B1[2][2];
    const char* cA = cur.a; const char* cB = cur.b;
    PG8_STAGE(PG8_SB(0, 0), cB, voffB); PG8_STAGE(PG8_SB(0, 1), cB + hstep, voffB); PG8_STAGE(PG8_SA(0, 0), cA, voffA); PG8_STAGE(PG8_SA(0, 1), cA + hstep, voffA);
    if (wr == 1) PG8_BAR;
    PG8_WAIT_V(2); PG8_BAR;
    PG8_STAGE(PG8_SB(1, 0), cB + kstep, voffB); PG8_STAGE(PG8_SA(1, 0), cA + kstep, voffA); PG8_STAGE(PG8_SB(1, 1), cB + hstep + kstep, voffB);
    PG8_WAIT_V(6); PG8_BAR;
    for (;;) {
        const bool has_next = S.next(ui + 1, nxt);
        const char* nA = has_next ? nxt.a : cA; const char* nB = has_next ? nxt.b : cB;
        for (int t = 0; t < nt; t += 2) {
            const bool last = (t == nt - 2);
            const char* a1 = cA + (size_t)(t + 1) * kstep;
            const char* a2 = last ? nA : cA + (size_t)(t + 2) * kstep; const char* b2 = last ? nB : cB + (size_t)(t + 2) * kstep;
            const char* a3 = a2 + kstep; const char* b3 = b2 + kstep;
            PG8_LDB(B0, 0, 0); PG8_LDB(B1, 0, 1); PG8_SCHED; PG8_LDA(At, 0, 0); PG8_STAGE(PG8_SA(1, 1), a1 + hstep, voffA);
            PG8_WAIT_V(8); PG8_WAIT_L(0); PG8_BAR; PG8_MMA(0, 0, At, B0); PG8_MMA(0, 1, At, B1); PG8_BAR; PG8_SCHED;
            PG8_LDA(At, 0, 1); PG8_STAGE(PG8_SB(0, 0), b2, voffB); PG8_STAGE(PG8_SB(0, 1), b2 + hstep, voffB); PG8_STAGE(PG8_SA(0, 0), a2, voffA);
            PG8_WAIT_V(8); PG8_WAIT_L(0); PG8_BAR; PG8_MMA(1, 0, At, B0); PG8_MMA(1, 1, At, B1); PG8_BAR; PG8_SCHED;
            PG8_LDB(B0, 1, 0); PG8_LDB(B1, 1, 1); PG8_SCHED; PG8_LDA(At, 1, 0); PG8_STAGE(PG8_SA(0, 1), a2 + hstep, voffA);
            PG8_WAIT_V(8); PG8_WAIT_L(0); PG8_BAR; PG8_MMA(0, 0, At, B0); PG8_MMA(0, 1, At, B1); PG8_BAR; PG8_SCHED;
            PG8_LDA(At, 1, 1); PG8_STAGE(PG8_SB(1, 0), b3, voffB); PG8_STAGE(PG8_SB(1, 1), b3 + hstep, voffB); PG8_STAGE(PG8_SA(1, 0), a3, voffA);
            PG8_WAIT_V(8); PG8_WAIT_L(0); PG8_BAR; PG8_MMA(1, 0, At, B0); PG8_MMA(1, 1, At, B1); PG8_BAR; PG8_SCHED;
        }
        if (wr == 0) PG8_BAR;
        E(acc, cur, wr, wc, fr, fq);
        if (!has_next) break;
#pragma unroll
        for (int a = 0; a < 2; ++a)
#pragma unroll
            for (int b = 0; b < 2; ++b)
#pragma unroll
                for (int m = 0; m < 4; ++m)
#pragma unroll
                    for (int n = 0; n < 2; ++n) acc[a][b][m][n] = (f32x4){0.f, 0.f, 0.f, 0.f};
        cur = nxt; cA = nA; cB = nB; ++ui;
        if (wr == 1) PG8_BAR;
    }
    PG8_WAIT_V(0);
    PG8_BAR;
#undef PG8_SA
#undef PG8_SB
#undef PG8_STAGE
#undef PG8_LDA
#undef PG8_LDB
#undef PG8_MMA
#undef PG8_WAIT_V
#undef PG8_WAIT_L
#undef PG8_BAR
#undef PG8_SCHED
}
}

namespace att {
constexpr int QBLK = 32, KVBLK = 64;
constexpr float SCALE = 0.125f;
constexpr float THR = 8.f;
constexpr float LOG2E = 1.4426950408889634f;
#define SBAR() __builtin_amdgcn_sched_barrier(0)
#define KSWZ(row, colB) ((row) * 128 + ((colB) ^ ((((row) >> 1) & 7) << 4)))
__device__ __forceinline__ int crow(int r, int hi) { return (r & 3) + 8 * (r >> 2) + 4 * hi; }
__device__ __forceinline__ unsigned cvtpk(float lo, float hi) { unsigned r; asm volatile("v_cvt_pk_bf16_f32 %0, %1, %2" : "=v"(r) : "v"(lo), "v"(hi)); return r; }

__device__ __forceinline__ void partialSM(f32x16& p0, f32x16& p1, float& m_reg, float& mn, float& alpha) {
    constexpr float C = SCALE * LOG2E;
    float pmax = p0[0];
#pragma unroll
    for (int r = 1; r < 16; ++r) pmax = fmaxf(pmax, p0[r]);
#pragma unroll
    for (int r = 0; r < 16; ++r) pmax = fmaxf(pmax, p1[r]);
    { auto rr = __builtin_amdgcn_permlane32_swap(__float_as_uint(pmax), __float_as_uint(pmax), false, false);
      pmax = fmaxf(__uint_as_float(rr[0]), __uint_as_float(rr[1])); }
    if (__builtin_expect(__all(pmax - m_reg <= THR / SCALE), 1)) { mn = m_reg; alpha = 1.f; }
    else { mn = fmaxf(m_reg, pmax); alpha = __builtin_amdgcn_exp2f((m_reg - mn) * C); m_reg = mn; }
    const float mnC = -mn * C;
#pragma unroll
    for (int r = 0; r < 16; ++r) p0[r] = fmaf(p0[r], C, mnC);
#pragma unroll
    for (int r = 0; r < 16; ++r) p1[r] = fmaf(p1[r], C, mnC);
#pragma unroll
    for (int r = 0; r < 16; ++r) p0[r] = __builtin_amdgcn_exp2f(p0[r]);
}
__device__ __forceinline__ void finishSM(f32x16& p0, f32x16& p1, float alpha, float& l_reg, bf16x8& pa0, bf16x8& pa1, bf16x8& pa2, bf16x8& pa3) {
#pragma unroll
    for (int r = 0; r < 16; ++r) p1[r] = __builtin_amdgcn_exp2f(p1[r]);
    float ps = 0;
#pragma unroll
    for (int r = 0; r < 16; ++r) ps += p0[r];
#pragma unroll
    for (int r = 0; r < 16; ++r) ps += p1[r];
    { auto rr = __builtin_amdgcn_permlane32_swap(__float_as_uint(ps), __float_as_uint(ps), false, false);
      ps = __uint_as_float(rr[0]) + __uint_as_float(rr[1]); }
    l_reg = l_reg * alpha + ps;
#define PK4(P, BASE, OUT) do { unsigned a0 = cvtpk(P[BASE + 0], P[BASE + 1]), a1 = cvtpk(P[BASE + 2], P[BASE + 3]);   \
    unsigned b0 = cvtpk(P[BASE + 4], P[BASE + 5]), b1 = cvtpk(P[BASE + 6], P[BASE + 7]);                              \
    auto r0 = __builtin_amdgcn_permlane32_swap(a0, b0, false, false); auto r1 = __builtin_amdgcn_permlane32_swap(a1, b1, false, false); \
    u32x4 w = {r0[0], r1[0], r0[1], r1[1]}; OUT = *reinterpret_cast<bf16x8*>(&w); } while (0)
    PK4(p0, 0, pa0); PK4(p0, 8, pa1); PK4(p1, 0, pa2); PK4(p1, 8, pa3);
#undef PK4
}
__device__ __forceinline__ void qkt(f32x16& p0, f32x16& p1, const LAS char* Ks, const bf16x8* qr, int r32, int hi) {
    p0 = f32x16{}; p1 = f32x16{};
#pragma unroll
    for (int d0 = 0; d0 < 4; ++d0) { const int cb = (d0 * 16 + hi * 8) * 2;
        const bf16x8 b0 = *(const LAS bf16x8*)(Ks + KSWZ(r32, cb));
        const bf16x8 b1 = *(const LAS bf16x8*)(Ks + KSWZ(32 + r32, cb));
        p0 = __builtin_amdgcn_mfma_f32_32x32x16_bf16(b0, qr[d0], p0, 0, 0, 0);
        p1 = __builtin_amdgcn_mfma_f32_32x32x16_bf16(b1, qr[d0], p1, 0, 0, 0); }
}
template <int NCB> __device__ __forceinline__ int v_st(int k, int c) { const int kk = (k & ~0xC) | ((k & 4) << 1) | ((k & 8) >> 1); return ((kk >> 3) * NCB + (c >> 5)) * 512 + ((kk & 7) * 32 + (c & 31)) * 2; }
__device__ __forceinline__ int v_rd_base(int lane) { return ((lane & 3) << 3) | (((lane >> 2) & 3) << 6) | (((lane >> 4) & 1) << 5) | (((lane >> 5) & 1) << 8); }
template <int OFF> __device__ __forceinline__ s16x4 tr_read(int vb) { s16x4 r; asm volatile("ds_read_b64_tr_b16 %0, %1 offset:%2" : "=&v"(r) : "v"(vb), "i"(OFF) : "memory"); return r; }
template <int NCB, int D0> __device__ __forceinline__ void pv_one(f32x16& od, int vb, bf16x8 pa0, bf16x8 pa1, bf16x8 pa2, bf16x8 pa3) {
    constexpr int KS = NCB * 1024, HS = NCB * 512;
    const s16x4 l0 = tr_read<D0 * 512 + 0 * KS>(vb), h0 = tr_read<D0 * 512 + 0 * KS + HS>(vb), l1 = tr_read<D0 * 512 + 1 * KS>(vb), h1 = tr_read<D0 * 512 + 1 * KS + HS>(vb);
    const s16x4 l2 = tr_read<D0 * 512 + 2 * KS>(vb), h2 = tr_read<D0 * 512 + 2 * KS + HS>(vb), l3 = tr_read<D0 * 512 + 3 * KS>(vb), h3 = tr_read<D0 * 512 + 3 * KS + HS>(vb);
    asm volatile("s_waitcnt lgkmcnt(0)" ::: "memory"); SBAR();
#define PK(L, H) (bf16x8){L[0], L[1], L[2], L[3], H[0], H[1], H[2], H[3]}
    od = __builtin_amdgcn_mfma_f32_32x32x16_bf16(pa0, PK(l0, h0), od, 0, 0, 0);
    od = __builtin_amdgcn_mfma_f32_32x32x16_bf16(pa1, PK(l1, h1), od, 0, 0, 0);
    od = __builtin_amdgcn_mfma_f32_32x32x16_bf16(pa2, PK(l2, h2), od, 0, 0, 0);
    od = __builtin_amdgcn_mfma_f32_32x32x16_bf16(pa3, PK(l3, h3), od, 0, 0, 0);
#undef PK
}
template <int NCB> __device__ __forceinline__ void pv_all(f32x16* o, int vb, bf16x8 pa0, bf16x8 pa1, bf16x8 pa2, bf16x8 pa3) {
    pv_one<NCB, 0>(o[0], vb, pa0, pa1, pa2, pa3); pv_one<NCB, 1>(o[1], vb, pa0, pa1, pa2, pa3);
    if constexpr (NCB == 4) { pv_one<NCB, 2>(o[2], vb, pa0, pa1, pa2, pa3); pv_one<NCB, 3>(o[3], vb, pa0, pa1, pa2, pa3); }
}

struct UnitDesc {
    const bf16_t* Q; int ldq;
    const bf16_t* K; const bf16_t* V; int ldk, ldv;
    bf16_t* O; int ldo;
    int ctx_row0, lat_row0, lat_t0, NT;
    int q0; float sinkl2;
};
template <int DV, bool SWA>
__device__ __forceinline__ void attn_unit(const UnitDesc& U, LAS char* lds, const int tid) {
    constexpr int NCB = DV / 32;
    constexpr int SHM_V = KVBLK * DV * 2, SHM_K = KVBLK * 64 * 2;
    constexpr int NLD = (DV == 128) ? 3 : 2;
    const int wid = tid >> 6, lane = tid & 63, r32 = lane & 31, hi = lane >> 5;
    LAS char* V_lds = lds; LAS char* K_lds = lds + 2 * SHM_V;
    LAS float* ws = (LAS float*)(lds + 2 * SHM_V + 2 * SHM_K) + wid * 64; LAS float* li_l = ws; LAS float* al_l = ws + 32;
    float m_reg = -1e30f, l_reg = 0; f32x16 o[NCB]; bf16x8 qr[4];
#pragma unroll
    for (int d = 0; d < NCB; ++d) o[d] = f32x16{};
    const bf16_t* Qw = U.Q + (size_t)(wid * QBLK + r32) * U.ldq + hi * 8;
#pragma unroll
    for (int d0 = 0; d0 < 4; ++d0) qr[d0] = *(const bf16x8*)(Qw + d0 * 16);
    const int kr = tid >> 3, kc = (tid & 7) * 8;
    const int sr = tid >> 4, sc = (tid & 15) * 8;
    const int kst = KSWZ(kr, kc * 2);
    const int vst0 = (DV == 128) ? v_st<NCB>(sr, sc) : v_st<NCB>(kr, kc), vst1 = (DV == 128) ? v_st<NCB>(32 + sr, sc) : 0;
    const int vb0 = (int)(uintptr_t)V_lds + v_rd_base(lane);
    bf16x8 svA0, svA1, skA, svB0, svB1, skB;
#define TROW(t) ((t) < 4 ? U.ctx_row0 + 64 * (t) : U.lat_row0 + 64 * (U.lat_t0 + (t) - 4))
#define SLOAD(S, t) do { const int k0_ = TROW(t); \
        if constexpr (DV == 128) { sv##S##0 = *(const bf16x8*)(U.V + (size_t)(k0_ + sr) * U.ldv + sc); sv##S##1 = *(const bf16x8*)(U.V + (size_t)(k0_ + 32 + sr) * U.ldv + sc); } \
        else { sv##S##0 = *(const bf16x8*)(U.V + (size_t)(k0_ + kr) * U.ldv + kc); } \
        sk##S = *(const bf16x8*)(U.K + (size_t)(k0_ + kr) * U.ldk + kc); } while (0)
#define SWRITE(b, S) do { *(LAS bf16x8*)(V_lds + (b) * SHM_V + vst0) = sv##S##0; if constexpr (DV == 128) *(LAS bf16x8*)(V_lds + (b) * SHM_V + vst1) = sv##S##1; \
        *(LAS bf16x8*)(K_lds + (b) * SHM_K + kst) = sk##S; } while (0)
#define SWAIT() do { if constexpr (NLD == 3) asm volatile("s_waitcnt vmcnt(3)" ::: "memory"); else asm volatile("s_waitcnt vmcnt(2)" ::: "memory"); } while (0)
#define RESC(a) do { if (__any((a) < 1.f)) { if (hi == 0) al_l[r32] = (a); asm volatile("s_waitcnt lgkmcnt(0)" ::: "memory"); \
        _Pragma("unroll") for (int d = 0; d < NCB; ++d) _Pragma("unroll") for (int r = 0; r < 16; ++r) o[d][r] *= al_l[crow(r, hi)]; } } while (0)
#define MASK(P0, P1, t) do { if constexpr (SWA) { if ((t) >= 4) { const int kb_ = 64 * (U.lat_t0 + (t) - 4) - (U.q0 + wid * QBLK + r32) + 4 * hi; \
        _Pragma("unroll") for (int r = 0; r < 16; ++r) { const int d0_ = kb_ + (r & 3) + 8 * (r >> 2); \
            if (d0_ > 128 || d0_ < -128) P0[r] = -1e30f; if (d0_ + 32 > 128 || d0_ + 32 < -128) P1[r] = -1e30f; } } } } while (0)
    f32x16 pA0, pA1, pB0, pB1; float mnA, mnB, alA, alB; bf16x8 pa0, pa1, pa2, pa3; const int NT = U.NT;
    SLOAD(A, 0); asm volatile("s_waitcnt vmcnt(0)" ::: "memory"); SWRITE(0, A); __syncthreads();
    qkt(pA0, pA1, K_lds, qr, r32, hi); MASK(pA0, pA1, 0); partialSM(pA0, pA1, m_reg, mnA, alA);
    SLOAD(B, 1); if (2 < NT) SLOAD(A, 2);
    SWAIT(); SWRITE(1, B); __syncthreads();
    for (int j = 1; j + 1 < NT; j += 2) {
        SBAR(); qkt(pB0, pB1, K_lds + SHM_K, qr, r32, hi); MASK(pB0, pB1, j);
        finishSM(pA0, pA1, alA, l_reg, pa0, pa1, pa2, pa3); SBAR();
        SLOAD(B, j + 2); SBAR();
        pv_all<NCB>(o, vb0, pa0, pa1, pa2, pa3); partialSM(pB0, pB1, m_reg, mnB, alB);
        __syncthreads(); SWAIT(); SWRITE(0, A);
        RESC(alB); __syncthreads();
        SBAR(); qkt(pA0, pA1, K_lds, qr, r32, hi); MASK(pA0, pA1, j + 1);
        finishSM(pB0, pB1, alB, l_reg, pa0, pa1, pa2, pa3); SBAR();
        if (j + 3 < NT) SLOAD(A, j + 3); SBAR();
        pv_all<NCB>(o, vb0 + SHM_V, pa0, pa1, pa2, pa3); partialSM(pA0, pA1, m_reg, mnA, alA);
        __syncthreads(); SWAIT(); SWRITE(1, B);
        RESC(alA); __syncthreads();
    }
    SBAR(); qkt(pB0, pB1, K_lds + SHM_K, qr, r32, hi); MASK(pB0, pB1, NT - 1);
    finishSM(pA0, pA1, alA, l_reg, pa0, pa1, pa2, pa3); SBAR();
    pv_all<NCB>(o, vb0, pa0, pa1, pa2, pa3); partialSM(pB0, pB1, m_reg, mnB, alB);
    __syncthreads(); RESC(alB);
    finishSM(pB0, pB1, alB, l_reg, pa0, pa1, pa2, pa3); SBAR();
    pv_all<NCB>(o, vb0 + SHM_V, pa0, pa1, pa2, pa3);
    if constexpr (SWA) l_reg += __builtin_amdgcn_exp2f(U.sinkl2 - m_reg * (SCALE * LOG2E));
    if (hi == 0) li_l[r32] = l_reg; asm volatile("s_waitcnt lgkmcnt(0)" ::: "memory");
    float rli[16];
#pragma unroll
    for (int r = 0; r < 16; ++r) rli[r] = __builtin_amdgcn_rcpf(li_l[crow(r, hi)]);
    bf16_t* Ow = U.O + (size_t)(wid * QBLK) * U.ldo;
#pragma unroll
    for (int r = 0; r < 16; ++r) { const int orow = crow(r, hi);
#pragma unroll
        for (int d0 = 0; d0 < NCB; ++d0) Ow[(size_t)orow * U.ldo + d0 * 32 + r32] = (bf16_t)f2bf(o[d0][r] * rli[r]); }
    __syncthreads();
#undef TROW
#undef SLOAD
#undef SWRITE
#undef SWAIT
#undef RESC
#undef MASK
}
#undef SBAR
#undef KSWZ
}

struct Args { const float* in[32]; float* out; unsigned char* ws; int ph_lo, ph_hi; };
struct ArgsD { const GAS float* in[32]; GAS float* out; GAS unsigned char* ws; int ph_lo, ph_hi; };
typedef const __attribute__((address_space(4))) ArgsD* ArgsP;
#define APIN(i) ((const float*)ap->in[i])
#define APOUT ((float*)ap->out)

struct Frame {
    LAS unsigned char* lds;
    int tid, lane, wave, vcu, G, gw, NGW;
    unsigned char* ws;
};

__device__ __forceinline__ int rope_src(int p) { return 16 * ((p >> 2) & 1) + 4 * (p >> 3) + (p & 3); }
__device__ __forceinline__ void transpose_item(const float* W, int N, bf16_t* WT, int src0, int dst_row0, int k0, bool perm, LAS float* scr, int lane) {
#pragma unroll 8
    for (int i = 0; i < 32; ++i) { const int kk = 2 * i + (lane >> 5); scr[kk * 33 + (lane & 31)] = W[(size_t)(k0 + kk) * N + src0 + (lane & 31)]; }
    LDS_WAIT(); asm volatile("" ::: "memory");
    const int c = lane & 7;
#pragma unroll
    for (int j = 0; j < 4; ++j) { const int n = (lane >> 3) + 8 * j; const int sn = perm ? rope_src(n) : n; const LAS float* s = scr + (8 * c) * 33 + sn;
        u32x4 o; o.x = pk2(s[0 * 33], s[1 * 33]); o.y = pk2(s[2 * 33], s[3 * 33]); o.z = pk2(s[4 * 33], s[5 * 33]); o.w = pk2(s[6 * 33], s[7 * 33]);
        *(u32x4*)(WT + (size_t)(dst_row0 + n) * DM + k0 + 8 * c) = o; }
    LDS_WAIT(); asm volatile("" ::: "memory");
}
__device__ __forceinline__ float silu_f(float v) { return v / (1.f + __expf(-v)); }

__device__ __forceinline__ void p0_prologue(Frame& F, ArgsP ap) {
    LAS float* scr = (LAS float*)(F.lds + F.wave * 16384);
    unsigned char* ws = F.ws;
    if (F.gw < 16) { const int pos = F.gw * 4 + (F.lane >> 4), f = F.lane & 15;
        const float inv = __builtin_amdgcn_exp2f(-(float)f * (13.287712379549449f / 16.f));
        const float ang = (float)pos * inv, rev = ang * 0.15915494309189535f;
        float* rp = (float*)(ws + WS_ROPE);
        rp[pos * 16 + f] = __builtin_amdgcn_cosf(rev); rp[1024 + pos * 16 + f] = __builtin_amdgcn_sinf(rev); }
    for (int it = F.gw; it < 2 * 16 * 24; it += F.NGW) {
        const int layer = it / 384, r = it % 384, kc = r / 24, nb = r % 24;
        const float* W = APIN(layer ? 20 : 4); const float* bias = APIN(layer ? 21 : 5);
        const int k0 = kc * 64, n0 = nb * 256 + 4 * F.lane;
        float sv[9];
#pragma unroll
        for (int b = 0; b < 8; ++b) sv[b] = silu_f(APIN(1)[b * DM + k0 + F.lane]);
        sv[8] = silu_f(APIN(3)[k0 + F.lane]);
        f32x4 acc[9];
#pragma unroll
        for (int b = 0; b < 9; ++b) acc[b] = (f32x4){0.f, 0.f, 0.f, 0.f};
        if (kc == 0) { const f32x4 bv = *(const f32x4*)(bias + n0);
#pragma unroll
            for (int b = 0; b < 9; ++b) acc[b] = bv; }
#pragma unroll 4
        for (int kk = 0; kk < 64; ++kk) { const f32x4 w = *(const f32x4*)(W + (size_t)(k0 + kk) * 6144 + n0);
#pragma unroll
            for (int b = 0; b < 9; ++b) { const float s = __builtin_bit_cast(float, __builtin_amdgcn_readlane(__builtin_bit_cast(int, sv[b]), kk)); acc[b] += w * s; } }
        float* mod = (float*)(ws + WS_MOD) + (size_t)layer * 9 * 6144;
#pragma unroll
        for (int b = 0; b < 9; ++b)
#pragma unroll
            for (int j = 0; j < 4; ++j) atomicAdd(mod + b * 6144 + n0 + j, acc[b][j]);
    }
    constexpr int I_IN = 96 * 16, I_O = 32 * 16, I_GU = 16 * 64 * 16, I_D = 16 * 32 * 16, I_QKV = 48 * 16;
    constexpr int NITEMS = I_IN + I_O + I_GU + I_D + I_QKV + I_O + I_GU + I_D;
    for (int it = F.gw; it < NITEMS; it += F.NGW) {
        int r = it;
        if (r < I_IN) { const int g = r / 16, kb = r % 16, r0 = 32 * g; int src0; bool perm = false;
            if (r0 < 512) src0 = r0;
            else if (r0 < 1536) { const int u = (r0 - 512) / 256, w = (r0 - 512) % 256; src0 = w < 128 ? 512 + u * 128 + w : 1024 + u * 128 + (w - 128); }
            else if (r0 < 2560) { src0 = r0; perm = true; }
            else src0 = r0;
            transpose_item(APIN(7), NWIN, (bf16_t*)(ws + W_IN), src0, r0, kb * 64, perm, scr, F.lane); continue; }
        r -= I_IN;
        if (r < I_O) { const int g = r / 16, kb = r % 16; transpose_item(APIN(14), DM, (bf16_t*)(ws + W_OUT0), 32 * g, 32 * g, kb * 64, false, scr, F.lane); continue; }
        r -= I_O;
        if (r < I_GU) { const int e = r / 1024, g = (r % 1024) / 16, kb = r % 16, r0 = 32 * g, u = r0 / 256, w = r0 % 256;
            const float* src = (w < 128 ? APIN(17) : APIN(18)) + (size_t)e * DM * FF;
            transpose_item(src, FF, (bf16_t*)(ws + W_GU0) + (size_t)e * 2 * FF * DM, u * 128 + (w & 127), r0, kb * 64, false, scr, F.lane); continue; }
        r -= I_GU;
        if (r < I_D) { const int e = r / 512, g = (r % 512) / 16, kb = r % 16;
            transpose_item(APIN(19) + (size_t)e * FF * DM, DM, (bf16_t*)(ws + W_D0) + (size_t)e * DM * FF, 32 * g, 32 * g, kb * 64, false, scr, F.lane); continue; }
        r -= I_D;
        if (r < I_QKV) { const int g = r / 16, kb = r % 16, r0 = 32 * g;
            transpose_item(APIN(23), NQKV1, (bf16_t*)(ws + W_QKV), r0, r0, kb * 64, r0 < 1280, scr, F.lane); continue; }
        r -= I_QKV;
        if (r < I_O) { const int g = r / 16, kb = r % 16; transpose_item(APIN(25), DM, (bf16_t*)(ws + W_OUT1), 32 * g, 32 * g, kb * 64, false, scr, F.lane); continue; }
        r -= I_O;
        if (r < I_GU) { const int e = r / 1024, g = (r % 1024) / 16, kb = r % 16, r0 = 32 * g, u = r0 / 256, w = r0 % 256;
            const float* src = (w < 128 ? APIN(28) : APIN(29)) + (size_t)e * DM * FF;
            transpose_item(src, FF, (bf16_t*)(ws + W_GU1) + (size_t)e * 2 * FF * DM, u * 128 + (w & 127), r0, kb * 64, false, scr, F.lane); continue; }
        r -= I_GU;
        { const int e = r / 512, g = (r % 512) / 16, kb = r % 16;
            transpose_item(APIN(30) + (size_t)e * FF * DM, DM, (bf16_t*)(ws + W_D1) + (size_t)e * DM * FF, 32 * g, 32 * g, kb * 64, false, scr, F.lane); }
    }
}

__device__ __forceinline__ void load_row(const float* p, int lane, f32x4 (&v)[4]) {
    const f32x4* r = (const f32x4*)p + lane;
#pragma unroll
    for (int j = 0; j < 4; ++j) v[j] = r[64 * j];
}
__device__ __forceinline__ void modulate_row(f32x4 (&v)[4], const float* gain, const float* shift, const float* scale, int lane, bf16_t* orow) {
    float s = 0.f;
#pragma unroll
    for (int j = 0; j < 4; ++j) s += (v[j].x * v[j].x + v[j].y * v[j].y) + (v[j].z * v[j].z + v[j].w * v[j].w);
    const float rs = 1.f / sqrtf(wave_sum(s) * (1.f / DM) + NORM_EPS);
    u32x2* o8 = (u32x2*)orow + lane;
#pragma unroll
    for (int j = 0; j < 4; ++j) { const f32x4 g = ((const f32x4*)gain)[lane + 64 * j], sh = ((const f32x4*)shift)[lane + 64 * j], sc = ((const f32x4*)scale)[lane + 64 * j];
        v[j] = (v[j] * rs) * g * (sc + 1.0f) + sh;
        u32x2 w; w.x = pk2(v[j].x, v[j].y); w.y = pk2(v[j].z, v[j].w); o8[64 * j] = w; }
}
__device__ __forceinline__ void norm1_phase(Frame& F, const float* xlat, const float* xctx, const float* gain, const float* mod) {
    bf16_t* XN = (bf16_t*)(F.ws + A_XN);
    for (int r = F.gw; r < MALL; r += F.NGW) {
        const bool lat = r < NLAT; const int b = lat ? (r >> 12) : 8;
        const float* xr = lat ? xlat + (size_t)r * DM : xctx + (size_t)(r - NLAT) * DM;
        f32x4 v[4]; load_row(xr, F.lane, v);
        modulate_row(v, gain, mod + (size_t)b * 6144, mod + (size_t)b * 6144 + 1024, F.lane, XN + (size_t)r * DM);
    }
}
__device__ __forceinline__ void load_router(Frame& F, const float* Wr) {
    LAS float* Wt = (LAS float*)F.lds;
    for (int i = F.tid; i < DM * 4; i += NTHREADS) { const int k = i >> 2, e4 = (i & 3) * 4; const f32x4 w = *(const f32x4*)(Wr + k * 16 + e4);
        Wt[(e4 + 0) * DM + k] = w.x; Wt[(e4 + 1) * DM + k] = w.y; Wt[(e4 + 2) * DM + k] = w.z; Wt[(e4 + 3) * DM + k] = w.w; }
    __syncthreads();
}
__device__ __forceinline__ void norm2_router_phase(Frame& F, const float* xlat, const float* xctx, int nrows, const float* gain, const float* mod, const float* Wr) {
    load_router(F, Wr);
    const LAS float* Wt = (const LAS float*)F.lds;
    bf16_t* XN = (bf16_t*)(F.ws + A_XN); float* AFF = (float*)(F.ws + WS_AFF);
    for (int r = F.gw; r < nrows; r += F.NGW) {
        const bool lat = r < NLAT; const int b = lat ? (r >> 12) : 8;
        const float* xr = lat ? xlat + (size_t)r * DM : xctx + (size_t)(r - NLAT) * DM;
        f32x4 v[4]; load_row(xr, F.lane, v);
        modulate_row(v, gain, mod + (size_t)b * 6144 + 3 * 1024, mod + (size_t)b * 6144 + 4 * 1024, F.lane, XN + (size_t)r * DM);
        float lg[16];
#pragma unroll
        for (int e = 0; e < 16; ++e) { float s = 0.f;
#pragma unroll
            for (int j = 0; j < 4; ++j) { const f32x4 w = *(const LAS f32x4*)(Wt + e * DM + 4 * F.lane + 256 * j); s += (v[j].x * w.x + v[j].y * w.y) + (v[j].z * w.z + v[j].w * w.w); }
            lg[e] = wave_sum(s); __builtin_amdgcn_sched_barrier(0); }
        float mx = lg[0];
#pragma unroll
        for (int e = 1; e < 16; ++e) mx = fmaxf(mx, lg[e]);
        float den = 0.f;
#pragma unroll
        for (int e = 0; e < 16; ++e) { lg[e] = __expf(lg[e] - mx); den += lg[e]; }
        const float inv = 1.f / den;
        float mine = 0.f;
#pragma unroll
        for (int e = 0; e < 16; ++e) mine = (F.lane == e) ? lg[e] * inv : mine;
        if (F.lane < 16) AFF[(size_t)r * 16 + F.lane] = mine;
    }
    __syncthreads();
}

__device__ __forceinline__ void mix0_combine_phase(Frame& F, ArgsP ap) {
    const bf16_t* BG = (const bf16_t*)(F.ws + A_BG); const bf16_t* CX = (const bf16_t*)(F.ws + A_CX); const bf16_t* OH = (const bf16_t*)(F.ws + A_OH);
    bf16_t* AO = (bf16_t*)(F.ws + A_XN);
    float d1 = APIN(9)[F.lane] * APIN(10)[F.lane], d2 = APIN(11)[F.lane] * APIN(12)[F.lane];
    const float lam = __expf(wave_sum(d1)) - __expf(wave_sum(d2)) + LAM_INIT;
    const int l = F.lane;
    float cw0[8], cw1[8], cw2[8], sg[8];
#pragma unroll
    for (int i = 0; i < 8; ++i) { cw0[i] = APIN(8)[8 * l + i]; cw1[i] = APIN(8)[512 + 8 * l + i]; cw2[i] = APIN(8)[1024 + 8 * l + i]; sg[i] = APIN(13)[(l & 15) * 8 + i] * (1.f - LAM_INIT); }
    for (int r = F.gw; r < MALL; r += F.NGW) {
        const bool lat = r < NLAT; const int t = lat ? (r & (SEQ - 1)) : ((r - NLAT) & (CTX - 1)); const int tl = lat ? SEQ : CTX;
        const u32x4 bgv = *(const u32x4*)(BG + (size_t)r * 512 + 8 * l);
        const u32x4 c1 = *(const u32x4*)(CX + (size_t)r * 512 + 8 * l);
        u32x4 c0 = (u32x4){0u, 0u, 0u, 0u}, c2 = (u32x4){0u, 0u, 0u, 0u};
        if (t > 0) c0 = *(const u32x4*)(CX + (size_t)(r - 1) * 512 + 8 * l);
        if (t < tl - 1) c2 = *(const u32x4*)(CX + (size_t)(r + 1) * 512 + 8 * l);
        u32x4 ow;
#pragma unroll
        for (int i = 0; i < 4; ++i) {
            const float lo = bf_lo(bgv[i]) * (cw0[2 * i] * bf_lo(c0[i]) + cw1[2 * i] * bf_lo(c1[i]) + cw2[2 * i] * bf_lo(c2[i]));
            const float hi = bf_hi(bgv[i]) * (cw0[2 * i + 1] * bf_hi(c0[i]) + cw1[2 * i + 1] * bf_hi(c1[i]) + cw2[2 * i + 1] * bf_hi(c2[i]));
            ow[i] = pk2(lo, hi); }
        *(u32x4*)(AO + (size_t)r * DM + 8 * l) = ow;
        const int h = l >> 4, d0 = (l & 15) * 8;
        const u32x4 o1 = *(const u32x4*)(OH + (size_t)r * DM + (2 * h) * 128 + d0), o2 = *(const u32x4*)(OH + (size_t)r * DM + (2 * h + 1) * 128 + d0);
        float ov[8]; float ss = 0.f;
#pragma unroll
        for (int i = 0; i < 4; ++i) { ov[2 * i] = bf_lo(o1[i]) - lam * bf_lo(o2[i]); ov[2 * i + 1] = bf_hi(o1[i]) - lam * bf_hi(o2[i]); ss += ov[2 * i] * ov[2 * i] + ov[2 * i + 1] * ov[2 * i + 1]; }
        ss += __shfl_xor(ss, 1); ss += __shfl_xor(ss, 2); ss += __shfl_xor(ss, 4); ss += __shfl_xor(ss, 8);
        const float rs = 1.f / sqrtf(ss * (1.f / 128.f) + NORM_EPS);
        u32x4 ow2;
#pragma unroll
        for (int i = 0; i < 4; ++i) ow2[i] = pk2(ov[2 * i] * rs * sg[2 * i], ov[2 * i + 1] * rs * sg[2 * i + 1]);
        *(u32x4*)(AO + (size_t)r * DM + 512 + h * 128 + d0) = ow2;
    }
}

__device__ __forceinline__ unsigned block_excl_scan(unsigned v, LAS unsigned* sc, int tid, unsigned& total) {
    unsigned x = v;
#pragma unroll
    for (int o = 1; o < 64; o <<= 1) { const unsigned y = __shfl_up(x, o); if ((tid & 63) >= o) x += y; }
    if ((tid & 63) == 63) sc[tid >> 6] = x;
    __syncthreads();
    unsigned base = 0, tot = 0;
#pragma unroll
    for (int w = 0; w < 8; ++w) { const unsigned s = sc[w]; if (w < (tid >> 6)) base += s; tot += s; }
    __syncthreads();
    total = tot;
    return base + x - v;
}
__device__ __forceinline__ void topk_list(Frame& F, int row0, int n, int e, int cap, int slot_row0) {
    LAS unsigned* keys = (LAS unsigned*)F.lds;
    LAS unsigned* hist = keys + 4096;
    LAS unsigned* sc = hist + 256;
    LAS unsigned* bc = sc + 16;
    const float* AFF = (const float*)(F.ws + WS_AFF); int* POS = (int*)(F.ws + WS_POS); int* IDX = (int*)(F.ws + WS_IDX);
    const int tid = F.tid;
    for (int i = tid; i < n; i += NTHREADS) keys[i] = __builtin_bit_cast(unsigned, AFF[(size_t)(row0 + i) * 16 + e]);
    __syncthreads();
    unsigned prefix = 0, mask = 0; unsigned krem = (unsigned)cap;
    for (int pass = 0; pass < 4; ++pass) {
        const int shift = 24 - 8 * pass;
        for (int i = tid; i < 256; i += NTHREADS) hist[i] = 0;
        __syncthreads();
        for (int i = tid; i < n; i += NTHREADS) { const unsigned k = keys[i]; if ((k & mask) == prefix) atomicAdd((unsigned*)&hist[(k >> shift) & 255u], 1u); }
        __syncthreads();
        if (tid < 64) {
            unsigned c[4]; unsigned s = 0;
#pragma unroll
            for (int q = 0; q < 4; ++q) { c[q] = hist[255 - (tid * 4 + q)]; s += c[q]; }
            unsigned inc = s;
#pragma unroll
            for (int o = 1; o < 64; o <<= 1) { const unsigned y = __shfl_up(inc, o); if (tid >= o) inc += y; }
            const unsigned exc = inc - s;
            if (exc < krem && inc >= krem) { unsigned run = exc; int bin = -1; unsigned above = 0;
#pragma unroll
                for (int q = 0; q < 4; ++q) { if (bin < 0 && run + c[q] >= krem) { bin = 255 - (tid * 4 + q); above = run; } run += c[q]; }
                bc[0] = prefix | ((unsigned)bin << shift); bc[1] = krem - above; }
        }
        __syncthreads();
        prefix = bc[0]; krem = bc[1]; mask |= 0xffu << shift;
        __syncthreads();
    }
    const int per = 8; const int base = tid * per; const bool act = base < n;
    unsigned kk[8]; unsigned neq = 0;
#pragma unroll
    for (int i = 0; i < per; ++i) { kk[i] = act ? keys[base + i] : 0u; neq += (act && kk[i] == prefix) ? 1u : 0u; }
    unsigned tot; const unsigned eq_before = block_excl_scan(neq, sc, tid, tot);
    unsigned nsel = 0; unsigned selm = 0; unsigned eqc = eq_before;
#pragma unroll
    for (int i = 0; i < per; ++i) { bool s = false; if (act) { if (kk[i] > prefix) s = true; else if (kk[i] == prefix) { s = eqc < krem; ++eqc; } } if (s) { selm |= 1u << i; ++nsel; } }
    const unsigned sel_before = block_excl_scan(nsel, sc, tid, tot);
    unsigned slot = sel_before;
    if (act) {
#pragma unroll
        for (int i = 0; i < per; ++i) { const int row = row0 + base + i;
            if (selm & (1u << i)) { IDX[e * EROWS0 + slot_row0 + slot] = row; POS[(size_t)row * 16 + e] = slot_row0 + (int)slot; ++slot; }
            else POS[(size_t)row * 16 + e] = -1; }
    }
    __syncthreads();
}
__device__ __forceinline__ void topk_phase(Frame& F, bool with_ctx) {
    const int nl = with_ctx ? 256 : 128;
    for (int lid = F.vcu; lid < nl; lid += F.G) {
        if (lid < 128) { const int b = lid >> 4, e = lid & 15; topk_list(F, b * SEQ, SEQ, e, CAP_L, b * CAP_L); }
        else { const int b = (lid - 128) >> 4, e = lid & 15; topk_list(F, NLAT + b * CTX, CTX, e, CAP_C, NB * CAP_L + b * CAP_C); }
    }
}
__device__ __forceinline__ void gather_phase(Frame& F, int erows) {
    const int* IDX = (const int*)(F.ws + WS_IDX); const bf16_t* XN = (const bf16_t*)(F.ws + A_XN); bf16_t* HS = (bf16_t*)(F.ws + A_HS);
    const int total = NE * erows;
    for (int i = F.gw; i < total; i += F.NGW) {
        const int e = i / erows, s = i % erows;
        const int src = __hip_atomic_load(IDX + e * EROWS0 + s, RLX_AGENT);
        const u32x4* sp = (const u32x4*)(XN + (size_t)src * DM) + F.lane; u32x4* dp = (u32x4*)(HS + ((size_t)e * erows + s) * DM) + F.lane;
        const u32x4 v0 = sp[0], v1 = sp[64];
        dp[0] = v0; dp[64] = v1;
    }
}
__device__ __forceinline__ void moe_combine_phase(Frame& F, float* xlat, float* xctx, int nrows, int erows, const float* mod_cur, bool final_norm,
                                                  const float* gain_next, const float* mod_next, float* outp) {
    const float* AFF = (const float*)(F.ws + WS_AFF); const int* POS = (const int*)(F.ws + WS_POS); const bf16_t* Y = (const bf16_t*)(F.ws + A_HS);
    bf16_t* XN = (bf16_t*)(F.ws + A_XN);
    for (int r = F.gw; r < nrows; r += F.NGW) {
        const bool lat = r < NLAT; const int b = lat ? (r >> 12) : 8;
        float* xr = lat ? xlat + (size_t)r * DM : xctx + (size_t)(r - NLAT) * DM;
        f32x4 v[4]; load_row(xr, F.lane, v);
        int pos = -1; float af = 0.f;
        if (F.lane < 16) { pos = POS[(size_t)r * 16 + F.lane]; af = AFF[(size_t)r * 16 + F.lane]; }
        f32x4 acc[4];
#pragma unroll
        for (int j = 0; j < 4; ++j) acc[j] = (f32x4){0.f, 0.f, 0.f, 0.f};
        unsigned long long m = __ballot(pos >= 0);
        while (m) { const int e = __builtin_ctzll(m); m &= m - 1;
            const int p = __builtin_amdgcn_readlane(pos, e); const float w = __builtin_bit_cast(float, __builtin_amdgcn_readlane(__builtin_bit_cast(int, af), e));
            const u32x2* yp = (const u32x2*)(Y + ((size_t)e * erows + p) * DM) + F.lane;
#pragma unroll
            for (int j = 0; j < 4; ++j) { const u32x2 y = yp[64 * j]; acc[j].x += w * bf_lo(y.x); acc[j].y += w * bf_hi(y.x); acc[j].z += w * bf_lo(y.y); acc[j].w += w * bf_hi(y.y); } }
        const float* g2 = mod_cur + (size_t)b * 6144 + 5 * 1024;
#pragma unroll
        for (int j = 0; j < 4; ++j) { const f32x4 g = ((const f32x4*)g2)[F.lane + 64 * j]; v[j] = v[j] + g * acc[j]; }
        if (!final_norm) {
            f32x4* xo = (f32x4*)xr + F.lane;
#pragma unroll
            for (int j = 0; j < 4; ++j) xo[64 * j] = v[j];
            modulate_row(v, gain_next, mod_next + (size_t)b * 6144, mod_next + (size_t)b * 6144 + 1024, F.lane, XN + (size_t)r * DM);
        } else {
            float s = 0.f;
#pragma unroll
            for (int j = 0; j < 4; ++j) s += (v[j].x * v[j].x + v[j].y * v[j].y) + (v[j].z * v[j].z + v[j].w * v[j].w);
            const float rs = 1.f / sqrtf(wave_sum(s) * (1.f / DM) + NORM_EPS);
            f32x4* xo = (f32x4*)(outp + (size_t)r * DM) + F.lane;
#pragma unroll
            for (int j = 0; j < 4; ++j) { const f32x4 g = ((const f32x4*)gain_next)[F.lane + 64 * j]; xo[64 * j] = (v[j] * rs) * g; }
        }
    }
}

__device__ __forceinline__ void attn0_phase(Frame& F) {
    const bf16_t* Q0 = (const bf16_t*)(F.ws + A_Q0); const bf16_t* K0 = (const bf16_t*)(F.ws + A_K0); const bf16_t* V0 = (const bf16_t*)(F.ws + A_V0);
    bf16_t* OH = (bf16_t*)(F.ws + A_OH);
    const int per = (1024 + F.G - 1) / F.G;
    for (int i = 0; i <= per; ++i) {
        att::UnitDesc U; int b, sh, qrow0;
        if (i < per) { const int u = F.vcu * per + i; if (u >= 1024) continue; b = u >> 7; sh = (u & 127) >> 4; const int qb = u & 15; qrow0 = b * SEQ + qb * 256; U.NT = 68; }
        else { const int cu = F.vcu; if (cu >= 64) continue; b = cu >> 3; sh = cu & 7; qrow0 = NLAT + b * CTX; U.NT = 4; }
        U.Q = Q0 + (size_t)qrow0 * 512 + sh * 64; U.ldq = 512;
        U.K = K0 + sh * 64; U.V = V0 + (sh >> 1) * 128; U.ldk = 512; U.ldv = 512;
        U.O = OH + (size_t)qrow0 * DM + sh * 128; U.ldo = DM;
        U.ctx_row0 = NLAT + b * CTX; U.lat_row0 = b * SEQ; U.lat_t0 = 0; U.q0 = 0; U.sinkl2 = 0.f;
        att::attn_unit<128, false>(U, (LAS char*)F.lds, F.tid);
    }
}
__device__ __forceinline__ void attn1_phase(Frame& F, const float* sink) {
    const bf16_t* Q1 = (const bf16_t*)(F.ws + A_Q1); const bf16_t* K1 = (const bf16_t*)(F.ws + A_K1); const bf16_t* V1 = (const bf16_t*)(F.ws + A_V1);
    bf16_t* AO = (bf16_t*)(F.ws + A_XN);
    const int per = (2048 + F.G - 1) / F.G;
    for (int i = 0; i < per; ++i) {
        const int u = F.vcu * per + i; if (u >= 2048) continue;
        const int b = u >> 8, head = (u & 255) >> 4, qb = u & 15, q0 = qb * 256, qrow0 = b * SEQ + q0;
        att::UnitDesc U;
        U.Q = Q1 + (size_t)qrow0 * DM + head * 64; U.ldq = DM;
        U.K = K1 + (head >> 2) * 64; U.V = V1 + (head >> 2) * 64; U.ldk = 256; U.ldv = 256;
        U.O = AO + (size_t)qrow0 * DM + head * 64; U.ldo = DM;
        const int lo = q0 - 128 < 0 ? 0 : q0 - 128, hi = q0 + 384 > SEQ ? SEQ : q0 + 384;
        U.ctx_row0 = NLAT + b * CTX; U.lat_row0 = b * SEQ; U.lat_t0 = lo >> 6; U.NT = 4 + ((hi - lo) >> 6);
        U.q0 = q0; U.sinkl2 = sink[head] * att::LOG2E;
        att::attn_unit<64, true>(U, (LAS char*)F.lds, F.tid);
    }
}

constexpr int N_PHASES = 21;
#ifndef PH_EN
#define PH_EN(p) 1
#endif
#ifndef GEMM_EN
#define GEMM_EN 1
#endif
__global__ void __launch_bounds__(NTHREADS, 2) fwd_kernel(Args args) {
    extern __shared__ __attribute__((aligned(16))) unsigned char lds_raw[];
    Frame F;
    F.lds = (LAS unsigned char*)lds_raw;
    F.tid = threadIdx.x; F.lane = F.tid & 63; F.wave = __builtin_amdgcn_readfirstlane(F.tid >> 6);
    F.G = gridDim.x; { const int bx = blockIdx.x; F.vcu = (F.G % 8 == 0) ? (bx % 8) * (F.G / 8) + bx / 8 : bx; }
    F.gw = F.vcu * NWAVES + F.wave; F.NGW = F.G * NWAVES;
    F.ws = args.ws;
    unsigned char* ws = args.ws;
    volatile LAS unsigned* MISC = (volatile LAS unsigned*)(F.lds + MISC_OFF);
    for (int u = F.tid; u < (LDS_BYTES - RING_BYTES) / 4; u += NTHREADS) ((LAS unsigned*)(F.lds + RING_BYTES))[u] = 0u;
    __syncthreads();
    const int lo = args.ph_lo, hi = args.ph_hi;
    XcdBarrier bar; bar.bar = (unsigned*)(ws + WS_CTL) + CW_BAR; bar.x = 0; bar.st = nullptr;
    if (hi - lo > 1) bar = xcd_barrier_post((unsigned*)(ws + WS_CTL) + CW_BAR, MISC + 8);

    const Frame F0 = F;
    for (int ph = lo; ph < hi; ++ph) {
        F = F0; asm volatile("" : "+v"(F.tid), "+v"(F.lane), "+s"(F.wave), "+s"(F.vcu), "+s"(F.gw));
        ArgsP ap = (ArgsP)__builtin_amdgcn_kernarg_segment_ptr(); asm volatile("" : "+s"(ap));
        { GAS unsigned char* wsg = ap->ws; asm volatile("" : "+s"(wsg)); F.ws = (unsigned char*)wsg; }
        ws = F.ws;
        const float* MOD0 = (const float*)(ws + WS_MOD); const float* MOD1 = MOD0 + 9 * 6144;
        float* XCTX = (float*)(ws + WS_XCTX);
        bool is_gemm = false; bool perm = true; pg8::Sched S; pg8::Epi E;
        S.G = F.G; S.c = (int)blockIdx.x; S.tpe = 1 << 20; S.A = nullptr; S.B = nullptr; S.nM = 0; S.nN = 0;
        E.kind = 0; E.layer = 0; E.ws = ws; E.xin_lat = nullptr; E.xin_ctx = nullptr; E.out_lat = nullptr;
        switch (ph) {
        case 0: if (!PH_EN(0)) break; p0_prologue(F, ap); break;
        case 1: if (!PH_EN(1)) break; norm1_phase(F, APIN(0), APIN(2), APIN(6), MOD0); break;
        case 2: if (!PH_EN(2)) break; is_gemm = true; S.A = (const char*)(ws + A_XN); S.B = (const char*)(ws + W_IN); S.nM = MALL / 256; S.nN = NWIN / 256; E.kind = pg8::EK_IN0; break;
        case 3: if (!PH_EN(3)) break; attn0_phase(F); break;
        case 4: if (!PH_EN(4)) break; mix0_combine_phase(F, ap); break;
        case 5: if (!PH_EN(5)) break; is_gemm = true; perm = false; S.A = (const char*)(ws + A_XN); S.B = (const char*)(ws + W_OUT0); S.nM = MALL / 256; S.nN = DM / 256;
                E.kind = pg8::EK_OUT; E.layer = 0; E.xin_lat = APIN(0); E.xin_ctx = APIN(2); E.out_lat = APOUT; break;
        case 6: if (!PH_EN(6)) break; norm2_router_phase(F, APOUT, XCTX, MALL, APIN(15), MOD0, APIN(16)); break;
        case 7: if (!PH_EN(7)) break; topk_phase(F, true); break;
        case 8: if (!PH_EN(8)) break; gather_phase(F, EROWS0); break;
        case 9: if (!PH_EN(9)) break; is_gemm = true; S.A = (const char*)(ws + A_HS); S.B = (const char*)(ws + W_GU0); S.nM = NE * EROWS0 / 256; S.nN = 2 * FF / 256; S.tpe = EROWS0 / 256; E.kind = pg8::EK_GU; break;
        case 10: if (!PH_EN(10)) break; is_gemm = true; S.A = (const char*)(ws + A_ACT); S.B = (const char*)(ws + W_D0); S.nM = NE * EROWS0 / 256; S.nN = DM / 256; S.tpe = EROWS0 / 256; E.kind = pg8::EK_DOWN; break;
        case 11: if (!PH_EN(11)) break; moe_combine_phase(F, APOUT, XCTX, MALL, EROWS0, MOD0, false, APIN(22), MOD1, nullptr); break;
        case 12: if (!PH_EN(12)) break; is_gemm = true; S.A = (const char*)(ws + A_XN); S.B = (const char*)(ws + W_QKV); S.nM = MALL / 256; S.nN = NQKV1 / 256; E.kind = pg8::EK_QKV1; break;
        case 13: if (!PH_EN(13)) break; attn1_phase(F, APIN(24)); break;
        case 14: if (!PH_EN(14)) break; is_gemm = true; perm = false; S.A = (const char*)(ws + A_XN); S.B = (const char*)(ws + W_OUT1); S.nM = NLAT / 256; S.nN = DM / 256;
                E.kind = pg8::EK_OUT; E.layer = 1; E.xin_lat = APOUT; E.xin_ctx = XCTX; E.out_lat = APOUT; break;
        case 15: if (!PH_EN(15)) break; norm2_router_phase(F, APOUT, XCTX, NLAT, APIN(26), MOD1, APIN(27)); break;
        case 16: if (!PH_EN(16)) break; topk_phase(F, false); break;
        case 17: if (!PH_EN(17)) break; gather_phase(F, EROWS1); break;
        case 18: if (!PH_EN(18)) break; is_gemm = true; S.A = (const char*)(ws + A_HS); S.B = (const char*)(ws + W_GU1); S.nM = NE * EROWS1 / 256; S.nN = 2 * FF / 256; S.tpe = EROWS1 / 256; E.kind = pg8::EK_GU; break;
        case 19: if (!PH_EN(19)) break; is_gemm = true; S.A = (const char*)(ws + A_ACT); S.B = (const char*)(ws + W_D1); S.nM = NE * EROWS1 / 256; S.nN = DM / 256; S.tpe = EROWS1 / 256; E.kind = pg8::EK_DOWN; break;
        case 20: if (!PH_EN(20)) break; moe_combine_phase(F, APOUT, XCTX, NLAT, EROWS1, MOD1, true, APIN(31), nullptr, APOUT); break;
        default: break;
        }
        if (GEMM_EN && is_gemm) pg8::gemm_phase(F.lds, F.tid, perm, S, E);
        if (ph + 1 < hi) xcd_barrier(bar);
    }
}

extern "C" void kernel_launch(void* const* d_in, const int* in_sizes, int n_in, void* d_out, int out_size, void* d_ws, size_t ws_size, hipStream_t stream) {
    static int grid = 0;
    if (grid == 0) {
        if (n_in != 32 || in_sizes[0] != NLAT * DM || out_size != NLAT * DM || ws_size < WS_END) {
            fprintf(stderr, "kernel_launch: unexpected shapes: n_in %d in0 %d out %d ws %zu (need %zu)\n", n_in, n_in > 0 ? in_sizes[0] : -1, out_size, ws_size, (size_t)WS_END); grid = -1; return; }
        int dev = 0, cus = 0, per_cu = 0;
        if (hipGetDevice(&dev) != hipSuccess || hipDeviceGetAttribute(&cus, hipDeviceAttributeMultiprocessorCount, dev) != hipSuccess) { grid = -1; return; }
        if (hipFuncSetAttribute((const void*)fwd_kernel, hipFuncAttributeMaxDynamicSharedMemorySize, LDS_BYTES) != hipSuccess) { fprintf(stderr, "kernel_launch: hipFuncSetAttribute failed\n"); grid = -1; return; }
        if (hipOccupancyMaxActiveBlocksPerMultiprocessor(&per_cu, (const void*)fwd_kernel, NTHREADS, LDS_BYTES) != hipSuccess || per_cu < 1) {
            fprintf(stderr, "kernel_launch: occupancy query reports %d blocks per CU\n", per_cu); (void)hipGetLastError(); grid = -1; return; }
        grid = cus;
    }
    if (grid < 0) return;
    (void)hipMemsetAsync((char*)d_ws + WS_CTL, 0, CTL_ZERO_BYTES, stream);
    Args a{};
    for (int i = 0; i < 32; ++i) a.in[i] = (const float*)d_in[i];
    a.out = (float*)d_out; a.ws = (unsigned char*)d_ws;
#if MK_N_LAUNCHES == 1
    a.ph_lo = 0; a.ph_hi = N_PHASES;
    hipLaunchKernelGGL(fwd_kernel, dim3(grid), dim3(NTHREADS), LDS_BYTES, stream, a);
#else
    for (int p = 0; p < N_PHASES; ++p) { a.ph_lo = p; a.ph_hi = p + 1; hipLaunchKernelGGL(fwd_kernel, dim3(grid), dim3(NTHREADS), LDS_BYTES, stream, a); }
#endif
}
```

```cpp
#include <hip/hip_runtime.h>
#include <hip/hip_bf16.h>
#include <cstdio>
#include <cstdint>

#ifndef MK_N_LAUNCHES
#define MK_N_LAUNCHES 1
#endif

#ifndef PROBE_ABL
#define PROBE_ABL 0
#endif
#ifndef PROBE_DUP
#define PROBE_DUP 0u
#endif

#define GAS __attribute__((address_space(1)))
#define LAS __attribute__((address_space(3)))
typedef unsigned short bf16_t;
typedef short bf16x8 __attribute__((ext_vector_type(8)));
typedef short s16x4 __attribute__((ext_vector_type(4)));
typedef float f32x2 __attribute__((ext_vector_type(2)));
typedef float f32x4 __attribute__((ext_vector_type(4)));
typedef float f32x16 __attribute__((ext_vector_type(16)));
typedef unsigned u32x2 __attribute__((ext_vector_type(2)));
typedef unsigned u32x4 __attribute__((ext_vector_type(4)));
typedef GAS unsigned gu32;
typedef int v8i32 __attribute__((ext_vector_type(8)));
typedef int v4i32 __attribute__((ext_vector_type(4)));

constexpr int DM = 1024, NB = 8, SEQ = 4096, CTX = 256;
constexpr int NLAT = NB * SEQ;
constexpr int NCTX = NB * CTX;
constexpr int MALL = NLAT + NCTX;
constexpr int NE = 16, FF = 1024;
constexpr int CAP_L = 512, CAP_C = 32;
constexpr int EROWS0 = NB * CAP_L + NB * CAP_C;
constexpr int EROWS1 = NB * CAP_L;
constexpr int NWIN = 3072, NQKV1 = 1536;
constexpr float NORM_EPS = 1e-6f;
constexpr float LAM_INIT = 0.2f;
constexpr int NWAVES = 8, NTHREADS = 512;

constexpr size_t KiB = 1024, MiB = 1024 * 1024;
constexpr size_t WS_CTL = 0, CTL_ZERO_BYTES = 1 * MiB;
constexpr int CW_BAR = 4096;
constexpr size_t WS_MOD = 64 * KiB;
constexpr size_t MOD_BYTES = 2 * 9 * 6144 * 4;
static_assert(WS_MOD + MOD_BYTES <= 640 * KiB, "mod");
constexpr size_t WS_ROPE = 1 * MiB;
constexpr size_t WS_AFF = WS_ROPE + 16 * KiB;
constexpr size_t WS_POS = WS_AFF + (size_t)MALL * 16 * 4;
constexpr size_t WS_IDX = WS_POS + (size_t)MALL * 16 * 4;
constexpr size_t WS_XCTX = WS_IDX + (size_t)NE * EROWS0 * 4 + 4096;
constexpr size_t WS_W = (WS_XCTX + (size_t)NCTX * DM * 4 + 4095) / 4096 * 4096;
constexpr size_t W_IN = WS_W;
constexpr size_t W_OUT0 = W_IN + (size_t)NWIN * DM * 2;
constexpr size_t W_GU0 = W_OUT0 + (size_t)DM * DM * 2;
constexpr size_t W_D0 = W_GU0 + (size_t)NE * 2 * FF * DM * 2;
constexpr size_t W_QKV = W_D0 + (size_t)NE * DM * FF * 2;
constexpr size_t W_OUT1 = W_QKV + (size_t)NQKV1 * DM * 2;
constexpr size_t W_GU1 = W_OUT1 + (size_t)DM * DM * 2;
constexpr size_t W_D1 = W_GU1 + (size_t)NE * 2 * FF * DM * 2;
constexpr size_t WS_ARENA = W_D1 + (size_t)NE * DM * FF * 2;
constexpr size_t SZ_XN = (size_t)MALL * DM * 2;
constexpr size_t SZ_H5 = (size_t)MALL * 512 * 2;
constexpr size_t SZ_E = (size_t)NE * EROWS0 * DM * 2;
constexpr size_t A_XN = WS_ARENA;
constexpr size_t A_BG = A_XN + SZ_XN, A_CX = A_BG + SZ_H5, A_Q0 = A_CX + SZ_H5, A_K0 = A_Q0 + SZ_H5, A_V0 = A_K0 + SZ_H5;
constexpr size_t A_OH = A_V0 + SZ_H5;
constexpr size_t A_HS = A_XN + SZ_XN;
constexpr size_t A_ACT = A_HS + SZ_E;
constexpr size_t A_Q1 = A_XN + SZ_XN;
constexpr size_t A_K1 = A_Q1 + SZ_XN;
constexpr size_t A_V1 = A_K1 + (size_t)MALL * 256 * 2;
constexpr size_t WS_END = A_ACT + SZ_E;
static_assert(A_OH + SZ_XN <= WS_END && A_V1 + (size_t)MALL * 256 * 2 <= WS_END, "arena");
static_assert(WS_END <= 600000000ull, "workspace budget");

constexpr int RING_BYTES = 131072;
constexpr int MISC_OFF = RING_BYTES + 320;
constexpr int GT_OFF = RING_BYTES + 1024;
constexpr int LDS_BYTES = 147456;

#define RLX_AGENT __ATOMIC_RELAXED, __HIP_MEMORY_SCOPE_AGENT
#define LDS_WAIT() asm volatile("s_waitcnt lgkmcnt(0)" ::: "memory")
#define VM_WAIT() asm volatile("s_waitcnt vmcnt(0)" ::: "memory")

__device__ __forceinline__ unsigned f2bf(float f) { unsigned u = __builtin_bit_cast(unsigned, f); return (u + 0x7fffu + ((u >> 16) & 1u)) >> 16; }
__device__ __forceinline__ unsigned pk2(float lo, float hi) { return f2bf(lo) | (f2bf(hi) << 16); }
__device__ __forceinline__ unsigned cvt_pk_bf16(float lo, float hi) { unsigned r; asm volatile("v_cvt_pk_bf16_f32 %0, %1, %2" : "=v"(r) : "v"(lo), "v"(hi)); return r; }
__device__ __forceinline__ unsigned pk4_fp8(float a, float b, float c, float d) {
    a = fminf(fmaxf(a, -448.f), 448.f); b = fminf(fmaxf(b, -448.f), 448.f); c = fminf(fmaxf(c, -448.f), 448.f); d = fminf(fmaxf(d, -448.f), 448.f);
    int w = 0; w = __builtin_amdgcn_cvt_pk_fp8_f32(a, b, w, false); w = __builtin_amdgcn_cvt_pk_fp8_f32(c, d, w, true); return (unsigned)w;
}
__device__ __forceinline__ float bf_lo(unsigned w) { return __builtin_bit_cast(float, w << 16); }
__device__ __forceinline__ float bf_hi(unsigned w) { return __builtin_bit_cast(float, w & 0xffff0000u); }
template <int CTRL> __device__ __forceinline__ float dpp_f(float x) { return __builtin_bit_cast(float, __builtin_amdgcn_mov_dpp(__builtin_bit_cast(int, x), CTRL, 0xf, 0xf, true)); }
__device__ __forceinline__ float row16_sum(float v) { v += dpp_f<0xB1>(v); v += dpp_f<0x4E>(v); v += dpp_f<0x141>(v); v += dpp_f<0x128>(v); return v; }
__device__ __forceinline__ float wave_sum(float v) { v = row16_sum(v); v += __shfl_xor(v, 16); v += __shfl_xor(v, 32); return v; }

#define XB_TMO      128
#define XB_XCNT(j)  (256  + 64 * (j))
#define XB_XSUB(j)  (1280 + 64 * (j))
#define XB_XGEN(j)  (2304 + 64 * (j))
#define XB_TOP      3328
#define XB_TOPGEN   3392
#define XCD_BAR_WORDS 3456
#define XB_SPIN_CAP (1u << 20)
__device__ __forceinline__ unsigned xb_ld(unsigned* p)              { return __hip_atomic_load(p, __ATOMIC_RELAXED, __HIP_MEMORY_SCOPE_AGENT); }
__device__ __forceinline__ unsigned xb_add(unsigned* p, unsigned v) { return __hip_atomic_fetch_add(p, v, __ATOMIC_RELAXED, __HIP_MEMORY_SCOPE_AGENT); }
__device__ __forceinline__ unsigned xb_xcc_id() { return (unsigned)__builtin_amdgcn_s_getreg((3 << 11) | 20) & 0xFu; }
#define XB_SPIN(cond, bar) do { unsigned _sp = 0; while (cond) { __builtin_amdgcn_s_sleep(1); \
    if ((++_sp & 255u) == 0u) { if (xb_ld(&(bar)[XB_TMO])) break; if (_sp > XB_SPIN_CAP) { atomicAdd(&(bar)[XB_TMO], 1u); break; } } } } while (0)
struct XcdBarrier { unsigned* bar; unsigned x; volatile LAS unsigned* st; };
__device__ __forceinline__ XcdBarrier xcd_barrier_post(unsigned* bar, volatile LAS unsigned* st) {
    XcdBarrier b; b.bar = bar; b.x = xb_xcc_id(); b.st = st;
    if (threadIdx.x == 0) (void)xb_add(&bar[XB_XCNT(b.x)], 1u);
    return b;
}
__device__ __forceinline__ void xcd_barrier_complete(unsigned* bar, unsigned x, unsigned& nloc, unsigned& nx) {
    const unsigned G = gridDim.x * gridDim.y * gridDim.z;
    unsigned sum, cnt, mine, sp = 0u;
    for (;;) {
        sum = 0u; cnt = 0u; mine = 0u;
#pragma unroll
        for (unsigned j = 0; j < 16; ++j) { const unsigned c = xb_ld(&bar[XB_XCNT(j)]); sum += c; cnt += (c > 0u) ? 1u : 0u; mine = (j == x) ? c : mine; }
        if (sum == G) break;
        __builtin_amdgcn_s_sleep(1);
        if ((++sp & 255u) == 0u) { if (xb_ld(&bar[XB_TMO])) break; if (sp > XB_SPIN_CAP) { atomicAdd(&bar[XB_TMO], 1u); break; } }
    }
    nloc = mine > 0u ? mine : 1u; nx = cnt > 0u ? cnt : 1u;
}
__device__ __forceinline__ void xcd_barrier(const XcdBarrier& b) {
    asm volatile("s_waitcnt vmcnt(0)" ::: "memory");
    __syncthreads();
    if (threadIdx.x == 0) {
        unsigned* bar = b.bar;
        __builtin_amdgcn_s_waitcnt(0);
        unsigned nloc = b.st[0], nx = b.st[1];
        if (nloc == 0u) { xcd_barrier_complete(bar, b.x, nloc, nx); b.st[0] = nloc; b.st[1] = nx; }
        const unsigned old = xb_add(&bar[XB_XSUB(b.x)], 1u);
        const unsigned gen = old / nloc;
        if (old + 1u == (gen + 1u) * nloc) {
            __builtin_amdgcn_fence(__ATOMIC_RELEASE, "agent");
            asm volatile("s_waitcnt vmcnt(0)" ::: "memory");
            const unsigned og = xb_add(&bar[XB_TOP], 1u);
            const unsigned tg = og / nx;
            if (og + 1u == (tg + 1u) * nx) xb_add(&bar[XB_TOPGEN], 1u);
            else XB_SPIN(xb_ld(&bar[XB_TOPGEN]) == tg, bar);
            __builtin_amdgcn_fence(__ATOMIC_ACQUIRE, "agent");
            xb_add(&bar[XB_XGEN(b.x)], 1u);
            asm volatile("s_waitcnt vmcnt(0)" ::: "memory");
        } else {
            XB_SPIN(xb_ld(&bar[XB_XGEN(b.x)]) == gen, bar);
            __builtin_amdgcn_fence(__ATOMIC_ACQUIRE, "agent");
            asm volatile("s_waitcnt vmcnt(0)" ::: "memory");
        }
    }
    __syncthreads();
}

namespace pg8 {
constexpr int BM = 256, BK = 64, HALF = 128, HTB = HALF * BK * 2, NXCD = 8, WGM = 8;
__device__ __forceinline__ int lds_byte(int r, int c) { const int st = (r >> 4) * 2 + (c >> 5), rr = r & 15, cc = c & 31, ob = rr * 64 + cc * 2; return st * 1024 + (ob ^ (((ob >> 9) & 1) << 5)); }
__device__ __forceinline__ void stage_rc(int b, int& R, int& C) { const int st = b / 1024, sb = b % 1024, swz = sb ^ (((sb >> 9) & 1) << 5); R = (st >> 1) * 16 + swz / 64; C = (st & 1) * 32 + (swz % 64) / 2; }
__device__ __forceinline__ int perm32(int rho) { const int n = rho >> 4, i = rho & 15; return 8 * (i >> 2) + 4 * n + (i & 3); }

struct Unit { int pm, pn; const char* a; const char* b; };
struct Sched {
    const char* A; const char* B; int nM, nN, tpe, G, c, pitch; const int* gidx;
    __device__ __forceinline__ bool next(int i, Unit& u) const {
        const int nwg = nM * nN; const long L = (long)i * G + c; if (L >= nwg) return false;
        int wgid = (int)L; { const int q = nwg / NXCD, r = nwg % NXCD, xcd = wgid % NXCD, off = wgid / NXCD; wgid = (xcd < r ? xcd * (q + 1) : r * (q + 1) + (xcd - r) * q) + off; }
        const int nig = WGM * nN, gid = wgid / nig, fm = gid * WGM, gsz = (nM - fm) < WGM ? (nM - fm) : WGM;
        u.pm = fm + ((wgid % nig) % gsz); u.pn = (wgid % nig) / gsz;
        const size_t tstep = (size_t)BM * pitch;
        u.a = gidx ? A : A + (size_t)u.pm * tstep; u.b = B + (size_t)((u.pm / tpe) * nN + u.pn) * tstep;
        return true;
    }
};

enum EpiKind { EK_IN0 = 0, EK_OUT = 1, EK_GU = 2, EK_DOWN = 3, EK_QKV1 = 4 };
struct Epi {
    int kind, layer; bool f8out; float wsc; unsigned char* ws; const float* xin_lat; const float* xin_ctx; float* out_lat;
    __device__ __forceinline__ void store8(bf16_t* p, const f32x4 a, const f32x4 b) const {
        u32x4 w; w.x = cvt_pk_bf16(a[0], a[1]); w.y = cvt_pk_bf16(a[2], a[3]); w.z = cvt_pk_bf16(b[0], b[1]); w.w = cvt_pk_bf16(b[2], b[3]);
        *(u32x4*)p = w;
    }
    __device__ __forceinline__ void operator()(const f32x4 (&acc)[2][2][4][2], const Unit& u, int wr, int wc, int fr, int fq) const {
        const int row0 = u.pm * BM + wr * 64 + fr;
        if (kind == EK_OUT) {
            const bool lat = row0 < NLAT;
            const int col0 = u.pn * BM + wc * 32 + 4 * fq;
            f32x4 gv[2][2];
            const int gb = lat ? (row0 >> 12) : 8;
#pragma unroll
            for (int bj = 0; bj < 2; ++bj)
#pragma unroll
                for (int n = 0; n < 2; ++n) gv[bj][n] = *(const f32x4*)((const float*)(ws + WS_MOD) + (size_t)(layer * 9 + gb) * 6144 + 2 * 1024 + col0 + bj * HALF + n * 16);
            const float* xi = lat ? xin_lat : xin_ctx - (size_t)NLAT * DM;
            float* xo = lat ? out_lat : (float*)(ws + WS_XCTX) - (size_t)NLAT * DM;
#pragma unroll
            for (int ai = 0; ai < 2; ++ai)
#pragma unroll
                for (int m = 0; m < 4; ++m) { const size_t off = (size_t)(row0 + ai * HALF + m * 16) * DM + col0;
#pragma unroll
                    for (int bj = 0; bj < 2; ++bj)
#pragma unroll
                        for (int n = 0; n < 2; ++n) { const f32x4 bs = *(const f32x4*)(xi + off + bj * HALF + n * 16);
                            *(f32x4*)(xo + off + bj * HALF + n * 16) = bs + gv[bj][n] * acc[ai][bj][m][n]; }
                    if (m & 1) asm volatile("" ::: "memory"); }
            return;
        }
        const int cw = wc * 32 + 8 * fq;
        if (kind == EK_GU) {
#pragma unroll
            for (int ai = 0; ai < 2; ++ai)
#pragma unroll
                for (int m = 0; m < 4; ++m) { f32x4 v[2];
#pragma unroll
                    for (int n = 0; n < 2; ++n) { const f32x4 g = acc[ai][0][m][n] * wsc, up = acc[ai][1][m][n] * wsc;
#pragma unroll
                        for (int j = 0; j < 4; ++j) v[n][j] = g[j] * __builtin_amdgcn_rcpf(1.f + __expf(-g[j])) * up[j]; }
                    if (f8out) { u32x2 w; w.x = pk4_fp8(v[0][0], v[0][1], v[0][2], v[0][3]); w.y = pk4_fp8(v[1][0], v[1][1], v[1][2], v[1][3]);
                        *(u32x2*)((unsigned char*)(ws + A_ACT) + (size_t)(row0 + ai * HALF + m * 16) * FF + u.pn * HALF + cw) = w; }
                    else store8((bf16_t*)(ws + A_ACT) + (size_t)(row0 + ai * HALF + m * 16) * FF + u.pn * HALF + cw, v[0], v[1]); }
            return;
        }
        if (kind == EK_DOWN) {
#pragma unroll
            for (int ai = 0; ai < 2; ++ai)
#pragma unroll
                for (int m = 0; m < 4; ++m)
#pragma unroll
                    for (int bj = 0; bj < 2; ++bj)
                        store8((bf16_t*)(ws + A_HS) + (size_t)(row0 + ai * HALF + m * 16) * DM + u.pn * BM + bj * HALF + cw, acc[ai][bj][m][0] * wsc, acc[ai][bj][m][1] * wsc);
            return;
        }
        int mode; size_t doff; int ld, cb;
        if (kind == EK_IN0) {
            if (u.pn < 2)       { mode = 0; doff = A_BG; ld = 512; cb = u.pn * 256; }
            else if (u.pn < 6)  { mode = 1; doff = A_CX; ld = 512; cb = (u.pn - 2) * 128; }
            else if (u.pn < 8)  { mode = 2; doff = A_Q0; ld = 512; cb = (u.pn - 6) * 256; }
            else if (u.pn < 10) { mode = 2; doff = A_K0; ld = 512; cb = (u.pn - 8) * 256; }
            else                { mode = 0; doff = A_V0; ld = 512; cb = (u.pn - 10) * 256; }
        } else {
            if (u.pn < 4)       { mode = 2; doff = A_Q1; ld = 1024; cb = u.pn * 256; }
            else if (u.pn == 4) { mode = 2; doff = A_K1; ld = 256; cb = 0; }
            else                { mode = 0; doff = A_V1; ld = 256; cb = 0; }
        }
        bf16_t* dst = (bf16_t*)(ws + doff); const float* rope = (const float*)(ws + WS_ROPE);
        const float qs = ((kind == EK_IN0 && (u.pn == 6 || u.pn == 7)) || (kind == EK_QKV1 && u.pn < 4)) ? 0.125f * 1.4426950408889634f : 1.0f;
        if (mode == 2 && row0 >= NLAT) mode = 0;
        if (mode == 1) {
#pragma unroll
            for (int ai = 0; ai < 2; ++ai)
#pragma unroll
                for (int m = 0; m < 4; ++m)
                    store8(dst + (size_t)(row0 + ai * HALF + m * 16) * ld + cb + cw, acc[ai][0][m][0] * acc[ai][1][m][0], acc[ai][0][m][1] * acc[ai][1][m][1]);
        } else if (mode == 0) {
#pragma unroll
            for (int ai = 0; ai < 2; ++ai)
#pragma unroll
                for (int m = 0; m < 4; ++m)
#pragma unroll
                    for (int bj = 0; bj < 2; ++bj)
                        store8(dst + (size_t)(row0 + ai * HALF + m * 16) * ld + cb + bj * HALF + cw, acc[ai][bj][m][0] * qs, acc[ai][bj][m][1] * qs);
        } else {
#pragma unroll
            for (int ai = 0; ai < 2; ++ai)
#pragma unroll
                for (int m = 0; m < 4; ++m) { const int row = row0 + ai * HALF + m * 16; const int t = row & (SEQ - 1);
                    const int pos = (wc & 1) ? (t & 63) : (t >> 6);
                    const f32x4 cs = *(const f32x4*)(rope + pos * 16 + 4 * fq) * qs, sn = *(const f32x4*)(rope + 1024 + pos * 16 + 4 * fq) * qs;
#pragma unroll
                    for (int bj = 0; bj < 2; ++bj) { const f32x4 x1 = acc[ai][bj][m][0], x2 = acc[ai][bj][m][1];
                        store8(dst + (size_t)row * ld + cb + bj * HALF + cw, x1 * cs - x2 * sn, x2 * cs + x1 * sn); } }
        }
    }
};

__device__ __forceinline__ void gemm_phase(LAS unsigned char* lds, const int tid, const bool perm, const Sched& S, const Epi& E) {
    const int wid = __builtin_amdgcn_readfirstlane(tid >> 6), lane = tid & 63, wr = wid >> 2, wc = wid & 3, fr = lane & 15, fq = lane >> 4;
    constexpr int K = DM, nt = K / BK;
    unsigned voffB[2]; int sR[2], sC[2];
#pragma unroll
    for (int i = 0; i < 2; ++i) { int R, C; stage_rc(tid * 16 + i * 8192, R, C); const int Rb = perm ? ((R & ~31) + perm32(R & 31)) : R;
        sR[i] = R; sC[i] = C; voffB[i] = (unsigned)(Rb * K + C) * 2u; }
    const bool gather = S.gidx != nullptr;
    LAS unsigned* gtab = (LAS unsigned*)(lds + GT_OFF);
    if (gather) {
        Unit tu;
        for (int i = 0; S.next(i, tu); ++i) if (tid < 256) gtab[i * 256 + tid] = (unsigned)S.gidx[(tu.pm / S.tpe) * EROWS0 + (tu.pm % S.tpe) * 256 + tid] * (unsigned)(K * 2);
        __syncthreads();
    }
    unsigned gc[2][2], gn[2][2];
#define PG8_GOFF(dst, ord) do { _Pragma("unroll") for (int h_ = 0; h_ < 2; ++h_) _Pragma("unroll") for (int i_ = 0; i_ < 2; ++i_) \
        dst[h_][i_] = gather ? gtab[(ord) * 256 + h_ * HALF + sR[i_]] + (unsigned)sC[i_] * 2u : (unsigned)((h_ * HALF + sR[i_]) * K + sC[i_]) * 2u; } while (0)
    constexpr size_t kstep = (size_t)(BK * 2);
    constexpr size_t hstep = (size_t)HALF * K * 2;
    const unsigned ldsw = (unsigned)wid * 1024u;
    const int aoff = lds_byte(wr * 64 + fr, fq * 8), boff = lds_byte(wc * 32 + fr, fq * 8);
#define PG8_SA(b, h) (((b) * 2 + (h)) * HTB)
#define PG8_SB(b, h) ((4 + (b) * 2 + (h)) * HTB)
#define PG8_STAGE(bufoff, gbase, voff) do { _Pragma("unroll") for (int _i = 0; _i < 2; ++_i) \
        __builtin_amdgcn_global_load_lds((const unsigned*)((const char*)(gbase) + (voff)[_i]), (LAS unsigned*)(lds + (bufoff) + ldsw + _i * 8192), 16, 0, 0); } while (0)
#define PG8_LDA(dst, b, h) do { _Pragma("unroll") for (int m = 0; m < 4; ++m) _Pragma("unroll") for (int k = 0; k < 2; ++k) dst[m][k] = *(const LAS bf16x8*)(lds + PG8_SA(b, h) + aoff + m * 2048 + k * 1024); } while (0)
#define PG8_LDB(dst, b, h) do { _Pragma("unroll") for (int n = 0; n < 2; ++n) _Pragma("unroll") for (int k = 0; k < 2; ++k) dst[n][k] = *(const LAS bf16x8*)(lds + PG8_SB(b, h) + boff + n * 2048 + k * 1024); } while (0)
#define PG8_MMA(ai, bj, At, Bt) do { __builtin_amdgcn_s_setprio(1); _Pragma("unroll") for (int m = 0; m < 4; ++m) _Pragma("unroll") for (int n = 0; n < 2; ++n) _Pragma("unroll") for (int k = 0; k < 2; ++k) \
        acc[ai][bj][m][n] = __builtin_amdgcn_mfma_f32_16x16x32_bf16(Bt[n][k], At[m][k], acc[ai][bj][m][n], 0, 0, 0); __builtin_amdgcn_s_setprio(0); } while (0)
#define PG8_WAIT_V(n) asm volatile("s_waitcnt vmcnt(" #n ")" ::: "memory")
#define PG8_WAIT_L(n) asm volatile("s_waitcnt lgkmcnt(" #n ")" ::: "memory")
#define PG8_BAR __builtin_amdgcn_s_barrier()
#define PG8_SCHED __builtin_amdgcn_sched_barrier(0)
    Unit cur, nxt; int ui = 0;
    if (!S.next(0, cur)) return;
    f32x4 acc[2][2][4][2];
#pragma unroll
    for (int a = 0; a < 2; ++a)
#pragma unroll
        for (int b = 0; b < 2; ++b)
#pragma unroll
            for (int m = 0; m < 4; ++m)
#pragma unroll
                for (int n = 0; n < 2; ++n) acc[a][b][m][n] = (f32x4){0.f, 0.f, 0.f, 0.f};
    bf16x8 At[4][2], B0[2][2], B1[2][2];
    const char* cA = cur.a; const char* cB = cur.b;
    PG8_GOFF(gc, 0);
    PG8_STAGE(PG8_SB(0, 0), cB, voffB); PG8_STAGE(PG8_SB(0, 1), cB + hstep, voffB); PG8_STAGE(PG8_SA(0, 0), cA, gc[0]); PG8_STAGE(PG8_SA(0, 1), cA, gc[1]);
    if (wr == 1) PG8_BAR;
    PG8_WAIT_V(2); PG8_BAR;
    PG8_STAGE(PG8_SB(1, 0), cB + kstep, voffB); PG8_STAGE(PG8_SA(1, 0), cA + kstep, gc[0]); PG8_STAGE(PG8_SB(1, 1), cB + hstep + kstep, voffB);
    PG8_WAIT_V(6); PG8_BAR;
    for (;;) {
        const bool has_next = S.next(ui + 1, nxt);
        const char* nA = has_next ? nxt.a : cA; const char* nB = has_next ? nxt.b : cB;
        if (has_next) PG8_GOFF(gn, ui + 1);
        else {
#pragma unroll
            for (int h_ = 0; h_ < 2; ++h_)
#pragma unroll
                for (int i_ = 0; i_ < 2; ++i_) gn[h_][i_] = gc[h_][i_]; }
        for (int t = 0; t < nt; t += 2) {
            const bool last = (t == nt - 2);
            const char* a1 = cA + (size_t)(t + 1) * kstep;
            const char* a2 = last ? nA : cA + (size_t)(t + 2) * kstep; const char* b2 = last ? nB : cB + (size_t)(t + 2) * kstep;
            const char* a3 = a2 + kstep; const char* b3 = b2 + kstep;
            unsigned g2[2][2];
#pragma unroll
            for (int h_ = 0; h_ < 2; ++h_)
#pragma unroll
                for (int i_ = 0; i_ < 2; ++i_) g2[h_][i_] = last ? gn[h_][i_] : gc[h_][i_];
            PG8_LDB(B0, 0, 0); PG8_LDB(B1, 0, 1); PG8_SCHED; PG8_LDA(At, 0, 0); PG8_STAGE(PG8_SA(1, 1), a1, gc[1]);
            PG8_WAIT_V(8); PG8_WAIT_L(0); PG8_BAR; PG8_MMA(0, 0, At, B0); PG8_MMA(0, 1, At, B1); PG8_BAR; PG8_SCHED;
            PG8_LDA(At, 0, 1); PG8_STAGE(PG8_SB(0, 0), b2, voffB); PG8_STAGE(PG8_SB(0, 1), b2 + hstep, voffB); PG8_STAGE(PG8_SA(0, 0), a2, g2[0]);
            PG8_WAIT_V(8); PG8_WAIT_L(0); PG8_BAR; PG8_MMA(1, 0, At, B0); PG8_MMA(1, 1, At, B1); PG8_BAR; PG8_SCHED;
            PG8_LDB(B0, 1, 0); PG8_LDB(B1, 1, 1); PG8_SCHED; PG8_LDA(At, 1, 0); PG8_STAGE(PG8_SA(0, 1), a2, g2[1]);
            PG8_WAIT_V(8); PG8_WAIT_L(0); PG8_BAR; PG8_MMA(0, 0, At, B0); PG8_MMA(0, 1, At, B1); PG8_BAR; PG8_SCHED;
            PG8_LDA(At, 1, 1); PG8_STAGE(PG8_SB(1, 0), b3, voffB); PG8_STAGE(PG8_SB(1, 1), b3 + hstep, voffB); PG8_STAGE(PG8_SA(1, 0), a3, g2[0]);
            PG8_WAIT_V(8); PG8_WAIT_L(0); PG8_BAR; PG8_MMA(1, 0, At, B0); PG8_MMA(1, 1, At, B1); PG8_BAR; PG8_SCHED;
        }
        if (wr == 0) PG8_BAR;
        E(acc, cur, wr, wc, fr, fq);
        if (!has_next) break;
#pragma unroll
        for (int a = 0; a < 2; ++a)
#pragma unroll
            for (int b = 0; b < 2; ++b)
#pragma unroll
                for (int m = 0; m < 4; ++m)
#pragma unroll
                    for (int n = 0; n < 2; ++n) acc[a][b][m][n] = (f32x4){0.f, 0.f, 0.f, 0.f};
        cur = nxt; cA = nA; cB = nB; ++ui;
#pragma unroll
        for (int h_ = 0; h_ < 2; ++h_)
#pragma unroll
            for (int i_ = 0; i_ < 2; ++i_) gc[h_][i_] = gn[h_][i_];
        if (wr == 1) PG8_BAR;
    }
    PG8_WAIT_V(0);
    PG8_BAR;
#undef PG8_GOFF
#undef PG8_SA
#undef PG8_SB
#undef PG8_STAGE
#undef PG8_LDA
#undef PG8_LDB
#undef PG8_MMA
#undef PG8_WAIT_V
#undef PG8_WAIT_L
#undef PG8_BAR
#undef PG8_SCHED
}
__device__ __forceinline__ void gemm_phase8(LAS unsigned char* lds, const int tid, const bool perm, const Sched& S, const Epi& E) {
    const int wid = __builtin_amdgcn_readfirstlane(tid >> 6), lane = tid & 63, wr = wid >> 2, wc = wid & 3, fr = lane & 15, fq = lane >> 4;
    constexpr int K = DM, nt = K / 128, PITCH = K;
    unsigned voffB[2]; int sR[2], sC[2];
#pragma unroll
    for (int i = 0; i < 2; ++i) { const int X = tid * 16 + i * 8192, p = X >> 10, l = (X >> 4) & 63, fr_ = l >> 2, g_ = fr_ >> 2, cp = (l & 3) ^ (g_ ^ (g_ >> 1));
        const int R = (p >> 1) * 16 + fr_, C = ((p & 1) * 4 + cp) * 16; const int Rb = perm ? ((R & ~31) + perm32(R & 31)) : R;
        sR[i] = R; sC[i] = C; voffB[i] = (unsigned)(Rb * PITCH + C); }
    const bool gather = S.gidx != nullptr;
    LAS unsigned* gtab = (LAS unsigned*)(lds + GT_OFF);
    if (gather) {
        Unit tu;
        for (int i = 0; S.next(i, tu); ++i) if (tid < 256) gtab[i * 256 + tid] = (unsigned)S.gidx[(tu.pm / S.tpe) * EROWS0 + (tu.pm % S.tpe) * 256 + tid] * (unsigned)PITCH;
        __syncthreads();
    }
    unsigned gc[2][2], gn[2][2];
#define PG8_GOFF(dst, ord) do { _Pragma("unroll") for (int h_ = 0; h_ < 2; ++h_) _Pragma("unroll") for (int i_ = 0; i_ < 2; ++i_) \
        dst[h_][i_] = gather ? gtab[(ord) * 256 + h_ * HALF + sR[i_]] + (unsigned)sC[i_] : (unsigned)((h_ * HALF + sR[i_]) * PITCH + sC[i_]); } while (0)
    constexpr size_t kstep = (size_t)(BK * 2);
    constexpr size_t hstep = (size_t)HALF * PITCH;
    const unsigned ldsw = (unsigned)wid * 1024u;
    int aoff[2], boff[2];
#pragma unroll
    for (int hh = 0; hh < 2; ++hh) { const int g_ = fr >> 2, ch = (((fq & 1) * 2 + hh) ^ (g_ ^ (g_ >> 1))); const int o_ = (fq >> 1) * 1024 + (4 * fr + ch) * 16;
        aoff[hh] = wr * 8192 + o_; boff[hh] = wc * 4096 + o_; }
#define PG8_SA(b, h) (((b) * 2 + (h)) * HTB)
#define PG8_SB(b, h) ((4 + (b) * 2 + (h)) * HTB)
#define PG8_STAGE(bufoff, gbase, voff) do { _Pragma("unroll") for (int _i = 0; _i < 2; ++_i) \
        __builtin_amdgcn_global_load_lds((const unsigned*)((const char*)(gbase) + (voff)[_i]), (LAS unsigned*)(lds + (bufoff) + ldsw + _i * 8192), 16, 0, 0); } while (0)
#define PG8_LDA(dst, b, h) do { _Pragma("unroll") for (int m = 0; m < 4; ++m) dst[m] = __builtin_shufflevector(*(const LAS v4i32*)(lds + PG8_SA(b, h) + aoff[0] + m * 2048), *(const LAS v4i32*)(lds + PG8_SA(b, h) + aoff[1] + m * 2048), 0, 1, 2, 3, 4, 5, 6, 7); } while (0)
#define PG8_LDB(dst, b, h) do { _Pragma("unroll") for (int n = 0; n < 2; ++n) dst[n] = __builtin_shufflevector(*(const LAS v4i32*)(lds + PG8_SB(b, h) + boff[0] + n * 2048), *(const LAS v4i32*)(lds + PG8_SB(b, h) + boff[1] + n * 2048), 0, 1, 2, 3, 4, 5, 6, 7); } while (0)
#define PG8_V8(x) (x)
#define PG8_MMA(ai, bj, At, Bt) do { __builtin_amdgcn_s_setprio(1); _Pragma("unroll") for (int m = 0; m < 4; ++m) _Pragma("unroll") for (int n = 0; n < 2; ++n) \
        asm volatile("v_mfma_f32_16x16x128_f8f6f4 %0, %1, %2, %0" : "+v"(acc[ai][bj][m][n]) : "v"(Bt[n]), "v"(At[m])); __builtin_amdgcn_s_setprio(0); } while (0)
#define PG8_WAIT_V(n) asm volatile("s_waitcnt vmcnt(" #n ")" ::: "memory")
#define PG8_WAIT_L(n) asm volatile("s_waitcnt lgkmcnt(" #n ")" ::: "memory")
#define PG8_BAR __builtin_amdgcn_s_barrier()
#define PG8_SCHED __builtin_amdgcn_sched_barrier(0)
    Unit cur, nxt; int ui = 0;
    if (!S.next(0, cur)) return;
    f32x4 acc[2][2][4][2];
#pragma unroll
    for (int a = 0; a < 2; ++a)
#pragma unroll
        for (int b = 0; b < 2; ++b)
#pragma unroll
            for (int m = 0; m < 4; ++m)
#pragma unroll
                for (int n = 0; n < 2; ++n) acc[a][b][m][n] = (f32x4){0.f, 0.f, 0.f, 0.f};
    v8i32 At[4], B0[2], B1[2];
    const char* cA = cur.a; const char* cB = cur.b;
    PG8_GOFF(gc, 0);
    PG8_STAGE(PG8_SB(0, 0), cB, voffB); PG8_STAGE(PG8_SB(0, 1), cB + hstep, voffB); PG8_STAGE(PG8_SA(0, 0), cA, gc[0]); PG8_STAGE(PG8_SA(0, 1), cA, gc[1]);
    if (wr == 1) PG8_BAR;
    PG8_WAIT_V(2); PG8_BAR;
    PG8_STAGE(PG8_SB(1, 0), cB + kstep, voffB); PG8_STAGE(PG8_SA(1, 0), cA + kstep, gc[0]); PG8_STAGE(PG8_SB(1, 1), cB + hstep + kstep, voffB);
    PG8_WAIT_V(6); PG8_BAR;
    for (;;) {
        const bool has_next = S.next(ui + 1, nxt);
        const char* nA = has_next ? nxt.a : cA; const char* nB = has_next ? nxt.b : cB;
        if (has_next) PG8_GOFF(gn, ui + 1);
        else {
#pragma unroll
            for (int h_ = 0; h_ < 2; ++h_)
#pragma unroll
                for (int i_ = 0; i_ < 2; ++i_) gn[h_][i_] = gc[h_][i_]; }
#pragma unroll 1
        for (int t = 0; t < nt; t += 2) {
            const bool last = (t == nt - 2);
            const char* a1 = cA + (size_t)(t + 1) * kstep;
            const char* a2 = last ? nA : cA + (size_t)(t + 2) * kstep; const char* b2 = last ? nB : cB + (size_t)(t + 2) * kstep;
            const char* a3 = a2 + kstep; const char* b3 = b2 + kstep;
            unsigned g2[2][2];
#pragma unroll
            for (int h_ = 0; h_ < 2; ++h_)
#pragma unroll
                for (int i_ = 0; i_ < 2; ++i_) g2[h_][i_] = last ? gn[h_][i_] : gc[h_][i_];
            PG8_LDB(B0, 0, 0); PG8_LDB(B1, 0, 1); PG8_SCHED; PG8_LDA(At, 0, 0); PG8_STAGE(PG8_SA(1, 1), a1, gc[1]);
            PG8_WAIT_V(8); PG8_WAIT_L(0); PG8_BAR; PG8_MMA(0, 0, At, B0); PG8_MMA(0, 1, At, B1); PG8_BAR; PG8_SCHED;
            PG8_LDA(At, 0, 1); PG8_STAGE(PG8_SB(0, 0), b2, voffB); PG8_STAGE(PG8_SB(0, 1), b2 + hstep, voffB); PG8_STAGE(PG8_SA(0, 0), a2, g2[0]);
            PG8_WAIT_V(8); PG8_WAIT_L(0); PG8_BAR; PG8_MMA(1, 0, At, B0); PG8_MMA(1, 1, At, B1); PG8_BAR; PG8_SCHED;
            PG8_LDB(B0, 1, 0); PG8_LDB(B1, 1, 1); PG8_SCHED; PG8_LDA(At, 1, 0); PG8_STAGE(PG8_SA(0, 1), a2, g2[1]);
            PG8_WAIT_V(8); PG8_WAIT_L(0); PG8_BAR; PG8_MMA(0, 0, At, B0); PG8_MMA(0, 1, At, B1); PG8_BAR; PG8_SCHED;
            PG8_LDA(At, 1, 1); PG8_STAGE(PG8_SB(1, 0), b3, voffB); PG8_STAGE(PG8_SB(1, 1), b3 + hstep, voffB); PG8_STAGE(PG8_SA(1, 0), a3, g2[0]);
            PG8_WAIT_V(8); PG8_WAIT_L(0); PG8_BAR; PG8_MMA(1, 0, At, B0); PG8_MMA(1, 1, At, B1); PG8_BAR; PG8_SCHED;
        }
        if (wr == 0) PG8_BAR;
        asm volatile("s_nop 15\n\ts_nop 15" ::: "memory");
        E(acc, cur, wr, wc, fr, fq);
        if (!has_next) break;
#pragma unroll
        for (int a = 0; a < 2; ++a)
#pragma unroll
            for (int b = 0; b < 2; ++b)
#pragma unroll
                for (int m = 0; m < 4; ++m)
#pragma unroll
                    for (int n = 0; n < 2; ++n) acc[a][b][m][n] = (f32x4){0.f, 0.f, 0.f, 0.f};
        cur = nxt; cA = nA; cB = nB; ++ui;
#pragma unroll
        for (int h_ = 0; h_ < 2; ++h_)
#pragma unroll
            for (int i_ = 0; i_ < 2; ++i_) gc[h_][i_] = gn[h_][i_];
        if (wr == 1) PG8_BAR;
    }
    PG8_WAIT_V(0);
    PG8_BAR;
#undef PG8_GOFF
#undef PG8_V8
#undef PG8_SA
#undef PG8_SB
#undef PG8_STAGE
#undef PG8_LDA
#undef PG8_LDB
#undef PG8_MMA
#undef PG8_WAIT_V
#undef PG8_WAIT_L
#undef PG8_BAR
#undef PG8_SCHED
}
}

namespace att {
constexpr int QBLK = 32, KVBLK = 64;
constexpr float SCALE = 0.125f;
constexpr float THR = 8.f;
constexpr float LOG2E = 1.4426950408889634f;
#define SBAR() __builtin_amdgcn_sched_barrier(0)
#define KSWZ(row, colB) ((row) * 128 + ((colB) ^ ((((row) >> 1) & 7) << 4)))
__device__ __forceinline__ int crow(int r, int hi) { return (r & 3) + 8 * (r >> 2) + 4 * hi; }
__device__ __forceinline__ unsigned cvtpk(float lo, float hi) { unsigned r; asm volatile("v_cvt_pk_bf16_f32 %0, %1, %2" : "=v"(r) : "v"(lo), "v"(hi)); return r; }

constexpr float THRL = 8.f;
__device__ __forceinline__ void partialSM(f32x16& p0, f32x16& p1, float& m_reg, f32x16& negm, float& alpha, const bool first) {
    float a = fmaxf(fmaxf(p0[0], p0[1]), p1[0]), b = fmaxf(fmaxf(p0[2], p0[3]), p1[1]); a = fmaxf(fmaxf(a, p1[2]), p1[3]);
#pragma unroll
    for (int r = 4; r < 16; r += 4) { a = fmaxf(fmaxf(a, p0[r]), p0[r + 1]); b = fmaxf(fmaxf(b, p0[r + 2]), p0[r + 3]); a = fmaxf(fmaxf(a, p1[r]), p1[r + 1]); b = fmaxf(fmaxf(b, p1[r + 2]), p1[r + 3]); }
    float pmax = fmaxf(a, b);
    { auto rr = __builtin_amdgcn_permlane32_swap(__float_as_uint(pmax), __float_as_uint(pmax), false, false);
      pmax = fmaxf(__uint_as_float(rr[0]), __uint_as_float(rr[1])); }
    alpha = 1.f;
    if (__builtin_expect(first || __any(pmax > THRL), 0)) {
        const float dl = first ? pmax : fmaxf(pmax, 0.f);
        m_reg += dl;
#pragma unroll
        for (int r = 0; r < 16; ++r) { p0[r] -= dl; p1[r] -= dl; }
#pragma unroll
        for (int r = 0; r < 16; ++r) negm[r] = -m_reg;
        alpha = __builtin_amdgcn_exp2f(-dl);
    }
#pragma unroll
    for (int r = 0; r < 16; ++r) p0[r] = __builtin_amdgcn_exp2f(p0[r]);
}
__device__ __forceinline__ void finishSM(f32x16& p0, f32x16& p1, float alpha, float& l_reg, bf16x8& pa0, bf16x8& pa1, bf16x8& pa2, bf16x8& pa3) {
#pragma unroll
    for (int r = 0; r < 16; ++r) p1[r] = __builtin_amdgcn_exp2f(p1[r]);
    float s0 = p0[0] + p0[1], s1 = p0[2] + p0[3], s2 = p0[4] + p0[5], s3 = p0[6] + p0[7];
    s0 += p0[8]; s1 += p0[9]; s2 += p0[10]; s3 += p0[11]; s0 += p0[12]; s1 += p0[13]; s2 += p0[14]; s3 += p0[15];
#pragma unroll
    for (int r = 0; r < 16; r += 4) { s0 += p1[r]; s1 += p1[r + 1]; s2 += p1[r + 2]; s3 += p1[r + 3]; }
    float ps = (s0 + s1) + (s2 + s3);
    { auto rr = __builtin_amdgcn_permlane32_swap(__float_as_uint(ps), __float_as_uint(ps), false, false);
      ps = __uint_as_float(rr[0]) + __uint_as_float(rr[1]); }
    l_reg = l_reg * alpha + ps;
#define PK8(P, BASE, OUT) do { u32x4 w = {cvtpk(P[BASE + 0], P[BASE + 1]), cvtpk(P[BASE + 2], P[BASE + 3]), cvtpk(P[BASE + 4], P[BASE + 5]), cvtpk(P[BASE + 6], P[BASE + 7])}; OUT = __builtin_bit_cast(bf16x8, w); } while (0)
    PK8(p0, 0, pa0); PK8(p0, 8, pa1); PK8(p1, 0, pa2); PK8(p1, 8, pa3);
#undef PK8
}
__device__ __forceinline__ void qkt(f32x16& p0, f32x16& p1, const LAS char* Ks, const LAS char* qf, const f32x16& cinit, int r32, int hi) {
#pragma unroll
    for (int d0 = 0; d0 < 4; ++d0) { const int cb = (d0 * 16 + hi * 8) * 2;
        const bf16x8 q = *(const LAS bf16x8*)(qf + d0 * 1024);
        const bf16x8 b0 = *(const LAS bf16x8*)(Ks + KSWZ(r32, cb));
        const bf16x8 b1 = *(const LAS bf16x8*)(Ks + KSWZ(32 + r32, cb));
        if (d0 == 0) { p0 = __builtin_amdgcn_mfma_f32_32x32x16_bf16(b0, q, cinit, 0, 0, 0); p1 = __builtin_amdgcn_mfma_f32_32x32x16_bf16(b1, q, cinit, 0, 0, 0); }
        else { p0 = __builtin_amdgcn_mfma_f32_32x32x16_bf16(b0, q, p0, 0, 0, 0); p1 = __builtin_amdgcn_mfma_f32_32x32x16_bf16(b1, q, p1, 0, 0, 0); } }
}
template <int NCB> __device__ __forceinline__ int v_st(int k, int c) { const int kk = k; return ((kk >> 3) * NCB + (c >> 5)) * 512 + ((kk & 7) * 32 + (c & 31)) * 2; }
__device__ __forceinline__ int v_rd_base(int lane) { return ((lane & 3) << 3) | (((lane >> 2) & 3) << 6) | (((lane >> 4) & 1) << 5) | (((lane >> 5) & 1) << 8); }
typedef short v4i16_t __attribute__((ext_vector_type(4)));
__device__ __forceinline__ s16x4 vtr(const LAS char* p) { return __builtin_bit_cast(s16x4, __builtin_amdgcn_ds_read_tr16_b64_v4i16((LAS v4i16_t*)p)); }
template <int NCB, int D0> __device__ __forceinline__ void pv_one(f32x16& od, const LAS char* vb, bf16x8 pa0, bf16x8 pa1, bf16x8 pa2, bf16x8 pa3) {
    constexpr int KS = NCB * 1024, HS = NCB * 512;
    const s16x4 l0 = vtr(vb + D0 * 512 + 0 * KS), h0 = vtr(vb + D0 * 512 + 0 * KS + HS), l1 = vtr(vb + D0 * 512 + 1 * KS), h1 = vtr(vb + D0 * 512 + 1 * KS + HS);
    const s16x4 l2 = vtr(vb + D0 * 512 + 2 * KS), h2 = vtr(vb + D0 * 512 + 2 * KS + HS), l3 = vtr(vb + D0 * 512 + 3 * KS), h3 = vtr(vb + D0 * 512 + 3 * KS + HS);
#define PK(L, H) (bf16x8){L[0], L[1], L[2], L[3], H[0], H[1], H[2], H[3]}
    od = __builtin_amdgcn_mfma_f32_32x32x16_bf16(pa0, PK(l0, h0), od, 0, 0, 0);
    od = __builtin_amdgcn_mfma_f32_32x32x16_bf16(pa1, PK(l1, h1), od, 0, 0, 0);
    od = __builtin_amdgcn_mfma_f32_32x32x16_bf16(pa2, PK(l2, h2), od, 0, 0, 0);
    od = __builtin_amdgcn_mfma_f32_32x32x16_bf16(pa3, PK(l3, h3), od, 0, 0, 0);
#undef PK
}
template <int NCB> __device__ __forceinline__ void pv_all(f32x16* o, const LAS char* vb, bf16x8 pa0, bf16x8 pa1, bf16x8 pa2, bf16x8 pa3) {
    pv_one<NCB, 0>(o[0], vb, pa0, pa1, pa2, pa3); pv_one<NCB, 1>(o[1], vb, pa0, pa1, pa2, pa3);
    if constexpr (NCB == 4) { pv_one<NCB, 2>(o[2], vb, pa0, pa1, pa2, pa3); pv_one<NCB, 3>(o[3], vb, pa0, pa1, pa2, pa3); }
}

struct UnitDesc {
    const bf16_t* Q; int ldq;
    const bf16_t* K; const bf16_t* V; int ldk, ldv;
    bf16_t* O; int ldo;
    int ctx_row0, lat_row0, lat_t0, NT;
    int q0; float sinkl2;
};
template <int DV, bool SWA, int ABL = 0>
__device__ __forceinline__ void attn_unit(const UnitDesc& U, LAS char* lds, const int tid) {
    constexpr int NCB = DV / 32;
    constexpr int LDQ = SWA ? 1024 : 512, LDK = SWA ? 256 : 512, LDV = LDK, LDO = 1024;
    constexpr int SHM_V = KVBLK * DV * 2, SHM_K = KVBLK * 64 * 2;
    constexpr int NLD = (DV == 128) ? 3 : 2;
    const int wid = __builtin_amdgcn_readfirstlane(tid >> 6), lane = tid & 63, r32 = lane & 31, hi = lane >> 5;
    LAS char* V_lds = lds; LAS char* K_lds = lds + 3 * SHM_V;
    LAS float* ws = (LAS float*)(lds + 3 * SHM_V + 3 * SHM_K) + wid * 64; LAS float* li_l = ws; LAS float* al_l = ws + 32;
    float m_reg = 0.f, l_reg = 0; f32x16 o[NCB]; f32x16 negm = f32x16{};
#pragma unroll
    for (int d = 0; d < NCB; ++d) o[d] = f32x16{};
    const bf16_t* Qw = U.Q + (size_t)(wid * QBLK + r32) * LDQ + hi * 8;
    LAS char* qf = lds + 3 * SHM_V + 3 * SHM_K + 2048 + wid * 4096 + lane * 16;
#pragma unroll
    for (int d0 = 0; d0 < 4; ++d0) *(LAS bf16x8*)(qf + d0 * 1024) = *(const bf16x8*)(Qw + d0 * 16);
    const int kr = tid >> 3, kc = (tid & 7) * 8;
    const int sr = tid >> 4, sc = (tid & 15) * 8;
    const int kst = KSWZ(kr, kc * 2);
    const int vst0 = (DV == 128) ? v_st<NCB>(sr, sc) : v_st<NCB>(kr, kc), vst1 = (DV == 128) ? v_st<NCB>(32 + sr, sc) : 0;
    const LAS char* vrd = V_lds + v_rd_base(lane);
    bf16x8 svA0, svA1, skA;
    const bf16_t* kp = U.K + (size_t)(U.ctx_row0 + kr) * LDK + kc;
    const bf16_t* vp = (DV == 128) ? U.V + (size_t)(U.ctx_row0 + sr) * LDV + sc : U.V + (size_t)(U.ctx_row0 + kr) * LDV + kc;
    const int jump = (U.lat_row0 + 64 * U.lat_t0) - (U.ctx_row0 + 192);
#define SLOAD(S, t) do { \
        if constexpr (DV == 128) { sv##S##0 = *(const bf16x8*)(vp); sv##S##1 = *(const bf16x8*)(vp + (size_t)32 * LDV); } \
        else { sv##S##0 = *(const bf16x8*)(vp); } \
        sk##S = *(const bf16x8*)(kp); \
        { const int adv_ = ((t) == 3) ? jump : 64; kp += (ptrdiff_t)adv_ * LDK; vp += (ptrdiff_t)adv_ * LDV; } } while (0)
#define SWRITE(slot, S) do { *(LAS bf16x8*)(V_lds + (slot) * SHM_V + vst0) = sv##S##0; if constexpr (DV == 128) *(LAS bf16x8*)(V_lds + (slot) * SHM_V + vst1) = sv##S##1; \
        *(LAS bf16x8*)(K_lds + (slot) * SHM_K + kst) = sk##S; } while (0)
#define RESC(a) do { if (__any((a) < 1.f)) { if (hi == 0) al_l[r32] = (a); asm volatile("s_waitcnt lgkmcnt(0)" ::: "memory"); \
        _Pragma("unroll") for (int d = 0; d < NCB; ++d) _Pragma("unroll") for (int r = 0; r < 16; ++r) o[d][r] *= al_l[crow(r, hi)]; } } while (0)
    const int qs = U.q0 + wid * QBLK;
#define ACTIVE(t) (!SWA || (t) < 4 || (64 * (U.lat_t0 + (t) - 4) + 63 >= qs - 128 && 64 * (U.lat_t0 + (t) - 4) <= qs + 31 + 128))
#define MASK(P0, P1, t) do { if constexpr (SWA) { if ((t) >= 4) { const int kb_ = 64 * (U.lat_t0 + (t) - 4) - (qs + r32) + 4 * hi; \
        _Pragma("unroll") for (int r = 0; r < 16; ++r) { const int d0_ = kb_ + (r & 3) + 8 * (r >> 2); \
            if (d0_ > 128 || d0_ < -128) P0[r] = -1e30f; if (d0_ + 32 > 128 || d0_ + 32 < -128) P1[r] = -1e30f; } } } } while (0)
    f32x16 pA0, pA1, pB0, pB1; float alA = 1.f, alB = 1.f; bf16x8 pa0, pa1, pa2, pa3; const int NT = U.NT;
    bool actA = true, actB = true;
    int sp = 0, scur = 0, snx = 1;
#define ROT() do { sp = scur; scur = snx; snx = (snx == 2) ? 0 : snx + 1; } while (0)
#define STEP(t, C, P, LOADN, WRITEN) do { \
        act##C = ACTIVE(t); \
        SBAR(); if (act##C) { if constexpr (ABL != 4) qkt(p##C##0, p##C##1, K_lds + scur * SHM_K, qf, negm, r32, hi); else { asm volatile("" : "+v"(p##C##0), "+v"(p##C##1)); } MASK(p##C##0, p##C##1, t); } \
        if (act##P) { finishSM(p##P##0, p##P##1, al##P, l_reg, pa0, pa1, pa2, pa3); } SBAR(); \
        if (WRITEN && ABL != 1) { SWRITE(snx, A); } \
        if (LOADN && ABL != 1) SLOAD(A, (t) + 2); SBAR(); \
        if (act##P) { if constexpr (ABL != 3) pv_all<NCB>(o, vrd + sp * SHM_V, pa0, pa1, pa2, pa3); else { asm volatile("" :: "v"(pa0), "v"(pa1), "v"(pa2), "v"(pa3)); } } \
        if (act##C) { partialSM(p##C##0, p##C##1, m_reg, negm, al##C, false); } else al##C = 1.f; \
        if (act##C) RESC(al##C); \
        __syncthreads(); ROT(); } while (0)
    SLOAD(A, 0); asm volatile("s_waitcnt vmcnt(0)" ::: "memory"); SWRITE(0, A); SLOAD(A, 1); __syncthreads();
    qkt(pA0, pA1, K_lds, qf, negm, r32, hi); MASK(pA0, pA1, 0); partialSM(pA0, pA1, m_reg, negm, alA, true);
    SWRITE(1, A); SLOAD(A, 2); __syncthreads();
    sp = 0; scur = 1; snx = 2;
    for (int j = 1; j + 1 < NT; j += 2) {
        STEP(j, B, A, true, true);
        STEP(j + 1, A, B, (j + 3 < NT), true);
    }
    STEP(NT - 1, B, A, false, false);
    if (actB) { finishSM(pB0, pB1, alB, l_reg, pa0, pa1, pa2, pa3); SBAR(); pv_all<NCB>(o, vrd + sp * SHM_V, pa0, pa1, pa2, pa3); }
    if constexpr (SWA) l_reg += __builtin_amdgcn_exp2f(U.sinkl2 - m_reg);
    if (hi == 0) li_l[r32] = l_reg; asm volatile("s_waitcnt lgkmcnt(0)" ::: "memory");
    float rli[16];
#pragma unroll
    for (int r = 0; r < 16; ++r) rli[r] = __builtin_amdgcn_rcpf(li_l[crow(r, hi)]);
    bf16_t* Ow = U.O + (size_t)(wid * QBLK) * LDO;
#pragma unroll
    for (int r = 0; r < 16; ++r) { const int orow = crow(r, hi);
#pragma unroll
        for (int d0 = 0; d0 < NCB; ++d0) Ow[(size_t)orow * LDO + d0 * 32 + r32] = (bf16_t)f2bf(o[d0][r] * rli[r]); }
    __syncthreads();
#undef SLOAD
#undef SWRITE
#undef RESC
#undef ACTIVE
#undef MASK
#undef ROT
#undef STEP
}
#undef SBAR
#undef KSWZ
}

struct Args { const float* in[32]; float* out; unsigned char* ws; int nprog, pad; unsigned char prog[64]; };
struct ArgsD { const GAS float* in[32]; GAS float* out; GAS unsigned char* ws; int nprog, pad; unsigned char prog[64]; };
typedef const __attribute__((address_space(4))) ArgsD* ArgsP;
#define APIN(i) ((const float*)ap->in[i])
#define APOUT ((float*)ap->out)

struct Frame {
    LAS unsigned char* lds;
    int tid, lane, wave, vcu, G, gw, NGW;
    unsigned char* ws;
};

__device__ __forceinline__ int rope_src(int p) { return 16 * ((p >> 2) & 1) + 4 * (p >> 3) + (p & 3); }
__device__ __forceinline__ void transpose_item(const float* W, int N, bf16_t* WT, int src0, int dst_row0, int k0, bool perm, LAS float* scr, int lane) {
    float tv[32];
#pragma unroll
    for (int i = 0; i < 32; ++i) { const int kk = 2 * i + (lane >> 5); tv[i] = W[(size_t)(k0 + kk) * N + src0 + (lane & 31)]; }
#pragma unroll
    for (int i = 0; i < 32; ++i) { const int kk = 2 * i + (lane >> 5); scr[kk * 33 + (lane & 31)] = tv[i]; }
    LDS_WAIT(); asm volatile("" ::: "memory");
    const int c = lane & 7;
#pragma unroll
    for (int j = 0; j < 4; ++j) { const int n = (lane >> 3) + 8 * j; const int sn = perm ? rope_src(n) : n; const LAS float* s = scr + (8 * c) * 33 + sn;
        u32x4 o; o.x = pk2(s[0 * 33], s[1 * 33]); o.y = pk2(s[2 * 33], s[3 * 33]); o.z = pk2(s[4 * 33], s[5 * 33]); o.w = pk2(s[6 * 33], s[7 * 33]);
        *(u32x4*)(WT + (size_t)(dst_row0 + n) * DM + k0 + 8 * c) = o; }
    LDS_WAIT(); asm volatile("" ::: "memory");
}
__device__ __forceinline__ void transpose_item8(const float* W, int N, unsigned char* WT, int src0, int dst_row0, int k0, LAS float* scr, int lane) {
    float tv[32];
#pragma unroll
    for (int i = 0; i < 32; ++i) { const int kk = 2 * i + (lane >> 5); tv[i] = W[(size_t)(k0 + kk) * N + src0 + (lane & 31)]; }
#pragma unroll
    for (int i = 0; i < 32; ++i) { const int kk = 2 * i + (lane >> 5); scr[kk * 33 + (lane & 31)] = tv[i] * 32.f; }
    LDS_WAIT(); asm volatile("" ::: "memory");
    const int c = lane & 7;
#pragma unroll
    for (int j = 0; j < 4; ++j) { const int n = (lane >> 3) + 8 * j; const LAS float* s = scr + (8 * c) * 33 + n;
        u32x2 o; o.x = pk4_fp8(s[0 * 33], s[1 * 33], s[2 * 33], s[3 * 33]); o.y = pk4_fp8(s[4 * 33], s[5 * 33], s[6 * 33], s[7 * 33]);
        *(u32x2*)(WT + (size_t)(dst_row0 + n) * DM + k0 + 8 * c) = o; }
    LDS_WAIT(); asm volatile("" ::: "memory");
}
__device__ __forceinline__ float silu_f(float v) { return v / (1.f + __expf(-v)); }

__device__ __forceinline__ void p0_prologue(Frame& F, ArgsP ap, const bool rerun) {
    LAS float* scr = (LAS float*)(F.lds + F.wave * 16384);
    unsigned char* ws = F.ws;
    if (F.gw < 16) { const int pos = F.gw * 4 + (F.lane >> 4), f = F.lane & 15;
        const float inv = __builtin_amdgcn_exp2f(-(float)f * (13.287712379549449f / 16.f));
        const float ang = (float)pos * inv, rev = ang * 0.15915494309189535f;
        float* rp = (float*)(ws + WS_ROPE);
        rp[pos * 16 + f] = __builtin_amdgcn_cosf(rev); rp[1024 + pos * 16 + f] = __builtin_amdgcn_sinf(rev); }
    for (int it = F.gw; it < (rerun ? 0 : 2 * 16 * 24); it += F.NGW) {
        const int layer = it / 384, r = it % 384, kc = r / 24, nb = r % 24;
        const float* W = APIN(layer ? 20 : 4); const float* bias = APIN(layer ? 21 : 5);
        const int k0 = kc * 64, n0 = nb * 256 + 4 * F.lane;
        float sv[9];
#pragma unroll
        for (int b = 0; b < 8; ++b) sv[b] = silu_f(APIN(1)[b * DM + k0 + F.lane]);
        sv[8] = silu_f(APIN(3)[k0 + F.lane]);
        f32x4 acc[9];
#pragma unroll
        for (int b = 0; b < 9; ++b) acc[b] = (f32x4){0.f, 0.f, 0.f, 0.f};
        if (kc == 0) { const f32x4 bv = *(const f32x4*)(bias + n0);
#pragma unroll
            for (int b = 0; b < 9; ++b) acc[b] = bv; }
#pragma unroll 4
        for (int kk = 0; kk < 64; ++kk) { const f32x4 w = *(const f32x4*)(W + (size_t)(k0 + kk) * 6144 + n0);
#pragma unroll
            for (int b = 0; b < 9; ++b) { const float s = __builtin_bit_cast(float, __builtin_amdgcn_readlane(__builtin_bit_cast(int, sv[b]), kk)); acc[b] += w * s; } }
        float* mod = (float*)(ws + WS_MOD) + (size_t)layer * 9 * 6144;
#pragma unroll
        for (int b = 0; b < 9; ++b)
#pragma unroll
            for (int j = 0; j < 4; ++j) atomicAdd(mod + b * 6144 + n0 + j, acc[b][j]);
    }
    constexpr int I_IN = 96 * 16, I_O = 32 * 16, I_GU = 16 * 64 * 16, I_D = 16 * 32 * 16, I_QKV = 48 * 16;
    constexpr int NITEMS = I_IN + I_O + I_GU + I_D + I_QKV + I_O + I_GU + I_D;
    for (int it = F.gw; it < NITEMS; it += F.NGW) {
        int r = it;
        if (r < I_IN) { const int g = r / 16, kb = r % 16, r0 = 32 * g; int src0; bool perm = false;
            if (r0 < 512) src0 = r0;
            else if (r0 < 1536) { const int u = (r0 - 512) / 256, w = (r0 - 512) % 256; src0 = w < 128 ? 512 + u * 128 + w : 1024 + u * 128 + (w - 128); }
            else if (r0 < 2560) { src0 = r0; perm = true; }
            else src0 = r0;
            transpose_item(APIN(7), NWIN, (bf16_t*)(ws + W_IN), src0, r0, kb * 64, perm, scr, F.lane); continue; }
        r -= I_IN;
        if (r < I_O) { const int g = r / 16, kb = r % 16; transpose_item(APIN(14), DM, (bf16_t*)(ws + W_OUT0), 32 * g, 32 * g, kb * 64, false, scr, F.lane); continue; }
        r -= I_O;
        if (r < I_GU) { const int e = r / 1024, g = (r % 1024) / 16, kb = r % 16, r0 = 32 * g, u = r0 / 256, w = r0 % 256;
            const float* src = (w < 128 ? APIN(17) : APIN(18)) + (size_t)e * DM * FF;
            transpose_item8(src, FF, (unsigned char*)(ws + W_GU0) + (size_t)e * 2 * FF * DM, u * 128 + (w & 127), r0, kb * 64, scr, F.lane); continue; }
        r -= I_GU;
        if (r < I_D) { const int e = r / 512, g = (r % 512) / 16, kb = r % 16;
            transpose_item8(APIN(19) + (size_t)e * FF * DM, DM, (unsigned char*)(ws + W_D0) + (size_t)e * DM * FF, 32 * g, 32 * g, kb * 64, scr, F.lane); continue; }
        r -= I_D;
        if (r < I_QKV) { const int g = r / 16, kb = r % 16, r0 = 32 * g;
            transpose_item(APIN(23), NQKV1, (bf16_t*)(ws + W_QKV), r0, r0, kb * 64, r0 < 1280, scr, F.lane); continue; }
        r -= I_QKV;
        if (r < I_O) { const int g = r / 16, kb = r % 16; transpose_item(APIN(25), DM, (bf16_t*)(ws + W_OUT1), 32 * g, 32 * g, kb * 64, false, scr, F.lane); continue; }
        r -= I_O;
        if (r < I_GU) { const int e = r / 1024, g = (r % 1024) / 16, kb = r % 16, r0 = 32 * g, u = r0 / 256, w = r0 % 256;
            const float* src = (w < 128 ? APIN(28) : APIN(29)) + (size_t)e * DM * FF;
            transpose_item8(src, FF, (unsigned char*)(ws + W_GU1) + (size_t)e * 2 * FF * DM, u * 128 + (w & 127), r0, kb * 64, scr, F.lane); continue; }
        r -= I_GU;
        { const int e = r / 512, g = (r % 512) / 16, kb = r % 16;
            transpose_item8(APIN(30) + (size_t)e * FF * DM, DM, (unsigned char*)(ws + W_D1) + (size_t)e * DM * FF, 32 * g, 32 * g, kb * 64, scr, F.lane); }
    }
}

__device__ __forceinline__ void load_row(const float* p, int lane, f32x4 (&v)[4]) {
    const f32x4* r = (const f32x4*)p + lane;
#pragma unroll
    for (int j = 0; j < 4; ++j) v[j] = r[64 * j];
}
__device__ __forceinline__ void wave_range(int total, int gw, int ngw, int& r0, int& r1) { const int per = (total + ngw - 1) / ngw; r0 = gw * per; r1 = r0 + per < total ? r0 + per : total; }
__device__ __forceinline__ const float* xrow_ptr(const float* xlat, const float* xctx, int r) { return r < NLAT ? xlat + (size_t)r * DM : xctx + (size_t)(r - NLAT) * DM; }
__device__ __forceinline__ void load_mod(const float* gain, const float* shift, const float* scale, int lane, f32x4 (&ga)[4], f32x4 (&sh)[4]) {
#pragma unroll
    for (int j = 0; j < 4; ++j) { const f32x4 g = ((const f32x4*)gain)[lane + 64 * j], sc = ((const f32x4*)scale)[lane + 64 * j]; ga[j] = g * (sc + 1.0f); sh[j] = ((const f32x4*)shift)[lane + 64 * j]; }
}
__device__ __forceinline__ void modulate_row(f32x4 (&v)[4], const f32x4 (&ga)[4], const f32x4 (&sh)[4], int lane, bf16_t* orow) {
    float s = 0.f;
#pragma unroll
    for (int j = 0; j < 4; ++j) s += (v[j].x * v[j].x + v[j].y * v[j].y) + (v[j].z * v[j].z + v[j].w * v[j].w);
    const float rs = 1.f / sqrtf(wave_sum(s) * (1.f / DM) + NORM_EPS);
    u32x2* o8 = (u32x2*)orow + lane;
#pragma unroll
    for (int j = 0; j < 4; ++j) { v[j] = (v[j] * rs) * ga[j] + sh[j];
        u32x2 w; w.x = cvt_pk_bf16(v[j].x, v[j].y); w.y = cvt_pk_bf16(v[j].z, v[j].w); o8[64 * j] = w; }
}
__device__ __forceinline__ void norm1_phase(Frame& F, const float* xlat, const float* xctx, const float* gain, const float* mod) {
    bf16_t* XN = (bf16_t*)(F.ws + A_XN);
    int r0, r1; wave_range(MALL, F.gw, F.NGW, r0, r1);
    f32x4 v[4], vn[4], ga[4], sh[4]; int cb = -1;
    if (r0 < r1) load_row(xrow_ptr(xlat, xctx, r0), F.lane, vn);
    for (int r = r0; r < r1; ++r) {
#pragma unroll
        for (int j = 0; j < 4; ++j) v[j] = vn[j];
        if (r + 1 < r1) load_row(xrow_ptr(xlat, xctx, r + 1), F.lane, vn);
        const int b = r < NLAT ? (r >> 12) : 8;
        if (b != cb) { cb = b; load_mod(gain, mod + (size_t)b * 6144, mod + (size_t)b * 6144 + 1024, F.lane, ga, sh); }
        modulate_row(v, ga, sh, F.lane, XN + (size_t)r * DM);
    }
}
__device__ __forceinline__ void load_router(Frame& F, const float* Wr) {
    LAS float* Wt = (LAS float*)F.lds;
    for (int i = F.tid; i < DM * 4; i += NTHREADS) { const int k = i >> 2, e4 = (i & 3) * 4; const f32x4 w = *(const f32x4*)(Wr + k * 16 + e4);
        Wt[(e4 + 0) * DM + k] = w.x; Wt[(e4 + 1) * DM + k] = w.y; Wt[(e4 + 2) * DM + k] = w.z; Wt[(e4 + 3) * DM + k] = w.w; }
    __syncthreads();
}
__device__ __forceinline__ void norm2_router_phase(Frame& F, const float* xlat, const float* xctx, int nrows, const float* gain, const float* mod, const float* Wr) {
    load_router(F, Wr);
    const LAS float* Wt = (const LAS float*)F.lds;
    unsigned char* XN8 = (unsigned char*)(F.ws + A_XN); float* AFF = (float*)(F.ws + WS_AFF);
    int r0, r1; wave_range(nrows, F.gw, F.NGW, r0, r1);
    f32x4 v[4], vn[4], ga[4], sh[4]; int cb = -1;
    const int l = F.lane;
    if (r0 < r1) load_row(xrow_ptr(xlat, xctx, r0), l, vn);
    for (int r = r0; r < r1; ++r) {
#pragma unroll
        for (int j = 0; j < 4; ++j) v[j] = vn[j];
        if (r + 1 < r1) load_row(xrow_ptr(xlat, xctx, r + 1), l, vn);
        const int b = r < NLAT ? (r >> 12) : 8;
        if (b != cb) { cb = b; load_mod(gain, mod + (size_t)b * 6144 + 3 * 1024, mod + (size_t)b * 6144 + 4 * 1024, l, ga, sh); }
        {
            float s = 0.f;
#pragma unroll
            for (int j = 0; j < 4; ++j) s += (v[j].x * v[j].x + v[j].y * v[j].y) + (v[j].z * v[j].z + v[j].w * v[j].w);
            const float rs = 1.f / sqrtf(wave_sum(s) * (1.f / DM) + NORM_EPS);
            unsigned* o4 = (unsigned*)(XN8 + (size_t)r * DM) + l;
#pragma unroll
            for (int j = 0; j < 4; ++j) { v[j] = (v[j] * rs) * ga[j] + sh[j]; o4[64 * j] = pk4_fp8(v[j].x, v[j].y, v[j].z, v[j].w); } }
        float lg[16];
#pragma unroll
        for (int e = 0; e < 16; ++e) { float s = 0.f;
#pragma unroll
            for (int j = 0; j < 4; ++j) { const f32x4 w = *(const LAS f32x4*)(Wt + e * DM + 4 * l + 256 * j); s += (v[j].x * w.x + v[j].y * w.y) + (v[j].z * w.z + v[j].w * w.w); }
            lg[e] = s; if ((e & 3) == 3) __builtin_amdgcn_sched_barrier(0); }
        float a8[8];
#pragma unroll
        for (int i = 0; i < 8; ++i) { const bool up = (l & 32) != 0; const float keep = up ? lg[8 + i] : lg[i], send = up ? lg[i] : lg[8 + i]; a8[i] = keep + __shfl_xor(send, 32); }
        float a4[4];
#pragma unroll
        for (int i = 0; i < 4; ++i) { const bool up = (l & 16) != 0; const float keep = up ? a8[4 + i] : a8[i], send = up ? a8[i] : a8[4 + i]; a4[i] = keep + __shfl_xor(send, 16); }
        float a2[2];
#pragma unroll
        for (int i = 0; i < 2; ++i) { const bool up = (l & 8) != 0; const float keep = up ? a4[2 + i] : a4[i], send = up ? a4[i] : a4[2 + i]; a2[i] = keep + dpp_f<0x128>(send); }
        float a1;
        { const bool up = (l & 4) != 0; const float keep = up ? a2[1] : a2[0], send = up ? a2[0] : a2[1]; a1 = keep + dpp_f<0x141>(send); }
        a1 += dpp_f<0x4E>(a1); a1 += dpp_f<0xB1>(a1);
        float mx = a1;
        mx = fmaxf(mx, dpp_f<0x141>(mx)); mx = fmaxf(mx, dpp_f<0x128>(mx)); mx = fmaxf(mx, __shfl_xor(mx, 16)); mx = fmaxf(mx, __shfl_xor(mx, 32));
        const float ex = __expf(a1 - mx);
        float den = ex; den += dpp_f<0x141>(den); den += dpp_f<0x128>(den); den += __shfl_xor(den, 16); den += __shfl_xor(den, 32);
        if ((l & 3) == 0) AFF[(size_t)r * 16 + (l >> 2)] = ex / den;
    }
    __syncthreads();
}

__device__ __forceinline__ void mix0_combine_phase(Frame& F, ArgsP ap) {
    const bf16_t* BG = (const bf16_t*)(F.ws + A_BG); const bf16_t* CX = (const bf16_t*)(F.ws + A_CX); const bf16_t* OH = (const bf16_t*)(F.ws + A_OH);
    bf16_t* AO = (bf16_t*)(F.ws + A_XN);
    float d1 = APIN(9)[F.lane] * APIN(10)[F.lane], d2 = APIN(11)[F.lane] * APIN(12)[F.lane];
    const float lam = __expf(wave_sum(d1)) - __expf(wave_sum(d2)) + LAM_INIT;
    const int l = F.lane;
    float cw0[8], cw1[8], cw2[8], sg[8];
#pragma unroll
    for (int i = 0; i < 8; ++i) { cw0[i] = APIN(8)[8 * l + i]; cw1[i] = APIN(8)[512 + 8 * l + i]; cw2[i] = APIN(8)[1024 + 8 * l + i]; sg[i] = APIN(13)[(l & 15) * 8 + i] * (1.f - LAM_INIT); }
    const int h = l >> 4, d0 = (l & 15) * 8;
    int r0, r1; wave_range(MALL, F.gw, F.NGW, r0, r1);
    if (r0 >= r1) return;
    const u32x4 zero = (u32x4){0u, 0u, 0u, 0u};
#define CXROW(r) (*(const u32x4*)(CX + (size_t)(r) * 512 + 8 * l))
    u32x4 c0 = r0 > 0 ? CXROW(r0 - 1) : zero, c1 = CXROW(r0), c2 = r0 + 1 < MALL ? CXROW(r0 + 1) : zero, c3;
    u32x4 bgn = *(const u32x4*)(BG + (size_t)r0 * 512 + 8 * l);
    u32x4 o1n = *(const u32x4*)(OH + (size_t)r0 * DM + (2 * h) * 128 + d0), o2n = *(const u32x4*)(OH + (size_t)r0 * DM + (2 * h + 1) * 128 + d0);
    for (int r = r0; r < r1; ++r) {
        const u32x4 bgv = bgn, o1 = o1n, o2 = o2n;
        c3 = r + 2 < MALL ? CXROW(r + 2) : zero;
        if (r + 1 < r1) { bgn = *(const u32x4*)(BG + (size_t)(r + 1) * 512 + 8 * l);
            o1n = *(const u32x4*)(OH + (size_t)(r + 1) * DM + (2 * h) * 128 + d0); o2n = *(const u32x4*)(OH + (size_t)(r + 1) * DM + (2 * h + 1) * 128 + d0); }
        const bool lat = r < NLAT; const int t = lat ? (r & (SEQ - 1)) : ((r - NLAT) & (CTX - 1)); const int tl = lat ? SEQ : CTX;
        const u32x4 ca = t > 0 ? c0 : zero, cc = t < tl - 1 ? c2 : zero;
        u32x4 ow;
#pragma unroll
        for (int i = 0; i < 4; ++i) {
            const float lo = bf_lo(bgv[i]) * (cw0[2 * i] * bf_lo(ca[i]) + cw1[2 * i] * bf_lo(c1[i]) + cw2[2 * i] * bf_lo(cc[i]));
            const float hi = bf_hi(bgv[i]) * (cw0[2 * i + 1] * bf_hi(ca[i]) + cw1[2 * i + 1] * bf_hi(c1[i]) + cw2[2 * i + 1] * bf_hi(cc[i]));
            ow[i] = cvt_pk_bf16(lo, hi); }
        *(u32x4*)(AO + (size_t)r * DM + 8 * l) = ow;
        c0 = c1; c1 = c2; c2 = c3;
        float ov[8]; float ss = 0.f;
#pragma unroll
        for (int i = 0; i < 4; ++i) { ov[2 * i] = bf_lo(o1[i]) - lam * bf_lo(o2[i]); ov[2 * i + 1] = bf_hi(o1[i]) - lam * bf_hi(o2[i]); ss += ov[2 * i] * ov[2 * i] + ov[2 * i + 1] * ov[2 * i + 1]; }
        ss = row16_sum(ss);
        const float rs = 1.f / sqrtf(ss * (1.f / 128.f) + NORM_EPS);
        u32x4 ow2;
#pragma unroll
        for (int i = 0; i < 4; ++i) ow2[i] = cvt_pk_bf16(ov[2 * i] * rs * sg[2 * i], ov[2 * i + 1] * rs * sg[2 * i + 1]);
        *(u32x4*)(AO + (size_t)r * DM + 512 + h * 128 + d0) = ow2;
    }
#undef CXROW
}

__device__ __forceinline__ unsigned block_excl_scan(unsigned v, LAS unsigned* sc, int tid, unsigned& total) {
    unsigned x = v;
#pragma unroll
    for (int o = 1; o < 64; o <<= 1) { const unsigned y = __shfl_up(x, o); if ((tid & 63) >= o) x += y; }
    if ((tid & 63) == 63) sc[tid >> 6] = x;
    __syncthreads();
    unsigned base = 0, tot = 0;
#pragma unroll
    for (int w = 0; w < 8; ++w) { const unsigned s = sc[w]; if (w < (tid >> 6)) base += s; tot += s; }
    __syncthreads();
    total = tot;
    return base + x - v;
}
__device__ __forceinline__ void topk_list(Frame& F, int row0, int n, int e, int cap, int slot_row0) {
    LAS unsigned* sc = (LAS unsigned*)F.lds;
    LAS unsigned* cw = sc + 16;
    const float* AFF = (const float*)(F.ws + WS_AFF); int* POS = (int*)(F.ws + WS_POS); int* IDX = (int*)(F.ws + WS_IDX);
    const int tid = F.tid, wave = tid >> 6;
    const int per = 8; const int base = tid * per; const bool act = base < n;
    unsigned kk[8];
#pragma unroll
    for (int i = 0; i < per; ++i) kk[i] = act ? __builtin_bit_cast(unsigned, AFF[(size_t)(row0 + base + i) * 16 + e]) : 0u;
    unsigned T = 0; int it = 0;
    for (int bit = 30; bit >= 0; --bit, ++it) {
        const unsigned cand = T | (1u << bit);
        unsigned c = 0;
#pragma unroll
        for (int i = 0; i < per; ++i) c += (unsigned)__builtin_popcountll(__ballot(act && kk[i] >= cand));
        if ((tid & 63) == 0) cw[(it & 1) * 8 + wave] = c;
        __syncthreads();
        unsigned tot = 0;
#pragma unroll
        for (int w = 0; w < 8; ++w) tot += cw[(it & 1) * 8 + w];
        if (tot >= (unsigned)cap) T = cand;
    }
    __syncthreads();
    const unsigned prefix = T;
    unsigned ngt_l = 0, neq = 0;
#pragma unroll
    for (int i = 0; i < per; ++i) { ngt_l += (act && kk[i] > prefix) ? 1u : 0u; neq += (act && kk[i] == prefix) ? 1u : 0u; }
    unsigned ngt; (void)block_excl_scan(ngt_l, sc, tid, ngt);
    const unsigned krem = (unsigned)cap - ngt;
    unsigned tot; const unsigned eq_before = block_excl_scan(neq, sc, tid, tot);
    unsigned nsel = 0; unsigned selm = 0; unsigned eqc = eq_before;
#pragma unroll
    for (int i = 0; i < per; ++i) { bool s = false; if (act) { if (kk[i] > prefix) s = true; else if (kk[i] == prefix) { s = eqc < krem; ++eqc; } } if (s) { selm |= 1u << i; ++nsel; } }
    const unsigned sel_before = block_excl_scan(nsel, sc, tid, tot);
    unsigned slot = sel_before;
    if (act) {
#pragma unroll
        for (int i = 0; i < per; ++i) { const int row = row0 + base + i;
            if (selm & (1u << i)) { IDX[e * EROWS0 + slot_row0 + slot] = row; POS[(size_t)row * 16 + e] = slot_row0 + (int)slot; ++slot; }
            else POS[(size_t)row * 16 + e] = -1; }
    }
    __syncthreads();
}
__device__ __forceinline__ void topk_phase(Frame& F, bool with_ctx) {
    const int nl = with_ctx ? 256 : 128;
    for (int lid = F.vcu; lid < nl; lid += F.G) {
        if (lid < 128) { const int b = lid >> 4, e = lid & 15; topk_list(F, b * SEQ, SEQ, e, CAP_L, b * CAP_L); }
        else { const int b = (lid - 128) >> 4, e = lid & 15; topk_list(F, NLAT + b * CTX, CTX, e, CAP_C, NB * CAP_L + b * CAP_C); }
    }
}
__device__ __forceinline__ void gather_phase(Frame& F, int erows) {
    const int* IDX = (const int*)(F.ws + WS_IDX); const bf16_t* XN = (const bf16_t*)(F.ws + A_XN); bf16_t* HS = (bf16_t*)(F.ws + A_HS);
    const int total = NE * erows;
    int r0, r1; wave_range(total, F.gw, F.NGW, r0, r1);
    for (int base = r0; base < r1; base += 64) {
        const int n = r1 - base < 64 ? r1 - base : 64;
        int myidx = 0;
        if (F.lane < n) { const int i = base + F.lane; const int e = i / erows, s = i - e * erows; myidx = __hip_atomic_load(IDX + e * EROWS0 + s, RLX_AGENT); }
        for (int k = 0; k < n; k += 4) {
            u32x4 va[4], vb[4];
#pragma unroll
            for (int q = 0; q < 4; ++q) { const int kk = k + q < n ? k + q : n - 1; const int src = __builtin_amdgcn_readlane(myidx, kk);
                const u32x4* sp = (const u32x4*)(XN + (size_t)src * DM) + F.lane; va[q] = sp[0]; vb[q] = sp[64]; }
#pragma unroll
            for (int q = 0; q < 4; ++q) { if (k + q < n) { u32x4* dp = (u32x4*)(HS + (size_t)(base + k + q) * DM) + F.lane; dp[0] = va[q]; dp[64] = vb[q]; } }
        }
    }
}
__device__ __forceinline__ void moe_combine_phase(Frame& F, float* xlat, float* xctx, int nrows, int erows, const float* mod_cur, bool final_norm,
                                                  const float* gain_next, const float* mod_next, float* outp) {
    const float* AFF = (const float*)(F.ws + WS_AFF); const int* POS = (const int*)(F.ws + WS_POS); const bf16_t* Y = (const bf16_t*)(F.ws + A_HS);
    bf16_t* XN = (bf16_t*)(F.ws + A_XN);
    int r0, r1; wave_range(nrows, F.gw, F.NGW, r0, r1);
    if (r0 >= r1) return;
    const int l = F.lane;
    f32x4 v[4], vn[4], ga[4], sh[4], g2[4]; int cb = -1; int pos_n = -1; float af_n = 0.f;
    load_row(xrow_ptr(xlat, xctx, r0), l, vn);
    if (l < 16) { pos_n = POS[(size_t)r0 * 16 + l]; af_n = AFF[(size_t)r0 * 16 + l]; }
    for (int r = r0; r < r1; ++r) {
#pragma unroll
        for (int j = 0; j < 4; ++j) v[j] = vn[j];
        const int pos = pos_n; const float af = af_n;
        if (r + 1 < r1) { load_row(xrow_ptr(xlat, xctx, r + 1), l, vn); if (l < 16) { pos_n = POS[(size_t)(r + 1) * 16 + l]; af_n = AFF[(size_t)(r + 1) * 16 + l]; } }
        const int b = r < NLAT ? (r >> 12) : 8;
        if (b != cb) { cb = b;
#pragma unroll
            for (int j = 0; j < 4; ++j) g2[j] = ((const f32x4*)(mod_cur + (size_t)b * 6144 + 5 * 1024))[l + 64 * j];
            if (!final_norm) load_mod(gain_next, mod_next + (size_t)b * 6144, mod_next + (size_t)b * 6144 + 1024, l, ga, sh);
            else {
#pragma unroll
                for (int j = 0; j < 4; ++j) ga[j] = ((const f32x4*)gain_next)[l + 64 * j]; } }
        f32x4 acc[4];
#pragma unroll
        for (int j = 0; j < 4; ++j) acc[j] = (f32x4){0.f, 0.f, 0.f, 0.f};
        unsigned long long m = __ballot(pos >= 0);
        while (m) {
            const int e0 = __builtin_ctzll(m); m &= m - 1; const bool two = m != 0; const int e1 = two ? __builtin_ctzll(m) : e0; if (two) m &= m - 1;
            const int p0 = __builtin_amdgcn_readlane(pos, e0), p1 = __builtin_amdgcn_readlane(pos, e1);
            const float w0 = __builtin_bit_cast(float, __builtin_amdgcn_readlane(__builtin_bit_cast(int, af), e0));
            const float w1 = two ? __builtin_bit_cast(float, __builtin_amdgcn_readlane(__builtin_bit_cast(int, af), e1)) : 0.f;
            const u32x2* y0 = (const u32x2*)(Y + ((size_t)e0 * erows + p0) * DM) + l; const u32x2* y1 = (const u32x2*)(Y + ((size_t)e1 * erows + p1) * DM) + l;
            u32x2 ya[4], yb[4];
#pragma unroll
            for (int j = 0; j < 4; ++j) { ya[j] = y0[64 * j]; yb[j] = y1[64 * j]; }
#pragma unroll
            for (int j = 0; j < 4; ++j) {
                acc[j].x += w0 * bf_lo(ya[j].x) + w1 * bf_lo(yb[j].x); acc[j].y += w0 * bf_hi(ya[j].x) + w1 * bf_hi(yb[j].x);
                acc[j].z += w0 * bf_lo(ya[j].y) + w1 * bf_lo(yb[j].y); acc[j].w += w0 * bf_hi(ya[j].y) + w1 * bf_hi(yb[j].y); }
        }
#pragma unroll
        for (int j = 0; j < 4; ++j) v[j] = v[j] + g2[j] * acc[j];
        if (!final_norm) {
            f32x4* xo = (f32x4*)(r < NLAT ? xlat + (size_t)r * DM : xctx + (size_t)(r - NLAT) * DM) + l;
#pragma unroll
            for (int j = 0; j < 4; ++j) xo[64 * j] = v[j];
            modulate_row(v, ga, sh, l, XN + (size_t)r * DM);
        } else {
            float s = 0.f;
#pragma unroll
            for (int j = 0; j < 4; ++j) s += (v[j].x * v[j].x + v[j].y * v[j].y) + (v[j].z * v[j].z + v[j].w * v[j].w);
            const float rs = 1.f / sqrtf(wave_sum(s) * (1.f / DM) + NORM_EPS);
            f32x4* xo = (f32x4*)(outp + (size_t)r * DM) + l;
#pragma unroll
            for (int j = 0; j < 4; ++j) xo[64 * j] = (v[j] * rs) * ga[j];
        }
    }
}

__device__ __forceinline__ void attn0_phase(Frame& F, const bool rerun) {
    const bf16_t* Q0 = (const bf16_t*)(F.ws + A_Q0); const bf16_t* K0 = (const bf16_t*)(F.ws + A_K0); const bf16_t* V0 = (const bf16_t*)(F.ws + A_V0);
    bf16_t* OH = (bf16_t*)(F.ws + A_OH);
    const int per = (1024 + F.G - 1) / F.G;
    for (int i = 0; i <= per; ++i) {
        att::UnitDesc U; int b, sh, qrow0;
        if (i < per) { const int u = F.vcu * per + i; if (u >= 1024) continue; b = u >> 7; sh = (u & 127) >> 4; const int qb = u & 15; qrow0 = b * SEQ + qb * 256; U.NT = 68; }
        else { const int cu = F.vcu; if (cu >= 64) continue; b = cu >> 3; sh = cu & 7; qrow0 = NLAT + b * CTX; U.NT = 4; }
        U.Q = Q0 + (size_t)qrow0 * 512 + sh * 64; U.ldq = 512;
        U.K = K0 + sh * 64; U.V = V0 + (sh >> 1) * 128; U.ldk = 512; U.ldv = 512;
        U.O = OH + (size_t)qrow0 * DM + sh * 128; U.ldo = DM;
        U.ctx_row0 = NLAT + b * CTX; U.lat_row0 = b * SEQ; U.lat_t0 = 0; U.q0 = 0; U.sinkl2 = 0.f;
#if PROBE_ABL
        if (rerun) { U.O = (bf16_t*)(F.ws + A_OH + SZ_XN + 4096) + sh * 128; att::attn_unit<128, false, PROBE_ABL>(U, (LAS char*)F.lds, F.tid); } else
#endif
        att::attn_unit<128, false>(U, (LAS char*)F.lds, F.tid);
    }
}
__device__ __forceinline__ void attn1_phase(Frame& F, const float* sink) {
    const bf16_t* Q1 = (const bf16_t*)(F.ws + A_Q1); const bf16_t* K1 = (const bf16_t*)(F.ws + A_K1); const bf16_t* V1 = (const bf16_t*)(F.ws + A_V1);
    bf16_t* AO = (bf16_t*)(F.ws + A_XN);
    const int per = (2048 + F.G - 1) / F.G;
    for (int i = 0; i < per; ++i) {
        const int u = F.vcu * per + i; if (u >= 2048) continue;
        const int b = u >> 8, head = (u & 255) >> 4, qb = u & 15, q0 = qb * 256, qrow0 = b * SEQ + q0;
        att::UnitDesc U;
        U.Q = Q1 + (size_t)qrow0 * DM + head * 64; U.ldq = DM;
        U.K = K1 + (head >> 2) * 64; U.V = V1 + (head >> 2) * 64; U.ldk = 256; U.ldv = 256;
        U.O = AO + (size_t)qrow0 * DM + head * 64; U.ldo = DM;
        const int lo = q0 - 128 < 0 ? 0 : q0 - 128, hi = q0 + 384 > SEQ ? SEQ : q0 + 384;
        U.ctx_row0 = NLAT + b * CTX; U.lat_row0 = b * SEQ; U.lat_t0 = lo >> 6; U.NT = 4 + ((hi - lo) >> 6);
        U.q0 = q0; U.sinkl2 = sink[head] * att::LOG2E;
        att::attn_unit<64, true>(U, (LAS char*)F.lds, F.tid);
    }
}

constexpr int N_PHASES = 21;
#ifndef PH_EN
#define PH_EN(p) ((p) != 8 && (p) != 17)
#endif
#ifndef GEMM_EN
#define GEMM_EN 1
#endif
__global__ void __launch_bounds__(NTHREADS, 2) fwd_kernel(Args args) {
    extern __shared__ __attribute__((aligned(16))) unsigned char lds_raw[];
    Frame F;
    F.lds = (LAS unsigned char*)lds_raw;
    F.tid = threadIdx.x; F.lane = F.tid & 63; F.wave = __builtin_amdgcn_readfirstlane(F.tid >> 6);
    F.G = gridDim.x; { const int bx = blockIdx.x; F.vcu = (F.G % 8 == 0) ? (bx % 8) * (F.G / 8) + bx / 8 : bx; }
    F.gw = F.vcu * NWAVES + F.wave; F.NGW = F.G * NWAVES;
    F.ws = args.ws;
    unsigned char* ws = args.ws;
    volatile LAS unsigned* MISC = (volatile LAS unsigned*)(F.lds + MISC_OFF);
    for (int u = F.tid; u < (LDS_BYTES - RING_BYTES) / 4; u += NTHREADS) ((LAS unsigned*)(F.lds + RING_BYTES))[u] = 0u;
    __syncthreads();
    const int nprog = args.nprog;
    XcdBarrier bar; bar.bar = (unsigned*)(ws + WS_CTL) + CW_BAR; bar.x = 0; bar.st = nullptr;
    if (nprog > 1) bar = xcd_barrier_post((unsigned*)(ws + WS_CTL) + CW_BAR, MISC + 8);

    const Frame F0 = F;
    for (int pi = 0; pi < nprog; ++pi) {
        F = F0; asm volatile("" : "+v"(F.tid), "+v"(F.lane), "+s"(F.wave), "+s"(F.vcu), "+s"(F.gw));
        ArgsP ap = (ArgsP)__builtin_amdgcn_kernarg_segment_ptr(); asm volatile("" : "+s"(ap));
        { GAS unsigned char* wsg = ap->ws; asm volatile("" : "+s"(wsg)); F.ws = (unsigned char*)wsg; }
        ws = F.ws;
        const int phx = ap->prog[pi], ph = phx & 31; const bool rerun = (phx & 32) != 0;
        const float* MOD0 = (const float*)(ws + WS_MOD); const float* MOD1 = MOD0 + 9 * 6144;
        float* XCTX = (float*)(ws + WS_XCTX);
        bool is_gemm = false, is_gemm8 = false; bool perm = true; pg8::Sched S; pg8::Epi E;
        S.G = F.G; S.c = (int)blockIdx.x; S.tpe = 1 << 20; S.pitch = 2 * DM; S.gidx = nullptr; S.A = nullptr; S.B = nullptr; S.nM = 0; S.nN = 0;
        E.kind = 0; E.layer = 0; E.f8out = false; E.wsc = 1.f; E.ws = ws; E.xin_lat = nullptr; E.xin_ctx = nullptr; E.out_lat = nullptr;
        switch (ph) {
        case 0: if (!PH_EN(0)) break; p0_prologue(F, ap, rerun); break;
        case 1: if (!PH_EN(1)) break; norm1_phase(F, APIN(0), APIN(2), APIN(6), MOD0); break;
        case 2: if (!PH_EN(2)) break; is_gemm = true; S.A = (const char*)(ws + A_XN); S.B = (const char*)(ws + W_IN); S.nM = MALL / 256; S.nN = NWIN / 256; E.kind = pg8::EK_IN0; break;
        case 3: if (!PH_EN(3)) break; attn0_phase(F, rerun); break;
        case 4: if (!PH_EN(4)) break; mix0_combine_phase(F, ap); break;
        case 5: if (!PH_EN(5)) break; is_gemm = true; perm = false; S.A = (const char*)(ws + A_XN); S.B = (const char*)(ws + W_OUT0); S.nM = MALL / 256; S.nN = DM / 256;
                E.kind = pg8::EK_OUT; E.layer = 0; E.xin_lat = APIN(0); E.xin_ctx = APIN(2); E.out_lat = APOUT; break;
        case 6: if (!PH_EN(6)) break; norm2_router_phase(F, APOUT, XCTX, MALL, APIN(15), MOD0, APIN(16)); break;
        case 7: if (!PH_EN(7)) break; topk_phase(F, true); break;
        case 8: if (!PH_EN(8)) break; gather_phase(F, EROWS0); break;
        case 9: if (!PH_EN(9)) break; is_gemm8 = true; S.pitch = DM; E.wsc = 1.f / 32.f; E.f8out = true; S.A = (const char*)(ws + A_XN); S.gidx = (const int*)(ws + WS_IDX); S.B = (const char*)(ws + W_GU0); S.nM = NE * EROWS0 / 256; S.nN = 2 * FF / 256; S.tpe = EROWS0 / 256; E.kind = pg8::EK_GU; break;
        case 10: if (!PH_EN(10)) break; is_gemm8 = true; S.pitch = DM; E.wsc = 1.f / 32.f; S.A = (const char*)(ws + A_ACT); S.B = (const char*)(ws + W_D0); S.nM = NE * EROWS0 / 256; S.nN = DM / 256; S.tpe = EROWS0 / 256; E.kind = pg8::EK_DOWN; break;
        case 11: if (!PH_EN(11)) break; moe_combine_phase(F, APOUT, XCTX, MALL, EROWS0, MOD0, false, APIN(22), MOD1, nullptr); break;
        case 12: if (!PH_EN(12)) break; is_gemm = true; S.A = (const char*)(ws + A_XN); S.B = (const char*)(ws + W_QKV); S.nM = MALL / 256; S.nN = NQKV1 / 256; E.kind = pg8::EK_QKV1; break;
        case 13: if (!PH_EN(13)) break; attn1_phase(F, APIN(24)); break;
        case 14: if (!PH_EN(14)) break; is_gemm = true; perm = false; S.A = (const char*)(ws + A_XN); S.B = (const char*)(ws + W_OUT1); S.nM = NLAT / 256; S.nN = DM / 256;
                E.kind = pg8::EK_OUT; E.layer = 1; E.xin_lat = APOUT; E.xin_ctx = XCTX; E.out_lat = APOUT; break;
        case 15: if (!PH_EN(15)) break; norm2_router_phase(F, APOUT, XCTX, NLAT, APIN(26), MOD1, APIN(27)); break;
        case 16: if (!PH_EN(16)) break; topk_phase(F, false); break;
        case 17: if (!PH_EN(17)) break; gather_phase(F, EROWS1); break;
        case 18: if (!PH_EN(18)) break; is_gemm8 = true; S.pitch = DM; E.wsc = 1.f / 32.f; E.f8out = true; S.A = (const char*)(ws + A_XN); S.gidx = (const int*)(ws + WS_IDX); S.B = (const char*)(ws + W_GU1); S.nM = NE * EROWS1 / 256; S.nN = 2 * FF / 256; S.tpe = EROWS1 / 256; E.kind = pg8::EK_GU; break;
        case 19: if (!PH_EN(19)) break; is_gemm8 = true; S.pitch = DM; E.wsc = 1.f / 32.f; S.A = (const char*)(ws + A_ACT); S.B = (const char*)(ws + W_D1); S.nM = NE * EROWS1 / 256; S.nN = DM / 256; S.tpe = EROWS1 / 256; E.kind = pg8::EK_DOWN; break;
        case 20: if (!PH_EN(20)) break; moe_combine_phase(F, APOUT, XCTX, NLAT, EROWS1, MOD1, true, APIN(31), nullptr, APOUT); break;
        default: break;
        }
        if (GEMM_EN && is_gemm) pg8::gemm_phase(F.lds, F.tid, perm, S, E);
        if (GEMM_EN && is_gemm8) pg8::gemm_phase8(F.lds, F.tid, perm, S, E);
        if (pi + 1 < nprog) { XcdBarrier bl = bar; { GAS unsigned* bp = (GAS unsigned*)(ap->ws + WS_CTL) + CW_BAR; asm volatile("" : "+s"(bp), "+s"(bl.x)); bl.bar = (unsigned*)bp; }
            xcd_barrier(bl); }
    }
}

extern "C" void kernel_launch(void* const* d_in, const int* in_sizes, int n_in, void* d_out, int out_size, void* d_ws, size_t ws_size, hipStream_t stream) {
    static int grid = 0;
    if (grid == 0) {
        if (n_in != 32 || in_sizes[0] != NLAT * DM || out_size != NLAT * DM || ws_size < WS_END) {
            fprintf(stderr, "kernel_launch: unexpected shapes: n_in %d in0 %d out %d ws %zu (need %zu)\n", n_in, n_in > 0 ? in_sizes[0] : -1, out_size, ws_size, (size_t)WS_END); grid = -1; return; }
        int dev = 0, cus = 0, per_cu = 0;
        if (hipGetDevice(&dev) != hipSuccess || hipDeviceGetAttribute(&cus, hipDeviceAttributeMultiprocessorCount, dev) != hipSuccess) { grid = -1; return; }
        if (hipFuncSetAttribute((const void*)fwd_kernel, hipFuncAttributeMaxDynamicSharedMemorySize, LDS_BYTES) != hipSuccess) { fprintf(stderr, "kernel_launch: hipFuncSetAttribute failed\n"); grid = -1; return; }
        if (hipOccupancyMaxActiveBlocksPerMultiprocessor(&per_cu, (const void*)fwd_kernel, NTHREADS, LDS_BYTES) != hipSuccess || per_cu < 1) {
            fprintf(stderr, "kernel_launch: occupancy query reports %d blocks per CU\n", per_cu); (void)hipGetLastError(); grid = -1; return; }
        grid = cus;
    }
    if (grid < 0) return;
    (void)hipMemsetAsync((char*)d_ws + WS_CTL, 0, CTL_ZERO_BYTES, stream);
    Args a{};
    for (int i = 0; i < 32; ++i) a.in[i] = (const float*)d_in[i];
    a.out = (float*)d_out; a.ws = (unsigned char*)d_ws;
#if MK_N_LAUNCHES == 1
    { int n = 0; for (int p = 0; p < N_PHASES; ++p) { if (p == 8 || p == 17) continue; a.prog[n++] = (unsigned char)p; if ((PROBE_DUP >> p) & 1u) a.prog[n++] = (unsigned char)(p | 32); } a.nprog = n; }
    hipLaunchKernelGGL(fwd_kernel, dim3(grid), dim3(NTHREADS), LDS_BYTES, stream, a);
#else
    for (int p = 0; p < N_PHASES; ++p) { a.nprog = 1; a.prog[0] = (unsigned char)p; hipLaunchKernelGGL(fwd_kernel, dim3(grid), dim3(NTHREADS), LDS_BYTES, stream, a); }
#endif
}
```

```cpp
#include <hip/hip_runtime.h>
#include <hip/hip_bf16.h>
#include <cstdio>
#include <cstdint>

#ifndef MK_N_LAUNCHES
#define MK_N_LAUNCHES 1
#endif

#ifndef PROBE_ABL
#define PROBE_ABL 0
#endif
#ifndef PROBE_MFMA
#define PROBE_MFMA 0
#endif
#ifndef PROBE_DUP
#define PROBE_DUP 0u
#endif

#define GAS __attribute__((address_space(1)))
#define LAS __attribute__((address_space(3)))
typedef unsigned short bf16_t;
typedef short bf16x8 __attribute__((ext_vector_type(8)));
typedef short s16x4 __attribute__((ext_vector_type(4)));
typedef float f32x2 __attribute__((ext_vector_type(2)));
typedef float f32x4 __attribute__((ext_vector_type(4)));
typedef float f32x16 __attribute__((ext_vector_type(16)));
typedef unsigned u32x2 __attribute__((ext_vector_type(2)));
typedef unsigned u32x4 __attribute__((ext_vector_type(4)));
typedef GAS unsigned gu32;
typedef int v8i32 __attribute__((ext_vector_type(8)));
typedef int v4i32 __attribute__((ext_vector_type(4)));

constexpr int DM = 1024, NB = 8, SEQ = 4096, CTX = 256;
constexpr int NLAT = NB * SEQ;
constexpr int NCTX = NB * CTX;
constexpr int MALL = NLAT + NCTX;
constexpr int NE = 16, FF = 1024;
constexpr int CAP_L = 512, CAP_C = 32;
constexpr int EROWS0 = NB * CAP_L + NB * CAP_C;
constexpr int EROWS1 = NB * CAP_L;
constexpr int NWIN = 3072, NQKV1 = 1536;
constexpr float NORM_EPS = 1e-6f;
constexpr float LAM_INIT = 0.2f;
constexpr int NWAVES = 8, NTHREADS = 512;

constexpr size_t KiB = 1024, MiB = 1024 * 1024;
constexpr size_t WS_CTL = 0, CTL_ZERO_BYTES = 1 * MiB;
constexpr int CW_BAR = 4096;
constexpr size_t WS_MOD = 64 * KiB;
constexpr size_t MOD_BYTES = 2 * 9 * 6144 * 4;
static_assert(WS_MOD + MOD_BYTES <= 640 * KiB, "mod");
constexpr size_t WS_ROPE = 1 * MiB;
constexpr size_t WS_PART = WS_ROPE + 16 * KiB;
constexpr size_t WS_AFF = WS_PART + (size_t)2 * 4 * 9 * 6144 * 4;
constexpr size_t WS_POS = WS_AFF + (size_t)MALL * 16 * 4;
constexpr size_t WS_IDX = WS_POS + (size_t)MALL * 16 * 4;
constexpr size_t WS_XB = (WS_IDX + (size_t)NE * EROWS0 * 4 + 4096 + 4095) / 4096 * 4096;
constexpr size_t WS_W = WS_XB + (size_t)MALL * DM * 2;
constexpr size_t W_IN = WS_W;
constexpr size_t W_OUT0 = W_IN + (size_t)NWIN * DM * 2;
constexpr size_t W_GU0 = W_OUT0 + (size_t)DM * DM * 2;
constexpr size_t W_D0 = W_GU0 + (size_t)NE * 2 * FF * DM;
constexpr size_t W_QKV = W_D0 + (size_t)NE * DM * FF;
constexpr size_t W_OUT1 = W_QKV + (size_t)NQKV1 * DM * 2;
constexpr size_t W_GU1 = W_OUT1 + (size_t)DM * DM * 2;
constexpr size_t W_D1 = W_GU1 + (size_t)NE * 2 * FF * DM;
constexpr size_t WS_ARENA = W_D1 + (size_t)NE * DM * FF;
constexpr size_t SZ_XN = (size_t)MALL * DM * 2;
constexpr size_t SZ_H5 = (size_t)MALL * 512 * 2;
constexpr size_t SZ_E = (size_t)NE * EROWS0 * DM * 2;
constexpr size_t A_XN = WS_ARENA;
constexpr size_t A_BG = A_XN + SZ_XN, A_CX = A_BG + SZ_H5, A_Q0 = A_CX + SZ_H5, A_K0 = A_Q0 + SZ_H5, A_V0 = A_K0 + SZ_H5;
constexpr size_t A_OH = A_V0 + SZ_H5;
constexpr size_t A_HS = A_XN + SZ_XN;
constexpr size_t A_ACT = A_HS + SZ_E;
constexpr size_t A_Q1 = A_XN + SZ_XN;
constexpr size_t A_K1 = A_Q1 + SZ_XN;
constexpr size_t A_V1 = A_K1 + (size_t)MALL * 256 * 2;
constexpr size_t WS_END = A_OH + SZ_XN + 1 * MiB;
static_assert(A_ACT + SZ_E / 2 <= WS_END && A_V1 + (size_t)MALL * 256 * 2 <= WS_END, "arena");
static_assert(WS_END <= 600000000ull, "workspace budget");

constexpr int RING_BYTES = 131072;
constexpr int MISC_OFF = RING_BYTES + 320;
constexpr int GT_OFF = RING_BYTES + 1024;
constexpr int LDS_BYTES = 147456;

#define RLX_AGENT __ATOMIC_RELAXED, __HIP_MEMORY_SCOPE_AGENT
#define LDS_WAIT() asm volatile("s_waitcnt lgkmcnt(0)" ::: "memory")
#define VM_WAIT() asm volatile("s_waitcnt vmcnt(0)" ::: "memory")

__device__ __forceinline__ unsigned f2bf(float f) { unsigned u = __builtin_bit_cast(unsigned, f); return (u + 0x7fffu + ((u >> 16) & 1u)) >> 16; }
__device__ __forceinline__ unsigned pk2(float lo, float hi) { return f2bf(lo) | (f2bf(hi) << 16); }
__device__ __forceinline__ unsigned cvt_pk_bf16(float lo, float hi) { unsigned r; asm volatile("v_cvt_pk_bf16_f32 %0, %1, %2" : "=v"(r) : "v"(lo), "v"(hi)); return r; }
__device__ __forceinline__ unsigned pk4_fp8(float a, float b, float c, float d) {
    a = fminf(fmaxf(a, -448.f), 448.f); b = fminf(fmaxf(b, -448.f), 448.f); c = fminf(fmaxf(c, -448.f), 448.f); d = fminf(fmaxf(d, -448.f), 448.f);
    int w = 0; w = __builtin_amdgcn_cvt_pk_fp8_f32(a, b, w, false); w = __builtin_amdgcn_cvt_pk_fp8_f32(c, d, w, true); return (unsigned)w;
}
__device__ __forceinline__ float bf_lo(unsigned w) { return __builtin_bit_cast(float, w << 16); }
__device__ __forceinline__ float bf_hi(unsigned w) { return __builtin_bit_cast(float, w & 0xffff0000u); }
template <int CTRL> __device__ __forceinline__ float dpp_f(float x) { return __builtin_bit_cast(float, __builtin_amdgcn_mov_dpp(__builtin_bit_cast(int, x), CTRL, 0xf, 0xf, true)); }
__device__ __forceinline__ float row16_sum(float v) { v += dpp_f<0xB1>(v); v += dpp_f<0x4E>(v); v += dpp_f<0x141>(v); v += dpp_f<0x128>(v); return v; }
__device__ __forceinline__ float xsum16(float v) { auto rr = __builtin_amdgcn_permlane16_swap(__float_as_uint(v), __float_as_uint(v), false, false); return __uint_as_float(rr[0]) + __uint_as_float(rr[1]); }
__device__ __forceinline__ float xsum32(float v) { auto rr = __builtin_amdgcn_permlane32_swap(__float_as_uint(v), __float_as_uint(v), false, false); return __uint_as_float(rr[0]) + __uint_as_float(rr[1]); }
__device__ __forceinline__ float xmax16(float v) { auto rr = __builtin_amdgcn_permlane16_swap(__float_as_uint(v), __float_as_uint(v), false, false); return fmaxf(__uint_as_float(rr[0]), __uint_as_float(rr[1])); }
__device__ __forceinline__ float xmax32(float v) { auto rr = __builtin_amdgcn_permlane32_swap(__float_as_uint(v), __float_as_uint(v), false, false); return fmaxf(__uint_as_float(rr[0]), __uint_as_float(rr[1])); }
__device__ __forceinline__ float wave_sum(float v) { v = row16_sum(v); v = xsum16(v); v = xsum32(v); return v; }

#define XB_TMO      128
#define XB_XCNT(j)  (256  + 64 * (j))
#define XB_XSUB(j)  (1280 + 64 * (j))
#define XB_XGEN(j)  (2304 + 64 * (j))
#define XB_TOP      3328
#define XB_TOPGEN   3392
#define XCD_BAR_WORDS 3456
#define XB_SPIN_CAP (1u << 20)
__device__ __forceinline__ unsigned xb_ld(unsigned* p)              { return __hip_atomic_load(p, __ATOMIC_RELAXED, __HIP_MEMORY_SCOPE_AGENT); }
__device__ __forceinline__ unsigned xb_add(unsigned* p, unsigned v) { return __hip_atomic_fetch_add(p, v, __ATOMIC_RELAXED, __HIP_MEMORY_SCOPE_AGENT); }
__device__ __forceinline__ unsigned xb_xcc_id() { return (unsigned)__builtin_amdgcn_s_getreg((3 << 11) | 20) & 0xFu; }
#define XB_SPIN(cond, bar) do { unsigned _sp = 0; while (cond) { __builtin_amdgcn_s_sleep(1); \
    if ((++_sp & 255u) == 0u) { if (xb_ld(&(bar)[XB_TMO])) break; if (_sp > XB_SPIN_CAP) { atomicAdd(&(bar)[XB_TMO], 1u); break; } } } } while (0)
struct XcdBarrier { unsigned* bar; unsigned x; volatile LAS unsigned* st; };
__device__ __forceinline__ XcdBarrier xcd_barrier_post(unsigned* bar, volatile LAS unsigned* st) {
    XcdBarrier b; b.bar = bar; b.x = xb_xcc_id(); b.st = st;
    if (threadIdx.x == 0) (void)xb_add(&bar[XB_XCNT(b.x)], 1u);
    return b;
}
__device__ __forceinline__ void xcd_barrier_complete(unsigned* bar, unsigned x, unsigned& nloc, unsigned& nx) {
    const unsigned G = gridDim.x * gridDim.y * gridDim.z;
    unsigned sum, cnt, mine, sp = 0u;
    for (;;) {
        sum = 0u; cnt = 0u; mine = 0u;
#pragma unroll
        for (unsigned j = 0; j < 16; ++j) { const unsigned c = xb_ld(&bar[XB_XCNT(j)]); sum += c; cnt += (c > 0u) ? 1u : 0u; mine = (j == x) ? c : mine; }
        if (sum == G) break;
        __builtin_amdgcn_s_sleep(1);
        if ((++sp & 255u) == 0u) { if (xb_ld(&bar[XB_TMO])) break; if (sp > XB_SPIN_CAP) { atomicAdd(&bar[XB_TMO], 1u); break; } }
    }
    nloc = mine > 0u ? mine : 1u; nx = cnt > 0u ? cnt : 1u;
}
__device__ __forceinline__ void xcd_barrier(const XcdBarrier& b) {
    asm volatile("s_waitcnt vmcnt(0)" ::: "memory");
    __syncthreads();
    if (threadIdx.x == 0) {
        unsigned* bar = b.bar;
        __builtin_amdgcn_s_waitcnt(0);
        unsigned nloc = b.st[0], nx = b.st[1];
        if (nloc == 0u) { xcd_barrier_complete(bar, b.x, nloc, nx); b.st[0] = nloc; b.st[1] = nx; }
        const unsigned old = xb_add(&bar[XB_XSUB(b.x)], 1u);
        const unsigned gen = old / nloc;
        if (old + 1u == (gen + 1u) * nloc) {
            __builtin_amdgcn_fence(__ATOMIC_RELEASE, "agent");
            asm volatile("s_waitcnt vmcnt(0)" ::: "memory");
            const unsigned og = xb_add(&bar[XB_TOP], 1u);
            const unsigned tg = og / nx;
            if (og + 1u == (tg + 1u) * nx) xb_add(&bar[XB_TOPGEN], 1u);
            else XB_SPIN(xb_ld(&bar[XB_TOPGEN]) == tg, bar);
            __builtin_amdgcn_fence(__ATOMIC_ACQUIRE, "agent");
            xb_add(&bar[XB_XGEN(b.x)], 1u);
            asm volatile("s_waitcnt vmcnt(0)" ::: "memory");
        } else {
            XB_SPIN(xb_ld(&bar[XB_XGEN(b.x)]) == gen, bar);
            __builtin_amdgcn_fence(__ATOMIC_ACQUIRE, "agent");
            asm volatile("s_waitcnt vmcnt(0)" ::: "memory");
        }
    }
    __syncthreads();
}

__device__ __forceinline__ int fresh_lane() { unsigned ones = ~0u; asm volatile("" : "+s"(ones)); return (int)__builtin_amdgcn_mbcnt_hi(ones, __builtin_amdgcn_mbcnt_lo(ones, 0u)); }
namespace pg8 {
constexpr int BM = 256, BK = 64, HALF = 128, HTB = HALF * BK * 2, NXCD = 8, WGM = 8;
__device__ __forceinline__ int lds_byte(int r, int c) { const int st = (r >> 4) * 2 + (c >> 5), rr = r & 15, cc = c & 31, ob = rr * 64 + cc * 2; return st * 1024 + (ob ^ (((ob >> 9) & 1) << 5)); }
__device__ __forceinline__ void stage_rc(int b, int& R, int& C) { const int st = b / 1024, sb = b % 1024, swz = sb ^ (((sb >> 9) & 1) << 5); R = (st >> 1) * 16 + swz / 64; C = (st & 1) * 32 + (swz % 64) / 2; }
__device__ __forceinline__ int perm32(int rho) { const int n = rho >> 4, i = rho & 15; return 8 * (i >> 2) + 4 * n + (i & 3); }

struct Unit { int pm, pn; const char* a; const char* b; };
struct Sched {
    const char* A; const char* B; int nM, nN, tpe, G, c, pitch, wgm; bool hot; const int* gidx;
    __device__ __forceinline__ bool next(int i, Unit& u) const {
        const int nwg = nM * nN; const long L = (long)i * G + c; if (L >= nwg) return false;
        int wgid = (int)L; { const int q = nwg / NXCD, r = nwg % NXCD, xcd = wgid % NXCD, off = wgid / NXCD; wgid = (xcd < r ? xcd * (q + 1) : r * (q + 1) + (xcd - r) * q) + off; }
        const int nig = wgm * nN, gid = wgid / nig, fm = gid * wgm, gsz = (nM - fm) < wgm ? (nM - fm) : wgm;
        u.pm = fm + ((wgid % nig) % gsz); u.pn = (wgid % nig) / gsz;
        const size_t tstep = (size_t)BM * pitch;
        u.a = gidx ? A : A + (size_t)u.pm * tstep; u.b = B + (size_t)((u.pm / tpe) * nN + u.pn) * tstep;
        if (hot) {
            if (PROBE_ABL != 13) u.a = A + (size_t)(c & 7) * tstep; if (PROBE_ABL != 12) u.b = B + (size_t)(c & 3) * tstep; }
        return true;
    }
};

enum EpiKind { EK_IN0 = 0, EK_OUT = 1, EK_GU = 2, EK_DOWN = 3, EK_QKV1 = 4, EK_NONE = 5 };
struct Epi {
    int kind, layer; bool f8out; float wsc; unsigned char* ws; const float* xin_lat; const float* xin_ctx;
    __device__ __forceinline__ int nstores(const Unit& u) const { return (kind == EK_GU || (kind == EK_IN0 && u.pn >= 2 && u.pn < 6)) ? 8 : 16; }
    __device__ __forceinline__ void store8(bf16_t* p, const f32x4 a, const f32x4 b) const {
        u32x4 w; w.x = cvt_pk_bf16(a[0], a[1]); w.y = cvt_pk_bf16(a[2], a[3]); w.z = cvt_pk_bf16(b[0], b[1]); w.w = cvt_pk_bf16(b[2], b[3]);
        *(u32x4*)p = w;
    }
    __device__ __forceinline__ void operator()(const f32x4 (&acc)[2][2][4][2], const Unit& u, int wr, int wc, int fr, int fq) const {
        if (kind == EK_NONE) {
#pragma unroll
            for (int ai = 0; ai < 2; ++ai)
#pragma unroll
                for (int bj = 0; bj < 2; ++bj)
#pragma unroll
                    for (int m = 0; m < 4; ++m) asm volatile("" :: "v"(acc[ai][bj][m][0]), "v"(acc[ai][bj][m][1]));
            return;
        }
        const int row0 = u.pm * BM + wr * 64 + fr;
        const int cw = wc * 32 + 8 * fq;
        if (kind == EK_OUT) {
            const bool lat = row0 < NLAT;
            const int col0 = u.pn * BM + cw;
            f32x4 gv[2][2];
            const int gb = lat ? (row0 >> 12) : 8;
#pragma unroll
            for (int bj = 0; bj < 2; ++bj)
#pragma unroll
                for (int n = 0; n < 2; ++n) gv[bj][n] = *(const f32x4*)((const float*)(ws + WS_MOD) + (size_t)(layer * 9 + gb) * 6144 + 2 * 1024 + col0 + bj * HALF + 4 * n);
            bf16_t* XB = (bf16_t*)(ws + WS_XB);
            const float* xi = lat ? xin_lat : xin_ctx - (size_t)NLAT * DM;
#pragma unroll
            for (int am = 0; am < 4; ++am) { const int ai = am >> 1, m0 = (am & 1) * 2;
                f32x4 r0[2][2], r1[2][2]; u32x4 rw[2][2];
#pragma unroll
                for (int mm = 0; mm < 2; ++mm) { const size_t off = (size_t)(row0 + ai * HALF + (m0 + mm) * 16) * DM + col0;
#pragma unroll
                    for (int bj = 0; bj < 2; ++bj) {
                        if (layer == 0) { r0[mm][bj] = *(const f32x4*)(xi + off + bj * HALF); r1[mm][bj] = *(const f32x4*)(xi + off + bj * HALF + 4); }
                        else rw[mm][bj] = *(const u32x4*)(XB + off + bj * HALF); } }
#pragma unroll
                for (int mm = 0; mm < 2; ++mm) { const int m = m0 + mm; const size_t off = (size_t)(row0 + ai * HALF + m * 16) * DM + col0;
#pragma unroll
                    for (int bj = 0; bj < 2; ++bj) { f32x4 b0, b1;
                        if (layer == 0) { b0 = r0[mm][bj]; b1 = r1[mm][bj]; }
                        else { const u32x4 w = rw[mm][bj]; b0 = (f32x4){bf_lo(w.x), bf_hi(w.x), bf_lo(w.y), bf_hi(w.y)}; b1 = (f32x4){bf_lo(w.z), bf_hi(w.z), bf_lo(w.w), bf_hi(w.w)}; }
                        store8(XB + off + bj * HALF, b0 + gv[bj][0] * acc[ai][bj][m][0], b1 + gv[bj][1] * acc[ai][bj][m][1]); } }
                asm volatile("" ::: "memory"); }
            return;
        }
        if (kind == EK_GU) {
#pragma unroll
            for (int ai = 0; ai < 2; ++ai)
#pragma unroll
                for (int m = 0; m < 4; ++m) { f32x4 v[2];
#pragma unroll
                    for (int n = 0; n < 2; ++n) { const f32x4 g = acc[ai][0][m][n] * wsc, up = acc[ai][1][m][n] * wsc;
#pragma unroll
                        for (int j = 0; j < 4; ++j) v[n][j] = g[j] * __builtin_amdgcn_rcpf(1.f + __expf(-g[j])) * up[j]; }
                    if (f8out) { u32x2 w; w.x = pk4_fp8(v[0][0], v[0][1], v[0][2], v[0][3]); w.y = pk4_fp8(v[1][0], v[1][1], v[1][2], v[1][3]);
                        *(u32x2*)((unsigned char*)(ws + A_ACT) + (size_t)(row0 + ai * HALF + m * 16) * FF + u.pn * HALF + cw) = w; }
                    else store8((bf16_t*)(ws + A_ACT) + (size_t)(row0 + ai * HALF + m * 16) * FF + u.pn * HALF + cw, v[0], v[1]); }
            return;
        }
        if (kind == EK_DOWN) {
#pragma unroll
            for (int ai = 0; ai < 2; ++ai)
#pragma unroll
                for (int m = 0; m < 4; ++m)
#pragma unroll
                    for (int bj = 0; bj < 2; ++bj)
                    { const f32x4 y0 = acc[ai][bj][m][0] * (wsc * 16.f), y1 = acc[ai][bj][m][1] * (wsc * 16.f);
                        u32x2 w; w.x = pk4_fp8(y0[0], y0[1], y0[2], y0[3]); w.y = pk4_fp8(y1[0], y1[1], y1[2], y1[3]);
                        *(u32x2*)((unsigned char*)(ws + A_HS) + (size_t)(row0 + ai * HALF + m * 16) * DM + u.pn * BM + bj * HALF + cw) = w; }
            return;
        }
        int mode; size_t doff; int ld, cb;
        if (kind == EK_IN0) {
            if (u.pn < 2)       { mode = 0; doff = A_BG; ld = 512; cb = u.pn * 256; }
            else if (u.pn < 6)  { mode = 1; doff = A_CX; ld = 512; cb = (u.pn - 2) * 128; }
            else if (u.pn < 8)  { mode = 2; doff = A_Q0; ld = 512; cb = (u.pn - 6) * 256; }
            else if (u.pn < 10) { mode = 2; doff = A_K0; ld = 512; cb = (u.pn - 8) * 256; }
            else                { mode = 0; doff = A_V0; ld = 512; cb = (u.pn - 10) * 256; }
        } else {
            if (u.pn < 4)       { mode = 2; doff = A_Q1; ld = 1024; cb = u.pn * 256; }
            else if (u.pn == 4) { mode = 2; doff = A_K1; ld = 256; cb = 0; }
            else                { mode = 0; doff = A_V1; ld = 256; cb = 0; }
        }
        bf16_t* dst = (bf16_t*)(ws + doff); const float* rope = (const float*)(ws + WS_ROPE);
        const float qs = ((kind == EK_IN0 && (u.pn == 6 || u.pn == 7)) || (kind == EK_QKV1 && u.pn < 4)) ? 0.125f * 1.4426950408889634f : 1.0f;
        if (mode == 2 && row0 >= NLAT) mode = 0;
        if (mode == 1) {
#pragma unroll
            for (int ai = 0; ai < 2; ++ai)
#pragma unroll
                for (int m = 0; m < 4; ++m)
                    store8(dst + (size_t)(row0 + ai * HALF + m * 16) * ld + cb + cw, acc[ai][0][m][0] * acc[ai][1][m][0], acc[ai][0][m][1] * acc[ai][1][m][1]);
        } else if (mode == 0) {
#pragma unroll
            for (int ai = 0; ai < 2; ++ai)
#pragma unroll
                for (int m = 0; m < 4; ++m)
#pragma unroll
                    for (int bj = 0; bj < 2; ++bj)
                        store8(dst + (size_t)(row0 + ai * HALF + m * 16) * ld + cb + bj * HALF + cw, acc[ai][bj][m][0] * qs, acc[ai][bj][m][1] * qs);
        } else {
            f32x4 csv[4], snv[4];
            const int t0 = row0 & (SEQ - 1);
            if (wc & 1) {
#pragma unroll
                for (int m = 0; m < 4; ++m) { const int pos = (t0 + m * 16) & 63; csv[m] = *(const f32x4*)(rope + pos * 16 + 4 * fq); snv[m] = *(const f32x4*)(rope + 1024 + pos * 16 + 4 * fq); }
            } else {
#pragma unroll
                for (int ai = 0; ai < 2; ++ai) { const int pos = ((t0 + ai * HALF) >> 6) & 63; csv[ai] = *(const f32x4*)(rope + pos * 16 + 4 * fq); snv[ai] = *(const f32x4*)(rope + 1024 + pos * 16 + 4 * fq); }
                csv[2] = csv[0]; snv[2] = snv[0]; csv[3] = csv[1]; snv[3] = snv[1];
            }
#pragma unroll
            for (int ai = 0; ai < 2; ++ai)
#pragma unroll
                for (int m = 0; m < 4; ++m) { const int row = row0 + ai * HALF + m * 16;
                    const f32x4 cs = ((wc & 1) ? csv[m] : csv[ai]) * qs, sn = ((wc & 1) ? snv[m] : snv[ai]) * qs;
#pragma unroll
                    for (int bj = 0; bj < 2; ++bj) { const f32x4 x1 = acc[ai][bj][m][0], x2 = acc[ai][bj][m][1];
                        store8(dst + (size_t)row * ld + cb + bj * HALF + cw, x1 * cs - x2 * sn, x2 * cs + x1 * sn); } }
        }
    }
};

__device__ __forceinline__ void gemm_phase(LAS unsigned char* lds, const int tid, const bool perm, const Sched& S, const Epi& E) {
    const int wid = __builtin_amdgcn_readfirstlane(tid >> 6), lane = tid & 63, wr = wid >> 2, wc = wid & 3, fr = lane & 15, fq = lane >> 4;
    constexpr int K = DM, nt = K / BK;
    unsigned voffB[2]; int sR[2], sC[2];
#pragma unroll
    for (int i = 0; i < 2; ++i) { int R, C; stage_rc(tid * 16 + i * 8192, R, C); const int Rb = perm ? ((R & ~31) + perm32(R & 31)) : R;
        sR[i] = R; sC[i] = C; voffB[i] = (unsigned)(Rb * K + C) * 2u; }
    const bool gather = S.gidx != nullptr;
    LAS unsigned* gtab = (LAS unsigned*)(lds + GT_OFF);
    if (gather) {
        Unit tu;
        for (int i = 0; S.next(i, tu); ++i) if (tid < 256) gtab[i * 256 + tid] = (unsigned)S.gidx[(tu.pm / S.tpe) * EROWS0 + (tu.pm % S.tpe) * 256 + tid] * (unsigned)(K * 2);
        __syncthreads();
    }
    unsigned gc[2][2], gn[2][2];
#define PG8_GOFF(dst, ord) do { const int t_ = wid * 64 + fresh_lane(); _Pragma("unroll") for (int i_ = 0; i_ < 2; ++i_) { int R_, C_; stage_rc(t_ * 16 + i_ * 8192, R_, C_); \
        _Pragma("unroll") for (int h_ = 0; h_ < 2; ++h_) dst[h_][i_] = gather ? gtab[(ord) * 256 + h_ * HALF + R_] + (unsigned)C_ * 2u : (unsigned)((h_ * HALF + R_) * K + C_) * 2u; } } while (0)
    constexpr size_t kstep = (size_t)(BK * 2);
    constexpr size_t hstep = (size_t)HALF * K * 2;
    const unsigned ldsw = (unsigned)wid * 1024u;
    const int aoff = lds_byte(wr * 64 + fr, fq * 8), boff = lds_byte(wc * 32 + fr, fq * 8);
#define PG8_SA(b, h) (((b) * 2 + (h)) * HTB)
#define PG8_SB(b, h) ((4 + (b) * 2 + (h)) * HTB)
#define PG8_STAGE(bufoff, gbase, voff) do { _Pragma("unroll") for (int _i = 0; _i < 2; ++_i) \
        __builtin_amdgcn_global_load_lds((const unsigned*)((const char*)(gbase) + (voff)[_i]), (LAS unsigned*)(lds + (bufoff) + ldsw + _i * 8192), 16, 0, 0); } while (0)
#define PG8_LDA(dst, b, h) do { _Pragma("unroll") for (int m = 0; m < 4; ++m) _Pragma("unroll") for (int k = 0; k < 2; ++k) dst[m][k] = *(const LAS bf16x8*)(lds + PG8_SA(b, h) + aoff + m * 2048 + k * 1024); } while (0)
#define PG8_LDB(dst, b, h) do { _Pragma("unroll") for (int n = 0; n < 2; ++n) _Pragma("unroll") for (int k = 0; k < 2; ++k) dst[n][k] = *(const LAS bf16x8*)(lds + PG8_SB(b, h) + boff + n * 2048 + k * 1024); } while (0)
#define PG8_MMA(ai, bj, At, Bt) do { __builtin_amdgcn_s_setprio(1); _Pragma("unroll") for (int m = 0; m < 4; ++m) _Pragma("unroll") for (int n = 0; n < 2; ++n) _Pragma("unroll") for (int k = 0; k < 2; ++k) \
        acc[ai][bj][m][n] = __builtin_amdgcn_mfma_f32_16x16x32_bf16(Bt[n][k], At[m][k], acc[ai][bj][m][n], 0, 0, 0); __builtin_amdgcn_s_setprio(0); } while (0)
#define PG8_WAIT_V(n) asm volatile("s_waitcnt vmcnt(" #n ")" ::: "memory")
#define PG8_WAIT_VE(n16, n8) do { if (fe) { if (ns == 16) asm volatile("s_waitcnt vmcnt(" #n16 ")" ::: "memory"); else asm volatile("s_waitcnt vmcnt(" #n8 ")" ::: "memory"); } else asm volatile("s_waitcnt vmcnt(8)" ::: "memory"); } while (0)
#define PG8_WAIT_L(n) asm volatile("s_waitcnt lgkmcnt(" #n ")" ::: "memory")
#define PG8_BAR __builtin_amdgcn_s_barrier()
#define PG8_SCHED __builtin_amdgcn_sched_barrier(0)
    Unit cur, nxt; int ui = 0; int ns = 16;
    if (!S.next(0, cur)) return;
    f32x4 acc[2][2][4][2];
#pragma unroll
    for (int a = 0; a < 2; ++a)
#pragma unroll
        for (int b = 0; b < 2; ++b)
#pragma unroll
            for (int m = 0; m < 4; ++m)
#pragma unroll
                for (int n = 0; n < 2; ++n) acc[a][b][m][n] = (f32x4){0.f, 0.f, 0.f, 0.f};
    bf16x8 At[4][2], B0[2][2], B1[2][2];
    const char* cA = cur.a; const char* cB = cur.b;
    PG8_GOFF(gc, 0);
    PG8_STAGE(PG8_SB(0, 0), cB, voffB); PG8_STAGE(PG8_SB(0, 1), cB + hstep, voffB); PG8_STAGE(PG8_SA(0, 0), cA, gc[0]); PG8_STAGE(PG8_SA(0, 1), cA, gc[1]);
    if (wr == 1) PG8_BAR;
    PG8_WAIT_V(2); PG8_BAR;
    PG8_STAGE(PG8_SB(1, 0), cB + kstep, voffB); PG8_STAGE(PG8_SA(1, 0), cA + kstep, gc[0]); PG8_STAGE(PG8_SB(1, 1), cB + hstep + kstep, voffB);
    PG8_WAIT_V(6); PG8_BAR;
    for (;;) {
        const bool has_next = S.next(ui + 1, nxt);
        const char* nA = has_next ? nxt.a : cA; const char* nB = has_next ? nxt.b : cB;
        if (has_next) PG8_GOFF(gn, ui + 1);
        else {
#pragma unroll
            for (int h_ = 0; h_ < 2; ++h_)
#pragma unroll
                for (int i_ = 0; i_ < 2; ++i_) gn[h_][i_] = gc[h_][i_]; }
        for (int t = 0; t < nt; t += 2) {
            const bool last = (t == nt - 2); const bool fe = (t == 0) && (ui > 0);
            const char* a1 = cA + (size_t)(t + 1) * kstep;
            const char* a2 = last ? nA : cA + (size_t)(t + 2) * kstep; const char* b2 = last ? nB : cB + (size_t)(t + 2) * kstep;
            const char* a3 = a2 + kstep; const char* b3 = b2 + kstep;
            unsigned g2[2][2];
#pragma unroll
            for (int h_ = 0; h_ < 2; ++h_)
#pragma unroll
                for (int i_ = 0; i_ < 2; ++i_) g2[h_][i_] = last ? gn[h_][i_] : gc[h_][i_];
            PG8_LDB(B0, 0, 0); PG8_LDB(B1, 0, 1); PG8_SCHED; PG8_LDA(At, 0, 0); PG8_STAGE(PG8_SA(1, 1), a1, gc[1]);
            PG8_WAIT_VE(18, 10); PG8_WAIT_L(0); PG8_BAR; PG8_MMA(0, 0, At, B0); PG8_MMA(0, 1, At, B1); PG8_BAR; PG8_SCHED;
            PG8_LDA(At, 0, 1); PG8_STAGE(PG8_SB(0, 0), b2, voffB); PG8_STAGE(PG8_SB(0, 1), b2 + hstep, voffB); PG8_STAGE(PG8_SA(0, 0), a2, g2[0]);
            PG8_WAIT_VE(24, 16); PG8_WAIT_L(0); PG8_BAR; PG8_MMA(1, 0, At, B0); PG8_MMA(1, 1, At, B1); PG8_BAR; PG8_SCHED;
            PG8_LDB(B0, 1, 0); PG8_LDB(B1, 1, 1); PG8_SCHED; PG8_LDA(At, 1, 0); PG8_STAGE(PG8_SA(0, 1), a2, g2[1]);
            PG8_WAIT_V(8); PG8_WAIT_L(0); PG8_BAR; PG8_MMA(0, 0, At, B0); PG8_MMA(0, 1, At, B1); PG8_BAR; PG8_SCHED;
            PG8_LDA(At, 1, 1); PG8_STAGE(PG8_SB(1, 0), b3, voffB); PG8_STAGE(PG8_SB(1, 1), b3 + hstep, voffB); PG8_STAGE(PG8_SA(1, 0), a3, g2[0]);
            PG8_WAIT_V(8); PG8_WAIT_L(0); PG8_BAR; PG8_MMA(1, 0, At, B0); PG8_MMA(1, 1, At, B1); PG8_BAR; PG8_SCHED;
        }
        if (wr == 0) PG8_BAR;
        PG8_WAIT_V(0);
        { int fr_ = fr, fq_ = fq; asm volatile("" : "+v"(fr_), "+v"(fq_));
          E(acc, cur, wr, wc, fr_, fq_); } ns = E.nstores(cur);
        if (!has_next) break;
#pragma unroll
        for (int a = 0; a < 2; ++a)
#pragma unroll
            for (int b = 0; b < 2; ++b)
#pragma unroll
                for (int m = 0; m < 4; ++m)
#pragma unroll
                    for (int n = 0; n < 2; ++n) acc[a][b][m][n] = (f32x4){0.f, 0.f, 0.f, 0.f};
        cur = nxt; cA = nA; cB = nB; ++ui;
#pragma unroll
        for (int h_ = 0; h_ < 2; ++h_)
#pragma unroll
            for (int i_ = 0; i_ < 2; ++i_) gc[h_][i_] = gn[h_][i_];
        if (wr == 1) PG8_BAR;
    }
    PG8_WAIT_V(0);
    PG8_BAR;
#undef PG8_GOFF
#undef PG8_SA
#undef PG8_SB
#undef PG8_STAGE
#undef PG8_LDA
#undef PG8_LDB
#undef PG8_MMA
#undef PG8_WAIT_V
#undef PG8_WAIT_VE
#undef PG8_WAIT_L
#undef PG8_BAR
#undef PG8_SCHED
}
__device__ __forceinline__ void gemm_phase8(LAS unsigned char* lds, const int tid, const bool perm, const Sched& S, const Epi& E) {
    const int wid = __builtin_amdgcn_readfirstlane(tid >> 6), lane = tid & 63, wr = wid >> 2, wc = wid & 3, fr = lane & 15, fq = lane >> 4;
    constexpr int K = DM, nt = K / 128, PITCH = K;
    unsigned voffB[2]; int sR[2], sC[2];
#pragma unroll
    for (int i = 0; i < 2; ++i) { const int X = tid * 16 + i * 8192, p = X >> 10, l = (X >> 4) & 63, fr_ = l >> 2, g_ = fr_ >> 2, cp = (l & 3) ^ (g_ ^ (g_ >> 1));
        const int R = (p >> 1) * 16 + fr_, C = ((p & 1) * 4 + cp) * 16; const int Rb = perm ? ((R & ~31) + perm32(R & 31)) : R;
        sR[i] = R; sC[i] = C; voffB[i] = (unsigned)(Rb * PITCH + C); }
    const bool gather = S.gidx != nullptr;
    LAS unsigned* gtab = (LAS unsigned*)(lds + GT_OFF);
    if (gather) {
        Unit tu;
        for (int i = 0; S.next(i, tu); ++i) if (tid < 256) gtab[i * 256 + tid] = (unsigned)S.gidx[(tu.pm / S.tpe) * EROWS0 + (tu.pm % S.tpe) * 256 + tid] * (unsigned)PITCH;
        __syncthreads();
    }
    unsigned gc[2][2], gn[2][2];
#define PG8_GOFF(dst, ord) do { const int t_ = wid * 64 + fresh_lane(); _Pragma("unroll") for (int i_ = 0; i_ < 2; ++i_) { const int X_ = t_ * 16 + i_ * 8192, p_ = X_ >> 10, l_ = (X_ >> 4) & 63, f_ = l_ >> 2, g_ = f_ >> 2; \
        const int R_ = (p_ >> 1) * 16 + f_, C_ = ((p_ & 1) * 4 + ((l_ & 3) ^ (g_ ^ (g_ >> 1)))) * 16; \
        _Pragma("unroll") for (int h_ = 0; h_ < 2; ++h_) dst[h_][i_] = gather ? gtab[(ord) * 256 + h_ * HALF + R_] + (unsigned)C_ : (unsigned)((h_ * HALF + R_) * PITCH + C_); } } while (0)
    constexpr size_t kstep = (size_t)(BK * 2);
    constexpr size_t hstep = (size_t)HALF * PITCH;
    const unsigned ldsw = (unsigned)wid * 1024u;
    int aoff[2], boff[2];
#pragma unroll
    for (int hh = 0; hh < 2; ++hh) { const int g_ = fr >> 2, ch = (((fq & 1) * 2 + hh) ^ (g_ ^ (g_ >> 1))); const int o_ = (fq >> 1) * 1024 + (4 * fr + ch) * 16;
        aoff[hh] = wr * 8192 + o_; boff[hh] = wc * 4096 + o_; }
#define PG8_SA(b, h) (((b) * 2 + (h)) * HTB)
#define PG8_SB(b, h) ((4 + (b) * 2 + (h)) * HTB)
#define PG8_STAGE(bufoff, gbase, voff) do { _Pragma("unroll") for (int _i = 0; _i < 2; ++_i) \
        __builtin_amdgcn_global_load_lds((const unsigned*)((const char*)(gbase) + (voff)[_i]), (LAS unsigned*)(lds + (bufoff) + ldsw + _i * 8192), 16, 0, 0); } while (0)
#define PG8_LDA(dst, b, h) do { _Pragma("unroll") for (int m = 0; m < 4; ++m) dst[m] = __builtin_shufflevector(*(const LAS v4i32*)(lds + PG8_SA(b, h) + aoff[0] + m * 2048), *(const LAS v4i32*)(lds + PG8_SA(b, h) + aoff[1] + m * 2048), 0, 1, 2, 3, 4, 5, 6, 7); } while (0)
#define PG8_LDB(dst, b, h) do { _Pragma("unroll") for (int n = 0; n < 2; ++n) dst[n] = __builtin_shufflevector(*(const LAS v4i32*)(lds + PG8_SB(b, h) + boff[0] + n * 2048), *(const LAS v4i32*)(lds + PG8_SB(b, h) + boff[1] + n * 2048), 0, 1, 2, 3, 4, 5, 6, 7); } while (0)
#define PG8_V8(x) (x)
#define PG8_MMA(ai, bj, At, Bt) do { __builtin_amdgcn_s_setprio(1); _Pragma("unroll") for (int m = 0; m < 4; ++m) _Pragma("unroll") for (int n = 0; n < 2; ++n) \
        asm volatile("v_mfma_f32_16x16x128_f8f6f4 %0, %1, %2, %0" : "+v"(acc[ai][bj][m][n]) : "v"(Bt[n]), "v"(At[m])); __builtin_amdgcn_s_setprio(0); } while (0)
#define PG8_WAIT_V(n) asm volatile("s_waitcnt vmcnt(" #n ")" ::: "memory")
#define PG8_WAIT_VE(n16, n8) do { if (fe) { if (ns == 16) asm volatile("s_waitcnt vmcnt(" #n16 ")" ::: "memory"); else asm volatile("s_waitcnt vmcnt(" #n8 ")" ::: "memory"); } else asm volatile("s_waitcnt vmcnt(8)" ::: "memory"); } while (0)
#define PG8_WAIT_L(n) asm volatile("s_waitcnt lgkmcnt(" #n ")" ::: "memory")
#define PG8_BAR __builtin_amdgcn_s_barrier()
#define PG8_SCHED __builtin_amdgcn_sched_barrier(0)
    Unit cur, nxt; int ui = 0; int ns = 16;
    if (!S.next(0, cur)) return;
    f32x4 acc[2][2][4][2];
#pragma unroll
    for (int a = 0; a < 2; ++a)
#pragma unroll
        for (int b = 0; b < 2; ++b)
#pragma unroll
            for (int m = 0; m < 4; ++m)
#pragma unroll
                for (int n = 0; n < 2; ++n) acc[a][b][m][n] = (f32x4){0.f, 0.f, 0.f, 0.f};
    v8i32 At[4], B0[2], B1[2];
    const char* cA = cur.a; const char* cB = cur.b;
    PG8_GOFF(gc, 0);
    PG8_STAGE(PG8_SB(0, 0), cB, voffB); PG8_STAGE(PG8_SB(0, 1), cB + hstep, voffB); PG8_STAGE(PG8_SA(0, 0), cA, gc[0]); PG8_STAGE(PG8_SA(0, 1), cA, gc[1]);
    if (wr == 1) PG8_BAR;
    PG8_WAIT_V(2); PG8_BAR;
    PG8_STAGE(PG8_SB(1, 0), cB + kstep, voffB); PG8_STAGE(PG8_SA(1, 0), cA + kstep, gc[0]); PG8_STAGE(PG8_SB(1, 1), cB + hstep + kstep, voffB);
    PG8_WAIT_V(6); PG8_BAR;
    for (;;) {
        const bool has_next = S.next(ui + 1, nxt);
        const char* nA = has_next ? nxt.a : cA; const char* nB = has_next ? nxt.b : cB;
        if (has_next) PG8_GOFF(gn, ui + 1);
        else {
#pragma unroll
            for (int h_ = 0; h_ < 2; ++h_)
#pragma unroll
                for (int i_ = 0; i_ < 2; ++i_) gn[h_][i_] = gc[h_][i_]; }
#pragma unroll 1
        for (int t = 0; t < nt; t += 2) {
            const bool last = (t == nt - 2); const bool fe = (t == 0) && (ui > 0);
            const char* a1 = cA + (size_t)(t + 1) * kstep;
            const char* a2 = last ? nA : cA + (size_t)(t + 2) * kstep; const char* b2 = last ? nB : cB + (size_t)(t + 2) * kstep;
            const char* a3 = a2 + kstep; const char* b3 = b2 + kstep;
            unsigned g2[2][2];
#pragma unroll
            for (int h_ = 0; h_ < 2; ++h_)
#pragma unroll
                for (int i_ = 0; i_ < 2; ++i_) g2[h_][i_] = last ? gn[h_][i_] : gc[h_][i_];
            PG8_LDB(B0, 0, 0); PG8_LDB(B1, 0, 1); PG8_SCHED; PG8_LDA(At, 0, 0); PG8_STAGE(PG8_SA(1, 1), a1, gc[1]);
            PG8_WAIT_VE(18, 10); PG8_WAIT_L(0); PG8_BAR; PG8_MMA(0, 0, At, B0); PG8_MMA(0, 1, At, B1); PG8_BAR; PG8_SCHED;
            PG8_LDA(At, 0, 1); PG8_STAGE(PG8_SB(0, 0), b2, voffB); PG8_STAGE(PG8_SB(0, 1), b2 + hstep, voffB); PG8_STAGE(PG8_SA(0, 0), a2, g2[0]);
            PG8_WAIT_VE(24, 16); PG8_WAIT_L(0); PG8_BAR; PG8_MMA(1, 0, At, B0); PG8_MMA(1, 1, At, B1); PG8_BAR; PG8_SCHED;
            PG8_LDB(B0, 1, 0); PG8_LDB(B1, 1, 1); PG8_SCHED; PG8_LDA(At, 1, 0); PG8_STAGE(PG8_SA(0, 1), a2, g2[1]);
            PG8_WAIT_V(8); PG8_WAIT_L(0); PG8_BAR; PG8_MMA(0, 0, At, B0); PG8_MMA(0, 1, At, B1); PG8_BAR; PG8_SCHED;
            PG8_LDA(At, 1, 1); PG8_STAGE(PG8_SB(1, 0), b3, voffB); PG8_STAGE(PG8_SB(1, 1), b3 + hstep, voffB); PG8_STAGE(PG8_SA(1, 0), a3, g2[0]);
            PG8_WAIT_V(8); PG8_WAIT_L(0); PG8_BAR; PG8_MMA(1, 0, At, B0); PG8_MMA(1, 1, At, B1); PG8_BAR; PG8_SCHED;
        }
        if (wr == 0) PG8_BAR;
        asm volatile("s_nop 15\n\ts_nop 15" ::: "memory");
        PG8_WAIT_V(0);
        { int fr_ = fr, fq_ = fq; asm volatile("" : "+v"(fr_), "+v"(fq_));
          E(acc, cur, wr, wc, fr_, fq_); } ns = E.nstores(cur);
        if (!has_next) break;
#pragma unroll
        for (int a = 0; a < 2; ++a)
#pragma unroll
            for (int b = 0; b < 2; ++b)
#pragma unroll
                for (int m = 0; m < 4; ++m)
#pragma unroll
                    for (int n = 0; n < 2; ++n) acc[a][b][m][n] = (f32x4){0.f, 0.f, 0.f, 0.f};
        cur = nxt; cA = nA; cB = nB; ++ui;
#pragma unroll
        for (int h_ = 0; h_ < 2; ++h_)
#pragma unroll
            for (int i_ = 0; i_ < 2; ++i_) gc[h_][i_] = gn[h_][i_];
        if (wr == 1) PG8_BAR;
    }
    PG8_WAIT_V(0);
    PG8_BAR;
#undef PG8_GOFF
#undef PG8_V8
#undef PG8_SA
#undef PG8_SB
#undef PG8_STAGE
#undef PG8_LDA
#undef PG8_LDB
#undef PG8_MMA
#undef PG8_WAIT_V
#undef PG8_WAIT_VE
#undef PG8_WAIT_L
#undef PG8_BAR
#undef PG8_SCHED
}
}

namespace att {
constexpr int QBLK = 32, KVBLK = 64;
constexpr float SCALE = 0.125f;
constexpr float THR = 8.f;
constexpr float LOG2E = 1.4426950408889634f;
#define SBAR() __builtin_amdgcn_sched_barrier(0)
#define KSWZ(row, colB) ((row) * 128 + ((colB) ^ ((((row) >> 1) & 7) << 4)))
__device__ __forceinline__ int crow(int r, int hi) { return (r & 3) + 8 * (r >> 2) + 4 * hi; }
__device__ __forceinline__ unsigned cvtpk(float lo, float hi) { unsigned r; asm volatile("v_cvt_pk_bf16_f32 %0, %1, %2" : "=v"(r) : "v"(lo), "v"(hi)); return r; }

constexpr float THRL = 8.f;
template <bool NEGM = true>
__device__ __forceinline__ void partialSM(f32x16& p0, f32x16& p1, float& m_reg, f32x16& negm, float& alpha, const bool first) {
    float a = fmaxf(fmaxf(p0[0], p0[1]), p1[0]), b = fmaxf(fmaxf(p0[2], p0[3]), p1[1]); a = fmaxf(fmaxf(a, p1[2]), p1[3]);
#pragma unroll
    for (int r = 4; r < 16; r += 4) { a = fmaxf(fmaxf(a, p0[r]), p0[r + 1]); b = fmaxf(fmaxf(b, p0[r + 2]), p0[r + 3]); a = fmaxf(fmaxf(a, p1[r]), p1[r + 1]); b = fmaxf(fmaxf(b, p1[r + 2]), p1[r + 3]); }
    float pmax = fmaxf(a, b);
    { auto rr = __builtin_amdgcn_permlane32_swap(__float_as_uint(pmax), __float_as_uint(pmax), false, false);
      pmax = fmaxf(__uint_as_float(rr[0]), __uint_as_float(rr[1])); }
    if constexpr (!NEGM) pmax -= m_reg;
    alpha = 1.f;
    if (__builtin_expect(first || __any(pmax > THRL), 0)) {
        const float dl = first ? pmax : fmaxf(pmax, 0.f);
        m_reg += dl;
        if constexpr (NEGM) {
#pragma unroll
            for (int r = 0; r < 16; ++r) { p0[r] -= dl; p1[r] -= dl; }
#pragma unroll
            for (int r = 0; r < 16; ++r) negm[r] = -m_reg; }
        alpha = __builtin_amdgcn_exp2f(-dl);
    }
    if constexpr (!NEGM) {
#pragma unroll
        for (int r = 0; r < 16; ++r) { p0[r] -= m_reg; p1[r] -= m_reg; } }
#pragma unroll
    for (int r = 0; r < 16; ++r) p0[r] = __builtin_amdgcn_exp2f(p0[r]);
}
__device__ __forceinline__ void finishSM(f32x16& p0, f32x16& p1, float alpha, float& l_reg, bf16x8& pa0, bf16x8& pa1, bf16x8& pa2, bf16x8& pa3) {
#pragma unroll
    for (int r = 0; r < 16; ++r) p1[r] = __builtin_amdgcn_exp2f(p1[r]);
#define ADDF(d, a, b) asm("v_add_f32 %0, %1, %2" : "=v"(d) : "v"(a), "v"(b))
    float s0, s1, s2, s3;
    ADDF(s0, p0[0], p0[4]); ADDF(s1, p0[1], p0[5]); ADDF(s2, p0[2], p0[6]); ADDF(s3, p0[3], p0[7]);
#pragma unroll
    for (int r = 8; r < 16; r += 4) { ADDF(s0, s0, p0[r]); ADDF(s1, s1, p0[r + 1]); ADDF(s2, s2, p0[r + 2]); ADDF(s3, s3, p0[r + 3]); }
#pragma unroll
    for (int r = 0; r < 16; r += 4) { ADDF(s0, s0, p1[r]); ADDF(s1, s1, p1[r + 1]); ADDF(s2, s2, p1[r + 2]); ADDF(s3, s3, p1[r + 3]); }
    ADDF(s0, s0, s1); ADDF(s2, s2, s3);
    float ps; ADDF(ps, s0, s2);
#undef ADDF
    { auto rr = __builtin_amdgcn_permlane32_swap(__float_as_uint(ps), __float_as_uint(ps), false, false);
      ps = __uint_as_float(rr[0]) + __uint_as_float(rr[1]); }
    l_reg = l_reg * alpha + ps;
#define PK8(P, BASE, OUT) do { u32x4 w = {cvtpk(P[BASE + 0], P[BASE + 1]), cvtpk(P[BASE + 2], P[BASE + 3]), cvtpk(P[BASE + 4], P[BASE + 5]), cvtpk(P[BASE + 6], P[BASE + 7])}; OUT = __builtin_bit_cast(bf16x8, w); } while (0)
    PK8(p0, 0, pa0); PK8(p0, 8, pa1); PK8(p1, 0, pa2); PK8(p1, 8, pa3);
#undef PK8
}
__device__ __forceinline__ void qkt(f32x16& p0, f32x16& p1, const LAS char* Ks, const LAS char* qf, const f32x16& cinit, int r32, int hi) {
#pragma unroll
    for (int d0 = 0; d0 < 4; ++d0) { const int cb = (d0 * 16 + hi * 8) * 2;
        const bf16x8 q = *(const LAS bf16x8*)(qf + d0 * 1024);
        const bf16x8 b0 = *(const LAS bf16x8*)(Ks + KSWZ(r32, cb));
        const bf16x8 b1 = *(const LAS bf16x8*)(Ks + KSWZ(32 + r32, cb));
        if (d0 == 0) { p0 = __builtin_amdgcn_mfma_f32_32x32x16_bf16(b0, q, cinit, 0, 0, 0); p1 = __builtin_amdgcn_mfma_f32_32x32x16_bf16(b1, q, cinit, 0, 0, 0); }
        else { p0 = __builtin_amdgcn_mfma_f32_32x32x16_bf16(b0, q, p0, 0, 0, 0); p1 = __builtin_amdgcn_mfma_f32_32x32x16_bf16(b1, q, p1, 0, 0, 0); } }
}
__device__ __forceinline__ void qkt_r(f32x16& p0, f32x16& p1, const LAS char* Ks, const bf16x8* qr, const f32x16& cinit, int r32, int hi) {
#pragma unroll
    for (int d0 = 0; d0 < 4; ++d0) { const int cb = (d0 * 16 + hi * 8) * 2;
        const bf16x8 b0 = *(const LAS bf16x8*)(Ks + KSWZ(r32, cb));
        const bf16x8 b1 = *(const LAS bf16x8*)(Ks + KSWZ(32 + r32, cb));
        if (d0 == 0) { p0 = __builtin_amdgcn_mfma_f32_32x32x16_bf16(b0, qr[0], cinit, 0, 0, 0); p1 = __builtin_amdgcn_mfma_f32_32x32x16_bf16(b1, qr[0], cinit, 0, 0, 0); }
        else { p0 = __builtin_amdgcn_mfma_f32_32x32x16_bf16(b0, qr[d0], p0, 0, 0, 0); p1 = __builtin_amdgcn_mfma_f32_32x32x16_bf16(b1, qr[d0], p1, 0, 0, 0); } }
}
template <int NCB> __device__ __forceinline__ int v_st(int k, int c) { const int kk = k; return ((kk >> 3) * NCB + (c >> 5)) * 512 + ((kk & 7) * 32 + (c & 31)) * 2; }
__device__ __forceinline__ int v_rd_base(int lane) { return ((lane & 3) << 3) | (((lane >> 2) & 3) << 6) | (((lane >> 4) & 1) << 5) | (((lane >> 5) & 1) << 8); }
typedef short v4i16_t __attribute__((ext_vector_type(4)));
__device__ __forceinline__ s16x4 vtr(const LAS char* p) { return __builtin_bit_cast(s16x4, __builtin_amdgcn_ds_read_tr16_b64_v4i16((LAS v4i16_t*)p)); }
template <int NCB, int D0> __device__ __forceinline__ void pv_one(f32x16& od, const LAS char* vb, bf16x8 pa0, bf16x8 pa1, bf16x8 pa2, bf16x8 pa3) {
    constexpr int KS = NCB * 1024, HS = NCB * 512;
    const s16x4 l0 = vtr(vb + D0 * 512 + 0 * KS), h0 = vtr(vb + D0 * 512 + 0 * KS + HS), l1 = vtr(vb + D0 * 512 + 1 * KS), h1 = vtr(vb + D0 * 512 + 1 * KS + HS);
    const s16x4 l2 = vtr(vb + D0 * 512 + 2 * KS), h2 = vtr(vb + D0 * 512 + 2 * KS + HS), l3 = vtr(vb + D0 * 512 + 3 * KS), h3 = vtr(vb + D0 * 512 + 3 * KS + HS);
#define PK(L, H) (bf16x8){L[0], L[1], L[2], L[3], H[0], H[1], H[2], H[3]}
    od = __builtin_amdgcn_mfma_f32_32x32x16_bf16(pa0, PK(l0, h0), od, 0, 0, 0);
    od = __builtin_amdgcn_mfma_f32_32x32x16_bf16(pa1, PK(l1, h1), od, 0, 0, 0);
    od = __builtin_amdgcn_mfma_f32_32x32x16_bf16(pa2, PK(l2, h2), od, 0, 0, 0);
    od = __builtin_amdgcn_mfma_f32_32x32x16_bf16(pa3, PK(l3, h3), od, 0, 0, 0);
#undef PK
}
template <int NCB> __device__ __forceinline__ void pv_all(f32x16* o, const LAS char* vb, bf16x8 pa0, bf16x8 pa1, bf16x8 pa2, bf16x8 pa3) {
    pv_one<NCB, 0>(o[0], vb, pa0, pa1, pa2, pa3); pv_one<NCB, 1>(o[1], vb, pa0, pa1, pa2, pa3);
    if constexpr (NCB == 4) { pv_one<NCB, 2>(o[2], vb, pa0, pa1, pa2, pa3); pv_one<NCB, 3>(o[3], vb, pa0, pa1, pa2, pa3); }
}

struct UnitDesc {
    const bf16_t* Q; int ldq;
    const bf16_t* K; const bf16_t* V; int ldk, ldv;
    bf16_t* O; int ldo;
    int ctx_row0, lat_row0, lat_t0, NT;
    int q0; const float* sink;
};
template <int DV, bool SWA, int ABL = 0>
__device__ __forceinline__ void attn_unit(const UnitDesc& U, LAS char* lds, const int tid) {
    constexpr int NCB = DV / 32;
    constexpr int LDQ = SWA ? 1024 : 512, LDK = SWA ? 256 : 512, LDV = LDK, LDO = 1024;
    constexpr int SHM_V = KVBLK * DV * 2, SHM_K = KVBLK * 64 * 2;
    constexpr int NLD = (DV == 128) ? 3 : 2;
    const int wid = __builtin_amdgcn_readfirstlane(tid >> 6), lane = tid & 63, r32 = lane & 31, hi = lane >> 5;
    LAS char* V_lds = lds; LAS char* K_lds = lds + 3 * SHM_V;
    LAS float* ws = (LAS float*)(lds + 3 * SHM_V + 3 * SHM_K) + wid * 64; LAS float* li_l = ws; LAS float* al_l = ws + 32;
    float m_reg = 0.f, l_reg = 0; f32x16 o[NCB]; f32x16 negm = f32x16{};
#pragma unroll
    for (int d = 0; d < NCB; ++d) o[d] = f32x16{};
    const bf16_t* Qw = U.Q + (size_t)(wid * QBLK + r32) * LDQ + hi * 8;
    LAS char* qf = lds + 3 * SHM_V + 3 * SHM_K + 2048 + wid * 4096 + lane * 16;
#pragma unroll
    for (int d0 = 0; d0 < 4; ++d0) *(LAS bf16x8*)(qf + d0 * 1024) = *(const bf16x8*)(Qw + d0 * 16);
    const int kr = tid >> 3, kc = (tid & 7) * 8;
    const int sr = tid >> 4, sc = (tid & 15) * 8;
    const int kst = KSWZ(kr, kc * 2);
    const int vst0 = (DV == 128) ? v_st<NCB>(sr, sc) : v_st<NCB>(kr, kc), vst1 = (DV == 128) ? v_st<NCB>(32 + sr, sc) : 0;
    const LAS char* vrd = V_lds + v_rd_base(lane);
    bf16x8 svA0, svA1, skA;
    const bf16_t* kp = U.K + (size_t)(U.ctx_row0 + kr) * LDK + kc;
    const bf16_t* vp = (DV == 128) ? U.V + (size_t)(U.ctx_row0 + sr) * LDV + sc : U.V + (size_t)(U.ctx_row0 + kr) * LDV + kc;
    const int jump = (U.lat_row0 + 64 * U.lat_t0) - (U.ctx_row0 + 192);
#define SLOAD(S, t) do { \
        if constexpr (DV == 128) { sv##S##0 = *(const bf16x8*)(vp); sv##S##1 = *(const bf16x8*)(vp + (size_t)32 * LDV); } \
        else { sv##S##0 = *(const bf16x8*)(vp); } \
        sk##S = *(const bf16x8*)(kp); \
        { const int adv_ = ((t) == 3) ? jump : 64; kp += (ptrdiff_t)adv_ * LDK; vp += (ptrdiff_t)adv_ * LDV; } } while (0)
#define SWRITE(slot, S) do { *(LAS bf16x8*)(V_lds + (slot) * SHM_V + vst0) = sv##S##0; if constexpr (DV == 128) *(LAS bf16x8*)(V_lds + (slot) * SHM_V + vst1) = sv##S##1; \
        *(LAS bf16x8*)(K_lds + (slot) * SHM_K + kst) = sk##S; } while (0)
#define RESC(a) do { if (__any((a) < 1.f)) { if (hi == 0) al_l[r32] = (a); asm volatile("s_waitcnt lgkmcnt(0)" ::: "memory"); \
        _Pragma("unroll") for (int d = 0; d < NCB; ++d) _Pragma("unroll") for (int r = 0; r < 16; ++r) o[d][r] *= al_l[crow(r, hi)]; } } while (0)
    const int qs = U.q0 + wid * QBLK;
#define ACTIVE(t) (!SWA || (t) < 4 || (64 * (U.lat_t0 + (t) - 4) + 63 >= qs - 128 && 64 * (U.lat_t0 + (t) - 4) <= qs + 31 + 128))
#define MASK(P0, P1, t) do { if constexpr (SWA) { if ((t) >= 4 && !(64 * (U.lat_t0 + (t) - 4) >= qs + 31 - 128 && 64 * (U.lat_t0 + (t) - 4) + 63 <= qs + 128)) { const int kb_ = 64 * (U.lat_t0 + (t) - 4) - (qs + r32) + 4 * hi; \
        _Pragma("unroll") for (int r = 0; r < 16; ++r) { const int d0_ = kb_ + (r & 3) + 8 * (r >> 2); \
            if (d0_ > 128 || d0_ < -128) P0[r] = -1e30f; if (d0_ + 32 > 128 || d0_ + 32 < -128) P1[r] = -1e30f; } } } } while (0)
    f32x16 pA0, pA1, pB0, pB1; float alA = 1.f, alB = 1.f; bf16x8 pa0, pa1, pa2, pa3; const int NT = U.NT;
    bool actA = true, actB = true;
    int sp = 0, scur = 0, snx = 1;
#define ROT() do { sp = scur; scur = snx; snx = (snx == 2) ? 0 : snx + 1; } while (0)
#define STEP(t, C, P, LOADN, WRITEN) do { \
        act##C = ACTIVE(t); \
        SBAR(); if (act##C) { if constexpr (ABL != 4) qkt(p##C##0, p##C##1, K_lds + scur * SHM_K, qf, negm, r32, hi); else { asm volatile("" : "+v"(p##C##0), "+v"(p##C##1)); } MASK(p##C##0, p##C##1, t); } \
        if (act##P) { finishSM(p##P##0, p##P##1, al##P, l_reg, pa0, pa1, pa2, pa3); } SBAR(); \
        if (WRITEN && ABL != 1) { SWRITE(snx, A); } \
        if (LOADN && ABL != 1) SLOAD(A, (t) + 2); SBAR(); \
        if (act##P) { if constexpr (ABL != 3) { pv_all<NCB>(o, vrd + sp * SHM_V, pa0, pa1, pa2, pa3); } else { asm volatile("" :: "v"(pa0), "v"(pa1), "v"(pa2), "v"(pa3)); } } \
        if (act##C) { partialSM(p##C##0, p##C##1, m_reg, negm, al##C, false); } else al##C = 1.f; \
        if (act##C) RESC(al##C); \
        __syncthreads(); ROT(); } while (0)
    SLOAD(A, 0); asm volatile("s_waitcnt vmcnt(0)" ::: "memory"); SWRITE(0, A); SLOAD(A, 1); __syncthreads();
    qkt(pA0, pA1, K_lds, qf, negm, r32, hi); MASK(pA0, pA1, 0); partialSM(pA0, pA1, m_reg, negm, alA, true);
    SWRITE(1, A); SLOAD(A, 2); __syncthreads();
    sp = 0; scur = 1; snx = 2;
    for (int j = 1; j + 1 < NT; j += 2) {
        STEP(j, B, A, true, true);
        STEP(j + 1, A, B, (j + 3 < NT), true);
    }
    STEP(NT - 1, B, A, false, false);
    if (actB) { finishSM(pB0, pB1, alB, l_reg, pa0, pa1, pa2, pa3); SBAR(); pv_all<NCB>(o, vrd + sp * SHM_V, pa0, pa1, pa2, pa3); }
    if constexpr (SWA) l_reg += __builtin_amdgcn_exp2f(U.sink[0] * LOG2E - m_reg);
    if (hi == 0) li_l[r32] = l_reg; asm volatile("s_waitcnt lgkmcnt(0)" ::: "memory");
    float rli[16];
#pragma unroll
    for (int r = 0; r < 16; ++r) rli[r] = __builtin_amdgcn_rcpf(li_l[crow(r, hi)]);
    bf16_t* Ow = U.O + (size_t)(wid * QBLK) * LDO;
#pragma unroll
    for (int r = 0; r < 16; ++r) { const int orow = crow(r, hi);
#pragma unroll
        for (int d0 = 0; d0 < NCB; ++d0) Ow[(size_t)orow * LDO + d0 * 32 + r32] = (bf16_t)f2bf(o[d0][r] * rli[r]); }
    __syncthreads();
#undef SLOAD
#undef SWRITE
#undef RESC
#undef ACTIVE
#undef MASK
#undef ROT
#undef STEP
}
template <int DV, bool SWA>
__device__ __forceinline__ void attn_unit_pp(const UnitDesc& U, LAS char* lds, const int tid) {
    constexpr int NCB = DV / 32;
    constexpr int LDQ = SWA ? 1024 : 512, LDK = SWA ? 256 : 512, LDV = LDK, LDO = 1024;
    constexpr int SHM_V = KVBLK * DV * 2, SHM_K = KVBLK * 64 * 2;
    const int wid = __builtin_amdgcn_readfirstlane(tid >> 6), lane = tid & 63, r32 = lane & 31, hi = lane >> 5;
    const int wrow = SWA ? (wid & 1) * QBLK : wid * QBLK, wcol = SWA ? (wid >> 1) * 64 : 0;
    LAS char* V_lds = lds; LAS char* K_lds = lds + 5 * SHM_V;
    LAS float* ws = (LAS float*)(lds + 5 * SHM_V + 4 * SHM_K) + wid * 64; LAS float* li_l = ws; LAS float* al_l = ws + 32;
    constexpr bool NEGM = true;
    float m_reg = 0.f, l_reg = 0; f32x16 o[NCB]; f32x16 negm = f32x16{};
#pragma unroll
    for (int d = 0; d < NCB; ++d) o[d] = f32x16{};
    const bf16_t* Qw = U.Q + (size_t)(wrow + r32) * LDQ + wcol + hi * 8;
    bf16x8 qf[4];
#pragma unroll
    for (int d0 = 0; d0 < 4; ++d0) qf[d0] = *(const bf16x8*)(Qw + d0 * 16);
    const int krow = 8 * wid + (lane >> 3), klog = (lane & 7) ^ ((krow >> 1) & 7);
    const bf16_t* kp = U.K + (size_t)(U.ctx_row0 + krow) * LDK + klog * 8;
    const int vsub = 2 * wid + (lane >> 5), vkey = ((DV == 128) ? (vsub >> 2) : (vsub >> 1)) * 8 + ((lane >> 2) & 7), vcol = ((DV == 128) ? (vsub & 3) : (vsub & 1)) * 32 + (lane & 3) * 8;
    const bf16_t* vp = U.V + (size_t)(U.ctx_row0 + vkey) * LDV + vcol;
    const LAS char* vrd = V_lds + v_rd_base(lane);
    const int jump = (U.lat_row0 + 64 * U.lat_t0) - (U.ctx_row0 + 192);
#define DMA1(gp, la) asm volatile("s_mov_b32 m0, %1\n\ts_nop 0\n\tglobal_load_lds_dwordx4 %0, off" :: "v"(gp), "s"(la) : "memory", "m0")
#define DWAIT() asm volatile("s_waitcnt vmcnt(0)" ::: "memory")
    const unsigned kl0 = (unsigned)(unsigned long)(K_lds + wid * 1024), vl0 = (unsigned)(unsigned long)(V_lds + wid * 1024);
#define DMA(t, ks, vs) do { \
        DMA1(kp, kl0 + (ks) * SHM_K); \
        DMA1(vp, vl0 + (vs) * SHM_V); \
        if constexpr (DV == 128) DMA1(vp + (size_t)32 * LDV, vl0 + (vs) * SHM_V + 8 * 1024); \
        { const int adv_ = ((t) == 3) ? jump : 64; kp += (ptrdiff_t)adv_ * LDK; vp += (ptrdiff_t)adv_ * LDV; } } while (0)
#define RESC(a) do { if (__any((a) < 1.f)) { if (hi == 0) al_l[r32] = (a); asm volatile("s_waitcnt lgkmcnt(0)" ::: "memory"); \
        _Pragma("unroll") for (int d = 0; d < NCB; ++d) _Pragma("unroll") for (int r = 0; r < 16; ++r) o[d][r] *= al_l[crow(r, hi)]; } } while (0)
    const int qs = U.q0 + wrow;
#define ACTIVE(t) (!SWA || (t) < 4 || (64 * (U.lat_t0 + (t) - 4) + 63 >= qs - 128 && 64 * (U.lat_t0 + (t) - 4) <= qs + 31 + 128))
#define MASK(P0, P1, t) do { if constexpr (SWA) { if ((t) >= 4 && !(64 * (U.lat_t0 + (t) - 4) >= qs + 31 - 128 && 64 * (U.lat_t0 + (t) - 4) + 63 <= qs + 128)) { const int kb_ = 64 * (U.lat_t0 + (t) - 4) - (qs + r32) + 4 * hi; \
        _Pragma("unroll") for (int r = 0; r < 16; ++r) { const int d0_ = kb_ + (r & 3) + 8 * (r >> 2); \
            if (d0_ > 128 || d0_ < -128) P0[r] = -1e30f; if (d0_ + 32 > 128 || d0_ + 32 < -128) P1[r] = -1e30f; } } } } while (0)
    f32x16 pA0, pA1, pB0, pB1; float alA = 1.f, alB = 1.f; bf16x8 pa0, pa1, pa2, pa3; const int NT = U.NT;
    bool actA = true, actB = true;
    int v5 = 0;
#define INC5(x) ((x) == 4 ? 0 : (x) + 1)
#define STEP0(t, C, P) do { \
        act##C = ACTIVE(t); \
        SBAR(); if (act##C) { qkt_r(p##C##0, p##C##1, K_lds + ((t) & 3) * SHM_K, qf, negm, r32, hi); MASK(p##C##0, p##C##1, t); } \
        if (act##P) finishSM(p##P##0, p##P##1, al##P, l_reg, pa0, pa1, pa2, pa3); SBAR(); \
        if (act##P) pv_all<NCB>(o, vrd + v5 * SHM_V, pa0, pa1, pa2, pa3); \
        if (act##C) { partialSM<NEGM>(p##C##0, p##C##1, m_reg, negm, al##C, false); RESC(al##C); } else al##C = 1.f; \
        v5 = INC5(v5); } while (0)
    DMA(0, 0, 0); DWAIT(); __syncthreads();
    asm volatile("" : "+v"(qf[0]), "+v"(qf[1]), "+v"(qf[2]), "+v"(qf[3]));
    DMA(1, 1, 1); DMA(2, 2, 2);
    qkt_r(pA0, pA1, K_lds, qf, negm, r32, hi); MASK(pA0, pA1, 0);
    partialSM<NEGM>(pA0, pA1, m_reg, negm, alA, true);
    DWAIT(); __syncthreads();
    int vw = 3;
    for (int j = 1; j + 1 < NT; j += 2) {
        if (j + 2 < NT) { DMA(j + 2, (j + 2) & 3, vw); vw = INC5(vw); }
        if (j + 3 < NT) { DMA(j + 3, (j + 3) & 3, vw); vw = INC5(vw); }
        STEP0(j, B, A); STEP0(j + 1, A, B);
        DWAIT(); __syncthreads();
    }
    if ((NT & 1) == 0) {
        STEP0(NT - 1, B, A);
        if (actB) { finishSM(pB0, pB1, alB, l_reg, pa0, pa1, pa2, pa3); SBAR(); pv_all<NCB>(o, vrd + v5 * SHM_V, pa0, pa1, pa2, pa3); }
    } else {
        if (actA) { finishSM(pA0, pA1, alA, l_reg, pa0, pa1, pa2, pa3); SBAR(); pv_all<NCB>(o, vrd + v5 * SHM_V, pa0, pa1, pa2, pa3); }
    }
    if constexpr (SWA) l_reg += __builtin_amdgcn_exp2f(U.sink[wid >> 1] * LOG2E - m_reg);
    if (hi == 0) li_l[r32] = l_reg; asm volatile("s_waitcnt lgkmcnt(0)" ::: "memory");
    float rli[16];
#pragma unroll
    for (int r = 0; r < 16; ++r) rli[r] = __builtin_amdgcn_rcpf(li_l[crow(r, hi)]);
    bf16_t* Ow = U.O + (size_t)wrow * LDO + wcol;
#pragma unroll
    for (int r = 0; r < 16; ++r) { const int orow = crow(r, hi);
#pragma unroll
        for (int d0 = 0; d0 < NCB; ++d0) Ow[(size_t)orow * LDO + d0 * 32 + r32] = (bf16_t)f2bf(o[d0][r] * rli[r]); }
    __syncthreads();
#undef DMA
#undef DMA1
#undef DWAIT
#undef RESC
#undef ACTIVE
#undef MASK
#undef INC5
#undef STEP0
}

template <int DV, bool SWA, class Gen>
__device__ __forceinline__ void attn_stream(const Gen& gen, const int nunits, LAS char* lds, const int tid) {
    constexpr int NCB = DV / 32;
    constexpr int LDQ = SWA ? 1024 : 512, LDK = SWA ? 256 : 512, LDV = LDK, LDO = 1024;
    constexpr int SHM_V = KVBLK * DV * 2, SHM_K = KVBLK * 64 * 2;
    static_assert(5 * SHM_V + 5 * SHM_K + 2048 <= RING_BYTES, "rings");
    if (nunits <= 0) return;
    const int wid = __builtin_amdgcn_readfirstlane(tid >> 6), lane = tid & 63, r32 = lane & 31, hi = lane >> 5;
    const int wrow = SWA ? (wid & 1) * QBLK : wid * QBLK, wcol = SWA ? (wid >> 1) * 64 : 0;
    LAS char* V_lds = lds; LAS char* K_lds = lds + 5 * SHM_V;
    LAS float* ws = (LAS float*)(lds + 5 * SHM_V + 5 * SHM_K) + wid * 64; LAS float* li_l = ws; LAS float* al_l = ws + 32;
    constexpr bool NEGM = true;
    const int krow = 8 * wid + (lane >> 3), klog = (lane & 7) ^ ((krow >> 1) & 7);
    const int vsub = 2 * wid + (lane >> 5), vkey = ((DV == 128) ? (vsub >> 2) : (vsub >> 1)) * 8 + ((lane >> 2) & 7), vcol = ((DV == 128) ? (vsub & 3) : (vsub & 1)) * 32 + (lane & 3) * 8;
    const LAS char* vrd = V_lds + v_rd_base(lane);
    const unsigned kl0 = (unsigned)(unsigned long)(K_lds + wid * 1024), vl0 = (unsigned)(unsigned long)(V_lds + wid * 1024);
    const bf16_t* kp; const bf16_t* vp; int jump; bf16x8 qf[4];
#define DMA1(gp, la) asm volatile("s_mov_b32 m0, %1\n\ts_nop 0\n\tglobal_load_lds_dwordx4 %0, off" :: "v"(gp), "s"(la) : "memory", "m0")
#define DWAIT() asm volatile("s_waitcnt vmcnt(0)" ::: "memory")
#define DMA(t, s) do { \
        DMA1(kp, kl0 + (s) * SHM_K); \
        DMA1(vp, vl0 + (s) * SHM_V); \
        if constexpr (DV == 128) DMA1(vp + (size_t)32 * LDV, vl0 + (s) * SHM_V + 8 * 1024); \
        { const int adv_ = ((t) == 3) ? jump : 64; kp += (ptrdiff_t)adv_ * LDK; vp += (ptrdiff_t)adv_ * LDV; } } while (0)
#define SETUP(UU) do { kp = (UU).K + (size_t)((UU).ctx_row0 + krow) * LDK + klog * 8; vp = (UU).V + (size_t)((UU).ctx_row0 + vkey) * LDV + vcol; \
        jump = ((UU).lat_row0 + 64 * (UU).lat_t0) - ((UU).ctx_row0 + 192); } while (0)
#define QLOAD(UU) do { const bf16_t* Qw_ = (UU).Q + (size_t)(wrow + r32) * LDQ + wcol + hi * 8; _Pragma("unroll") for (int d0 = 0; d0 < 4; ++d0) qf[d0] = *(const bf16x8*)(Qw_ + d0 * 16); } while (0)
#define INC5(x) ((x) == 4 ? 0 : (x) + 1)
#define RESC(a) do { if (__any((a) < 1.f)) { if (hi == 0) al_l[r32] = (a); asm volatile("s_waitcnt lgkmcnt(0)" ::: "memory"); \
        _Pragma("unroll") for (int d = 0; d < NCB; ++d) _Pragma("unroll") for (int r = 0; r < 16; ++r) o[d][r] *= al_l[crow(r, hi)]; } } while (0)
#define ACTIVE(t) (!SWA || (t) < 4 || (64 * (U.lat_t0 + (t) - 4) + 63 >= qs - 128 && 64 * (U.lat_t0 + (t) - 4) <= qs + 31 + 128))
#define MASK(P0, P1, t) do { if constexpr (SWA) { if ((t) >= 4 && !(64 * (U.lat_t0 + (t) - 4) >= qs + 31 - 128 && 64 * (U.lat_t0 + (t) - 4) + 63 <= qs + 128)) { const int kb_ = 64 * (U.lat_t0 + (t) - 4) - (qs + r32) + 4 * hi; \
        _Pragma("unroll") for (int r = 0; r < 16; ++r) { const int d0_ = kb_ + (r & 3) + 8 * (r >> 2); \
            if (d0_ > 128 || d0_ < -128) P0[r] = -1e30f; if (d0_ + 32 > 128 || d0_ + 32 < -128) P1[r] = -1e30f; } } } } while (0)
#define STEP0(t, C, P) do { \
        act##C = ACTIVE(t); \
        SBAR(); if (act##C) { qkt_r(p##C##0, p##C##1, K_lds + INC5(v5) * SHM_K, qf, negm, r32, hi); MASK(p##C##0, p##C##1, t); } \
        if (act##P) finishSM(p##P##0, p##P##1, al##P, l_reg, pa0, pa1, pa2, pa3); SBAR(); \
        if (act##P) pv_all<NCB>(o, vrd + v5 * SHM_V, pa0, pa1, pa2, pa3); \
        if (act##C) { partialSM<NEGM>(p##C##0, p##C##1, m_reg, negm, al##C, false); RESC(al##C); } else al##C = 1.f; \
        v5 = INC5(v5); } while (0)
    UnitDesc U, Un; float sink_n = 0.f;
    gen(0, Un); SETUP(Un); if constexpr (SWA) sink_n = Un.sink[wid >> 1]; QLOAD(Un);
    DMA(0, 0); DMA(1, 1); DMA(2, 2);
    DWAIT(); __syncthreads();
    int rb = 0;
    for (int ui = 0; ui < nunits; ++ui) {
        U = Un; const float sinkv = sink_n;
        const int NT = U.NT, qs = U.q0 + wrow;
        float m_reg = 0.f, l_reg = 0.f; f32x16 o[NCB]; f32x16 negm = f32x16{};
#pragma unroll
        for (int d = 0; d < NCB; ++d) o[d] = f32x16{};
        f32x16 pA0, pA1, pB0, pB1; float alA = 1.f, alB = 1.f; bf16x8 pa0, pa1, pa2, pa3;
        bool actA = true, actB = true;
        int v5 = rb;
        int vw = rb + 3 >= 5 ? rb - 2 : rb + 3;
        qkt_r(pA0, pA1, K_lds + rb * SHM_K, qf, negm, r32, hi); MASK(pA0, pA1, 0);
        partialSM<NEGM>(pA0, pA1, m_reg, negm, alA, true);
        for (int j = 1; j + 1 < NT; j += 2) {
            if (j + 2 < NT) { DMA(j + 2, vw); vw = INC5(vw); }
            if (j + 3 < NT) { DMA(j + 3, vw); vw = INC5(vw); }
            STEP0(j, B, A); STEP0(j + 1, A, B);
            DWAIT(); __syncthreads();
        }
        const bool has_next = ui + 1 < nunits;
        const int rbn = vw;
        if (has_next) { gen(ui + 1, Un); SETUP(Un); DMA(0, vw); vw = INC5(vw); DMA(1, vw); vw = INC5(vw); DMA(2, vw); }
        if ((NT & 1) == 0) {
            STEP0(NT - 1, B, A);
            if (actB) { finishSM(pB0, pB1, alB, l_reg, pa0, pa1, pa2, pa3); SBAR(); pv_all<NCB>(o, vrd + v5 * SHM_V, pa0, pa1, pa2, pa3); }
        } else {
            if (actA) { finishSM(pA0, pA1, alA, l_reg, pa0, pa1, pa2, pa3); SBAR(); pv_all<NCB>(o, vrd + v5 * SHM_V, pa0, pa1, pa2, pa3); }
        }
        SBAR();
        if (has_next) { if constexpr (SWA) sink_n = Un.sink[wid >> 1]; QLOAD(Un); }
        if constexpr (SWA) l_reg += __builtin_amdgcn_exp2f(sinkv * LOG2E - m_reg);
        if (hi == 0) li_l[r32] = l_reg; asm volatile("s_waitcnt lgkmcnt(0)" ::: "memory");
        float rli[16];
#pragma unroll
        for (int r = 0; r < 16; ++r) rli[r] = __builtin_amdgcn_rcpf(li_l[crow(r, hi)]);
        bf16_t* Ow = U.O + (size_t)wrow * LDO + wcol;
#pragma unroll
        for (int r = 0; r < 16; ++r) { const int orow = crow(r, hi);
#pragma unroll
            for (int d0 = 0; d0 < NCB; ++d0) Ow[(size_t)orow * LDO + d0 * 32 + r32] = (bf16_t)f2bf(o[d0][r] * rli[r]); }
        if (has_next) { constexpr int NAFTER = 4 + 16 * NCB > 63 ? 63 : 4 + 16 * NCB; asm volatile("s_waitcnt vmcnt(%0) lgkmcnt(0)\n\ts_barrier" :: "n"(NAFTER) : "memory"); }
        else __syncthreads();
        rb = rbn;
    }
#undef DMA
#undef DMA1
#undef DWAIT
#undef SETUP
#undef QLOAD
#undef RESC
#undef ACTIVE
#undef MASK
#undef INC5
#undef STEP0
}
#undef SBAR
#undef KSWZ
}

struct Args { const float* in[32]; float* out; unsigned char* ws; int nprog, pad; unsigned char prog[64]; };
struct ArgsD { const GAS float* in[32]; GAS float* out; GAS unsigned char* ws; int nprog, pad; unsigned char prog[64]; };
typedef const __attribute__((address_space(4))) ArgsD* ArgsP;
#define APIN(i) ((const float*)ap->in[i])
#define APOUT ((float*)ap->out)

struct Frame {
    LAS unsigned char* lds;
    int tid, lane, wave, vcu, G, gw, NGW;
    unsigned char* ws;
};

__device__ __forceinline__ int rope_src(int p) { return 16 * ((p >> 2) & 1) + 4 * (p >> 3) + (p & 3); }
__device__ __forceinline__ void transpose_item(const float* W, int N, bf16_t* WT, int src0, int dst_row0, int k0, bool perm, LAS float* scr, int lane) {
    float tv[32];
#pragma unroll
    for (int i = 0; i < 32; ++i) { const int kk = 2 * i + (lane >> 5); tv[i] = W[(size_t)(k0 + kk) * N + src0 + (lane & 31)]; }
#pragma unroll
    for (int i = 0; i < 32; ++i) { const int kk = 2 * i + (lane >> 5); scr[kk * 33 + (lane & 31)] = tv[i]; }
    LDS_WAIT(); asm volatile("" ::: "memory");
    const int c = lane & 7;
#pragma unroll
    for (int j = 0; j < 4; ++j) { const int n = (lane >> 3) + 8 * j; const int sn = perm ? rope_src(n) : n; const LAS float* s = scr + (8 * c) * 33 + sn;
        u32x4 o; o.x = pk2(s[0 * 33], s[1 * 33]); o.y = pk2(s[2 * 33], s[3 * 33]); o.z = pk2(s[4 * 33], s[5 * 33]); o.w = pk2(s[6 * 33], s[7 * 33]);
        *(u32x4*)(WT + (size_t)(dst_row0 + n) * DM + k0 + 8 * c) = o; }
    LDS_WAIT(); asm volatile("" ::: "memory");
}
__device__ __forceinline__ void transpose_item8(const float* W, int N, unsigned char* WT, int src0, int dst_row0, int k0, LAS float* scr, int lane) {
    float tv[32];
#pragma unroll
    for (int i = 0; i < 32; ++i) { const int kk = 2 * i + (lane >> 5); tv[i] = W[(size_t)(k0 + kk) * N + src0 + (lane & 31)]; }
#pragma unroll
    for (int i = 0; i < 32; ++i) { const int kk = 2 * i + (lane >> 5); scr[kk * 33 + (lane & 31)] = tv[i] * 32.f; }
    LDS_WAIT(); asm volatile("" ::: "memory");
    const int c = lane & 7;
#pragma unroll
    for (int j = 0; j < 4; ++j) { const int n = (lane >> 3) + 8 * j; const LAS float* s = scr + (8 * c) * 33 + n;
        u32x2 o; o.x = pk4_fp8(s[0 * 33], s[1 * 33], s[2 * 33], s[3 * 33]); o.y = pk4_fp8(s[4 * 33], s[5 * 33], s[6 * 33], s[7 * 33]);
        *(u32x2*)(WT + (size_t)(dst_row0 + n) * DM + k0 + 8 * c) = o; }
    LDS_WAIT(); asm volatile("" ::: "memory");
}
__device__ __forceinline__ float silu_f(float v) { return v / (1.f + __expf(-v)); }

namespace wc { constexpr int I_IN = 96 * 16, I_O = 32 * 16, I_GU = 16 * 64 * 16, I_D = 16 * 32 * 16, I_QKV = 48 * 16;
    constexpr int NITEMS = I_IN + I_O + I_GU + I_D + I_QKV + I_O + I_GU + I_D;
    constexpr int L0E = I_IN + I_O, L1 = L0E + I_GU + I_D;
    constexpr int F1_LO = L0E, F1_HI = F1_LO + 160 * 54, F2_HI = F1_HI + 224 * 54;
    constexpr int F3_LO = L1, F3_HI = F3_LO + 128 * 34, F4_HI = F3_HI + 192 * 34, F5_HI = F4_HI + 208 * 54;
    static_assert(F2_HI < L1 && F5_HI < NITEMS && F3_LO + I_QKV + I_O <= F3_HI, "filler slices");
}
__device__ __forceinline__ void weight_item(Frame& F, ArgsP ap, int it, LAS float* scr) {
    using namespace wc; unsigned char* ws = F.ws;
        int r = it;
        if (r < I_IN) { const int g = r / 16, kb = r % 16, r0 = 32 * g; int src0; bool perm = false;
            if (r0 < 512) src0 = r0;
            else if (r0 < 1536) { const int u = (r0 - 512) / 256, w = (r0 - 512) % 256; src0 = w < 128 ? 512 + u * 128 + w : 1024 + u * 128 + (w - 128); }
            else if (r0 < 2560) { src0 = r0; perm = true; }
            else src0 = r0;
            transpose_item(APIN(7), NWIN, (bf16_t*)(ws + W_IN), src0, r0, kb * 64, perm, scr, F.lane); return; }
        r -= I_IN;
        if (r < I_O) { const int g = r / 16, kb = r % 16; transpose_item(APIN(14), DM, (bf16_t*)(ws + W_OUT0), 32 * g, 32 * g, kb * 64, false, scr, F.lane); return; }
        r -= I_O;
        if (r < I_GU) { const int e = r / 1024, g = (r % 1024) / 16, kb = r % 16, r0 = 32 * g, u = r0 / 256, w = r0 % 256;
            const float* src = (w < 128 ? APIN(17) : APIN(18)) + (size_t)e * DM * FF;
            transpose_item8(src, FF, (unsigned char*)(ws + W_GU0) + (size_t)e * 2 * FF * DM, u * 128 + (w & 127), r0, kb * 64, scr, F.lane); return; }
        r -= I_GU;
        if (r < I_D) { const int e = r / 512, g = (r % 512) / 16, kb = r % 16;
            transpose_item8(APIN(19) + (size_t)e * FF * DM, DM, (unsigned char*)(ws + W_D0) + (size_t)e * DM * FF, 32 * g, 32 * g, kb * 64, scr, F.lane); return; }
        r -= I_D;
        if (r < I_QKV) { const int g = r / 16, kb = r % 16, r0 = 32 * g;
            transpose_item(APIN(23), NQKV1, (bf16_t*)(ws + W_QKV), r0, r0, kb * 64, r0 < 1280, scr, F.lane); return; }
        r -= I_QKV;
        if (r < I_O) { const int g = r / 16, kb = r % 16; transpose_item(APIN(25), DM, (bf16_t*)(ws + W_OUT1), 32 * g, 32 * g, kb * 64, false, scr, F.lane); return; }
        r -= I_O;
        if (r < I_GU) { const int e = r / 1024, g = (r % 1024) / 16, kb = r % 16, r0 = 32 * g, u = r0 / 256, w = r0 % 256;
            const float* src = (w < 128 ? APIN(28) : APIN(29)) + (size_t)e * DM * FF;
            transpose_item8(src, FF, (unsigned char*)(ws + W_GU1) + (size_t)e * 2 * FF * DM, u * 128 + (w & 127), r0, kb * 64, scr, F.lane); return; }
        r -= I_GU;
        { const int e = r / 512, g = (r % 512) / 16, kb = r % 16;
            transpose_item8(APIN(30) + (size_t)e * FF * DM, DM, (unsigned char*)(ws + W_D1) + (size_t)e * DM * FF, 32 * g, 32 * g, kb * 64, scr, F.lane); }
}
__device__ __forceinline__ void weight_items(Frame& F, ArgsP ap, int lo, int hi, int wv, int nw) {
    LAS float* scr = (LAS float*)(F.lds + F.wave * 16384);
    for (int it = lo + wv; it < hi; it += nw) weight_item(F, ap, it, scr);
}
__device__ __forceinline__ void p0_prologue(Frame& F, ArgsP ap, const bool rerun) {
    LAS float* scr = (LAS float*)(F.lds + F.wave * 16384);
    unsigned char* ws = F.ws;
    if (F.gw < 16) { const int pos = F.gw * 4 + (F.lane >> 4), f = F.lane & 15;
        const float inv = __builtin_amdgcn_exp2f(-(float)f * (13.287712379549449f / 16.f));
        const float ang = (float)pos * inv, rev = ang * 0.15915494309189535f;
        float* rp = (float*)(ws + WS_ROPE);
        rp[pos * 16 + f] = __builtin_amdgcn_cosf(rev); rp[1024 + pos * 16 + f] = __builtin_amdgcn_sinf(rev); }
    if (!rerun && F.vcu < 2 * 4 * 24) {
        const int it = F.vcu, layer = it / 96, r = it % 96, kq = r / 24, nb = r % 24;
        const float* W = APIN(layer ? 20 : 4);
        const int n0 = nb * 256 + 4 * F.lane, k0 = kq * 256 + F.wave * 32;
        f32x4 acc[9];
#pragma unroll
        for (int b = 0; b < 9; ++b) acc[b] = (f32x4){0.f, 0.f, 0.f, 0.f};
        float sv[9];
#pragma unroll
        for (int b = 0; b < 8; ++b) sv[b] = silu_f(APIN(1)[b * DM + k0 + (F.lane & 31)]);
        sv[8] = silu_f(APIN(3)[k0 + (F.lane & 31)]);
#pragma unroll 8
        for (int kk = 0; kk < 32; ++kk) { const f32x4 w = *(const f32x4*)(W + (size_t)(k0 + kk) * 6144 + n0);
#pragma unroll
            for (int b = 0; b < 9; ++b) { const float s = __builtin_bit_cast(float, __builtin_amdgcn_readlane(__builtin_bit_cast(int, sv[b]), kk)); acc[b] += w * s; } }
#pragma unroll
        for (int b = 0; b < 9; ++b) *(LAS f32x4*)(scr + b * 256 + 4 * F.lane) = acc[b];
        __syncthreads();
        float* part = (float*)(ws + WS_PART) + (size_t)(layer * 4 + kq) * 9 * 6144;
        for (int o = F.tid; o < 9 * 256; o += NTHREADS) { float s = 0.f;
#pragma unroll
            for (int w = 0; w < 8; ++w) s += ((LAS float*)(F.lds + w * 16384))[o];
            part[(o >> 8) * 6144 + nb * 256 + (o & 255)] = s; }
        __syncthreads();
    }
    weight_items(F, ap, 0, wc::L0E, F.gw, F.NGW);
    weight_items(F, ap, wc::F2_HI, wc::L1, F.gw, F.NGW);
    weight_items(F, ap, wc::F5_HI, wc::NITEMS, F.gw, F.NGW);
}

__device__ __forceinline__ void load_row(const float* p, int lane, f32x4 (&v)[4]) {
    const f32x4* r = (const f32x4*)p + lane;
#pragma unroll
    for (int j = 0; j < 4; ++j) v[j] = r[64 * j];
}
__device__ __forceinline__ void load_row_bf(const bf16_t* p, int lane, f32x4 (&v)[4]) {
    const u32x2* r = (const u32x2*)p + lane;
#pragma unroll
    for (int j = 0; j < 4; ++j) { const u32x2 w = r[64 * j]; v[j] = (f32x4){bf_lo(w.x), bf_hi(w.x), bf_lo(w.y), bf_hi(w.y)}; }
}
__device__ __forceinline__ void wave_range(int total, int gw, int ngw, int& r0, int& r1) { const int per = (total + ngw - 1) / ngw; r0 = gw * per; r1 = r0 + per < total ? r0 + per : total; }
__device__ __forceinline__ const float* xrow_ptr(const float* xlat, const float* xctx, int r) { return r < NLAT ? xlat + (size_t)r * DM : xctx + (size_t)(r - NLAT) * DM; }
__device__ __forceinline__ void load_mod(const float* gain, const float* shift, const float* scale, int lane, f32x4 (&ga)[4], f32x4 (&sh)[4]) {
#pragma unroll
    for (int j = 0; j < 4; ++j) { const f32x4 g = ((const f32x4*)gain)[lane + 64 * j], sc = ((const f32x4*)scale)[lane + 64 * j]; ga[j] = g * (sc + 1.0f); sh[j] = ((const f32x4*)shift)[lane + 64 * j]; }
}
__device__ __forceinline__ void modulate_row(f32x4 (&v)[4], const f32x4 (&ga)[4], const f32x4 (&sh)[4], int lane, bf16_t* orow) {
    float s = 0.f;
#pragma unroll
    for (int j = 0; j < 4; ++j) s += (v[j].x * v[j].x + v[j].y * v[j].y) + (v[j].z * v[j].z + v[j].w * v[j].w);
    const float rs = 1.f / sqrtf(wave_sum(s) * (1.f / DM) + NORM_EPS);
    u32x2* o8 = (u32x2*)orow + lane;
#pragma unroll
    for (int j = 0; j < 4; ++j) { v[j] = (v[j] * rs) * ga[j] + sh[j];
        u32x2 w; w.x = cvt_pk_bf16(v[j].x, v[j].y); w.y = cvt_pk_bf16(v[j].z, v[j].w); o8[64 * j] = w; }
}
__device__ __forceinline__ f32x4 mod_sum4(const float* part_layer, const float* bias, int b, int n) {
    f32x4 s = *(const f32x4*)(bias + n);
#pragma unroll
    for (int q = 0; q < 4; ++q) s += *(const f32x4*)(part_layer + (size_t)(q * 9 + b) * 6144 + n);
    return s;
}
__device__ __forceinline__ void norm1_phase(Frame& F, const float* xlat, const float* xctx, const float* gain, const float* bias0, const float* bias1) {
    bf16_t* XN = (bf16_t*)(F.ws + A_XN);
    const float* part = (const float*)(F.ws + WS_PART); float* mod = (float*)(F.ws + WS_MOD);
    for (int i = (F.gw * 64 + F.lane) * 4; i < 2 * 9 * 6144; i += F.NGW * 64 * 4) {
        const int layer = i / (9 * 6144), r = i % (9 * 6144), b = r / 6144, n = r % 6144;
        *(f32x4*)(mod + i) = mod_sum4(part + (size_t)layer * 4 * 9 * 6144, layer ? bias1 : bias0, b, n);
    }
    int r0, r1; wave_range(MALL, F.gw, F.NGW, r0, r1);
    f32x4 v[4], vn[4], ga[4], sh[4]; int cb = -1;
    if (r0 < r1) load_row(xrow_ptr(xlat, xctx, r0), F.lane, vn);
    for (int r = r0; r < r1; ++r) {
#pragma unroll
        for (int j = 0; j < 4; ++j) v[j] = vn[j];
        if (r + 1 < r1) load_row(xrow_ptr(xlat, xctx, r + 1), F.lane, vn);
        const int b = r < NLAT ? (r >> 12) : 8;
        if (b != cb) { cb = b;
#pragma unroll
            for (int j = 0; j < 4; ++j) { const int k = 4 * (F.lane + 64 * j); const f32x4 g = ((const f32x4*)gain)[F.lane + 64 * j];
                const f32x4 shv = mod_sum4(part, bias0, b, k), scv = mod_sum4(part, bias0, b, 1024 + k); ga[j] = g * (scv + 1.0f); sh[j] = shv; } }
        modulate_row(v, ga, sh, F.lane, XN + (size_t)r * DM);
    }
}
__device__ __forceinline__ void load_router(Frame& F, const float* Wr) {
    LAS float* Wt = (LAS float*)F.lds;
    for (int i = F.tid; i < DM * 4; i += NTHREADS) { const int k = i >> 2, e4 = (i & 3) * 4; const f32x4 w = *(const f32x4*)(Wr + k * 16 + e4);
        Wt[(e4 + 0) * DM + k] = w.x; Wt[(e4 + 1) * DM + k] = w.y; Wt[(e4 + 2) * DM + k] = w.z; Wt[(e4 + 3) * DM + k] = w.w; }
    __syncthreads();
}
__device__ __forceinline__ void router_dot2(const LAS char* Wl, const f32x4 (&va)[4], const f32x4 (&vb)[4], float (&la)[16], float (&lb)[16]) {
#pragma unroll
    for (int e = 0; e < 16; ++e) { f32x2 sa = {0.f, 0.f}, sb = {0.f, 0.f};
#pragma unroll
        for (int j = 0; j < 4; ++j) { const f32x4 w = *(const LAS f32x4*)(Wl + (e * DM + 256 * j) * 4);
            const f32x2 wl = {w.x, w.y}, wh = {w.z, w.w};
            sa = __builtin_elementwise_fma((f32x2){va[j].x, va[j].y}, wl, sa); sa = __builtin_elementwise_fma((f32x2){va[j].z, va[j].w}, wh, sa);
            sb = __builtin_elementwise_fma((f32x2){vb[j].x, vb[j].y}, wl, sb); sb = __builtin_elementwise_fma((f32x2){vb[j].z, vb[j].w}, wh, sb); }
        la[e] = sa.x + sa.y; lb[e] = sb.x + sb.y; if ((e & 1) == 1) __builtin_amdgcn_sched_barrier(0); }
}
__device__ __forceinline__ float router_softmax(const float (&lg)[16], int l) {
    float a8[8];
#pragma unroll
    for (int i = 0; i < 8; ++i) { auto rr = __builtin_amdgcn_permlane32_swap(__float_as_uint(lg[i]), __float_as_uint(lg[8 + i]), false, false); a8[i] = __uint_as_float(rr[0]) + __uint_as_float(rr[1]); }
    float a4[4];
#pragma unroll
    for (int i = 0; i < 4; ++i) { auto rr = __builtin_amdgcn_permlane16_swap(__float_as_uint(a8[i]), __float_as_uint(a8[4 + i]), false, false); a4[i] = __uint_as_float(rr[0]) + __uint_as_float(rr[1]); }
    float a2[2];
#pragma unroll
    for (int i = 0; i < 2; ++i) { const bool up = (l & 8) != 0; const float keep = up ? a4[2 + i] : a4[i], send = up ? a4[i] : a4[2 + i]; a2[i] = keep + dpp_f<0x128>(send); }
    float a1;
    { const bool up = (l & 4) != 0; const float keep = up ? a2[1] : a2[0], send = up ? a2[0] : a2[1]; a1 = keep + dpp_f<0x141>(send); }
    a1 += dpp_f<0x4E>(a1); a1 += dpp_f<0xB1>(a1);
    float mx = a1;
    mx = fmaxf(mx, dpp_f<0x141>(mx)); mx = fmaxf(mx, dpp_f<0x128>(mx)); mx = xmax16(mx); mx = xmax32(mx);
    const float ex = __expf(a1 - mx);
    float den = ex; den += dpp_f<0x141>(den); den += dpp_f<0x128>(den); den = xsum16(den); den = xsum32(den);
    return ex / den;
}
__device__ __forceinline__ void norm2_router_phase(Frame& F, int nrows, const float* gain, const float* mod, const float* Wr) {
    load_router(F, Wr);
    unsigned char* XN8 = (unsigned char*)(F.ws + A_XN); float* AFF = (float*)(F.ws + WS_AFF); const bf16_t* XB = (const bf16_t*)(F.ws + WS_XB);
    const int npairs = nrows >> 1;
    int p0, p1; wave_range(npairs, F.gw, F.NGW, p0, p1);
    f32x4 ga[4], sh[4]; int cb = -1;
    const int l = F.lane;
    u32x2 na[4], nb[4];
    if (p0 < p1) { const u32x2* ra = (const u32x2*)(XB + (size_t)(2 * p0) * DM) + l; const u32x2* rb = (const u32x2*)(XB + (size_t)(2 * p0 + 1) * DM) + l;
#pragma unroll
        for (int j = 0; j < 4; ++j) { na[j] = ra[64 * j]; nb[j] = rb[64 * j]; } }
    for (int p = p0; p < p1; ++p) {
        const int r = 2 * p;
        f32x4 va[4], vb[4];
#pragma unroll
        for (int j = 0; j < 4; ++j) { va[j] = (f32x4){bf_lo(na[j].x), bf_hi(na[j].x), bf_lo(na[j].y), bf_hi(na[j].y)}; vb[j] = (f32x4){bf_lo(nb[j].x), bf_hi(nb[j].x), bf_lo(nb[j].y), bf_hi(nb[j].y)}; }
        if (p + 1 < p1) { const u32x2* ra = (const u32x2*)(XB + (size_t)(r + 2) * DM) + l; const u32x2* rb = (const u32x2*)(XB + (size_t)(r + 3) * DM) + l;
#pragma unroll
            for (int j = 0; j < 4; ++j) { na[j] = ra[64 * j]; nb[j] = rb[64 * j]; } }
        const int b = r < NLAT ? (r >> 12) : 8;
        if (b != cb) { cb = b; load_mod(gain, mod + (size_t)b * 6144 + 3 * 1024, mod + (size_t)b * 6144 + 4 * 1024, l, ga, sh); }
        float s0 = 0.f, s1 = 0.f;
#pragma unroll
        for (int j = 0; j < 4; ++j) { s0 += (va[j].x * va[j].x + va[j].y * va[j].y) + (va[j].z * va[j].z + va[j].w * va[j].w); s1 += (vb[j].x * vb[j].x + vb[j].y * vb[j].y) + (vb[j].z * vb[j].z + vb[j].w * vb[j].w); }
        const float rs0 = 1.f / sqrtf(wave_sum(s0) * (1.f / DM) + NORM_EPS), rs1 = 1.f / sqrtf(wave_sum(s1) * (1.f / DM) + NORM_EPS);
        unsigned* oa = (unsigned*)(XN8 + (size_t)r * DM) + l; unsigned* ob = (unsigned*)(XN8 + (size_t)(r + 1) * DM) + l;
#pragma unroll
        for (int j = 0; j < 4; ++j) { va[j] = (va[j] * rs0) * ga[j] + sh[j]; vb[j] = (vb[j] * rs1) * ga[j] + sh[j];
            oa[64 * j] = pk4_fp8(va[j].x, va[j].y, va[j].z, va[j].w); ob[64 * j] = pk4_fp8(vb[j].x, vb[j].y, vb[j].z, vb[j].w); }
        int wofs = 16 * l; asm volatile("" : "+v"(wofs));
        float la[16], lb[16];
        router_dot2((const LAS char*)F.lds + wofs, va, vb, la, lb);
        const float pa_ = router_softmax(la, l), pb_ = router_softmax(lb, l);
        if ((l & 3) == 0) { AFF[(size_t)r * 16 + (l >> 2)] = pa_; AFF[(size_t)(r + 1) * 16 + (l >> 2)] = pb_; }
    }
    __syncthreads();
}

__device__ __forceinline__ void mix0_combine_phase(Frame& F, ArgsP ap) {
    const bf16_t* BG = (const bf16_t*)(F.ws + A_BG); const bf16_t* CX = (const bf16_t*)(F.ws + A_CX); const bf16_t* OH = (const bf16_t*)(F.ws + A_OH);
    bf16_t* AO = (bf16_t*)(F.ws + A_XN);
    float d1 = APIN(9)[F.lane] * APIN(10)[F.lane], d2 = APIN(11)[F.lane] * APIN(12)[F.lane];
    const float lam = __expf(wave_sum(d1)) - __expf(wave_sum(d2)) + LAM_INIT;
    const int l = F.lane;
    float cw0[8], cw1[8], cw2[8], sg[8];
#pragma unroll
    for (int i = 0; i < 8; ++i) { cw0[i] = APIN(8)[8 * l + i]; cw1[i] = APIN(8)[512 + 8 * l + i]; cw2[i] = APIN(8)[1024 + 8 * l + i]; sg[i] = APIN(13)[(l & 15) * 8 + i] * (1.f - LAM_INIT); }
    const int h = l >> 4, d0 = (l & 15) * 8;
    int r0, r1; wave_range(MALL, F.gw, F.NGW, r0, r1);
    if (r0 >= r1) return;
    const u32x4 zero = (u32x4){0u, 0u, 0u, 0u};
#define CXROW(r) (*(const u32x4*)(CX + (size_t)(r) * 512 + 8 * l))
    u32x4 c0 = r0 > 0 ? CXROW(r0 - 1) : zero, c1 = CXROW(r0), c2 = r0 + 1 < MALL ? CXROW(r0 + 1) : zero, c3;
    u32x4 bgn = *(const u32x4*)(BG + (size_t)r0 * 512 + 8 * l);
    u32x4 o1n = *(const u32x4*)(OH + (size_t)r0 * DM + (2 * h) * 128 + d0), o2n = *(const u32x4*)(OH + (size_t)r0 * DM + (2 * h + 1) * 128 + d0);
    for (int r = r0; r < r1; ++r) {
        const u32x4 bgv = bgn, o1 = o1n, o2 = o2n;
        c3 = r + 2 < MALL ? CXROW(r + 2) : zero;
        if (r + 1 < r1) { bgn = *(const u32x4*)(BG + (size_t)(r + 1) * 512 + 8 * l);
            o1n = *(const u32x4*)(OH + (size_t)(r + 1) * DM + (2 * h) * 128 + d0); o2n = *(const u32x4*)(OH + (size_t)(r + 1) * DM + (2 * h + 1) * 128 + d0); }
        const bool lat = r < NLAT; const int t = lat ? (r & (SEQ - 1)) : ((r - NLAT) & (CTX - 1)); const int tl = lat ? SEQ : CTX;
        const u32x4 ca = t > 0 ? c0 : zero, cc = t < tl - 1 ? c2 : zero;
        u32x4 ow;
#pragma unroll
        for (int i = 0; i < 4; ++i) {
            const float lo = bf_lo(bgv[i]) * (cw0[2 * i] * bf_lo(ca[i]) + cw1[2 * i] * bf_lo(c1[i]) + cw2[2 * i] * bf_lo(cc[i]));
            const float hi = bf_hi(bgv[i]) * (cw0[2 * i + 1] * bf_hi(ca[i]) + cw1[2 * i + 1] * bf_hi(c1[i]) + cw2[2 * i + 1] * bf_hi(cc[i]));
            ow[i] = cvt_pk_bf16(lo, hi); }
        *(u32x4*)(AO + (size_t)r * DM + 8 * l) = ow;
        c0 = c1; c1 = c2; c2 = c3;
        float ov[8]; float ss = 0.f;
#pragma unroll
        for (int i = 0; i < 4; ++i) { ov[2 * i] = bf_lo(o1[i]) - lam * bf_lo(o2[i]); ov[2 * i + 1] = bf_hi(o1[i]) - lam * bf_hi(o2[i]); ss += ov[2 * i] * ov[2 * i] + ov[2 * i + 1] * ov[2 * i + 1]; }
        ss = row16_sum(ss);
        const float rs = 1.f / sqrtf(ss * (1.f / 128.f) + NORM_EPS);
        u32x4 ow2;
#pragma unroll
        for (int i = 0; i < 4; ++i) ow2[i] = cvt_pk_bf16(ov[2 * i] * rs * sg[2 * i], ov[2 * i + 1] * rs * sg[2 * i + 1]);
        *(u32x4*)(AO + (size_t)r * DM + 512 + h * 128 + d0) = ow2;
    }
#undef CXROW
}

__device__ __forceinline__ unsigned block_excl_scan(unsigned v, LAS unsigned* sc, int tid, unsigned& total) {
    unsigned x = v;
    x += (unsigned)__builtin_amdgcn_update_dpp(0, (int)x, 0x111, 0xf, 0xf, true); x += (unsigned)__builtin_amdgcn_update_dpp(0, (int)x, 0x112, 0xf, 0xf, true);
    x += (unsigned)__builtin_amdgcn_update_dpp(0, (int)x, 0x114, 0xf, 0xf, true); x += (unsigned)__builtin_amdgcn_update_dpp(0, (int)x, 0x118, 0xf, 0xf, true);
    x += (unsigned)__builtin_amdgcn_update_dpp(0, (int)x, 0x142, 0xa, 0xf, false); x += (unsigned)__builtin_amdgcn_update_dpp(0, (int)x, 0x143, 0xc, 0xf, false);
    if ((tid & 63) == 63) sc[tid >> 6] = x;
    __syncthreads();
    unsigned base = 0, tot = 0;
#pragma unroll
    for (int w = 0; w < 8; ++w) { const unsigned s = sc[w]; if (w < (tid >> 6)) base += s; tot += s; }
    __syncthreads();
    total = tot;
    return base + x - v;
}
__device__ __forceinline__ void topk_list(Frame& F, int row0, int n, int e, int cap, int slot_row0) {
    LAS unsigned* sc = (LAS unsigned*)F.lds;
    LAS unsigned* cw = sc + 16;
    const float* AFF = (const float*)(F.ws + WS_AFF); int* POS = (int*)(F.ws + WS_POS); int* IDX = (int*)(F.ws + WS_IDX);
    const int tid = F.tid, wave = tid >> 6;
    const int per = 8; const int base = tid * per; const bool act = base < n;
    unsigned kk[8];
#pragma unroll
    for (int i = 0; i < per; ++i) kk[i] = act ? __builtin_bit_cast(unsigned, AFF[(size_t)(row0 + base + i) * 16 + e]) : 0u;
    unsigned T = 0; int it = 0;
    for (int bit = 30; bit >= 0; --bit, ++it) {
        const unsigned cand = T | (1u << bit);
        unsigned c = 0;
#pragma unroll
        for (int i = 0; i < per; ++i) c += (unsigned)__builtin_popcountll(__ballot(act && kk[i] >= cand));
        if ((tid & 63) == 0) cw[(it & 1) * 8 + wave] = c;
        __syncthreads();
        unsigned tot = 0;
#pragma unroll
        for (int w = 0; w < 8; ++w) tot += cw[(it & 1) * 8 + w];
        if (tot >= (unsigned)cap) T = cand;
    }
    __syncthreads();
    const unsigned prefix = T;
    unsigned ngt_l = 0, neq = 0;
#pragma unroll
    for (int i = 0; i < per; ++i) { ngt_l += (act && kk[i] > prefix) ? 1u : 0u; neq += (act && kk[i] == prefix) ? 1u : 0u; }
    unsigned ngt; (void)block_excl_scan(ngt_l, sc, tid, ngt);
    const unsigned krem = (unsigned)cap - ngt;
    unsigned tot; const unsigned eq_before = block_excl_scan(neq, sc, tid, tot);
    unsigned nsel = 0; unsigned selm = 0; unsigned eqc = eq_before;
#pragma unroll
    for (int i = 0; i < per; ++i) { bool s = false; if (act) { if (kk[i] > prefix) s = true; else if (kk[i] == prefix) { s = eqc < krem; ++eqc; } } if (s) { selm |= 1u << i; ++nsel; } }
    const unsigned sel_before = block_excl_scan(nsel, sc, tid, tot);
    unsigned slot = sel_before;
    if (act) {
#pragma unroll
        for (int i = 0; i < per; ++i) { const int row = row0 + base + i;
            if (selm & (1u << i)) { IDX[e * EROWS0 + slot_row0 + slot] = row; POS[(size_t)row * 16 + e] = slot_row0 + (int)slot; ++slot; }
            else POS[(size_t)row * 16 + e] = -1; }
    }
    __syncthreads();
}
__device__ __forceinline__ void topk_phase(Frame& F, bool with_ctx) {
    const int nl = with_ctx ? 256 : 128;
    for (int lid = F.vcu; lid < nl; lid += F.G) {
        if (lid < 128) { const int b = lid >> 4, e = lid & 15; topk_list(F, b * SEQ, SEQ, e, CAP_L, b * CAP_L); }
        else { const int b = (lid - 128) >> 4, e = lid & 15; topk_list(F, NLAT + b * CTX, CTX, e, CAP_C, NB * CAP_L + b * CAP_C); }
    }
}
__device__ __forceinline__ void gather_phase(Frame& F, int erows) {
    const int* IDX = (const int*)(F.ws + WS_IDX); const bf16_t* XN = (const bf16_t*)(F.ws + A_XN); bf16_t* HS = (bf16_t*)(F.ws + A_HS);
    const int total = NE * erows;
    int r0, r1; wave_range(total, F.gw, F.NGW, r0, r1);
    for (int base = r0; base < r1; base += 64) {
        const int n = r1 - base < 64 ? r1 - base : 64;
        int myidx = 0;
        if (F.lane < n) { const int i = base + F.lane; const int e = i / erows, s = i - e * erows; myidx = __hip_atomic_load(IDX + e * EROWS0 + s, RLX_AGENT); }
        for (int k = 0; k < n; k += 4) {
            u32x4 va[4], vb[4];
#pragma unroll
            for (int q = 0; q < 4; ++q) { const int kk = k + q < n ? k + q : n - 1; const int src = __builtin_amdgcn_readlane(myidx, kk);
                const u32x4* sp = (const u32x4*)(XN + (size_t)src * DM) + F.lane; va[q] = sp[0]; vb[q] = sp[64]; }
#pragma unroll
            for (int q = 0; q < 4; ++q) { if (k + q < n) { u32x4* dp = (u32x4*)(HS + (size_t)(base + k + q) * DM) + F.lane; dp[0] = va[q]; dp[64] = vb[q]; } }
        }
    }
}
__device__ __forceinline__ void moe_combine_phase(Frame& F, int nrows, int erows, const float* mod_cur, bool final_norm,
                                                  const float* gain_next, const float* mod_next, float* outp) {
    const float* AFF = (const float*)(F.ws + WS_AFF); const int* POS = (const int*)(F.ws + WS_POS); const unsigned char* Y = (const unsigned char*)(F.ws + A_HS);
    bf16_t* XN = (bf16_t*)(F.ws + A_XN); bf16_t* XB = (bf16_t*)(F.ws + WS_XB);
    int r0, r1; wave_range(nrows, F.gw, F.NGW, r0, r1);
    if (r0 >= r1) return;
    const int l = F.lane;
    f32x4 v[4], vn[4], ga[4], sh[4], g2[4]; int cb = -1; int pos_n = -1; float af_n = 0.f;
    load_row_bf(XB + (size_t)r0 * DM, l, vn);
    if (l < 16) { pos_n = POS[(size_t)r0 * 16 + l]; af_n = AFF[(size_t)r0 * 16 + l]; }
    for (int r = r0; r < r1; ++r) {
#pragma unroll
        for (int j = 0; j < 4; ++j) v[j] = vn[j];
        const int pos = pos_n; const float af = af_n;
        if (r + 1 < r1) { load_row_bf(XB + (size_t)(r + 1) * DM, l, vn); if (l < 16) { pos_n = POS[(size_t)(r + 1) * 16 + l]; af_n = AFF[(size_t)(r + 1) * 16 + l]; } }
        const int b = r < NLAT ? (r >> 12) : 8;
        if (b != cb) { cb = b;
#pragma unroll
            for (int j = 0; j < 4; ++j) g2[j] = ((const f32x4*)(mod_cur + (size_t)b * 6144 + 5 * 1024))[l + 64 * j];
            if (!final_norm) load_mod(gain_next, mod_next + (size_t)b * 6144, mod_next + (size_t)b * 6144 + 1024, l, ga, sh);
            else {
#pragma unroll
                for (int j = 0; j < 4; ++j) ga[j] = ((const f32x4*)gain_next)[l + 64 * j]; } }
        f32x4 acc[4];
#pragma unroll
        for (int j = 0; j < 4; ++j) acc[j] = (f32x4){0.f, 0.f, 0.f, 0.f};
        unsigned long long m = __ballot(pos >= 0);
        while (m) {
            const int e0 = __builtin_ctzll(m); m &= m - 1; const bool two = m != 0; const int e1 = two ? __builtin_ctzll(m) : e0; if (two) m &= m - 1;
            const int p0 = __builtin_amdgcn_readlane(pos, e0), p1 = __builtin_amdgcn_readlane(pos, e1);
            const float w0 = __builtin_bit_cast(float, __builtin_amdgcn_readlane(__builtin_bit_cast(int, af), e0));
            const float w1 = two ? __builtin_bit_cast(float, __builtin_amdgcn_readlane(__builtin_bit_cast(int, af), e1)) : 0.f;
            const unsigned* y0 = (const unsigned*)(Y + ((size_t)e0 * erows + p0) * DM) + l; const unsigned* y1 = (const unsigned*)(Y + ((size_t)e1 * erows + p1) * DM) + l;
            unsigned ya[4], yb[4];
#pragma unroll
            for (int j = 0; j < 4; ++j) { ya[j] = y0[64 * j]; yb[j] = y1[64 * j]; }
#pragma unroll
            for (int j = 0; j < 4; ++j) {
                const f32x2 a01 = __builtin_amdgcn_cvt_pk_f32_fp8((int)ya[j], false), a23 = __builtin_amdgcn_cvt_pk_f32_fp8((int)ya[j], true);
                const f32x2 b01 = __builtin_amdgcn_cvt_pk_f32_fp8((int)yb[j], false), b23 = __builtin_amdgcn_cvt_pk_f32_fp8((int)yb[j], true);
                acc[j].x += w0 * a01.x + w1 * b01.x; acc[j].y += w0 * a01.y + w1 * b01.y; acc[j].z += w0 * a23.x + w1 * b23.x; acc[j].w += w0 * a23.y + w1 * b23.y; }
        }
#pragma unroll
        for (int j = 0; j < 4; ++j) v[j] = v[j] + g2[j] * acc[j] * (1.f / 16.f);
        if (!final_norm) {
            u32x2* xo = (u32x2*)(XB + (size_t)r * DM) + l;
#pragma unroll
            for (int j = 0; j < 4; ++j) { u32x2 w; w.x = cvt_pk_bf16(v[j].x, v[j].y); w.y = cvt_pk_bf16(v[j].z, v[j].w); xo[64 * j] = w; }
            modulate_row(v, ga, sh, l, XN + (size_t)r * DM);
        } else {
            float s = 0.f;
#pragma unroll
            for (int j = 0; j < 4; ++j) s += (v[j].x * v[j].x + v[j].y * v[j].y) + (v[j].z * v[j].z + v[j].w * v[j].w);
            const float rs = 1.f / sqrtf(wave_sum(s) * (1.f / DM) + NORM_EPS);
            f32x4* xo = (f32x4*)(outp + (size_t)r * DM) + l;
#pragma unroll
            for (int j = 0; j < 4; ++j) xo[64 * j] = (v[j] * rs) * ga[j];
        }
    }
}

__device__ __forceinline__ void attn0_phase(Frame& F, const bool rerun) {
    const bf16_t* Q0 = (const bf16_t*)(F.ws + A_Q0); const bf16_t* K0 = (const bf16_t*)(F.ws + A_K0); const bf16_t* V0 = (const bf16_t*)(F.ws + A_V0);
    bf16_t* OH = (bf16_t*)(F.ws + A_OH);
    const int per = (1024 + F.G - 1) / F.G;
    const int u0 = F.vcu * per, nlat = u0 >= 1024 ? 0 : (u0 + per > 1024 ? 1024 - u0 : per), nctx = F.vcu < 64 ? 1 : 0, vcu = F.vcu;
    auto gen = [=](int i, att::UnitDesc& U) {
        int b, sh, qrow0;
        if (i < nlat) { const int u = u0 + i; b = u >> 7; sh = (u & 127) >> 4; const int qb = u & 15; qrow0 = b * SEQ + qb * 256; U.NT = 68; }
        else { b = vcu >> 3; sh = vcu & 7; qrow0 = NLAT + b * CTX; U.NT = 4; }
        U.Q = Q0 + (size_t)qrow0 * 512 + sh * 64; U.ldq = 512;
        U.K = K0 + sh * 64; U.V = V0 + (sh >> 1) * 128; U.ldk = 512; U.ldv = 512;
        U.O = OH + (size_t)qrow0 * DM + sh * 128; U.ldo = DM;
        U.ctx_row0 = NLAT + b * CTX; U.lat_row0 = b * SEQ; U.lat_t0 = 0; U.q0 = 0; U.sink = nullptr;
    };
    att::attn_stream<128, false>(gen, nlat + nctx, (LAS char*)F.lds, F.tid);
}
__device__ __forceinline__ void attn1_phase(Frame& F, const float* sink) {
    const bf16_t* Q1 = (const bf16_t*)(F.ws + A_Q1); const bf16_t* K1 = (const bf16_t*)(F.ws + A_K1); const bf16_t* V1 = (const bf16_t*)(F.ws + A_V1);
    bf16_t* AO = (bf16_t*)(F.ws + A_XN);
    const int per = (2048 + F.G - 1) / F.G;
    const int u0 = F.vcu * per, n = u0 >= 2048 ? 0 : (u0 + per > 2048 ? 2048 - u0 : per);
    auto gen = [=](int i, att::UnitDesc& U) {
        const int u = u0 + i;
        const int b = u >> 8, kvh = (u & 255) >> 6, qb = u & 63, q0 = qb * 64, qrow0 = b * SEQ + q0;
        U.Q = Q1 + (size_t)qrow0 * DM + kvh * 256; U.ldq = DM;
        U.K = K1 + kvh * 64; U.V = V1 + kvh * 64; U.ldk = 256; U.ldv = 256;
        U.O = AO + (size_t)qrow0 * DM + kvh * 256; U.ldo = DM;
        const int lo = q0 - 128 < 0 ? 0 : q0 - 128, hi = q0 + 192 > SEQ ? SEQ : q0 + 192;
        U.ctx_row0 = NLAT + b * CTX; U.lat_row0 = b * SEQ; U.lat_t0 = lo >> 6; U.NT = 4 + ((hi - lo) >> 6);
        U.q0 = q0; U.sink = sink + kvh * 4;
    };
    att::attn_stream<64, true>(gen, n, (LAS char*)F.lds, F.tid);
}

constexpr int N_PHASES = 21;
#ifndef PH_EN
#define PH_EN(p) ((p) != 8 && (p) != 17)
#endif
#ifndef GEMM_EN
#define GEMM_EN 1
#endif
__global__ void __launch_bounds__(NTHREADS, 2) fwd_kernel(Args args) {
    extern __shared__ __attribute__((aligned(16))) unsigned char lds_raw[];
    Frame F;
    F.lds = (LAS unsigned char*)lds_raw;
    F.tid = threadIdx.x; F.lane = F.tid & 63; F.wave = __builtin_amdgcn_readfirstlane(F.tid >> 6);
    F.G = gridDim.x; { const int bx = blockIdx.x; F.vcu = (F.G % 8 == 0) ? (bx % 8) * (F.G / 8) + bx / 8 : bx; }
    F.gw = F.vcu * NWAVES + F.wave; F.NGW = F.G * NWAVES;
    F.ws = args.ws;
    unsigned char* ws = args.ws;
    volatile LAS unsigned* MISC = (volatile LAS unsigned*)(F.lds + MISC_OFF);
    for (int u = F.tid; u < (LDS_BYTES - RING_BYTES) / 4; u += NTHREADS) ((LAS unsigned*)(F.lds + RING_BYTES))[u] = 0u;
    __syncthreads();
    const int nprog = args.nprog;
    XcdBarrier bar; bar.bar = (unsigned*)(ws + WS_CTL) + CW_BAR; bar.x = 0; bar.st = nullptr;
    if (nprog > 1) bar = xcd_barrier_post((unsigned*)(ws + WS_CTL) + CW_BAR, MISC + 8);

    const Frame F0 = F;
    for (int pi = 0; pi < nprog; ++pi) {
        F = F0; asm volatile("" : "+s"(F.wave), "+s"(F.vcu), "+s"(F.gw));
        { unsigned ones = ~0u; asm volatile("" : "+s"(ones));
          F.lane = (int)__builtin_amdgcn_mbcnt_hi(ones, __builtin_amdgcn_mbcnt_lo(ones, 0u)); F.tid = F.wave * 64 + F.lane; }
        ArgsP ap = (ArgsP)__builtin_amdgcn_kernarg_segment_ptr(); asm volatile("" : "+s"(ap));
        { GAS unsigned char* wsg = ap->ws; asm volatile("" : "+s"(wsg)); F.ws = (unsigned char*)wsg; }
        ws = F.ws;
        const int phx = ap->prog[pi], ph = phx & 31; const bool rerun = (phx & 32) != 0;
        const float* MOD0 = (const float*)(ws + WS_MOD); const float* MOD1 = MOD0 + 9 * 6144;
        bool is_gemm = false, is_gemm8 = false; bool perm = true; pg8::Sched S; pg8::Epi E;
        S.G = F.G; S.c = (int)blockIdx.x; S.tpe = 1 << 20; S.pitch = 2 * DM; S.wgm = 8; S.hot = false; S.gidx = nullptr; S.A = nullptr; S.B = nullptr; S.nM = 0; S.nN = 0;
        E.kind = 0; E.layer = 0; E.f8out = false; E.wsc = 1.f; E.ws = ws; E.xin_lat = nullptr; E.xin_ctx = nullptr;
        switch (ph) {
        case 0: if (!PH_EN(0)) break; p0_prologue(F, ap, rerun); break;
        case 1: if (!PH_EN(1)) break; norm1_phase(F, APIN(0), APIN(2), APIN(6), APIN(5), APIN(21)); break;
        case 2: if (!PH_EN(2)) break; is_gemm = true; S.A = (const char*)(ws + A_XN); S.B = (const char*)(ws + W_IN); S.nM = MALL / 256; S.nN = NWIN / 256; E.kind = pg8::EK_IN0; break;
        case 3: if (!PH_EN(3)) break; attn0_phase(F, rerun); break;
        case 4: if (!PH_EN(4)) break; mix0_combine_phase(F, ap); break;
        case 5: if (!PH_EN(5)) break; is_gemm = true; S.A = (const char*)(ws + A_XN); S.B = (const char*)(ws + W_OUT0); S.nM = MALL / 256; S.nN = DM / 256;
                E.kind = pg8::EK_OUT; E.layer = 0; E.xin_lat = APIN(0); E.xin_ctx = APIN(2); break;
        case 6: if (!PH_EN(6)) break; norm2_router_phase(F, MALL, APIN(15), MOD0, APIN(16)); break;
        case 7: if (!PH_EN(7)) break; topk_phase(F, true); break;
        case 8: if (!PH_EN(8)) break; gather_phase(F, EROWS0); break;
        case 9: if (!PH_EN(9)) break; is_gemm8 = true; S.pitch = DM; S.wgm = 4; E.wsc = 1.f / 32.f; E.f8out = true; S.A = (const char*)(ws + A_XN); S.gidx = (const int*)(ws + WS_IDX); S.B = (const char*)(ws + W_GU0); S.nM = NE * EROWS0 / 256; S.nN = 2 * FF / 256; S.tpe = EROWS0 / 256; E.kind = pg8::EK_GU; break;
        case 10: if (!PH_EN(10)) break; is_gemm8 = true; S.pitch = DM; E.wsc = 1.f / 32.f; S.A = (const char*)(ws + A_ACT); S.B = (const char*)(ws + W_D0); S.nM = NE * EROWS0 / 256; S.nN = DM / 256; S.tpe = EROWS0 / 256; E.kind = pg8::EK_DOWN; break;
        case 11: if (!PH_EN(11)) break; moe_combine_phase(F, MALL, EROWS0, MOD0, false, APIN(22), MOD1, nullptr); break;
        case 12: if (!PH_EN(12)) break; is_gemm = true; S.A = (const char*)(ws + A_XN); S.B = (const char*)(ws + W_QKV); S.nM = MALL / 256; S.nN = NQKV1 / 256; E.kind = pg8::EK_QKV1; break;
        case 13: if (!PH_EN(13)) break; attn1_phase(F, APIN(24)); break;
        case 14: if (!PH_EN(14)) break; is_gemm = true; S.A = (const char*)(ws + A_XN); S.B = (const char*)(ws + W_OUT1); S.nM = NLAT / 256; S.nN = DM / 256;
                E.kind = pg8::EK_OUT; E.layer = 1; break;
        case 15: if (!PH_EN(15)) break; norm2_router_phase(F, NLAT, APIN(26), MOD1, APIN(27)); break;
        case 16: if (!PH_EN(16)) break; topk_phase(F, false); break;
        case 17: if (!PH_EN(17)) break; gather_phase(F, EROWS1); break;
        case 18: if (!PH_EN(18)) break; is_gemm8 = true; S.pitch = DM; S.wgm = 4; E.wsc = 1.f / 32.f; E.f8out = true; S.A = (const char*)(ws + A_XN); S.gidx = (const int*)(ws + WS_IDX); S.B = (const char*)(ws + W_GU1); S.nM = NE * EROWS1 / 256; S.nN = 2 * FF / 256; S.tpe = EROWS1 / 256; E.kind = pg8::EK_GU; break;
        case 19: if (!PH_EN(19)) break; is_gemm8 = true; S.pitch = DM; E.wsc = 1.f / 32.f; S.A = (const char*)(ws + A_ACT); S.B = (const char*)(ws + W_D1); S.nM = NE * EROWS1 / 256; S.nN = DM / 256; S.tpe = EROWS1 / 256; E.kind = pg8::EK_DOWN; break;
        case 20: if (!PH_EN(20)) break; moe_combine_phase(F, NLAT, EROWS1, MOD1, true, APIN(31), nullptr, APOUT); break;
#if PROBE_MFMA
        case 21: {
            typedef int v8i_ __attribute__((ext_vector_type(8))); typedef int v6i_ __attribute__((ext_vector_type(6)));
            int z_ = F.lane; asm volatile("" : "+v"(z_));
#if PROBE_MFMA == 1 || PROBE_MFMA == 5
            bf16x8 OA, OB;
#pragma unroll
            for (int q = 0; q < 8; ++q) { OA[q] = (short)(z_ + q); OB[q] = (short)(z_ + 2 * q); }
#elif PROBE_MFMA == 4
            v6i_ OA, OB;
#pragma unroll
            for (int q = 0; q < 6; ++q) { OA[q] = z_ + q; OB[q] = z_ + 2 * q; }
#else
            v8i_ OA, OB;
#pragma unroll
            for (int q = 0; q < 8; ++q) { OA[q] = z_ + q; OB[q] = z_ + 2 * q; }
#endif
#if PROBE_MFMA == 3 || PROBE_MFMA == 5
            f32x16 c0 = f32x16{}, c1 = c0, c2 = c0, c3 = c0;
#else
            f32x4 c0 = {0, 0, 0, 0}, c1 = c0, c2 = c0, c3 = c0;
#endif
#if PROBE_MFMA == 1
#define MF_ "v_mfma_f32_16x16x32_bf16"
#define MS_ ""
#elif PROBE_MFMA == 2
#define MF_ "v_mfma_f32_16x16x128_f8f6f4"
#define MS_ ""
#elif PROBE_MFMA == 3
#define MF_ "v_mfma_f32_32x32x64_f8f6f4"
#define MS_ ""
#elif PROBE_MFMA == 4
#define MF_ "v_mfma_f32_16x16x128_f8f6f4"
#define MS_ " cbsz:2 blgp:2"
#else
#define MF_ "v_mfma_f32_32x32x16_bf16"
#define MS_ ""
#endif
            asm volatile("" : "+v"(OA), "+v"(OB));
            for (int i = 0; i < 2000; ++i)
                asm volatile(MF_ " %0, %4, %5, %0" MS_ "\n\t" MF_ " %1, %4, %5, %1" MS_ "\n\t" MF_ " %2, %4, %5, %2" MS_ "\n\t" MF_ " %3, %4, %5, %3" MS_ : "+v"(c0), "+v"(c1), "+v"(c2), "+v"(c3) : "v"(OA), "v"(OB));
            asm volatile("s_nop 15\n\ts_nop 15" ::: "memory");
            if (c0[0] + c1[0] + c2[0] + c3[0] == 123.456f) ((float*)(ws + A_OH + SZ_XN + 4096))[F.tid] = 1.f;
        } break;
#endif
        default: break;
        }
#if PROBE_ABL == 9 || PROBE_ABL >= 11
        if (rerun) { E.kind = pg8::EK_NONE; if (PROBE_ABL >= 11) S.hot = true; }
#endif
        if (GEMM_EN && is_gemm) pg8::gemm_phase(F.lds, F.tid, perm, S, E);
        if (GEMM_EN && is_gemm8) pg8::gemm_phase8(F.lds, F.tid, perm, S, E);
        if ((is_gemm || is_gemm8) && !rerun) {
            int flo = 0, fhi = 0;
            if (ph == 2) { flo = wc::F1_LO; fhi = wc::F1_HI; } else if (ph == 5) { flo = wc::F1_HI; fhi = wc::F2_HI; }
            else if (ph == 9) { flo = wc::F3_LO; fhi = wc::F3_HI; } else if (ph == 10) { flo = wc::F3_HI; fhi = wc::F4_HI; } else if (ph == 12) { flo = wc::F4_HI; fhi = wc::F5_HI; }
            const int nwg = S.nM * S.nN, rounds = (nwg + F.G - 1) / F.G, nlast = nwg - (rounds - 1) * F.G, q = (int)blockIdx.x - nlast;
            if (fhi > flo) { if (nlast == F.G) weight_items(F, ap, flo, fhi, F.gw, F.NGW);
                             else if (q >= 0) weight_items(F, ap, flo, fhi, q * NWAVES + F.wave, (F.G - nlast) * NWAVES); }
        }
        if (pi + 1 < nprog) { XcdBarrier bl = bar; { GAS unsigned* bp = (GAS unsigned*)(ap->ws + WS_CTL) + CW_BAR; asm volatile("" : "+s"(bp), "+s"(bl.x)); bl.bar = (unsigned*)bp; }
            xcd_barrier(bl); }
    }
}

extern "C" void kernel_launch(void* const* d_in, const int* in_sizes, int n_in, void* d_out, int out_size, void* d_ws, size_t ws_size, hipStream_t stream) {
    static int grid = 0;
    if (grid == 0) {
        if (n_in != 32 || in_sizes[0] != NLAT * DM || out_size != NLAT * DM || ws_size < WS_END) {
            fprintf(stderr, "kernel_launch: unexpected shapes: n_in %d in0 %d out %d ws %zu (need %zu)\n", n_in, n_in > 0 ? in_sizes[0] : -1, out_size, ws_size, (size_t)WS_END); grid = -1; return; }
        int dev = 0, cus = 0, per_cu = 0;
        if (hipGetDevice(&dev) != hipSuccess || hipDeviceGetAttribute(&cus, hipDeviceAttributeMultiprocessorCount, dev) != hipSuccess) { grid = -1; return; }
        if (hipFuncSetAttribute((const void*)fwd_kernel, hipFuncAttributeMaxDynamicSharedMemorySize, LDS_BYTES) != hipSuccess) { fprintf(stderr, "kernel_launch: hipFuncSetAttribute failed\n"); grid = -1; return; }
        if (hipOccupancyMaxActiveBlocksPerMultiprocessor(&per_cu, (const void*)fwd_kernel, NTHREADS, LDS_BYTES) != hipSuccess || per_cu < 1) {
            fprintf(stderr, "kernel_launch: occupancy query reports %d blocks per CU\n", per_cu); (void)hipGetLastError(); grid = -1; return; }
        if (cus < 192 || cus % 8 != 0) { fprintf(stderr, "kernel_launch: built for >= 192 CUs in multiples of 8, got %d\n", cus); grid = -1; return; }
        grid = cus;
    }
    if (grid < 0) return;
    (void)hipMemsetAsync((char*)d_ws + WS_CTL, 0, CTL_ZERO_BYTES, stream);
    Args a{};
    for (int i = 0; i < 32; ++i) a.in[i] = (const float*)d_in[i];
    a.out = (float*)d_out; a.ws = (unsigned char*)d_ws;
#if MK_N_LAUNCHES == 1
    { int n = 0; for (int p = 0; p < N_PHASES; ++p) { if (p == 8 || p == 17) continue; a.prog[n++] = (unsigned char)p; if ((PROBE_DUP >> p) & 1u) a.prog[n++] = (unsigned char)(p | 32); }
      if (PROBE_MFMA) a.prog[n++] = 21;
      a.nprog = n; }
    hipLaunchKernelGGL(fwd_kernel, dim3(grid), dim3(NTHREADS), LDS_BYTES, stream, a);
#else
    for (int p = 0; p < N_PHASES; ++p) { a.nprog = 1; a.prog[0] = (unsigned char)p; hipLaunchKernelGGL(fwd_kernel, dim3(grid), dim3(NTHREADS), LDS_BYTES, stream, a); }
#endif
}
```

```cpp
#include <hip/hip_runtime.h>
#include <hip/hip_bf16.h>
#include <cstdio>
#include <cstdint>

#ifndef MK_N_LAUNCHES
#define MK_N_LAUNCHES 1
#endif

#ifndef PROBE_ABL
#define PROBE_ABL 0
#endif
#ifndef PROBE_MFMA
#define PROBE_MFMA 0
#endif
#ifndef PROBE_DUP
#define ATT0_STREAM 0
#define ATT1_STREAM 1
#define PROBE_DUP 0u
#endif

#define GAS __attribute__((address_space(1)))
#define LAS __attribute__((address_space(3)))
typedef unsigned short bf16_t;
typedef short bf16x8 __attribute__((ext_vector_type(8)));
typedef short s16x4 __attribute__((ext_vector_type(4)));
typedef float f32x2 __attribute__((ext_vector_type(2)));
typedef float f32x4 __attribute__((ext_vector_type(4)));
typedef float f32x16 __attribute__((ext_vector_type(16)));
typedef unsigned u32x2 __attribute__((ext_vector_type(2)));
typedef unsigned u32x4 __attribute__((ext_vector_type(4)));
typedef GAS unsigned gu32;
typedef int v8i32 __attribute__((ext_vector_type(8)));
typedef int v4i32 __attribute__((ext_vector_type(4)));

constexpr int DM = 1024, NB = 8, SEQ = 4096, CTX = 256;
constexpr int NLAT = NB * SEQ;
constexpr int NCTX = NB * CTX;
constexpr int MALL = NLAT + NCTX;
constexpr int NE = 16, FF = 1024;
constexpr int CAP_L = 512, CAP_C = 32;
constexpr int EROWS0 = NB * CAP_L + NB * CAP_C;
constexpr int EROWS1 = NB * CAP_L;
constexpr int NWIN = 3072, NQKV1 = 1536;
constexpr float NORM_EPS = 1e-6f;
constexpr float LAM_INIT = 0.2f;
constexpr int NWAVES = 8, NTHREADS = 512;

constexpr size_t KiB = 1024, MiB = 1024 * 1024;
constexpr size_t WS_CTL = 0, CTL_ZERO_BYTES = 1 * MiB;
constexpr int CW_BAR = 4096;
constexpr size_t WS_MOD = 64 * KiB;
constexpr size_t MOD_BYTES = 2 * 9 * 6144 * 4;
static_assert(WS_MOD + MOD_BYTES <= 640 * KiB, "mod");
constexpr size_t WS_ROPE = 1 * MiB;
constexpr size_t WS_PART = WS_ROPE + 16 * KiB;
constexpr size_t WS_AFF = WS_PART + (size_t)2 * 4 * 9 * 6144 * 4;
constexpr size_t WS_POS = WS_AFF + (size_t)MALL * 16 * 4;
constexpr size_t WS_IDX = WS_POS + (size_t)MALL * 16 * 4;
constexpr size_t WS_XB = (WS_IDX + (size_t)NE * EROWS0 * 4 + 4096 + 4095) / 4096 * 4096;
constexpr size_t WS_W = WS_XB + (size_t)MALL * DM * 2;
constexpr size_t W_IN = WS_W;
constexpr size_t W_OUT0 = W_IN + (size_t)NWIN * DM * 2;
constexpr size_t W_GU0 = W_OUT0 + (size_t)DM * DM * 2;
constexpr size_t W_D0 = W_GU0 + (size_t)NE * 2 * FF * DM;
constexpr size_t W_QKV = W_D0 + (size_t)NE * DM * FF;
constexpr size_t W_OUT1 = W_QKV + (size_t)NQKV1 * DM * 2;
constexpr size_t W_GU1 = W_OUT1 + (size_t)DM * DM * 2;
constexpr size_t W_D1 = W_GU1 + (size_t)NE * 2 * FF * DM;
constexpr size_t WS_ARENA = W_D1 + (size_t)NE * DM * FF;
constexpr size_t SZ_XN = (size_t)MALL * DM * 2;
constexpr size_t SZ_H5 = (size_t)MALL * 512 * 2;
constexpr size_t SZ_E = (size_t)NE * EROWS0 * DM * 2;
constexpr size_t A_XN = WS_ARENA;
constexpr size_t A_BG = A_XN + SZ_XN, A_CX = A_BG + SZ_H5, A_Q0 = A_CX + SZ_H5, A_K0 = A_Q0 + SZ_H5, A_V0 = A_K0 + SZ_H5;
constexpr size_t A_OH = A_V0 + SZ_H5;
constexpr size_t A_HS = A_XN + SZ_XN;
constexpr size_t A_ACT = A_HS + SZ_E;
constexpr size_t A_Q1 = A_XN + SZ_XN;
constexpr size_t A_K1 = A_Q1 + SZ_XN;
constexpr size_t A_V1 = A_K1 + (size_t)MALL * 256 * 2;
constexpr size_t WS_END = A_OH + SZ_XN + 1 * MiB;
static_assert(A_ACT + SZ_E / 2 <= WS_END && A_V1 + (size_t)MALL * 256 * 2 <= WS_END, "arena");
static_assert(WS_END <= 600000000ull, "workspace budget");

constexpr int RING_BYTES = 131072;
constexpr int MISC_OFF = RING_BYTES + 320;
constexpr int GT_OFF = RING_BYTES + 1024;
constexpr int LDS_BYTES = 147456;

#define RLX_AGENT __ATOMIC_RELAXED, __HIP_MEMORY_SCOPE_AGENT
#define LDS_WAIT() asm volatile("s_waitcnt lgkmcnt(0)" ::: "memory")
#define VM_WAIT() asm volatile("s_waitcnt vmcnt(0)" ::: "memory")

__device__ __forceinline__ unsigned f2bf(float f) { unsigned u = __builtin_bit_cast(unsigned, f); return (u + 0x7fffu + ((u >> 16) & 1u)) >> 16; }
__device__ __forceinline__ unsigned pk2(float lo, float hi) { return f2bf(lo) | (f2bf(hi) << 16); }
__device__ __forceinline__ unsigned cvt_pk_bf16(float lo, float hi) { unsigned r; asm volatile("v_cvt_pk_bf16_f32 %0, %1, %2" : "=v"(r) : "v"(lo), "v"(hi)); return r; }
__device__ __forceinline__ unsigned pk4_fp8(float a, float b, float c, float d) {
    a = fminf(fmaxf(a, -448.f), 448.f); b = fminf(fmaxf(b, -448.f), 448.f); c = fminf(fmaxf(c, -448.f), 448.f); d = fminf(fmaxf(d, -448.f), 448.f);
    int w = 0; w = __builtin_amdgcn_cvt_pk_fp8_f32(a, b, w, false); w = __builtin_amdgcn_cvt_pk_fp8_f32(c, d, w, true); return (unsigned)w;
}
__device__ __forceinline__ float bf_lo(unsigned w) { return __builtin_bit_cast(float, w << 16); }
__device__ __forceinline__ float bf_hi(unsigned w) { return __builtin_bit_cast(float, w & 0xffff0000u); }
template <int CTRL> __device__ __forceinline__ float dpp_f(float x) { return __builtin_bit_cast(float, __builtin_amdgcn_mov_dpp(__builtin_bit_cast(int, x), CTRL, 0xf, 0xf, true)); }
__device__ __forceinline__ float row16_sum(float v) { v += dpp_f<0xB1>(v); v += dpp_f<0x4E>(v); v += dpp_f<0x141>(v); v += dpp_f<0x128>(v); return v; }
__device__ __forceinline__ float xsum16(float v) { auto rr = __builtin_amdgcn_permlane16_swap(__float_as_uint(v), __float_as_uint(v), false, false); return __uint_as_float(rr[0]) + __uint_as_float(rr[1]); }
__device__ __forceinline__ float xsum32(float v) { auto rr = __builtin_amdgcn_permlane32_swap(__float_as_uint(v), __float_as_uint(v), false, false); return __uint_as_float(rr[0]) + __uint_as_float(rr[1]); }
__device__ __forceinline__ float xmax16(float v) { auto rr = __builtin_amdgcn_permlane16_swap(__float_as_uint(v), __float_as_uint(v), false, false); return fmaxf(__uint_as_float(rr[0]), __uint_as_float(rr[1])); }
__device__ __forceinline__ float xmax32(float v) { auto rr = __builtin_amdgcn_permlane32_swap(__float_as_uint(v), __float_as_uint(v), false, false); return fmaxf(__uint_as_float(rr[0]), __uint_as_float(rr[1])); }
__device__ __forceinline__ float wave_sum(float v) { v = row16_sum(v); v = xsum16(v); v = xsum32(v); return v; }

#define XB_TMO      128
#define XB_XCNT(j)  (256  + 64 * (j))
#define XB_XSUB(j)  (1280 + 64 * (j))
#define XB_XGEN(j)  (2304 + 64 * (j))
#define XB_TOP      3328
#define XB_TOPGEN   3392
#define XCD_BAR_WORDS 3456
#define XB_SPIN_CAP (1u << 20)
__device__ __forceinline__ unsigned xb_ld(unsigned* p)              { return __hip_atomic_load(p, __ATOMIC_RELAXED, __HIP_MEMORY_SCOPE_AGENT); }
__device__ __forceinline__ unsigned xb_add(unsigned* p, unsigned v) { return __hip_atomic_fetch_add(p, v, __ATOMIC_RELAXED, __HIP_MEMORY_SCOPE_AGENT); }
__device__ __forceinline__ unsigned xb_xcc_id() { return (unsigned)__builtin_amdgcn_s_getreg((3 << 11) | 20) & 0xFu; }
#define XB_SPIN(cond, bar) do { unsigned _sp = 0; while (cond) { __builtin_amdgcn_s_sleep(1); \
    if ((++_sp & 255u) == 0u) { if (xb_ld(&(bar)[XB_TMO])) break; if (_sp > XB_SPIN_CAP) { atomicAdd(&(bar)[XB_TMO], 1u); break; } } } } while (0)
struct XcdBarrier { unsigned* bar; unsigned x; volatile LAS unsigned* st; };
__device__ __forceinline__ XcdBarrier xcd_barrier_post(unsigned* bar, volatile LAS unsigned* st) {
    XcdBarrier b; b.bar = bar; b.x = xb_xcc_id(); b.st = st;
    if (threadIdx.x == 0) (void)xb_add(&bar[XB_XCNT(b.x)], 1u);
    return b;
}
__device__ __forceinline__ void xcd_barrier_complete(unsigned* bar, unsigned x, unsigned& nloc, unsigned& nx) {
    const unsigned G = gridDim.x * gridDim.y * gridDim.z;
    unsigned sum, cnt, mine, sp = 0u;
    for (;;) {
        sum = 0u; cnt = 0u; mine = 0u;
#pragma unroll
        for (unsigned j = 0; j < 16; ++j) { const unsigned c = xb_ld(&bar[XB_XCNT(j)]); sum += c; cnt += (c > 0u) ? 1u : 0u; mine = (j == x) ? c : mine; }
        if (sum == G) break;
        __builtin_amdgcn_s_sleep(1);
        if ((++sp & 255u) == 0u) { if (xb_ld(&bar[XB_TMO])) break; if (sp > XB_SPIN_CAP) { atomicAdd(&bar[XB_TMO], 1u); break; } }
    }
    nloc = mine > 0u ? mine : 1u; nx = cnt > 0u ? cnt : 1u;
}
__device__ __forceinline__ void xcd_barrier(const XcdBarrier& b) {
    asm volatile("s_waitcnt vmcnt(0)" ::: "memory");
    __syncthreads();
    if (threadIdx.x == 0) {
        unsigned* bar = b.bar;
        __builtin_amdgcn_s_waitcnt(0);
        unsigned nloc = b.st[0], nx = b.st[1];
        if (nloc == 0u) { xcd_barrier_complete(bar, b.x, nloc, nx); b.st[0] = nloc; b.st[1] = nx; }
        const unsigned old = xb_add(&bar[XB_XSUB(b.x)], 1u);
        const unsigned gen = old / nloc;
        if (old + 1u == (gen + 1u) * nloc) {
            __builtin_amdgcn_fence(__ATOMIC_RELEASE, "agent");
            asm volatile("s_waitcnt vmcnt(0)" ::: "memory");
            const unsigned og = xb_add(&bar[XB_TOP], 1u);
            const unsigned tg = og / nx;
            if (og + 1u == (tg + 1u) * nx) xb_add(&bar[XB_TOPGEN], 1u);
            else XB_SPIN(xb_ld(&bar[XB_TOPGEN]) == tg, bar);
            __builtin_amdgcn_fence(__ATOMIC_ACQUIRE, "agent");
            xb_add(&bar[XB_XGEN(b.x)], 1u);
            asm volatile("s_waitcnt vmcnt(0)" ::: "memory");
        } else {
            XB_SPIN(xb_ld(&bar[XB_XGEN(b.x)]) == gen, bar);
            __builtin_amdgcn_fence(__ATOMIC_ACQUIRE, "agent");
            asm volatile("s_waitcnt vmcnt(0)" ::: "memory");
        }
    }
    __syncthreads();
}

__device__ __forceinline__ int fresh_lane() { unsigned ones = ~0u; asm volatile("" : "+s"(ones)); return (int)__builtin_amdgcn_mbcnt_hi(ones, __builtin_amdgcn_mbcnt_lo(ones, 0u)); }
namespace pg8 {
constexpr int BM = 256, BK = 64, HALF = 128, HTB = HALF * BK * 2, NXCD = 8, WGM = 8;
__device__ __forceinline__ int lds_byte(int r, int c) { const int st = (r >> 4) * 2 + (c >> 5), rr = r & 15, cc = c & 31, ob = rr * 64 + cc * 2; return st * 1024 + (ob ^ (((ob >> 9) & 1) << 5)); }
__device__ __forceinline__ void stage_rc(int b, int& R, int& C) { const int st = b / 1024, sb = b % 1024, swz = sb ^ (((sb >> 9) & 1) << 5); R = (st >> 1) * 16 + swz / 64; C = (st & 1) * 32 + (swz % 64) / 2; }
__device__ __forceinline__ int perm32(int rho) { const int n = rho >> 4, i = rho & 15; return 8 * (i >> 2) + 4 * n + (i & 3); }

struct Unit { int pm, pn; const char* a; const char* b; };
struct Sched {
    const char* A; const char* B; int nM, nN, tpe, G, c, pitch, wgm; bool hot; const int* gidx;
    __device__ __forceinline__ bool next(int i, Unit& u) const {
        const int nwg = nM * nN; const long L = (long)i * G + c; if (L >= nwg) return false;
        int wgid = (int)L; { const int q = nwg / NXCD, r = nwg % NXCD, xcd = wgid % NXCD, off = wgid / NXCD; wgid = (xcd < r ? xcd * (q + 1) : r * (q + 1) + (xcd - r) * q) + off; }
        const int nig = wgm * nN, gid = wgid / nig, fm = gid * wgm, gsz = (nM - fm) < wgm ? (nM - fm) : wgm;
        u.pm = fm + ((wgid % nig) % gsz); u.pn = (wgid % nig) / gsz;
        const size_t tstep = (size_t)BM * pitch;
        u.a = gidx ? A : A + (size_t)u.pm * tstep; u.b = B + (size_t)((u.pm / tpe) * nN + u.pn) * tstep;
        if (hot) {
            if (PROBE_ABL != 13) u.a = A + (size_t)(c & 7) * tstep; if (PROBE_ABL != 12) u.b = B + (size_t)(c & 3) * tstep; }
        return true;
    }
};

enum EpiKind { EK_IN0 = 0, EK_OUT = 1, EK_GU = 2, EK_DOWN = 3, EK_QKV1 = 4, EK_NONE = 5 };
struct Epi {
    int kind, layer; bool f8out; float wsc; unsigned char* ws; const float* xin_lat; const float* xin_ctx;
    __device__ __forceinline__ int nstores(const Unit& u) const { return (kind == EK_GU || (kind == EK_IN0 && u.pn >= 2 && u.pn < 6)) ? 8 : 16; }
    __device__ __forceinline__ void store8(bf16_t* p, const f32x4 a, const f32x4 b) const {
        u32x4 w; w.x = cvt_pk_bf16(a[0], a[1]); w.y = cvt_pk_bf16(a[2], a[3]); w.z = cvt_pk_bf16(b[0], b[1]); w.w = cvt_pk_bf16(b[2], b[3]);
        *(u32x4*)p = w;
    }
    __device__ __forceinline__ void operator()(const f32x4 (&acc)[2][2][4][2], const Unit& u, int wr, int wc, int fr, int fq) const {
        if (kind == EK_NONE) {
#pragma unroll
            for (int ai = 0; ai < 2; ++ai)
#pragma unroll
                for (int bj = 0; bj < 2; ++bj)
#pragma unroll
                    for (int m = 0; m < 4; ++m) asm volatile("" :: "v"(acc[ai][bj][m][0]), "v"(acc[ai][bj][m][1]));
            return;
        }
        const int row0 = u.pm * BM + wr * 64 + fr;
        const int cw = wc * 32 + 8 * fq;
        if (kind == EK_OUT) {
            const bool lat = row0 < NLAT;
            const int col0 = u.pn * BM + cw;
            f32x4 gv[2][2];
            const int gb = lat ? (row0 >> 12) : 8;
#pragma unroll
            for (int bj = 0; bj < 2; ++bj)
#pragma unroll
                for (int n = 0; n < 2; ++n) gv[bj][n] = *(const f32x4*)((const float*)(ws + WS_MOD) + (size_t)(layer * 9 + gb) * 6144 + 2 * 1024 + col0 + bj * HALF + 4 * n);
            bf16_t* XB = (bf16_t*)(ws + WS_XB);
            const float* xi = lat ? xin_lat : xin_ctx - (size_t)NLAT * DM;
#pragma unroll
            for (int am = 0; am < 4; ++am) { const int ai = am >> 1, m0 = (am & 1) * 2;
                f32x4 r0[2][2], r1[2][2]; u32x4 rw[2][2];
#pragma unroll
                for (int mm = 0; mm < 2; ++mm) { const size_t off = (size_t)(row0 + ai * HALF + (m0 + mm) * 16) * DM + col0;
#pragma unroll
                    for (int bj = 0; bj < 2; ++bj) {
                        if (layer == 0) { r0[mm][bj] = *(const f32x4*)(xi + off + bj * HALF); r1[mm][bj] = *(const f32x4*)(xi + off + bj * HALF + 4); }
                        else rw[mm][bj] = *(const u32x4*)(XB + off + bj * HALF); } }
#pragma unroll
                for (int mm = 0; mm < 2; ++mm) { const int m = m0 + mm; const size_t off = (size_t)(row0 + ai * HALF + m * 16) * DM + col0;
#pragma unroll
                    for (int bj = 0; bj < 2; ++bj) { f32x4 b0, b1;
                        if (layer == 0) { b0 = r0[mm][bj]; b1 = r1[mm][bj]; }
                        else { const u32x4 w = rw[mm][bj]; b0 = (f32x4){bf_lo(w.x), bf_hi(w.x), bf_lo(w.y), bf_hi(w.y)}; b1 = (f32x4){bf_lo(w.z), bf_hi(w.z), bf_lo(w.w), bf_hi(w.w)}; }
                        store8(XB + off + bj * HALF, b0 + gv[bj][0] * acc[ai][bj][m][0], b1 + gv[bj][1] * acc[ai][bj][m][1]); } }
                asm volatile("" ::: "memory"); }
            return;
        }
        if (kind == EK_GU) {
#pragma unroll
            for (int ai = 0; ai < 2; ++ai)
#pragma unroll
                for (int m = 0; m < 4; ++m) { f32x4 v[2];
#pragma unroll
                    for (int n = 0; n < 2; ++n) { const f32x4 g = acc[ai][0][m][n] * wsc, up = acc[ai][1][m][n] * wsc;
#pragma unroll
                        for (int j = 0; j < 4; ++j) v[n][j] = g[j] * __builtin_amdgcn_rcpf(1.f + __expf(-g[j])) * up[j]; }
                    if (f8out) { u32x2 w; w.x = pk4_fp8(v[0][0], v[0][1], v[0][2], v[0][3]); w.y = pk4_fp8(v[1][0], v[1][1], v[1][2], v[1][3]);
                        *(u32x2*)((unsigned char*)(ws + A_ACT) + (size_t)(row0 + ai * HALF + m * 16) * FF + u.pn * HALF + cw) = w; }
                    else store8((bf16_t*)(ws + A_ACT) + (size_t)(row0 + ai * HALF + m * 16) * FF + u.pn * HALF + cw, v[0], v[1]); }
            return;
        }
        if (kind == EK_DOWN) {
#pragma unroll
            for (int ai = 0; ai < 2; ++ai)
#pragma unroll
                for (int m = 0; m < 4; ++m)
#pragma unroll
                    for (int bj = 0; bj < 2; ++bj)
                    { const f32x4 y0 = acc[ai][bj][m][0] * (wsc * 16.f), y1 = acc[ai][bj][m][1] * (wsc * 16.f);
                        u32x2 w; w.x = pk4_fp8(y0[0], y0[1], y0[2], y0[3]); w.y = pk4_fp8(y1[0], y1[1], y1[2], y1[3]);
                        *(u32x2*)((unsigned char*)(ws + A_HS) + (size_t)(row0 + ai * HALF + m * 16) * DM + u.pn * BM + bj * HALF + cw) = w; }
            return;
        }
        int mode; size_t doff; int ld, cb;
        if (kind == EK_IN0) {
            if (u.pn < 2)       { mode = 0; doff = A_BG; ld = 512; cb = u.pn * 256; }
            else if (u.pn < 6)  { mode = 1; doff = A_CX; ld = 512; cb = (u.pn - 2) * 128; }
            else if (u.pn < 8)  { mode = 2; doff = A_Q0; ld = 512; cb = (u.pn - 6) * 256; }
            else if (u.pn < 10) { mode = 2; doff = A_K0; ld = 512; cb = (u.pn - 8) * 256; }
            else                { mode = 0; doff = A_V0; ld = 512; cb = (u.pn - 10) * 256; }
        } else {
            if (u.pn < 4)       { mode = 2; doff = A_Q1; ld = 1024; cb = u.pn * 256; }
            else if (u.pn == 4) { mode = 2; doff = A_K1; ld = 256; cb = 0; }
            else                { mode = 0; doff = A_V1; ld = 256; cb = 0; }
        }
        bf16_t* dst = (bf16_t*)(ws + doff); const float* rope = (const float*)(ws + WS_ROPE);
        const float qs = ((kind == EK_IN0 && (u.pn == 6 || u.pn == 7)) || (kind == EK_QKV1 && u.pn < 4)) ? 0.125f * 1.4426950408889634f : 1.0f;
        if (mode == 2 && row0 >= NLAT) mode = 0;
        if (mode == 1) {
#pragma unroll
            for (int ai = 0; ai < 2; ++ai)
#pragma unroll
                for (int m = 0; m < 4; ++m)
                    store8(dst + (size_t)(row0 + ai * HALF + m * 16) * ld + cb + cw, acc[ai][0][m][0] * acc[ai][1][m][0], acc[ai][0][m][1] * acc[ai][1][m][1]);
        } else if (mode == 0) {
#pragma unroll
            for (int ai = 0; ai < 2; ++ai)
#pragma unroll
                for (int m = 0; m < 4; ++m)
#pragma unroll
                    for (int bj = 0; bj < 2; ++bj)
                        store8(dst + (size_t)(row0 + ai * HALF + m * 16) * ld + cb + bj * HALF + cw, acc[ai][bj][m][0] * qs, acc[ai][bj][m][1] * qs);
        } else {
            f32x4 csv[4], snv[4];
            const int t0 = row0 & (SEQ - 1);
            if (wc & 1) {
#pragma unroll
                for (int m = 0; m < 4; ++m) { const int pos = (t0 + m * 16) & 63; csv[m] = *(const f32x4*)(rope + pos * 16 + 4 * fq); snv[m] = *(const f32x4*)(rope + 1024 + pos * 16 + 4 * fq); }
            } else {
#pragma unroll
                for (int ai = 0; ai < 2; ++ai) { const int pos = ((t0 + ai * HALF) >> 6) & 63; csv[ai] = *(const f32x4*)(rope + pos * 16 + 4 * fq); snv[ai] = *(const f32x4*)(rope + 1024 + pos * 16 + 4 * fq); }
                csv[2] = csv[0]; snv[2] = snv[0]; csv[3] = csv[1]; snv[3] = snv[1];
            }
#pragma unroll
            for (int ai = 0; ai < 2; ++ai)
#pragma unroll
                for (int m = 0; m < 4; ++m) { const int row = row0 + ai * HALF + m * 16;
                    const f32x4 cs = ((wc & 1) ? csv[m] : csv[ai]) * qs, sn = ((wc & 1) ? snv[m] : snv[ai]) * qs;
#pragma unroll
                    for (int bj = 0; bj < 2; ++bj) { const f32x4 x1 = acc[ai][bj][m][0], x2 = acc[ai][bj][m][1];
                        store8(dst + (size_t)row * ld + cb + bj * HALF + cw, x1 * cs - x2 * sn, x2 * cs + x1 * sn); } }
        }
    }
};

__device__ __forceinline__ void gemm_phase(LAS unsigned char* lds, const int tid, const bool perm, const Sched& S, const Epi& E) {
    const int wid = __builtin_amdgcn_readfirstlane(tid >> 6), lane = tid & 63, wr = wid >> 2, wc = wid & 3, fr = lane & 15, fq = lane >> 4;
    constexpr int K = DM, nt = K / BK;
    unsigned voffB[2]; int sR[2], sC[2];
#pragma unroll
    for (int i = 0; i < 2; ++i) { int R, C; stage_rc(tid * 16 + i * 8192, R, C); const int Rb = perm ? ((R & ~31) + perm32(R & 31)) : R;
        sR[i] = R; sC[i] = C; voffB[i] = (unsigned)(Rb * K + C) * 2u; }
    const bool gather = S.gidx != nullptr;
    LAS unsigned* gtab = (LAS unsigned*)(lds + GT_OFF);
    if (gather) {
        Unit tu;
        for (int i = 0; S.next(i, tu); ++i) if (tid < 256) gtab[i * 256 + tid] = (unsigned)S.gidx[(tu.pm / S.tpe) * EROWS0 + (tu.pm % S.tpe) * 256 + tid] * (unsigned)(K * 2);
        __syncthreads();
    }
    unsigned gc[2][2], gn[2][2];
#define PG8_GOFF(dst, ord) do { const int t_ = wid * 64 + fresh_lane(); _Pragma("unroll") for (int i_ = 0; i_ < 2; ++i_) { int R_, C_; stage_rc(t_ * 16 + i_ * 8192, R_, C_); \
        _Pragma("unroll") for (int h_ = 0; h_ < 2; ++h_) dst[h_][i_] = gather ? gtab[(ord) * 256 + h_ * HALF + R_] + (unsigned)C_ * 2u : (unsigned)((h_ * HALF + R_) * K + C_) * 2u; } } while (0)
    constexpr size_t kstep = (size_t)(BK * 2);
    constexpr size_t hstep = (size_t)HALF * K * 2;
    const unsigned ldsw = (unsigned)wid * 1024u;
    const int aoff = lds_byte(wr * 64 + fr, fq * 8), boff = lds_byte(wc * 32 + fr, fq * 8);
#define PG8_SA(b, h) (((b) * 2 + (h)) * HTB)
#define PG8_SB(b, h) ((4 + (b) * 2 + (h)) * HTB)
#define PG8_STAGE(bufoff, gbase, voff) do { _Pragma("unroll") for (int _i = 0; _i < 2; ++_i) \
        __builtin_amdgcn_global_load_lds((const unsigned*)((const char*)(gbase) + (voff)[_i]), (LAS unsigned*)(lds + (bufoff) + ldsw + _i * 8192), 16, 0, 0); } while (0)
#define PG8_LDA(dst, b, h) do { _Pragma("unroll") for (int m = 0; m < 4; ++m) _Pragma("unroll") for (int k = 0; k < 2; ++k) dst[m][k] = *(const LAS bf16x8*)(lds + PG8_SA(b, h) + aoff + m * 2048 + k * 1024); } while (0)
#define PG8_LDB(dst, b, h) do { _Pragma("unroll") for (int n = 0; n < 2; ++n) _Pragma("unroll") for (int k = 0; k < 2; ++k) dst[n][k] = *(const LAS bf16x8*)(lds + PG8_SB(b, h) + boff + n * 2048 + k * 1024); } while (0)
#define PG8_MMA(ai, bj, At, Bt) do { __builtin_amdgcn_s_setprio(1); _Pragma("unroll") for (int m = 0; m < 4; ++m) _Pragma("unroll") for (int n = 0; n < 2; ++n) _Pragma("unroll") for (int k = 0; k < 2; ++k) \
        acc[ai][bj][m][n] = __builtin_amdgcn_mfma_f32_16x16x32_bf16(Bt[n][k], At[m][k], acc[ai][bj][m][n], 0, 0, 0); __builtin_amdgcn_s_setprio(0); } while (0)
#define PG8_WAIT_V(n) asm volatile("s_waitcnt vmcnt(" #n ")" ::: "memory")
#define PG8_WAIT_VE(n16, n8) do { if (fe) { if (ns == 16) asm volatile("s_waitcnt vmcnt(" #n16 ")" ::: "memory"); else asm volatile("s_waitcnt vmcnt(" #n8 ")" ::: "memory"); } else asm volatile("s_waitcnt vmcnt(8)" ::: "memory"); } while (0)
#define PG8_WAIT_L(n) asm volatile("s_waitcnt lgkmcnt(" #n ")" ::: "memory")
#define PG8_BAR __builtin_amdgcn_s_barrier()
#define PG8_SCHED __builtin_amdgcn_sched_barrier(0)
    Unit cur, nxt; int ui = 0; int ns = 16;
    if (!S.next(0, cur)) return;
    f32x4 acc[2][2][4][2];
#pragma unroll
    for (int a = 0; a < 2; ++a)
#pragma unroll
        for (int b = 0; b < 2; ++b)
#pragma unroll
            for (int m = 0; m < 4; ++m)
#pragma unroll
                for (int n = 0; n < 2; ++n) acc[a][b][m][n] = (f32x4){0.f, 0.f, 0.f, 0.f};
    bf16x8 At[4][2], B0[2][2], B1[2][2];
    const char* cA = cur.a; const char* cB = cur.b;
    PG8_GOFF(gc, 0);
    PG8_STAGE(PG8_SB(0, 0), cB, voffB); PG8_STAGE(PG8_SB(0, 1), cB + hstep, voffB); PG8_STAGE(PG8_SA(0, 0), cA, gc[0]); PG8_STAGE(PG8_SA(0, 1), cA, gc[1]);
    if (wr == 1) PG8_BAR;
    PG8_WAIT_V(2); PG8_BAR;
    PG8_STAGE(PG8_SB(1, 0), cB + kstep, voffB); PG8_STAGE(PG8_SA(1, 0), cA + kstep, gc[0]); PG8_STAGE(PG8_SB(1, 1), cB + hstep + kstep, voffB);
    PG8_WAIT_V(6); PG8_BAR;
    for (;;) {
        const bool has_next = S.next(ui + 1, nxt);
        const char* nA = has_next ? nxt.a : cA; const char* nB = has_next ? nxt.b : cB;
        if (has_next) PG8_GOFF(gn, ui + 1);
        else {
#pragma unroll
            for (int h_ = 0; h_ < 2; ++h_)
#pragma unroll
                for (int i_ = 0; i_ < 2; ++i_) gn[h_][i_] = gc[h_][i_]; }
        for (int t = 0; t < nt; t += 2) {
            const bool last = (t == nt - 2); const bool fe = (t == 0) && (ui > 0);
            const char* a1 = cA + (size_t)(t + 1) * kstep;
            const char* a2 = last ? nA : cA + (size_t)(t + 2) * kstep; const char* b2 = last ? nB : cB + (size_t)(t + 2) * kstep;
            const char* a3 = a2 + kstep; const char* b3 = b2 + kstep;
            unsigned g2[2][2];
#pragma unroll
            for (int h_ = 0; h_ < 2; ++h_)
#pragma unroll
                for (int i_ = 0; i_ < 2; ++i_) g2[h_][i_] = last ? gn[h_][i_] : gc[h_][i_];
            PG8_LDB(B0, 0, 0); PG8_LDB(B1, 0, 1); PG8_SCHED; PG8_LDA(At, 0, 0); PG8_STAGE(PG8_SA(1, 1), a1, gc[1]);
            PG8_WAIT_VE(18, 10); PG8_WAIT_L(0); PG8_BAR; PG8_MMA(0, 0, At, B0); PG8_MMA(0, 1, At, B1); PG8_BAR; PG8_SCHED;
            PG8_LDA(At, 0, 1); PG8_STAGE(PG8_SB(0, 0), b2, voffB); PG8_STAGE(PG8_SB(0, 1), b2 + hstep, voffB); PG8_STAGE(PG8_SA(0, 0), a2, g2[0]);
            PG8_WAIT_VE(24, 16); PG8_WAIT_L(0); PG8_BAR; PG8_MMA(1, 0, At, B0); PG8_MMA(1, 1, At, B1); PG8_BAR; PG8_SCHED;
            PG8_LDB(B0, 1, 0); PG8_LDB(B1, 1, 1); PG8_SCHED; PG8_LDA(At, 1, 0); PG8_STAGE(PG8_SA(0, 1), a2, g2[1]);
            PG8_WAIT_V(8); PG8_WAIT_L(0); PG8_BAR; PG8_MMA(0, 0, At, B0); PG8_MMA(0, 1, At, B1); PG8_BAR; PG8_SCHED;
            PG8_LDA(At, 1, 1); PG8_STAGE(PG8_SB(1, 0), b3, voffB); PG8_STAGE(PG8_SB(1, 1), b3 + hstep, voffB); PG8_STAGE(PG8_SA(1, 0), a3, g2[0]);
            PG8_WAIT_V(8); PG8_WAIT_L(0); PG8_BAR; PG8_MMA(1, 0, At, B0); PG8_MMA(1, 1, At, B1); PG8_BAR; PG8_SCHED;
        }
        if (wr == 0) PG8_BAR;
        PG8_WAIT_V(0);
        { int fr_ = fr, fq_ = fq; asm volatile("" : "+v"(fr_), "+v"(fq_));
          E(acc, cur, wr, wc, fr_, fq_); } ns = E.nstores(cur);
        if (!has_next) break;
#pragma unroll
        for (int a = 0; a < 2; ++a)
#pragma unroll
            for (int b = 0; b < 2; ++b)
#pragma unroll
                for (int m = 0; m < 4; ++m)
#pragma unroll
                    for (int n = 0; n < 2; ++n) acc[a][b][m][n] = (f32x4){0.f, 0.f, 0.f, 0.f};
        cur = nxt; cA = nA; cB = nB; ++ui;
#pragma unroll
        for (int h_ = 0; h_ < 2; ++h_)
#pragma unroll
            for (int i_ = 0; i_ < 2; ++i_) gc[h_][i_] = gn[h_][i_];
        if (wr == 1) PG8_BAR;
    }
    PG8_WAIT_V(0);
    PG8_BAR;
#undef PG8_GOFF
#undef PG8_SA
#undef PG8_SB
#undef PG8_STAGE
#undef PG8_LDA
#undef PG8_LDB
#undef PG8_MMA
#undef PG8_WAIT_V
#undef PG8_WAIT_VE
#undef PG8_WAIT_L
#undef PG8_BAR
#undef PG8_SCHED
}
__device__ __forceinline__ void gemm_phase8(LAS unsigned char* lds, const int tid, const bool perm, const Sched& S, const Epi& E) {
    const int wid = __builtin_amdgcn_readfirstlane(tid >> 6), lane = tid & 63, wr = wid >> 2, wc = wid & 3, fr = lane & 15, fq = lane >> 4;
    constexpr int K = DM, nt = K / 128, PITCH = K;
    unsigned voffB[2]; int sR[2], sC[2];
#pragma unroll
    for (int i = 0; i < 2; ++i) { const int X = tid * 16 + i * 8192, p = X >> 10, l = (X >> 4) & 63, fr_ = l >> 2, g_ = fr_ >> 2, cp = (l & 3) ^ (g_ ^ (g_ >> 1));
        const int R = (p >> 1) * 16 + fr_, C = ((p & 1) * 4 + cp) * 16; const int Rb = perm ? ((R & ~31) + perm32(R & 31)) : R;
        sR[i] = R; sC[i] = C; voffB[i] = (unsigned)(Rb * PITCH + C); }
    const bool gather = S.gidx != nullptr;
    LAS unsigned* gtab = (LAS unsigned*)(lds + GT_OFF);
    if (gather) {
        Unit tu;
        for (int i = 0; S.next(i, tu); ++i) if (tid < 256) gtab[i * 256 + tid] = (unsigned)S.gidx[(tu.pm / S.tpe) * EROWS0 + (tu.pm % S.tpe) * 256 + tid] * (unsigned)PITCH;
        __syncthreads();
    }
    unsigned gc[2][2], gn[2][2];
#define PG8_GOFF(dst, ord) do { const int t_ = wid * 64 + fresh_lane(); _Pragma("unroll") for (int i_ = 0; i_ < 2; ++i_) { const int X_ = t_ * 16 + i_ * 8192, p_ = X_ >> 10, l_ = (X_ >> 4) & 63, f_ = l_ >> 2, g_ = f_ >> 2; \
        const int R_ = (p_ >> 1) * 16 + f_, C_ = ((p_ & 1) * 4 + ((l_ & 3) ^ (g_ ^ (g_ >> 1)))) * 16; \
        _Pragma("unroll") for (int h_ = 0; h_ < 2; ++h_) dst[h_][i_] = gather ? gtab[(ord) * 256 + h_ * HALF + R_] + (unsigned)C_ : (unsigned)((h_ * HALF + R_) * PITCH + C_); } } while (0)
    constexpr size_t kstep = (size_t)(BK * 2);
    constexpr size_t hstep = (size_t)HALF * PITCH;
    const unsigned ldsw = (unsigned)wid * 1024u;
    int aoff[2], boff[2];
#pragma unroll
    for (int hh = 0; hh < 2; ++hh) { const int g_ = fr >> 2, ch = (((fq & 1) * 2 + hh) ^ (g_ ^ (g_ >> 1))); const int o_ = (fq >> 1) * 1024 + (4 * fr + ch) * 16;
        aoff[hh] = wr * 8192 + o_; boff[hh] = wc * 4096 + o_; }
#define PG8_SA(b, h) (((b) * 2 + (h)) * HTB)
#define PG8_SB(b, h) ((4 + (b) * 2 + (h)) * HTB)
#define PG8_STAGE(bufoff, gbase, voff) do { _Pragma("unroll") for (int _i = 0; _i < 2; ++_i) \
        __builtin_amdgcn_global_load_lds((const unsigned*)((const char*)(gbase) + (voff)[_i]), (LAS unsigned*)(lds + (bufoff) + ldsw + _i * 8192), 16, 0, 0); } while (0)
#define PG8_LDA(dst, b, h) do { _Pragma("unroll") for (int m = 0; m < 4; ++m) dst[m] = __builtin_shufflevector(*(const LAS v4i32*)(lds + PG8_SA(b, h) + aoff[0] + m * 2048), *(const LAS v4i32*)(lds + PG8_SA(b, h) + aoff[1] + m * 2048), 0, 1, 2, 3, 4, 5, 6, 7); } while (0)
#define PG8_LDB(dst, b, h) do { _Pragma("unroll") for (int n = 0; n < 2; ++n) dst[n] = __builtin_shufflevector(*(const LAS v4i32*)(lds + PG8_SB(b, h) + boff[0] + n * 2048), *(const LAS v4i32*)(lds + PG8_SB(b, h) + boff[1] + n * 2048), 0, 1, 2, 3, 4, 5, 6, 7); } while (0)
#define PG8_V8(x) (x)
#define PG8_MMA(ai, bj, At, Bt) do { __builtin_amdgcn_s_setprio(1); _Pragma("unroll") for (int m = 0; m < 4; ++m) _Pragma("unroll") for (int n = 0; n < 2; ++n) \
        asm volatile("v_mfma_f32_16x16x128_f8f6f4 %0, %1, %2, %0" : "+v"(acc[ai][bj][m][n]) : "v"(Bt[n]), "v"(At[m])); __builtin_amdgcn_s_setprio(0); } while (0)
#define PG8_WAIT_V(n) asm volatile("s_waitcnt vmcnt(" #n ")" ::: "memory")
#define PG8_WAIT_VE(n16, n8) do { if (fe) { if (ns == 16) asm volatile("s_waitcnt vmcnt(" #n16 ")" ::: "memory"); else asm volatile("s_waitcnt vmcnt(" #n8 ")" ::: "memory"); } else asm volatile("s_waitcnt vmcnt(8)" ::: "memory"); } while (0)
#define PG8_WAIT_L(n) asm volatile("s_waitcnt lgkmcnt(" #n ")" ::: "memory")
#define PG8_BAR __builtin_amdgcn_s_barrier()
#define PG8_SCHED __builtin_amdgcn_sched_barrier(0)
    Unit cur, nxt; int ui = 0; int ns = 16;
    if (!S.next(0, cur)) return;
    f32x4 acc[2][2][4][2];
#pragma unroll
    for (int a = 0; a < 2; ++a)
#pragma unroll
        for (int b = 0; b < 2; ++b)
#pragma unroll
            for (int m = 0; m < 4; ++m)
#pragma unroll
                for (int n = 0; n < 2; ++n) acc[a][b][m][n] = (f32x4){0.f, 0.f, 0.f, 0.f};
    v8i32 At[4], B0[2], B1[2];
    const char* cA = cur.a; const char* cB = cur.b;
    PG8_GOFF(gc, 0);
    PG8_STAGE(PG8_SB(0, 0), cB, voffB); PG8_STAGE(PG8_SB(0, 1), cB + hstep, voffB); PG8_STAGE(PG8_SA(0, 0), cA, gc[0]); PG8_STAGE(PG8_SA(0, 1), cA, gc[1]);
    if (wr == 1) PG8_BAR;
    PG8_WAIT_V(2); PG8_BAR;
    PG8_STAGE(PG8_SB(1, 0), cB + kstep, voffB); PG8_STAGE(PG8_SA(1, 0), cA + kstep, gc[0]); PG8_STAGE(PG8_SB(1, 1), cB + hstep + kstep, voffB);
    PG8_WAIT_V(6); PG8_BAR;
    for (;;) {
        const bool has_next = S.next(ui + 1, nxt);
        const char* nA = has_next ? nxt.a : cA; const char* nB = has_next ? nxt.b : cB;
        if (has_next) PG8_GOFF(gn, ui + 1);
        else {
#pragma unroll
            for (int h_ = 0; h_ < 2; ++h_)
#pragma unroll
                for (int i_ = 0; i_ < 2; ++i_) gn[h_][i_] = gc[h_][i_]; }
#pragma unroll 1
        for (int t = 0; t < nt; t += 2) {
            const bool last = (t == nt - 2); const bool fe = (t == 0) && (ui > 0);
            const char* a1 = cA + (size_t)(t + 1) * kstep;
            const char* a2 = last ? nA : cA + (size_t)(t + 2) * kstep; const char* b2 = last ? nB : cB + (size_t)(t + 2) * kstep;
            const char* a3 = a2 + kstep; const char* b3 = b2 + kstep;
            unsigned g2[2][2];
#pragma unroll
            for (int h_ = 0; h_ < 2; ++h_)
#pragma unroll
                for (int i_ = 0; i_ < 2; ++i_) g2[h_][i_] = last ? gn[h_][i_] : gc[h_][i_];
            PG8_LDB(B0, 0, 0); PG8_LDB(B1, 0, 1); PG8_SCHED; PG8_LDA(At, 0, 0); PG8_STAGE(PG8_SA(1, 1), a1, gc[1]);
            PG8_WAIT_VE(18, 10); PG8_WAIT_L(0); PG8_BAR; PG8_MMA(0, 0, At, B0); PG8_MMA(0, 1, At, B1); PG8_BAR; PG8_SCHED;
            PG8_LDA(At, 0, 1); PG8_STAGE(PG8_SB(0, 0), b2, voffB); PG8_STAGE(PG8_SB(0, 1), b2 + hstep, voffB); PG8_STAGE(PG8_SA(0, 0), a2, g2[0]);
            PG8_WAIT_VE(24, 16); PG8_WAIT_L(0); PG8_BAR; PG8_MMA(1, 0, At, B0); PG8_MMA(1, 1, At, B1); PG8_BAR; PG8_SCHED;
            PG8_LDB(B0, 1, 0); PG8_LDB(B1, 1, 1); PG8_SCHED; PG8_LDA(At, 1, 0); PG8_STAGE(PG8_SA(0, 1), a2, g2[1]);
            PG8_WAIT_V(8); PG8_WAIT_L(0); PG8_BAR; PG8_MMA(0, 0, At, B0); PG8_MMA(0, 1, At, B1); PG8_BAR; PG8_SCHED;
            PG8_LDA(At, 1, 1); PG8_STAGE(PG8_SB(1, 0), b3, voffB); PG8_STAGE(PG8_SB(1, 1), b3 + hstep, voffB); PG8_STAGE(PG8_SA(1, 0), a3, g2[0]);
            PG8_WAIT_V(8); PG8_WAIT_L(0); PG8_BAR; PG8_MMA(1, 0, At, B0); PG8_MMA(1, 1, At, B1); PG8_BAR; PG8_SCHED;
        }
        if (wr == 0) PG8_BAR;
        asm volatile("s_nop 15\n\ts_nop 15" ::: "memory");
        PG8_WAIT_V(0);
        { int fr_ = fr, fq_ = fq; asm volatile("" : "+v"(fr_), "+v"(fq_));
          E(acc, cur, wr, wc, fr_, fq_); } ns = E.nstores(cur);
        if (!has_next) break;
#pragma unroll
        for (int a = 0; a < 2; ++a)
#pragma unroll
            for (int b = 0; b < 2; ++b)
#pragma unroll
                for (int m = 0; m < 4; ++m)
#pragma unroll
                    for (int n = 0; n < 2; ++n) acc[a][b][m][n] = (f32x4){0.f, 0.f, 0.f, 0.f};
        cur = nxt; cA = nA; cB = nB; ++ui;
#pragma unroll
        for (int h_ = 0; h_ < 2; ++h_)
#pragma unroll
            for (int i_ = 0; i_ < 2; ++i_) gc[h_][i_] = gn[h_][i_];
        if (wr == 1) PG8_BAR;
    }
    PG8_WAIT_V(0);
    PG8_BAR;
#undef PG8_GOFF
#undef PG8_V8
#undef PG8_SA
#undef PG8_SB
#undef PG8_STAGE
#undef PG8_LDA
#undef PG8_LDB
#undef PG8_MMA
#undef PG8_WAIT_V
#undef PG8_WAIT_VE
#undef PG8_WAIT_L
#undef PG8_BAR
#undef PG8_SCHED
}
}

namespace att {
constexpr int QBLK = 32, KVBLK = 64;
constexpr float SCALE = 0.125f;
constexpr float THR = 8.f;
constexpr float LOG2E = 1.4426950408889634f;
#define SBAR() __builtin_amdgcn_sched_barrier(0)
#define KSWZ(row, colB) ((row) * 128 + ((colB) ^ ((((row) >> 1) & 7) << 4)))
__device__ __forceinline__ int crow(int r, int hi) { return (r & 3) + 8 * (r >> 2) + 4 * hi; }
__device__ __forceinline__ unsigned cvtpk(float lo, float hi) { unsigned r; asm volatile("v_cvt_pk_bf16_f32 %0, %1, %2" : "=v"(r) : "v"(lo), "v"(hi)); return r; }

constexpr float THRL = 8.f;
template <bool NEGM = true>
__device__ __forceinline__ void partialSM(f32x16& p0, f32x16& p1, float& m_reg, f32x16& negm, float& alpha, const bool first) {
    float a = fmaxf(fmaxf(p0[0], p0[1]), p1[0]), b = fmaxf(fmaxf(p0[2], p0[3]), p1[1]); a = fmaxf(fmaxf(a, p1[2]), p1[3]);
#pragma unroll
    for (int r = 4; r < 16; r += 4) { a = fmaxf(fmaxf(a, p0[r]), p0[r + 1]); b = fmaxf(fmaxf(b, p0[r + 2]), p0[r + 3]); a = fmaxf(fmaxf(a, p1[r]), p1[r + 1]); b = fmaxf(fmaxf(b, p1[r + 2]), p1[r + 3]); }
    float pmax = fmaxf(a, b);
    { auto rr = __builtin_amdgcn_permlane32_swap(__float_as_uint(pmax), __float_as_uint(pmax), false, false);
      pmax = fmaxf(__uint_as_float(rr[0]), __uint_as_float(rr[1])); }
    if constexpr (!NEGM) pmax -= m_reg;
    alpha = 1.f;
    if (__builtin_expect(first || __any(pmax > THRL), 0)) {
        const float dl = first ? pmax : fmaxf(pmax, 0.f);
        m_reg += dl;
        if constexpr (NEGM) {
#pragma unroll
            for (int r = 0; r < 16; ++r) { p0[r] -= dl; p1[r] -= dl; }
#pragma unroll
            for (int r = 0; r < 16; ++r) negm[r] = -m_reg; }
        alpha = __builtin_amdgcn_exp2f(-dl);
    }
    if constexpr (!NEGM) {
#pragma unroll
        for (int r = 0; r < 16; ++r) { p0[r] -= m_reg; p1[r] -= m_reg; } }
#pragma unroll
    for (int r = 0; r < 16; ++r) p0[r] = __builtin_amdgcn_exp2f(p0[r]);
}
__device__ __forceinline__ void finishSM(f32x16& p0, f32x16& p1, float alpha, float& l_reg, bf16x8& pa0, bf16x8& pa1, bf16x8& pa2, bf16x8& pa3) {
#pragma unroll
    for (int r = 0; r < 16; ++r) p1[r] = __builtin_amdgcn_exp2f(p1[r]);
#define ADDF(d, a, b) asm("v_add_f32 %0, %1, %2" : "=v"(d) : "v"(a), "v"(b))
    float s0, s1, s2, s3;
    ADDF(s0, p0[0], p0[4]); ADDF(s1, p0[1], p0[5]); ADDF(s2, p0[2], p0[6]); ADDF(s3, p0[3], p0[7]);
#pragma unroll
    for (int r = 8; r < 16; r += 4) { ADDF(s0, s0, p0[r]); ADDF(s1, s1, p0[r + 1]); ADDF(s2, s2, p0[r + 2]); ADDF(s3, s3, p0[r + 3]); }
#pragma unroll
    for (int r = 0; r < 16; r += 4) { ADDF(s0, s0, p1[r]); ADDF(s1, s1, p1[r + 1]); ADDF(s2, s2, p1[r + 2]); ADDF(s3, s3, p1[r + 3]); }
    ADDF(s0, s0, s1); ADDF(s2, s2, s3);
    float ps; ADDF(ps, s0, s2);
#undef ADDF
    { auto rr = __builtin_amdgcn_permlane32_swap(__float_as_uint(ps), __float_as_uint(ps), false, false);
      ps = __uint_as_float(rr[0]) + __uint_as_float(rr[1]); }
    l_reg = l_reg * alpha + ps;
#define PK8(P, BASE, OUT) do { u32x4 w = {cvtpk(P[BASE + 0], P[BASE + 1]), cvtpk(P[BASE + 2], P[BASE + 3]), cvtpk(P[BASE + 4], P[BASE + 5]), cvtpk(P[BASE + 6], P[BASE + 7])}; OUT = __builtin_bit_cast(bf16x8, w); } while (0)
    PK8(p0, 0, pa0); PK8(p0, 8, pa1); PK8(p1, 0, pa2); PK8(p1, 8, pa3);
#undef PK8
}
__device__ __forceinline__ void qkt(f32x16& p0, f32x16& p1, const LAS char* Ks, const LAS char* qf, const f32x16& cinit, int r32, int hi) {
#pragma unroll
    for (int d0 = 0; d0 < 4; ++d0) { const int cb = (d0 * 16 + hi * 8) * 2;
        const bf16x8 q = *(const LAS bf16x8*)(qf + d0 * 1024);
        const bf16x8 b0 = *(const LAS bf16x8*)(Ks + KSWZ(r32, cb));
        const bf16x8 b1 = *(const LAS bf16x8*)(Ks + KSWZ(32 + r32, cb));
        if (d0 == 0) { p0 = __builtin_amdgcn_mfma_f32_32x32x16_bf16(b0, q, cinit, 0, 0, 0); p1 = __builtin_amdgcn_mfma_f32_32x32x16_bf16(b1, q, cinit, 0, 0, 0); }
        else { p0 = __builtin_amdgcn_mfma_f32_32x32x16_bf16(b0, q, p0, 0, 0, 0); p1 = __builtin_amdgcn_mfma_f32_32x32x16_bf16(b1, q, p1, 0, 0, 0); } }
}
__device__ __forceinline__ void qkt_r(f32x16& p0, f32x16& p1, const LAS char* Ks, const bf16x8* qr, const f32x16& cinit, int r32, int hi) {
#pragma unroll
    for (int d0 = 0; d0 < 4; ++d0) { const int cb = (d0 * 16 + hi * 8) * 2;
        const bf16x8 b0 = *(const LAS bf16x8*)(Ks + KSWZ(r32, cb));
        const bf16x8 b1 = *(const LAS bf16x8*)(Ks + KSWZ(32 + r32, cb));
        if (d0 == 0) { p0 = __builtin_amdgcn_mfma_f32_32x32x16_bf16(b0, qr[0], cinit, 0, 0, 0); p1 = __builtin_amdgcn_mfma_f32_32x32x16_bf16(b1, qr[0], cinit, 0, 0, 0); }
        else { p0 = __builtin_amdgcn_mfma_f32_32x32x16_bf16(b0, qr[d0], p0, 0, 0, 0); p1 = __builtin_amdgcn_mfma_f32_32x32x16_bf16(b1, qr[d0], p1, 0, 0, 0); } }
}
template <int NCB> __device__ __forceinline__ int v_st(int k, int c) { const int kk = k; return ((kk >> 3) * NCB + (c >> 5)) * 512 + ((kk & 7) * 32 + (c & 31)) * 2; }
__device__ __forceinline__ int v_rd_base(int lane) { return ((lane & 3) << 3) | (((lane >> 2) & 3) << 6) | (((lane >> 4) & 1) << 5) | (((lane >> 5) & 1) << 8); }
typedef short v4i16_t __attribute__((ext_vector_type(4)));
__device__ __forceinline__ s16x4 vtr(const LAS char* p) { return __builtin_bit_cast(s16x4, __builtin_amdgcn_ds_read_tr16_b64_v4i16((LAS v4i16_t*)p)); }
template <int NCB, int D0> __device__ __forceinline__ void pv_one(f32x16& od, const LAS char* vb, bf16x8 pa0, bf16x8 pa1, bf16x8 pa2, bf16x8 pa3) {
    constexpr int KS = NCB * 1024, HS = NCB * 512;
    const s16x4 l0 = vtr(vb + D0 * 512 + 0 * KS), h0 = vtr(vb + D0 * 512 + 0 * KS + HS), l1 = vtr(vb + D0 * 512 + 1 * KS), h1 = vtr(vb + D0 * 512 + 1 * KS + HS);
    const s16x4 l2 = vtr(vb + D0 * 512 + 2 * KS), h2 = vtr(vb + D0 * 512 + 2 * KS + HS), l3 = vtr(vb + D0 * 512 + 3 * KS), h3 = vtr(vb + D0 * 512 + 3 * KS + HS);
#define PK(L, H) (bf16x8){L[0], L[1], L[2], L[3], H[0], H[1], H[2], H[3]}
    od = __builtin_amdgcn_mfma_f32_32x32x16_bf16(pa0, PK(l0, h0), od, 0, 0, 0);
    od = __builtin_amdgcn_mfma_f32_32x32x16_bf16(pa1, PK(l1, h1), od, 0, 0, 0);
    od = __builtin_amdgcn_mfma_f32_32x32x16_bf16(pa2, PK(l2, h2), od, 0, 0, 0);
    od = __builtin_amdgcn_mfma_f32_32x32x16_bf16(pa3, PK(l3, h3), od, 0, 0, 0);
#undef PK
}
template <int NCB> __device__ __forceinline__ void pv_all(f32x16* o, const LAS char* vb, bf16x8 pa0, bf16x8 pa1, bf16x8 pa2, bf16x8 pa3) {
    pv_one<NCB, 0>(o[0], vb, pa0, pa1, pa2, pa3); pv_one<NCB, 1>(o[1], vb, pa0, pa1, pa2, pa3);
    if constexpr (NCB == 4) { pv_one<NCB, 2>(o[2], vb, pa0, pa1, pa2, pa3); pv_one<NCB, 3>(o[3], vb, pa0, pa1, pa2, pa3); }
}

struct UnitDesc {
    const bf16_t* Q; int ldq;
    const bf16_t* K; const bf16_t* V; int ldk, ldv;
    bf16_t* O; int ldo;
    int ctx_row0, lat_row0, lat_t0, NT;
    int q0; const float* sink;
};
template <int DV, bool SWA, int ABL = 0>
__device__ __forceinline__ void attn_unit(const UnitDesc& U, LAS char* lds, const int tid) {
    constexpr int NCB = DV / 32;
    constexpr int LDQ = SWA ? 1024 : 512, LDK = SWA ? 256 : 512, LDV = LDK, LDO = 1024;
    constexpr int SHM_V = KVBLK * DV * 2, SHM_K = KVBLK * 64 * 2;
    constexpr int NLD = (DV == 128) ? 3 : 2;
    const int wid = __builtin_amdgcn_readfirstlane(tid >> 6), lane = tid & 63, r32 = lane & 31, hi = lane >> 5;
    LAS char* V_lds = lds; LAS char* K_lds = lds + 3 * SHM_V;
    LAS float* ws = (LAS float*)(lds + 3 * SHM_V + 3 * SHM_K) + wid * 64; LAS float* li_l = ws; LAS float* al_l = ws + 32;
    float m_reg = 0.f, l_reg = 0; f32x16 o[NCB]; f32x16 negm = f32x16{};
#pragma unroll
    for (int d = 0; d < NCB; ++d) o[d] = f32x16{};
    const bf16_t* Qw = U.Q + (size_t)(wid * QBLK + r32) * LDQ + hi * 8;
    LAS char* qf = lds + 3 * SHM_V + 3 * SHM_K + 2048 + wid * 4096 + lane * 16;
#pragma unroll
    for (int d0 = 0; d0 < 4; ++d0) *(LAS bf16x8*)(qf + d0 * 1024) = *(const bf16x8*)(Qw + d0 * 16);
    const int kr = tid >> 3, kc = (tid & 7) * 8;
    const int sr = tid >> 4, sc = (tid & 15) * 8;
    const int kst = KSWZ(kr, kc * 2);
    const int vst0 = (DV == 128) ? v_st<NCB>(sr, sc) : v_st<NCB>(kr, kc), vst1 = (DV == 128) ? v_st<NCB>(32 + sr, sc) : 0;
    const LAS char* vrd = V_lds + v_rd_base(lane);
    bf16x8 svA0, svA1, skA;
    const bf16_t* kp = U.K + (size_t)(U.ctx_row0 + kr) * LDK + kc;
    const bf16_t* vp = (DV == 128) ? U.V + (size_t)(U.ctx_row0 + sr) * LDV + sc : U.V + (size_t)(U.ctx_row0 + kr) * LDV + kc;
    const int jump = (U.lat_row0 + 64 * U.lat_t0) - (U.ctx_row0 + 192);
#define SLOAD(S, t) do { \
        if constexpr (DV == 128) { sv##S##0 = *(const bf16x8*)(vp); sv##S##1 = *(const bf16x8*)(vp + (size_t)32 * LDV); } \
        else { sv##S##0 = *(const bf16x8*)(vp); } \
        sk##S = *(const bf16x8*)(kp); \
        { const int adv_ = ((t) == 3) ? jump : 64; kp += (ptrdiff_t)adv_ * LDK; vp += (ptrdiff_t)adv_ * LDV; } } while (0)
#define SWRITE(slot, S) do { *(LAS bf16x8*)(V_lds + (slot) * SHM_V + vst0) = sv##S##0; if constexpr (DV == 128) *(LAS bf16x8*)(V_lds + (slot) * SHM_V + vst1) = sv##S##1; \
        *(LAS bf16x8*)(K_lds + (slot) * SHM_K + kst) = sk##S; } while (0)
#define RESC(a) do { if (__any((a) < 1.f)) { if (hi == 0) al_l[r32] = (a); asm volatile("s_waitcnt lgkmcnt(0)" ::: "memory"); \
        _Pragma("unroll") for (int d = 0; d < NCB; ++d) _Pragma("unroll") for (int r = 0; r < 16; ++r) o[d][r] *= al_l[crow(r, hi)]; } } while (0)
    const int qs = U.q0 + wid * QBLK;
#define ACTIVE(t) (!SWA || (t) < 4 || (64 * (U.lat_t0 + (t) - 4) + 63 >= qs - 128 && 64 * (U.lat_t0 + (t) - 4) <= qs + 31 + 128))
#define MASK(P0, P1, t) do { if constexpr (SWA) { if ((t) >= 4 && !(64 * (U.lat_t0 + (t) - 4) >= qs + 31 - 128 && 64 * (U.lat_t0 + (t) - 4) + 63 <= qs + 128)) { const int kb_ = 64 * (U.lat_t0 + (t) - 4) - (qs + r32) + 4 * hi; \
        _Pragma("unroll") for (int r = 0; r < 16; ++r) { const int d0_ = kb_ + (r & 3) + 8 * (r >> 2); \
            if (d0_ > 128 || d0_ < -128) P0[r] = -1e30f; if (d0_ + 32 > 128 || d0_ + 32 < -128) P1[r] = -1e30f; } } } } while (0)
    f32x16 pA0, pA1, pB0, pB1; float alA = 1.f, alB = 1.f; bf16x8 pa0, pa1, pa2, pa3; const int NT = U.NT;
    bool actA = true, actB = true;
    int sp = 0, scur = 0, snx = 1;
#define ROT() do { sp = scur; scur = snx; snx = (snx == 2) ? 0 : snx + 1; } while (0)
#define STEP(t, C, P, LOADN, WRITEN) do { \
        act##C = ACTIVE(t); \
        SBAR(); if (act##C) { if constexpr (ABL != 4) qkt(p##C##0, p##C##1, K_lds + scur * SHM_K, qf, negm, r32, hi); else { asm volatile("" : "+v"(p##C##0), "+v"(p##C##1)); } MASK(p##C##0, p##C##1, t); } \
        if (act##P) { finishSM(p##P##0, p##P##1, al##P, l_reg, pa0, pa1, pa2, pa3); } SBAR(); \
        if (WRITEN && ABL != 1) { SWRITE(snx, A); } \
        if (LOADN && ABL != 1) SLOAD(A, (t) + 2); SBAR(); \
        if (act##P) { if constexpr (ABL != 3) { pv_all<NCB>(o, vrd + sp * SHM_V, pa0, pa1, pa2, pa3); } else { asm volatile("" :: "v"(pa0), "v"(pa1), "v"(pa2), "v"(pa3)); } } \
        if (act##C) { partialSM(p##C##0, p##C##1, m_reg, negm, al##C, false); } else al##C = 1.f; \
        if (act##C) RESC(al##C); \
        __syncthreads(); ROT(); } while (0)
    SLOAD(A, 0); asm volatile("s_waitcnt vmcnt(0)" ::: "memory"); SWRITE(0, A); SLOAD(A, 1); __syncthreads();
    qkt(pA0, pA1, K_lds, qf, negm, r32, hi); MASK(pA0, pA1, 0); partialSM(pA0, pA1, m_reg, negm, alA, true);
    SWRITE(1, A); SLOAD(A, 2); __syncthreads();
    sp = 0; scur = 1; snx = 2;
    for (int j = 1; j + 1 < NT; j += 2) {
        STEP(j, B, A, true, true);
        STEP(j + 1, A, B, (j + 3 < NT), true);
    }
    STEP(NT - 1, B, A, false, false);
    if (actB) { finishSM(pB0, pB1, alB, l_reg, pa0, pa1, pa2, pa3); SBAR(); pv_all<NCB>(o, vrd + sp * SHM_V, pa0, pa1, pa2, pa3); }
    if constexpr (SWA) l_reg += __builtin_amdgcn_exp2f(U.sink[0] * LOG2E - m_reg);
    if (hi == 0) li_l[r32] = l_reg; asm volatile("s_waitcnt lgkmcnt(0)" ::: "memory");
    float rli[16];
#pragma unroll
    for (int r = 0; r < 16; ++r) rli[r] = __builtin_amdgcn_rcpf(li_l[crow(r, hi)]);
    bf16_t* Ow = U.O + (size_t)(wid * QBLK) * LDO;
#pragma unroll
    for (int r = 0; r < 16; ++r) { const int orow = crow(r, hi);
#pragma unroll
        for (int d0 = 0; d0 < NCB; ++d0) Ow[(size_t)orow * LDO + d0 * 32 + r32] = (bf16_t)f2bf(o[d0][r] * rli[r]); }
    __syncthreads();
#undef SLOAD
#undef SWRITE
#undef RESC
#undef ACTIVE
#undef MASK
#undef ROT
#undef STEP
}
template <int DV, bool SWA>
__device__ __forceinline__ void attn_unit_pp(const UnitDesc& U, LAS char* lds, const int tid) {
    constexpr int NCB = DV / 32;
    constexpr int LDQ = SWA ? 1024 : 512, LDK = SWA ? 256 : 512, LDV = LDK, LDO = 1024;
    constexpr int SHM_V = KVBLK * DV * 2, SHM_K = KVBLK * 64 * 2;
    const int wid = __builtin_amdgcn_readfirstlane(tid >> 6), lane = tid & 63, r32 = lane & 31, hi = lane >> 5;
    const int wrow = SWA ? (wid & 1) * QBLK : wid * QBLK, wcol = SWA ? (wid >> 1) * 64 : 0;
    LAS char* V_lds = lds; LAS char* K_lds = lds + 5 * SHM_V;
    LAS float* ws = (LAS float*)(lds + 5 * SHM_V + 4 * SHM_K) + wid * 64; LAS float* li_l = ws; LAS float* al_l = ws + 32;
    constexpr bool NEGM = true;
    float m_reg = 0.f, l_reg = 0; f32x16 o[NCB]; f32x16 negm = f32x16{};
#pragma unroll
    for (int d = 0; d < NCB; ++d) o[d] = f32x16{};
    const bf16_t* Qw = U.Q + (size_t)(wrow + r32) * LDQ + wcol + hi * 8;
    bf16x8 qf[4];
#pragma unroll
    for (int d0 = 0; d0 < 4; ++d0) qf[d0] = *(const bf16x8*)(Qw + d0 * 16);
    const int krow = 8 * wid + (lane >> 3), klog = (lane & 7) ^ ((krow >> 1) & 7);
    const bf16_t* kp = U.K + (size_t)(U.ctx_row0 + krow) * LDK + klog * 8;
    const int vsub = 2 * wid + (lane >> 5), vkey = ((DV == 128) ? (vsub >> 2) : (vsub >> 1)) * 8 + ((lane >> 2) & 7), vcol = ((DV == 128) ? (vsub & 3) : (vsub & 1)) * 32 + (lane & 3) * 8;
    const bf16_t* vp = U.V + (size_t)(U.ctx_row0 + vkey) * LDV + vcol;
    const LAS char* vrd = V_lds + v_rd_base(lane);
    const int jump = (U.lat_row0 + 64 * U.lat_t0) - (U.ctx_row0 + 192);
#define DMA1(gp, la) asm volatile("s_mov_b32 m0, %1\n\ts_nop 0\n\tglobal_load_lds_dwordx4 %0, off" :: "v"(gp), "s"(la) : "memory", "m0")
#define DWAIT() asm volatile("s_waitcnt vmcnt(0)" ::: "memory")
    const unsigned kl0 = (unsigned)(unsigned long)(K_lds + wid * 1024), vl0 = (unsigned)(unsigned long)(V_lds + wid * 1024);
#define DMA(t, ks, vs) do { \
        DMA1(kp, kl0 + (ks) * SHM_K); \
        DMA1(vp, vl0 + (vs) * SHM_V); \
        if constexpr (DV == 128) DMA1(vp + (size_t)32 * LDV, vl0 + (vs) * SHM_V + 8 * 1024); \
        { const int adv_ = ((t) == 3) ? jump : 64; kp += (ptrdiff_t)adv_ * LDK; vp += (ptrdiff_t)adv_ * LDV; } } while (0)
#define RESC(a) do { if (__any((a) < 1.f)) { if (hi == 0) al_l[r32] = (a); asm volatile("s_waitcnt lgkmcnt(0)" ::: "memory"); \
        _Pragma("unroll") for (int d = 0; d < NCB; ++d) _Pragma("unroll") for (int r = 0; r < 16; ++r) o[d][r] *= al_l[crow(r, hi)]; } } while (0)
    const int qs = U.q0 + wrow;
#define ACTIVE(t) (!SWA || (t) < 4 || (64 * (U.lat_t0 + (t) - 4) + 63 >= qs - 128 && 64 * (U.lat_t0 + (t) - 4) <= qs + 31 + 128))
#define MASK(P0, P1, t) do { if constexpr (SWA) { if ((t) >= 4 && !(64 * (U.lat_t0 + (t) - 4) >= qs + 31 - 128 && 64 * (U.lat_t0 + (t) - 4) + 63 <= qs + 128)) { const int kb_ = 64 * (U.lat_t0 + (t) - 4) - (qs + r32) + 4 * hi; \
        _Pragma("unroll") for (int r = 0; r < 16; ++r) { const int d0_ = kb_ + (r & 3) + 8 * (r >> 2); \
            if (d0_ > 128 || d0_ < -128) P0[r] = -1e30f; if (d0_ + 32 > 128 || d0_ + 32 < -128) P1[r] = -1e30f; } } } } while (0)
    f32x16 pA0, pA1, pB0, pB1; float alA = 1.f, alB = 1.f; bf16x8 pa0, pa1, pa2, pa3; const int NT = U.NT;
    bool actA = true, actB = true;
    int v5 = 0;
#define INC5(x) ((x) == 4 ? 0 : (x) + 1)
#define STEP0(t, C, P) do { \
        act##C = ACTIVE(t); \
        SBAR(); if (act##C) { qkt_r(p##C##0, p##C##1, K_lds + ((t) & 3) * SHM_K, qf, negm, r32, hi); MASK(p##C##0, p##C##1, t); } \
        if (act##P) finishSM(p##P##0, p##P##1, al##P, l_reg, pa0, pa1, pa2, pa3); SBAR(); \
        if (act##P) pv_all<NCB>(o, vrd + v5 * SHM_V, pa0, pa1, pa2, pa3); \
        if (act##C) { partialSM<NEGM>(p##C##0, p##C##1, m_reg, negm, al##C, false); RESC(al##C); } else al##C = 1.f; \
        v5 = INC5(v5); } while (0)
    DMA(0, 0, 0); DWAIT(); __syncthreads();
    asm volatile("" : "+v"(qf[0]), "+v"(qf[1]), "+v"(qf[2]), "+v"(qf[3]));
    DMA(1, 1, 1); DMA(2, 2, 2);
    qkt_r(pA0, pA1, K_lds, qf, negm, r32, hi); MASK(pA0, pA1, 0);
    partialSM<NEGM>(pA0, pA1, m_reg, negm, alA, true);
    DWAIT(); __syncthreads();
    int vw = 3;
    for (int j = 1; j + 1 < NT; j += 2) {
        if (j + 2 < NT) { DMA(j + 2, (j + 2) & 3, vw); vw = INC5(vw); }
        if (j + 3 < NT) { DMA(j + 3, (j + 3) & 3, vw); vw = INC5(vw); }
        STEP0(j, B, A); STEP0(j + 1, A, B);
        DWAIT(); __syncthreads();
    }
    if ((NT & 1) == 0) {
        STEP0(NT - 1, B, A);
        if (actB) { finishSM(pB0, pB1, alB, l_reg, pa0, pa1, pa2, pa3); SBAR(); pv_all<NCB>(o, vrd + v5 * SHM_V, pa0, pa1, pa2, pa3); }
    } else {
        if (actA) { finishSM(pA0, pA1, alA, l_reg, pa0, pa1, pa2, pa3); SBAR(); pv_all<NCB>(o, vrd + v5 * SHM_V, pa0, pa1, pa2, pa3); }
    }
    if constexpr (SWA) l_reg += __builtin_amdgcn_exp2f(U.sink[wid >> 1] * LOG2E - m_reg);
    if (hi == 0) li_l[r32] = l_reg; asm volatile("s_waitcnt lgkmcnt(0)" ::: "memory");
    float rli[16];
#pragma unroll
    for (int r = 0; r < 16; ++r) rli[r] = __builtin_amdgcn_rcpf(li_l[crow(r, hi)]);
    bf16_t* Ow = U.O + (size_t)wrow * LDO + wcol;
#pragma unroll
    for (int r = 0; r < 16; ++r) { const int orow = crow(r, hi);
#pragma unroll
        for (int d0 = 0; d0 < NCB; ++d0) Ow[(size_t)orow * LDO + d0 * 32 + r32] = (bf16_t)f2bf(o[d0][r] * rli[r]); }
    __syncthreads();
#undef DMA
#undef DMA1
#undef DWAIT
#undef RESC
#undef ACTIVE
#undef MASK
#undef INC5
#undef STEP0
}

template <int DV, bool SWA, class Gen>
__device__ __forceinline__ void attn_stream(const Gen& gen, const int nunits, LAS char* lds, const int tid) {
    constexpr int NCB = DV / 32;
    constexpr int LDQ = SWA ? 1024 : 512, LDK = SWA ? 256 : 512, LDV = LDK, LDO = 1024;
    constexpr int SHM_V = KVBLK * DV * 2, SHM_K = KVBLK * 64 * 2;
    static_assert(5 * SHM_V + 5 * SHM_K + 2048 <= RING_BYTES, "rings");
    if (nunits <= 0) return;
    const int wid = __builtin_amdgcn_readfirstlane(tid >> 6), lane = tid & 63, r32 = lane & 31, hi = lane >> 5;
    const int wrow = SWA ? (wid & 1) * QBLK : wid * QBLK, wcol = SWA ? (wid >> 1) * 64 : 0;
    LAS char* V_lds = lds; LAS char* K_lds = lds + 5 * SHM_V;
    LAS float* ws = (LAS float*)(lds + 5 * SHM_V + 5 * SHM_K) + wid * 64; LAS float* li_l = ws; LAS float* al_l = ws + 32;
    constexpr bool NEGM = true;
    const int krow = 8 * wid + (lane >> 3), klog = (lane & 7) ^ ((krow >> 1) & 7);
    const int vsub = 2 * wid + (lane >> 5), vkey = ((DV == 128) ? (vsub >> 2) : (vsub >> 1)) * 8 + ((lane >> 2) & 7), vcol = ((DV == 128) ? (vsub & 3) : (vsub & 1)) * 32 + (lane & 3) * 8;
    const LAS char* vrd = V_lds + v_rd_base(lane);
    const unsigned kl0 = (unsigned)(unsigned long)(K_lds + wid * 1024), vl0 = (unsigned)(unsigned long)(V_lds + wid * 1024);
    const bf16_t* kp; const bf16_t* vp; int jump; bf16x8 qf[4];
#define DMA1(gp, la) asm volatile("s_mov_b32 m0, %1\n\ts_nop 0\n\tglobal_load_lds_dwordx4 %0, off" :: "v"(gp), "s"(la) : "memory", "m0")
#define DWAIT() asm volatile("s_waitcnt vmcnt(0)" ::: "memory")
#define DMA(t, s) do { \
        DMA1(kp, kl0 + (s) * SHM_K); \
        DMA1(vp, vl0 + (s) * SHM_V); \
        if constexpr (DV == 128) DMA1(vp + (size_t)32 * LDV, vl0 + (s) * SHM_V + 8 * 1024); \
        { const int adv_ = ((t) == 3) ? jump : 64; kp += (ptrdiff_t)adv_ * LDK; vp += (ptrdiff_t)adv_ * LDV; } } while (0)
#define SETUP(UU) do { kp = (UU).K + (size_t)((UU).ctx_row0 + krow) * LDK + klog * 8; vp = (UU).V + (size_t)((UU).ctx_row0 + vkey) * LDV + vcol; \
        jump = ((UU).lat_row0 + 64 * (UU).lat_t0) - ((UU).ctx_row0 + 192); } while (0)
#define QLOAD(UU) do { const bf16_t* Qw_ = (UU).Q + (size_t)(wrow + r32) * LDQ + wcol + hi * 8; _Pragma("unroll") for (int d0 = 0; d0 < 4; ++d0) qf[d0] = *(const bf16x8*)(Qw_ + d0 * 16); } while (0)
#define INC5(x) ((x) == 4 ? 0 : (x) + 1)
#define RESC(a) do { if (__any((a) < 1.f)) { if (hi == 0) al_l[r32] = (a); asm volatile("s_waitcnt lgkmcnt(0)" ::: "memory"); \
        _Pragma("unroll") for (int d = 0; d < NCB; ++d) _Pragma("unroll") for (int r = 0; r < 16; ++r) o[d][r] *= al_l[crow(r, hi)]; } } while (0)
#define ACTIVE(t) (!SWA || (t) < 4 || (64 * (U.lat_t0 + (t) - 4) + 63 >= qs - 128 && 64 * (U.lat_t0 + (t) - 4) <= qs + 31 + 128))
#define MASK(P0, P1, t) do { if constexpr (SWA) { if ((t) >= 4 && !(64 * (U.lat_t0 + (t) - 4) >= qs + 31 - 128 && 64 * (U.lat_t0 + (t) - 4) + 63 <= qs + 128)) { const int kb_ = 64 * (U.lat_t0 + (t) - 4) - (qs + r32) + 4 * hi; \
        _Pragma("unroll") for (int r = 0; r < 16; ++r) { const int d0_ = kb_ + (r & 3) + 8 * (r >> 2); \
            if (d0_ > 128 || d0_ < -128) P0[r] = -1e30f; if (d0_ + 32 > 128 || d0_ + 32 < -128) P1[r] = -1e30f; } } } } while (0)
#define STEP0(t, C, P) do { \
        act##C = ACTIVE(t); \
        SBAR(); if (act##C) { qkt_r(p##C##0, p##C##1, K_lds + INC5(v5) * SHM_K, qf, negm, r32, hi); MASK(p##C##0, p##C##1, t); } \
        if (act##P) finishSM(p##P##0, p##P##1, al##P, l_reg, pa0, pa1, pa2, pa3); SBAR(); \
        if (act##P) pv_all<NCB>(o, vrd + v5 * SHM_V, pa0, pa1, pa2, pa3); \
        if (act##C) { partialSM<NEGM>(p##C##0, p##C##1, m_reg, negm, al##C, false); RESC(al##C); } else al##C = 1.f; \
        v5 = INC5(v5); } while (0)
    UnitDesc U, Un; float sink_n = 0.f;
    gen(0, Un); SETUP(Un); if constexpr (SWA) sink_n = Un.sink[wid >> 1]; QLOAD(Un);
    DMA(0, 0); DMA(1, 1); DMA(2, 2);
    DWAIT(); __syncthreads();
    asm volatile("" : "+v"(qf[0]), "+v"(qf[1]), "+v"(qf[2]), "+v"(qf[3]), "+v"(sink_n));
    int rb = 0;
    for (int ui = 0; ui < nunits; ++ui) {
        U = Un; const float sinkv = sink_n;
        const int NT = U.NT, qs = U.q0 + wrow;
        float m_reg = 0.f, l_reg = 0.f; f32x16 o[NCB]; f32x16 negm = f32x16{};
#pragma unroll
        for (int d = 0; d < NCB; ++d) o[d] = f32x16{};
        f32x16 pA0, pA1, pB0, pB1; float alA = 1.f, alB = 1.f; bf16x8 pa0, pa1, pa2, pa3;
        bool actA = true, actB = true;
        int v5 = rb;
        int vw = rb + 3 >= 5 ? rb - 2 : rb + 3;
        qkt_r(pA0, pA1, K_lds + rb * SHM_K, qf, negm, r32, hi); MASK(pA0, pA1, 0);
        partialSM<NEGM>(pA0, pA1, m_reg, negm, alA, true);
        for (int j = 1; j + 1 < NT; j += 2) {
            if (j + 2 < NT) { DMA(j + 2, vw); vw = INC5(vw); }
            if (j + 3 < NT) { DMA(j + 3, vw); vw = INC5(vw); }
            STEP0(j, B, A); STEP0(j + 1, A, B);
            DWAIT(); __syncthreads();
        }
        const bool has_next = ui + 1 < nunits;
        const int rbn = vw;
        if (has_next) { gen(ui + 1, Un); SETUP(Un); DMA(0, vw); vw = INC5(vw); DMA(1, vw); vw = INC5(vw); DMA(2, vw); }
        const bool even = (NT & 1) == 0;
        if (even) STEP0(NT - 1, B, A);
        SBAR();
        if (has_next) { if constexpr (SWA) sink_n = Un.sink[wid >> 1]; QLOAD(Un); }
        if (even) { if (actB) { finishSM(pB0, pB1, alB, l_reg, pa0, pa1, pa2, pa3); SBAR(); pv_all<NCB>(o, vrd + v5 * SHM_V, pa0, pa1, pa2, pa3); } }
        else      { if (actA) { finishSM(pA0, pA1, alA, l_reg, pa0, pa1, pa2, pa3); SBAR(); pv_all<NCB>(o, vrd + v5 * SHM_V, pa0, pa1, pa2, pa3); } }
        SBAR();
        if constexpr (SWA) l_reg += __builtin_amdgcn_exp2f(sinkv * LOG2E - m_reg);
        if (hi == 0) li_l[r32] = l_reg; asm volatile("s_waitcnt lgkmcnt(0)" ::: "memory");
        float rli[16];
#pragma unroll
        for (int r = 0; r < 16; ++r) rli[r] = __builtin_amdgcn_rcpf(li_l[crow(r, hi)]);
        bf16_t* Ow = U.O + (size_t)wrow * LDO + wcol;
        asm volatile("" : "+v"(qf[0]), "+v"(qf[1]), "+v"(qf[2]), "+v"(qf[3]), "+v"(sink_n));
#pragma unroll
        for (int r = 0; r < 16; ++r) { const int orow = crow(r, hi);
#pragma unroll
            for (int d0 = 0; d0 < NCB; ++d0) Ow[(size_t)orow * LDO + d0 * 32 + r32] = (bf16_t)f2bf(o[d0][r] * rli[r]); }
        if (has_next) asm volatile("s_waitcnt lgkmcnt(0)\n\ts_barrier" ::: "memory");
        else __syncthreads();
        rb = rbn;
    }
#undef DMA
#undef DMA1
#undef DWAIT
#undef SETUP
#undef QLOAD
#undef RESC
#undef ACTIVE
#undef MASK
#undef INC5
#undef STEP0
}
#undef SBAR
#undef KSWZ
}

struct Args { const float* in[32]; float* out; unsigned char* ws; int nprog, pad; unsigned char prog[64]; };
struct ArgsD { const GAS float* in[32]; GAS float* out; GAS unsigned char* ws; int nprog, pad; unsigned char prog[64]; };
typedef const __attribute__((address_space(4))) ArgsD* ArgsP;
#define APIN(i) ((const float*)ap->in[i])
#define APOUT ((float*)ap->out)

struct Frame {
    LAS unsigned char* lds;
    int tid, lane, wave, vcu, G, gw, NGW;
    unsigned char* ws;
};

__device__ __forceinline__ int rope_src(int p) { return 16 * ((p >> 2) & 1) + 4 * (p >> 3) + (p & 3); }
__device__ __forceinline__ void transpose_item(const float* W, int N, bf16_t* WT, int src0, int dst_row0, int k0, bool perm, LAS float* scr, int lane) {
    float tv[32];
#pragma unroll
    for (int i = 0; i < 32; ++i) { const int kk = 2 * i + (lane >> 5); tv[i] = W[(size_t)(k0 + kk) * N + src0 + (lane & 31)]; }
#pragma unroll
    for (int i = 0; i < 32; ++i) { const int kk = 2 * i + (lane >> 5); scr[kk * 33 + (lane & 31)] = tv[i]; }
    LDS_WAIT(); asm volatile("" ::: "memory");
    const int c = lane & 7;
#pragma unroll
    for (int j = 0; j < 4; ++j) { const int n = (lane >> 3) + 8 * j; const int sn = perm ? rope_src(n) : n; const LAS float* s = scr + (8 * c) * 33 + sn;
        u32x4 o; o.x = pk2(s[0 * 33], s[1 * 33]); o.y = pk2(s[2 * 33], s[3 * 33]); o.z = pk2(s[4 * 33], s[5 * 33]); o.w = pk2(s[6 * 33], s[7 * 33]);
        *(u32x4*)(WT + (size_t)(dst_row0 + n) * DM + k0 + 8 * c) = o; }
    LDS_WAIT(); asm volatile("" ::: "memory");
}
__device__ __forceinline__ void transpose_item8(const float* W, int N, unsigned char* WT, int src0, int dst_row0, int k0, LAS float* scr, int lane) {
    float tv[32];
#pragma unroll
    for (int i = 0; i < 32; ++i) { const int kk = 2 * i + (lane >> 5); tv[i] = W[(size_t)(k0 + kk) * N + src0 + (lane & 31)]; }
#pragma unroll
    for (int i = 0; i < 32; ++i) { const int kk = 2 * i + (lane >> 5); scr[kk * 33 + (lane & 31)] = tv[i] * 32.f; }
    LDS_WAIT(); asm volatile("" ::: "memory");
    const int c = lane & 7;
#pragma unroll
    for (int j = 0; j < 4; ++j) { const int n = (lane >> 3) + 8 * j; const LAS float* s = scr + (8 * c) * 33 + n;
        u32x2 o; o.x = pk4_fp8(s[0 * 33], s[1 * 33], s[2 * 33], s[3 * 33]); o.y = pk4_fp8(s[4 * 33], s[5 * 33], s[6 * 33], s[7 * 33]);
        *(u32x2*)(WT + (size_t)(dst_row0 + n) * DM + k0 + 8 * c) = o; }
    LDS_WAIT(); asm volatile("" ::: "memory");
}
__device__ __forceinline__ float silu_f(float v) { return v / (1.f + __expf(-v)); }

namespace wc { constexpr int I_IN = 96 * 16, I_O = 32 * 16, I_GU = 16 * 64 * 16, I_D = 16 * 32 * 16, I_QKV = 48 * 16;
    constexpr int NITEMS = I_IN + I_O + I_GU + I_D + I_QKV + I_O + I_GU + I_D;
    constexpr int L0E = I_IN + I_O, L1 = L0E + I_GU + I_D;
    constexpr int F1_LO = L0E, F1_HI = F1_LO + 160 * 54, F2_HI = F1_HI + 224 * 54;
    constexpr int F3_LO = L1, F3_HI = F3_LO + 128 * 34, F4_HI = F3_HI + 192 * 34, F5_HI = F4_HI + 208 * 54;
    static_assert(F2_HI < L1 && F5_HI < NITEMS && F3_LO + I_QKV + I_O <= F3_HI, "filler slices");
}
__device__ __forceinline__ void weight_item(Frame& F, ArgsP ap, int it, LAS float* scr) {
    using namespace wc; unsigned char* ws = F.ws;
        int r = it;
        if (r < I_IN) { const int g = r / 16, kb = r % 16, r0 = 32 * g; int src0; bool perm = false;
            if (r0 < 512) src0 = r0;
            else if (r0 < 1536) { const int u = (r0 - 512) / 256, w = (r0 - 512) % 256; src0 = w < 128 ? 512 + u * 128 + w : 1024 + u * 128 + (w - 128); }
            else if (r0 < 2560) { src0 = r0; perm = true; }
            else src0 = r0;
            transpose_item(APIN(7), NWIN, (bf16_t*)(ws + W_IN), src0, r0, kb * 64, perm, scr, F.lane); return; }
        r -= I_IN;
        if (r < I_O) { const int g = r / 16, kb = r % 16; transpose_item(APIN(14), DM, (bf16_t*)(ws + W_OUT0), 32 * g, 32 * g, kb * 64, false, scr, F.lane); return; }
        r -= I_O;
        if (r < I_GU) { const int e = r / 1024, g = (r % 1024) / 16, kb = r % 16, r0 = 32 * g, u = r0 / 256, w = r0 % 256;
            const float* src = (w < 128 ? APIN(17) : APIN(18)) + (size_t)e * DM * FF;
            transpose_item8(src, FF, (unsigned char*)(ws + W_GU0) + (size_t)e * 2 * FF * DM, u * 128 + (w & 127), r0, kb * 64, scr, F.lane); return; }
        r -= I_GU;
        if (r < I_D) { const int e = r / 512, g = (r % 512) / 16, kb = r % 16;
            transpose_item8(APIN(19) + (size_t)e * FF * DM, DM, (unsigned char*)(ws + W_D0) + (size_t)e * DM * FF, 32 * g, 32 * g, kb * 64, scr, F.lane); return; }
        r -= I_D;
        if (r < I_QKV) { const int g = r / 16, kb = r % 16, r0 = 32 * g;
            transpose_item(APIN(23), NQKV1, (bf16_t*)(ws + W_QKV), r0, r0, kb * 64, r0 < 1280, scr, F.lane); return; }
        r -= I_QKV;
        if (r < I_O) { const int g = r / 16, kb = r % 16; transpose_item(APIN(25), DM, (bf16_t*)(ws + W_OUT1), 32 * g, 32 * g, kb * 64, false, scr, F.lane); return; }
        r -= I_O;
        if (r < I_GU) { const int e = r / 1024, g = (r % 1024) / 16, kb = r % 16, r0 = 32 * g, u = r0 / 256, w = r0 % 256;
            const float* src = (w < 128 ? APIN(28) : APIN(29)) + (size_t)e * DM * FF;
            transpose_item8(src, FF, (unsigned char*)(ws + W_GU1) + (size_t)e * 2 * FF * DM, u * 128 + (w & 127), r0, kb * 64, scr, F.lane); return; }
        r -= I_GU;
        { const int e = r / 512, g = (r % 512) / 16, kb = r % 16;
            transpose_item8(APIN(30) + (size_t)e * FF * DM, DM, (unsigned char*)(ws + W_D1) + (size_t)e * DM * FF, 32 * g, 32 * g, kb * 64, scr, F.lane); }
}
__device__ __forceinline__ void weight_items(Frame& F, ArgsP ap, int lo, int hi, int wv, int nw) {
    LAS float* scr = (LAS float*)(F.lds + F.wave * 16384);
    for (int it = lo + wv; it < hi; it += nw) weight_item(F, ap, it, scr);
}
__device__ __forceinline__ void p0_prologue(Frame& F, ArgsP ap, const bool rerun) {
    LAS float* scr = (LAS float*)(F.lds + F.wave * 16384);
    unsigned char* ws = F.ws;
    if (F.gw < 16) { const int pos = F.gw * 4 + (F.lane >> 4), f = F.lane & 15;
        const float inv = __builtin_amdgcn_exp2f(-(float)f * (13.287712379549449f / 16.f));
        const float ang = (float)pos * inv, rev = ang * 0.15915494309189535f;
        float* rp = (float*)(ws + WS_ROPE);
        rp[pos * 16 + f] = __builtin_amdgcn_cosf(rev); rp[1024 + pos * 16 + f] = __builtin_amdgcn_sinf(rev); }
    if (!rerun && F.vcu < 2 * 4 * 24) {
        const int it = F.vcu, layer = it / 96, r = it % 96, kq = r / 24, nb = r % 24;
        const float* W = APIN(layer ? 20 : 4);
        const int n0 = nb * 256 + 4 * F.lane, k0 = kq * 256 + F.wave * 32;
        f32x4 acc[9];
#pragma unroll
        for (int b = 0; b < 9; ++b) acc[b] = (f32x4){0.f, 0.f, 0.f, 0.f};
        float sv[9];
#pragma unroll
        for (int b = 0; b < 8; ++b) sv[b] = silu_f(APIN(1)[b * DM + k0 + (F.lane & 31)]);
        sv[8] = silu_f(APIN(3)[k0 + (F.lane & 31)]);
#pragma unroll 8
        for (int kk = 0; kk < 32; ++kk) { const f32x4 w = *(const f32x4*)(W + (size_t)(k0 + kk) * 6144 + n0);
#pragma unroll
            for (int b = 0; b < 9; ++b) { const float s = __builtin_bit_cast(float, __builtin_amdgcn_readlane(__builtin_bit_cast(int, sv[b]), kk)); acc[b] += w * s; } }
#pragma unroll
        for (int b = 0; b < 9; ++b) *(LAS f32x4*)(scr + b * 256 + 4 * F.lane) = acc[b];
        __syncthreads();
        float* part = (float*)(ws + WS_PART) + (size_t)(layer * 4 + kq) * 9 * 6144;
        for (int o = F.tid; o < 9 * 256; o += NTHREADS) { float s = 0.f;
#pragma unroll
            for (int w = 0; w < 8; ++w) s += ((LAS float*)(F.lds + w * 16384))[o];
            part[(o >> 8) * 6144 + nb * 256 + (o & 255)] = s; }
        __syncthreads();
    }
    weight_items(F, ap, 0, wc::L0E, F.gw, F.NGW);
    weight_items(F, ap, wc::F2_HI, wc::L1, F.gw, F.NGW);
    weight_items(F, ap, wc::F5_HI, wc::NITEMS, F.gw, F.NGW);
}

__device__ __forceinline__ void load_row(const float* p, int lane, f32x4 (&v)[4]) {
    const f32x4* r = (const f32x4*)p + lane;
#pragma unroll
    for (int j = 0; j < 4; ++j) v[j] = r[64 * j];
}
__device__ __forceinline__ void load_row_bf(const bf16_t* p, int lane, f32x4 (&v)[4]) {
    const u32x2* r = (const u32x2*)p + lane;
#pragma unroll
    for (int j = 0; j < 4; ++j) { const u32x2 w = r[64 * j]; v[j] = (f32x4){bf_lo(w.x), bf_hi(w.x), bf_lo(w.y), bf_hi(w.y)}; }
}
__device__ __forceinline__ void wave_range(int total, int gw, int ngw, int& r0, int& r1) { const int per = (total + ngw - 1) / ngw; r0 = gw * per; r1 = r0 + per < total ? r0 + per : total; }
__device__ __forceinline__ const float* xrow_ptr(const float* xlat, const float* xctx, int r) { return r < NLAT ? xlat + (size_t)r * DM : xctx + (size_t)(r - NLAT) * DM; }
__device__ __forceinline__ void load_mod(const float* gain, const float* shift, const float* scale, int lane, f32x4 (&ga)[4], f32x4 (&sh)[4]) {
#pragma unroll
    for (int j = 0; j < 4; ++j) { const f32x4 g = ((const f32x4*)gain)[lane + 64 * j], sc = ((const f32x4*)scale)[lane + 64 * j]; ga[j] = g * (sc + 1.0f); sh[j] = ((const f32x4*)shift)[lane + 64 * j]; }
}
__device__ __forceinline__ void modulate_row(f32x4 (&v)[4], const f32x4 (&ga)[4], const f32x4 (&sh)[4], int lane, bf16_t* orow) {
    float s = 0.f;
#pragma unroll
    for (int j = 0; j < 4; ++j) s += (v[j].x * v[j].x + v[j].y * v[j].y) + (v[j].z * v[j].z + v[j].w * v[j].w);
    const float rs = 1.f / sqrtf(wave_sum(s) * (1.f / DM) + NORM_EPS);
    u32x2* o8 = (u32x2*)orow + lane;
#pragma unroll
    for (int j = 0; j < 4; ++j) { v[j] = (v[j] * rs) * ga[j] + sh[j];
        u32x2 w; w.x = cvt_pk_bf16(v[j].x, v[j].y); w.y = cvt_pk_bf16(v[j].z, v[j].w); o8[64 * j] = w; }
}
__device__ __forceinline__ f32x4 mod_sum4(const float* part_layer, const float* bias, int b, int n) {
    f32x4 s = *(const f32x4*)(bias + n);
#pragma unroll
    for (int q = 0; q < 4; ++q) s += *(const f32x4*)(part_layer + (size_t)(q * 9 + b) * 6144 + n);
    return s;
}
__device__ __forceinline__ void norm1_phase(Frame& F, const float* xlat, const float* xctx, const float* gain, const float* bias0, const float* bias1) {
    bf16_t* XN = (bf16_t*)(F.ws + A_XN);
    const float* part = (const float*)(F.ws + WS_PART); float* mod = (float*)(F.ws + WS_MOD);
    for (int i = (F.gw * 64 + F.lane) * 4; i < 2 * 9 * 6144; i += F.NGW * 64 * 4) {
        const int layer = i / (9 * 6144), r = i % (9 * 6144), b = r / 6144, n = r % 6144;
        *(f32x4*)(mod + i) = mod_sum4(part + (size_t)layer * 4 * 9 * 6144, layer ? bias1 : bias0, b, n);
    }
    int r0, r1; wave_range(MALL, F.gw, F.NGW, r0, r1);
    f32x4 v[4], vn[4], ga[4], sh[4]; int cb = -1;
    if (r0 < r1) load_row(xrow_ptr(xlat, xctx, r0), F.lane, vn);
    for (int r = r0; r < r1; ++r) {
#pragma unroll
        for (int j = 0; j < 4; ++j) v[j] = vn[j];
        if (r + 1 < r1) load_row(xrow_ptr(xlat, xctx, r + 1), F.lane, vn);
        const int b = r < NLAT ? (r >> 12) : 8;
        if (b != cb) { cb = b;
#pragma unroll
            for (int j = 0; j < 4; ++j) { const int k = 4 * (F.lane + 64 * j); const f32x4 g = ((const f32x4*)gain)[F.lane + 64 * j];
                const f32x4 shv = mod_sum4(part, bias0, b, k), scv = mod_sum4(part, bias0, b, 1024 + k); ga[j] = g * (scv + 1.0f); sh[j] = shv; } }
        modulate_row(v, ga, sh, F.lane, XN + (size_t)r * DM);
    }
}
__device__ __forceinline__ void load_router(Frame& F, const float* Wr) {
    LAS float* Wt = (LAS float*)F.lds;
    for (int i = F.tid; i < DM * 4; i += NTHREADS) { const int k = i >> 2, e4 = (i & 3) * 4; const f32x4 w = *(const f32x4*)(Wr + k * 16 + e4);
        Wt[(e4 + 0) * DM + k] = w.x; Wt[(e4 + 1) * DM + k] = w.y; Wt[(e4 + 2) * DM + k] = w.z; Wt[(e4 + 3) * DM + k] = w.w; }
    __syncthreads();
}
__device__ __forceinline__ void router_dot2(const LAS char* Wl, const f32x4 (&va)[4], const f32x4 (&vb)[4], float (&la)[16], float (&lb)[16]) {
#pragma unroll
    for (int e = 0; e < 16; ++e) { f32x2 sa = {0.f, 0.f}, sb = {0.f, 0.f};
#pragma unroll
        for (int j = 0; j < 4; ++j) { const f32x4 w = *(const LAS f32x4*)(Wl + (e * DM + 256 * j) * 4);
            const f32x2 wl = {w.x, w.y}, wh = {w.z, w.w};
            sa = __builtin_elementwise_fma((f32x2){va[j].x, va[j].y}, wl, sa); sa = __builtin_elementwise_fma((f32x2){va[j].z, va[j].w}, wh, sa);
            sb = __builtin_elementwise_fma((f32x2){vb[j].x, vb[j].y}, wl, sb); sb = __builtin_elementwise_fma((f32x2){vb[j].z, vb[j].w}, wh, sb); }
        la[e] = sa.x + sa.y; lb[e] = sb.x + sb.y; if ((e & 1) == 1) __builtin_amdgcn_sched_barrier(0); }
}
__device__ __forceinline__ float router_softmax(const float (&lg)[16], int l) {
    float a8[8];
#pragma unroll
    for (int i = 0; i < 8; ++i) { auto rr = __builtin_amdgcn_permlane32_swap(__float_as_uint(lg[i]), __float_as_uint(lg[8 + i]), false, false); a8[i] = __uint_as_float(rr[0]) + __uint_as_float(rr[1]); }
    float a4[4];
#pragma unroll
    for (int i = 0; i < 4; ++i) { auto rr = __builtin_amdgcn_permlane16_swap(__float_as_uint(a8[i]), __float_as_uint(a8[4 + i]), false, false); a4[i] = __uint_as_float(rr[0]) + __uint_as_float(rr[1]); }
    float a2[2];
#pragma unroll
    for (int i = 0; i < 2; ++i) { const bool up = (l & 8) != 0; const float keep = up ? a4[2 + i] : a4[i], send = up ? a4[i] : a4[2 + i]; a2[i] = keep + dpp_f<0x128>(send); }
    float a1;
    { const bool up = (l & 4) != 0; const float keep = up ? a2[1] : a2[0], send = up ? a2[0] : a2[1]; a1 = keep + dpp_f<0x141>(send); }
    a1 += dpp_f<0x4E>(a1); a1 += dpp_f<0xB1>(a1);
    float mx = a1;
    mx = fmaxf(mx, dpp_f<0x141>(mx)); mx = fmaxf(mx, dpp_f<0x128>(mx)); mx = xmax16(mx); mx = xmax32(mx);
    const float ex = __expf(a1 - mx);
    float den = ex; den += dpp_f<0x141>(den); den += dpp_f<0x128>(den); den = xsum16(den); den = xsum32(den);
    return ex / den;
}
__device__ __forceinline__ void norm2_router_phase(Frame& F, int nrows, const float* gain, const float* mod, const float* Wr) {
    load_router(F, Wr);
    unsigned char* XN8 = (unsigned char*)(F.ws + A_XN); float* AFF = (float*)(F.ws + WS_AFF); const bf16_t* XB = (const bf16_t*)(F.ws + WS_XB);
    const int npairs = nrows >> 1;
    int p0, p1; wave_range(npairs, F.gw, F.NGW, p0, p1);
    f32x4 ga[4], sh[4]; int cb = -1;
    const int l = F.lane;
    u32x2 na[4], nb[4];
    if (p0 < p1) { const u32x2* ra = (const u32x2*)(XB + (size_t)(2 * p0) * DM) + l; const u32x2* rb = (const u32x2*)(XB + (size_t)(2 * p0 + 1) * DM) + l;
#pragma unroll
        for (int j = 0; j < 4; ++j) { na[j] = ra[64 * j]; nb[j] = rb[64 * j]; } }
    for (int p = p0; p < p1; ++p) {
        const int r = 2 * p;
        f32x4 va[4], vb[4];
#pragma unroll
        for (int j = 0; j < 4; ++j) { va[j] = (f32x4){bf_lo(na[j].x), bf_hi(na[j].x), bf_lo(na[j].y), bf_hi(na[j].y)}; vb[j] = (f32x4){bf_lo(nb[j].x), bf_hi(nb[j].x), bf_lo(nb[j].y), bf_hi(nb[j].y)}; }
        if (p + 1 < p1) { const u32x2* ra = (const u32x2*)(XB + (size_t)(r + 2) * DM) + l; const u32x2* rb = (const u32x2*)(XB + (size_t)(r + 3) * DM) + l;
#pragma unroll
            for (int j = 0; j < 4; ++j) { na[j] = ra[64 * j]; nb[j] = rb[64 * j]; } }
        const int b = r < NLAT ? (r >> 12) : 8;
        if (b != cb) { cb = b; load_mod(gain, mod + (size_t)b * 6144 + 3 * 1024, mod + (size_t)b * 6144 + 4 * 1024, l, ga, sh); }
        float s0 = 0.f, s1 = 0.f;
#pragma unroll
        for (int j = 0; j < 4; ++j) { s0 += (va[j].x * va[j].x + va[j].y * va[j].y) + (va[j].z * va[j].z + va[j].w * va[j].w); s1 += (vb[j].x * vb[j].x + vb[j].y * vb[j].y) + (vb[j].z * vb[j].z + vb[j].w * vb[j].w); }
        const float rs0 = 1.f / sqrtf(wave_sum(s0) * (1.f / DM) + NORM_EPS), rs1 = 1.f / sqrtf(wave_sum(s1) * (1.f / DM) + NORM_EPS);
        unsigned* oa = (unsigned*)(XN8 + (size_t)r * DM) + l; unsigned* ob = (unsigned*)(XN8 + (size_t)(r + 1) * DM) + l;
#pragma unroll
        for (int j = 0; j < 4; ++j) { va[j] = (va[j] * rs0) * ga[j] + sh[j]; vb[j] = (vb[j] * rs1) * ga[j] + sh[j];
            oa[64 * j] = pk4_fp8(va[j].x, va[j].y, va[j].z, va[j].w); ob[64 * j] = pk4_fp8(vb[j].x, vb[j].y, vb[j].z, vb[j].w); }
        int wofs = 16 * l; asm volatile("" : "+v"(wofs));
        float la[16], lb[16];
        router_dot2((const LAS char*)F.lds + wofs, va, vb, la, lb);
        const float pa_ = router_softmax(la, l), pb_ = router_softmax(lb, l);
        if ((l & 3) == 0) { AFF[(size_t)r * 16 + (l >> 2)] = pa_; AFF[(size_t)(r + 1) * 16 + (l >> 2)] = pb_; }
    }
    __syncthreads();
}

__device__ __forceinline__ void mix0_combine_phase(Frame& F, ArgsP ap) {
    const bf16_t* BG = (const bf16_t*)(F.ws + A_BG); const bf16_t* CX = (const bf16_t*)(F.ws + A_CX); const bf16_t* OH = (const bf16_t*)(F.ws + A_OH);
    bf16_t* AO = (bf16_t*)(F.ws + A_XN);
    float d1 = APIN(9)[F.lane] * APIN(10)[F.lane], d2 = APIN(11)[F.lane] * APIN(12)[F.lane];
    const float lam = __expf(wave_sum(d1)) - __expf(wave_sum(d2)) + LAM_INIT;
    const int l = F.lane;
    float cw0[8], cw1[8], cw2[8], sg[8];
#pragma unroll
    for (int i = 0; i < 8; ++i) { cw0[i] = APIN(8)[8 * l + i]; cw1[i] = APIN(8)[512 + 8 * l + i]; cw2[i] = APIN(8)[1024 + 8 * l + i]; sg[i] = APIN(13)[(l & 15) * 8 + i] * (1.f - LAM_INIT); }
    const int h = l >> 4, d0 = (l & 15) * 8;
    int r0, r1; wave_range(MALL, F.gw, F.NGW, r0, r1);
    if (r0 >= r1) return;
    const u32x4 zero = (u32x4){0u, 0u, 0u, 0u};
#define CXROW(r) (*(const u32x4*)(CX + (size_t)(r) * 512 + 8 * l))
    u32x4 c0 = r0 > 0 ? CXROW(r0 - 1) : zero, c1 = CXROW(r0), c2 = r0 + 1 < MALL ? CXROW(r0 + 1) : zero, c3;
    u32x4 bgn = *(const u32x4*)(BG + (size_t)r0 * 512 + 8 * l);
    u32x4 o1n = *(const u32x4*)(OH + (size_t)r0 * DM + (2 * h) * 128 + d0), o2n = *(const u32x4*)(OH + (size_t)r0 * DM + (2 * h + 1) * 128 + d0);
    for (int r = r0; r < r1; ++r) {
        const u32x4 bgv = bgn, o1 = o1n, o2 = o2n;
        c3 = r + 2 < MALL ? CXROW(r + 2) : zero;
        if (r + 1 < r1) { bgn = *(const u32x4*)(BG + (size_t)(r + 1) * 512 + 8 * l);
            o1n = *(const u32x4*)(OH + (size_t)(r + 1) * DM + (2 * h) * 128 + d0); o2n = *(const u32x4*)(OH + (size_t)(r + 1) * DM + (2 * h + 1) * 128 + d0); }
        const bool lat = r < NLAT; const int t = lat ? (r & (SEQ - 1)) : ((r - NLAT) & (CTX - 1)); const int tl = lat ? SEQ : CTX;
        const u32x4 ca = t > 0 ? c0 : zero, cc = t < tl - 1 ? c2 : zero;
        u32x4 ow;
#pragma unroll
        for (int i = 0; i < 4; ++i) {
            const float lo = bf_lo(bgv[i]) * (cw0[2 * i] * bf_lo(ca[i]) + cw1[2 * i] * bf_lo(c1[i]) + cw2[2 * i] * bf_lo(cc[i]));
            const float hi = bf_hi(bgv[i]) * (cw0[2 * i + 1] * bf_hi(ca[i]) + cw1[2 * i + 1] * bf_hi(c1[i]) + cw2[2 * i + 1] * bf_hi(cc[i]));
            ow[i] = cvt_pk_bf16(lo, hi); }
        *(u32x4*)(AO + (size_t)r * DM + 8 * l) = ow;
        c0 = c1; c1 = c2; c2 = c3;
        float ov[8]; float ss = 0.f;
#pragma unroll
        for (int i = 0; i < 4; ++i) { ov[2 * i] = bf_lo(o1[i]) - lam * bf_lo(o2[i]); ov[2 * i + 1] = bf_hi(o1[i]) - lam * bf_hi(o2[i]); ss += ov[2 * i] * ov[2 * i] + ov[2 * i + 1] * ov[2 * i + 1]; }
        ss = row16_sum(ss);
        const float rs = 1.f / sqrtf(ss * (1.f / 128.f) + NORM_EPS);
        u32x4 ow2;
#pragma unroll
        for (int i = 0; i < 4; ++i) ow2[i] = cvt_pk_bf16(ov[2 * i] * rs * sg[2 * i], ov[2 * i + 1] * rs * sg[2 * i + 1]);
        *(u32x4*)(AO + (size_t)r * DM + 512 + h * 128 + d0) = ow2;
    }
#undef CXROW
}

__device__ __forceinline__ unsigned block_excl_scan(unsigned v, LAS unsigned* sc, int tid, unsigned& total) {
    unsigned x = v;
    x += (unsigned)__builtin_amdgcn_update_dpp(0, (int)x, 0x111, 0xf, 0xf, true); x += (unsigned)__builtin_amdgcn_update_dpp(0, (int)x, 0x112, 0xf, 0xf, true);
    x += (unsigned)__builtin_amdgcn_update_dpp(0, (int)x, 0x114, 0xf, 0xf, true); x += (unsigned)__builtin_amdgcn_update_dpp(0, (int)x, 0x118, 0xf, 0xf, true);
    x += (unsigned)__builtin_amdgcn_update_dpp(0, (int)x, 0x142, 0xa, 0xf, false); x += (unsigned)__builtin_amdgcn_update_dpp(0, (int)x, 0x143, 0xc, 0xf, false);
    if ((tid & 63) == 63) sc[tid >> 6] = x;
    __syncthreads();
    unsigned base = 0, tot = 0;
#pragma unroll
    for (int w = 0; w < 8; ++w) { const unsigned s = sc[w]; if (w < (tid >> 6)) base += s; tot += s; }
    __syncthreads();
    total = tot;
    return base + x - v;
}
__device__ __forceinline__ void topk_list(Frame& F, int row0, int n, int e, int cap, int slot_row0) {
    LAS unsigned* sc = (LAS unsigned*)F.lds;
    LAS unsigned* cw = sc + 16;
    const float* AFF = (const float*)(F.ws + WS_AFF); int* POS = (int*)(F.ws + WS_POS); int* IDX = (int*)(F.ws + WS_IDX);
    const int tid = F.tid, wave = tid >> 6;
    const int per = 8; const int base = tid * per; const bool act = base < n;
    unsigned kk[8];
#pragma unroll
    for (int i = 0; i < per; ++i) kk[i] = act ? __builtin_bit_cast(unsigned, AFF[(size_t)(row0 + base + i) * 16 + e]) : 0u;
    unsigned T = 0; int it = 0;
    for (int bit = 30; bit >= 0; --bit, ++it) {
        const unsigned cand = T | (1u << bit);
        unsigned c = 0;
#pragma unroll
        for (int i = 0; i < per; ++i) c += (unsigned)__builtin_popcountll(__ballot(act && kk[i] >= cand));
        if ((tid & 63) == 0) cw[(it & 1) * 8 + wave] = c;
        __syncthreads();
        unsigned tot = 0;
#pragma unroll
        for (int w = 0; w < 8; ++w) tot += cw[(it & 1) * 8 + w];
        if (tot >= (unsigned)cap) T = cand;
    }
    __syncthreads();
    const unsigned prefix = T;
    unsigned ngt_l = 0, neq = 0;
#pragma unroll
    for (int i = 0; i < per; ++i) { ngt_l += (act && kk[i] > prefix) ? 1u : 0u; neq += (act && kk[i] == prefix) ? 1u : 0u; }
    unsigned ngt; (void)block_excl_scan(ngt_l, sc, tid, ngt);
    const unsigned krem = (unsigned)cap - ngt;
    unsigned tot; const unsigned eq_before = block_excl_scan(neq, sc, tid, tot);
    unsigned nsel = 0; unsigned selm = 0; unsigned eqc = eq_before;
#pragma unroll
    for (int i = 0; i < per; ++i) { bool s = false; if (act) { if (kk[i] > prefix) s = true; else if (kk[i] == prefix) { s = eqc < krem; ++eqc; } } if (s) { selm |= 1u << i; ++nsel; } }
    const unsigned sel_before = block_excl_scan(nsel, sc, tid, tot);
    unsigned slot = sel_before;
    if (act) {
#pragma unroll
        for (int i = 0; i < per; ++i) { const int row = row0 + base + i;
            if (selm & (1u << i)) { IDX[e * EROWS0 + slot_row0 + slot] = row; POS[(size_t)row * 16 + e] = slot_row0 + (int)slot; ++slot; }
            else POS[(size_t)row * 16 + e] = -1; }
    }
    __syncthreads();
}
__device__ __forceinline__ void topk_phase(Frame& F, bool with_ctx) {
    const int nl = with_ctx ? 256 : 128;
    for (int lid = F.vcu; lid < nl; lid += F.G) {
        if (lid < 128) { const int b = lid >> 4, e = lid & 15; topk_list(F, b * SEQ, SEQ, e, CAP_L, b * CAP_L); }
        else { const int b = (lid - 128) >> 4, e = lid & 15; topk_list(F, NLAT + b * CTX, CTX, e, CAP_C, NB * CAP_L + b * CAP_C); }
    }
}
__device__ __forceinline__ void gather_phase(Frame& F, int erows) {
    const int* IDX = (const int*)(F.ws + WS_IDX); const bf16_t* XN = (const bf16_t*)(F.ws + A_XN); bf16_t* HS = (bf16_t*)(F.ws + A_HS);
    const int total = NE * erows;
    int r0, r1; wave_range(total, F.gw, F.NGW, r0, r1);
    for (int base = r0; base < r1; base += 64) {
        const int n = r1 - base < 64 ? r1 - base : 64;
        int myidx = 0;
        if (F.lane < n) { const int i = base + F.lane; const int e = i / erows, s = i - e * erows; myidx = __hip_atomic_load(IDX + e * EROWS0 + s, RLX_AGENT); }
        for (int k = 0; k < n; k += 4) {
            u32x4 va[4], vb[4];
#pragma unroll
            for (int q = 0; q < 4; ++q) { const int kk = k + q < n ? k + q : n - 1; const int src = __builtin_amdgcn_readlane(myidx, kk);
                const u32x4* sp = (const u32x4*)(XN + (size_t)src * DM) + F.lane; va[q] = sp[0]; vb[q] = sp[64]; }
#pragma unroll
            for (int q = 0; q < 4; ++q) { if (k + q < n) { u32x4* dp = (u32x4*)(HS + (size_t)(base + k + q) * DM) + F.lane; dp[0] = va[q]; dp[64] = vb[q]; } }
        }
    }
}
__device__ __forceinline__ void moe_combine_phase(Frame& F, int nrows, int erows, const float* mod_cur, bool final_norm,
                                                  const float* gain_next, const float* mod_next, float* outp) {
    const float* AFF = (const float*)(F.ws + WS_AFF); const int* POS = (const int*)(F.ws + WS_POS); const unsigned char* Y = (const unsigned char*)(F.ws + A_HS);
    bf16_t* XN = (bf16_t*)(F.ws + A_XN); bf16_t* XB = (bf16_t*)(F.ws + WS_XB);
    int r0, r1; wave_range(nrows, F.gw, F.NGW, r0, r1);
    if (r0 >= r1) return;
    const int l = F.lane;
    f32x4 v[4], vn[4], ga[4], sh[4], g2[4]; int cb = -1; int pos_n = -1; float af_n = 0.f;
    load_row_bf(XB + (size_t)r0 * DM, l, vn);
    if (l < 16) { pos_n = POS[(size_t)r0 * 16 + l]; af_n = AFF[(size_t)r0 * 16 + l]; }
    for (int r = r0; r < r1; ++r) {
#pragma unroll
        for (int j = 0; j < 4; ++j) v[j] = vn[j];
        const int pos = pos_n; const float af = af_n;
        if (r + 1 < r1) { load_row_bf(XB + (size_t)(r + 1) * DM, l, vn); if (l < 16) { pos_n = POS[(size_t)(r + 1) * 16 + l]; af_n = AFF[(size_t)(r + 1) * 16 + l]; } }
        const int b = r < NLAT ? (r >> 12) : 8;
        if (b != cb) { cb = b;
#pragma unroll
            for (int j = 0; j < 4; ++j) g2[j] = ((const f32x4*)(mod_cur + (size_t)b * 6144 + 5 * 1024))[l + 64 * j];
            if (!final_norm) load_mod(gain_next, mod_next + (size_t)b * 6144, mod_next + (size_t)b * 6144 + 1024, l, ga, sh);
            else {
#pragma unroll
                for (int j = 0; j < 4; ++j) ga[j] = ((const f32x4*)gain_next)[l + 64 * j]; } }
        f32x4 acc[4];
#pragma unroll
        for (int j = 0; j < 4; ++j) acc[j] = (f32x4){0.f, 0.f, 0.f, 0.f};
        unsigned long long m = __ballot(pos >= 0);
        while (m) {
            const int e0 = __builtin_ctzll(m); m &= m - 1; const bool two = m != 0; const int e1 = two ? __builtin_ctzll(m) : e0; if (two) m &= m - 1;
            const int p0 = __builtin_amdgcn_readlane(pos, e0), p1 = __builtin_amdgcn_readlane(pos, e1);
            const float w0 = __builtin_bit_cast(float, __builtin_amdgcn_readlane(__builtin_bit_cast(int, af), e0));
            const float w1 = two ? __builtin_bit_cast(float, __builtin_amdgcn_readlane(__builtin_bit_cast(int, af), e1)) : 0.f;
            const unsigned* y0 = (const unsigned*)(Y + ((size_t)e0 * erows + p0) * DM) + l; const unsigned* y1 = (const unsigned*)(Y + ((size_t)e1 * erows + p1) * DM) + l;
            unsigned ya[4], yb[4];
#pragma unroll
            for (int j = 0; j < 4; ++j) { ya[j] = y0[64 * j]; yb[j] = y1[64 * j]; }
#pragma unroll
            for (int j = 0; j < 4; ++j) {
                const f32x2 a01 = __builtin_amdgcn_cvt_pk_f32_fp8((int)ya[j], false), a23 = __builtin_amdgcn_cvt_pk_f32_fp8((int)ya[j], true);
                const f32x2 b01 = __builtin_amdgcn_cvt_pk_f32_fp8((int)yb[j], false), b23 = __builtin_amdgcn_cvt_pk_f32_fp8((int)yb[j], true);
                acc[j].x += w0 * a01.x + w1 * b01.x; acc[j].y += w0 * a01.y + w1 * b01.y; acc[j].z += w0 * a23.x + w1 * b23.x; acc[j].w += w0 * a23.y + w1 * b23.y; }
        }
#pragma unroll
        for (int j = 0; j < 4; ++j) v[j] = v[j] + g2[j] * acc[j] * (1.f / 16.f);
        if (!final_norm) {
            u32x2* xo = (u32x2*)(XB + (size_t)r * DM) + l;
#pragma unroll
            for (int j = 0; j < 4; ++j) { u32x2 w; w.x = cvt_pk_bf16(v[j].x, v[j].y); w.y = cvt_pk_bf16(v[j].z, v[j].w); xo[64 * j] = w; }
            modulate_row(v, ga, sh, l, XN + (size_t)r * DM);
        } else {
            float s = 0.f;
#pragma unroll
            for (int j = 0; j < 4; ++j) s += (v[j].x * v[j].x + v[j].y * v[j].y) + (v[j].z * v[j].z + v[j].w * v[j].w);
            const float rs = 1.f / sqrtf(wave_sum(s) * (1.f / DM) + NORM_EPS);
            f32x4* xo = (f32x4*)(outp + (size_t)r * DM) + l;
#pragma unroll
            for (int j = 0; j < 4; ++j) xo[64 * j] = (v[j] * rs) * ga[j];
        }
    }
}

__device__ __forceinline__ void attn0_phase(Frame& F, const bool rerun) {
    const bf16_t* Q0 = (const bf16_t*)(F.ws + A_Q0); const bf16_t* K0 = (const bf16_t*)(F.ws + A_K0); const bf16_t* V0 = (const bf16_t*)(F.ws + A_V0);
    bf16_t* OH = (bf16_t*)(F.ws + A_OH);
    const int per = (1024 + F.G - 1) / F.G;
    const int u0 = F.vcu * per, nlat = u0 >= 1024 ? 0 : (u0 + per > 1024 ? 1024 - u0 : per), nctx = F.vcu < 64 ? 1 : 0, vcu = F.vcu;
    auto gen = [=](int i, att::UnitDesc& U) {
        int b, sh, qrow0;
        if (i < nlat) { const int u = u0 + i; b = u >> 7; sh = (u & 127) >> 4; const int qb = u & 15; qrow0 = b * SEQ + qb * 256; U.NT = 68; }
        else { b = vcu >> 3; sh = vcu & 7; qrow0 = NLAT + b * CTX; U.NT = 4; }
        U.Q = Q0 + (size_t)qrow0 * 512 + sh * 64; U.ldq = 512;
        U.K = K0 + sh * 64; U.V = V0 + (sh >> 1) * 128; U.ldk = 512; U.ldv = 512;
        U.O = OH + (size_t)qrow0 * DM + sh * 128; U.ldo = DM;
        U.ctx_row0 = NLAT + b * CTX; U.lat_row0 = b * SEQ; U.lat_t0 = 0; U.q0 = 0; U.sink = nullptr;
    };
#if ATT0_STREAM
    att::attn_stream<128, false>(gen, nlat + nctx, (LAS char*)F.lds, F.tid);
#else
    for (int i = 0; i < nlat + nctx; ++i) { att::UnitDesc U; gen(i, U); att::attn_unit_pp<128, false>(U, (LAS char*)F.lds, F.tid); }
#endif
}
__device__ __forceinline__ void attn1_phase(Frame& F, const float* sink) {
    const bf16_t* Q1 = (const bf16_t*)(F.ws + A_Q1); const bf16_t* K1 = (const bf16_t*)(F.ws + A_K1); const bf16_t* V1 = (const bf16_t*)(F.ws + A_V1);
    bf16_t* AO = (bf16_t*)(F.ws + A_XN);
    const int per = (2048 + F.G - 1) / F.G;
    const int u0 = F.vcu * per, n = u0 >= 2048 ? 0 : (u0 + per > 2048 ? 2048 - u0 : per);
    auto gen = [=](int i, att::UnitDesc& U) {
        const int u = u0 + i;
        const int b = u >> 8, kvh = (u & 255) >> 6, qb = u & 63, q0 = qb * 64, qrow0 = b * SEQ + q0;
        U.Q = Q1 + (size_t)qrow0 * DM + kvh * 256; U.ldq = DM;
        U.K = K1 + kvh * 64; U.V = V1 + kvh * 64; U.ldk = 256; U.ldv = 256;
        U.O = AO + (size_t)qrow0 * DM + kvh * 256; U.ldo = DM;
        const int lo = q0 - 128 < 0 ? 0 : q0 - 128, hi = q0 + 192 > SEQ ? SEQ : q0 + 192;
        U.ctx_row0 = NLAT + b * CTX; U.lat_row0 = b * SEQ; U.lat_t0 = lo >> 6; U.NT = 4 + ((hi - lo) >> 6);
        U.q0 = q0; U.sink = sink + kvh * 4;
    };
#if ATT1_STREAM
    att::attn_stream<64, true>(gen, n, (LAS char*)F.lds, F.tid);
#else
    for (int i = 0; i < n; ++i) { att::UnitDesc U; gen(i, U); att::attn_unit_pp<64, true>(U, (LAS char*)F.lds, F.tid); }
#endif
}

constexpr int N_PHASES = 21;
#ifndef PH_EN
#define PH_EN(p) ((p) != 8 && (p) != 17)
#endif
#ifndef GEMM_EN
#define GEMM_EN 1
#endif
__global__ void __launch_bounds__(NTHREADS, 2) fwd_kernel(Args args) {
    extern __shared__ __attribute__((aligned(16))) unsigned char lds_raw[];
    Frame F;
    F.lds = (LAS unsigned char*)lds_raw;
    F.tid = threadIdx.x; F.lane = F.tid & 63; F.wave = __builtin_amdgcn_readfirstlane(F.tid >> 6);
    F.G = gridDim.x; { const int bx = blockIdx.x; F.vcu = (F.G % 8 == 0) ? (bx % 8) * (F.G / 8) + bx / 8 : bx; }
    F.gw = F.vcu * NWAVES + F.wave; F.NGW = F.G * NWAVES;
    F.ws = args.ws;
    unsigned char* ws = args.ws;
    volatile LAS unsigned* MISC = (volatile LAS unsigned*)(F.lds + MISC_OFF);
    for (int u = F.tid; u < (LDS_BYTES - RING_BYTES) / 4; u += NTHREADS) ((LAS unsigned*)(F.lds + RING_BYTES))[u] = 0u;
    __syncthreads();
    const int nprog = args.nprog;
    XcdBarrier bar; bar.bar = (unsigned*)(ws + WS_CTL) + CW_BAR; bar.x = 0; bar.st = nullptr;
    if (nprog > 1) bar = xcd_barrier_post((unsigned*)(ws + WS_CTL) + CW_BAR, MISC + 8);

    const Frame F0 = F;
    for (int pi = 0; pi < nprog; ++pi) {
        F = F0; asm volatile("" : "+s"(F.wave), "+s"(F.vcu), "+s"(F.gw));
        { unsigned ones = ~0u; asm volatile("" : "+s"(ones));
          F.lane = (int)__builtin_amdgcn_mbcnt_hi(ones, __builtin_amdgcn_mbcnt_lo(ones, 0u)); F.tid = F.wave * 64 + F.lane; }
        ArgsP ap = (ArgsP)__builtin_amdgcn_kernarg_segment_ptr(); asm volatile("" : "+s"(ap));
        { GAS unsigned char* wsg = ap->ws; asm volatile("" : "+s"(wsg)); F.ws = (unsigned char*)wsg; }
        ws = F.ws;
        const int phx = ap->prog[pi], ph = phx & 31; const bool rerun = (phx & 32) != 0;
        const float* MOD0 = (const float*)(ws + WS_MOD); const float* MOD1 = MOD0 + 9 * 6144;
        bool is_gemm = false, is_gemm8 = false; bool perm = true; pg8::Sched S; pg8::Epi E;
        S.G = F.G; S.c = (int)blockIdx.x; S.tpe = 1 << 20; S.pitch = 2 * DM; S.wgm = 8; S.hot = false; S.gidx = nullptr; S.A = nullptr; S.B = nullptr; S.nM = 0; S.nN = 0;
        E.kind = 0; E.layer = 0; E.f8out = false; E.wsc = 1.f; E.ws = ws; E.xin_lat = nullptr; E.xin_ctx = nullptr;
        switch (ph) {
        case 0: if (!PH_EN(0)) break; p0_prologue(F, ap, rerun); break;
        case 1: if (!PH_EN(1)) break; norm1_phase(F, APIN(0), APIN(2), APIN(6), APIN(5), APIN(21)); break;
        case 2: if (!PH_EN(2)) break; is_gemm = true; S.A = (const char*)(ws + A_XN); S.B = (const char*)(ws + W_IN); S.nM = MALL / 256; S.nN = NWIN / 256; E.kind = pg8::EK_IN0; break;
        case 3: if (!PH_EN(3)) break; attn0_phase(F, rerun); break;
        case 4: if (!PH_EN(4)) break; mix0_combine_phase(F, ap); break;
        case 5: if (!PH_EN(5)) break; is_gemm = true; S.A = (const char*)(ws + A_XN); S.B = (const char*)(ws + W_OUT0); S.nM = MALL / 256; S.nN = DM / 256;
                E.kind = pg8::EK_OUT; E.layer = 0; E.xin_lat = APIN(0); E.xin_ctx = APIN(2); break;
        case 6: if (!PH_EN(6)) break; norm2_router_phase(F, MALL, APIN(15), MOD0, APIN(16)); break;
        case 7: if (!PH_EN(7)) break; topk_phase(F, true); break;
        case 8: if (!PH_EN(8)) break; gather_phase(F, EROWS0); break;
        case 9: if (!PH_EN(9)) break; is_gemm8 = true; S.pitch = DM; S.wgm = 4; E.wsc = 1.f / 32.f; E.f8out = true; S.A = (const char*)(ws + A_XN); S.gidx = (const int*)(ws + WS_IDX); S.B = (const char*)(ws + W_GU0); S.nM = NE * EROWS0 / 256; S.nN = 2 * FF / 256; S.tpe = EROWS0 / 256; E.kind = pg8::EK_GU; break;
        case 10: if (!PH_EN(10)) break; is_gemm8 = true; S.pitch = DM; E.wsc = 1.f / 32.f; S.A = (const char*)(ws + A_ACT); S.B = (const char*)(ws + W_D0); S.nM = NE * EROWS0 / 256; S.nN = DM / 256; S.tpe = EROWS0 / 256; E.kind = pg8::EK_DOWN; break;
        case 11: if (!PH_EN(11)) break; moe_combine_phase(F, MALL, EROWS0, MOD0, false, APIN(22), MOD1, nullptr); break;
        case 12: if (!PH_EN(12)) break; is_gemm = true; S.A = (const char*)(ws + A_XN); S.B = (const char*)(ws + W_QKV); S.nM = MALL / 256; S.nN = NQKV1 / 256; E.kind = pg8::EK_QKV1; break;
        case 13: if (!PH_EN(13)) break; attn1_phase(F, APIN(24)); break;
        case 14: if (!PH_EN(14)) break; is_gemm = true; S.A = (const char*)(ws + A_XN); S.B = (const char*)(ws + W_OUT1); S.nM = NLAT / 256; S.nN = DM / 256;
                E.kind = pg8::EK_OUT; E.layer = 1; break;
        case 15: if (!PH_EN(15)) break; norm2_router_phase(F, NLAT, APIN(26), MOD1, APIN(27)); break;
        case 16: if (!PH_EN(16)) break; topk_phase(F, false); break;
        case 17: if (!PH_EN(17)) break; gather_phase(F, EROWS1); break;
        case 18: if (!PH_EN(18)) break; is_gemm8 = true; S.pitch = DM; S.wgm = 4; E.wsc = 1.f / 32.f; E.f8out = true; S.A = (const char*)(ws + A_XN); S.gidx = (const int*)(ws + WS_IDX); S.B = (const char*)(ws + W_GU1); S.nM = NE * EROWS1 / 256; S.nN = 2 * FF / 256; S.tpe = EROWS1 / 256; E.kind = pg8::EK_GU; break;
        case 19: if (!PH_EN(19)) break; is_gemm8 = true; S.pitch = DM; E.wsc = 1.f / 32.f; S.A = (const char*)(ws + A_ACT); S.B = (const char*)(ws + W_D1); S.nM = NE * EROWS1 / 256; S.nN = DM / 256; S.tpe = EROWS1 / 256; E.kind = pg8::EK_DOWN; break;
        case 20: if (!PH_EN(20)) break; moe_combine_phase(F, NLAT, EROWS1, MOD1, true, APIN(31), nullptr, APOUT); break;
#if PROBE_MFMA
        case 21: {
            typedef int v8i_ __attribute__((ext_vector_type(8))); typedef int v6i_ __attribute__((ext_vector_type(6)));
            int z_ = F.lane; asm volatile("" : "+v"(z_));
#if PROBE_MFMA == 1 || PROBE_MFMA == 5
            bf16x8 OA, OB;
#pragma unroll
            for (int q = 0; q < 8; ++q) { OA[q] = (short)(z_ + q); OB[q] = (short)(z_ + 2 * q); }
#elif PROBE_MFMA == 4
            v6i_ OA, OB;
#pragma unroll
            for (int q = 0; q < 6; ++q) { OA[q] = z_ + q; OB[q] = z_ + 2 * q; }
#else
            v8i_ OA, OB;
#pragma unroll
            for (int q = 0; q < 8; ++q) { OA[q] = z_ + q; OB[q] = z_ + 2 * q; }
#endif
#if PROBE_MFMA == 3 || PROBE_MFMA == 5
            f32x16 c0 = f32x16{}, c1 = c0, c2 = c0, c3 = c0;
#else
            f32x4 c0 = {0, 0, 0, 0}, c1 = c0, c2 = c0, c3 = c0;
#endif
#if PROBE_MFMA == 1
#define MF_ "v_mfma_f32_16x16x32_bf16"
#define MS_ ""
#elif PROBE_MFMA == 2
#define MF_ "v_mfma_f32_16x16x128_f8f6f4"
#define MS_ ""
#elif PROBE_MFMA == 3
#define MF_ "v_mfma_f32_32x32x64_f8f6f4"
#define MS_ ""
#elif PROBE_MFMA == 4
#define MF_ "v_mfma_f32_16x16x128_f8f6f4"
#define MS_ " cbsz:2 blgp:2"
#else
#define MF_ "v_mfma_f32_32x32x16_bf16"
#define MS_ ""
#endif
            asm volatile("" : "+v"(OA), "+v"(OB));
            for (int i = 0; i < 2000; ++i)
                asm volatile(MF_ " %0, %4, %5, %0" MS_ "\n\t" MF_ " %1, %4, %5, %1" MS_ "\n\t" MF_ " %2, %4, %5, %2" MS_ "\n\t" MF_ " %3, %4, %5, %3" MS_ : "+v"(c0), "+v"(c1), "+v"(c2), "+v"(c3) : "v"(OA), "v"(OB));
            asm volatile("s_nop 15\n\ts_nop 15" ::: "memory");
            if (c0[0] + c1[0] + c2[0] + c3[0] == 123.456f) ((float*)(ws + A_OH + SZ_XN + 4096))[F.tid] = 1.f;
        } break;
#endif
        default: break;
        }
#if PROBE_ABL == 9 || PROBE_ABL >= 11
        if (rerun) { E.kind = pg8::EK_NONE; if (PROBE_ABL >= 11) S.hot = true; }
#endif
        if (GEMM_EN && is_gemm) pg8::gemm_phase(F.lds, F.tid, perm, S, E);
        if (GEMM_EN && is_gemm8) pg8::gemm_phase8(F.lds, F.tid, perm, S, E);
        if ((is_gemm || is_gemm8) && !rerun) {
            int flo = 0, fhi = 0;
            if (ph == 2) { flo = wc::F1_LO; fhi = wc::F1_HI; } else if (ph == 5) { flo = wc::F1_HI; fhi = wc::F2_HI; }
            else if (ph == 9) { flo = wc::F3_LO; fhi = wc::F3_HI; } else if (ph == 10) { flo = wc::F3_HI; fhi = wc::F4_HI; } else if (ph == 12) { flo = wc::F4_HI; fhi = wc::F5_HI; }
            const int nwg = S.nM * S.nN, rounds = (nwg + F.G - 1) / F.G, nlast = nwg - (rounds - 1) * F.G, q = (int)blockIdx.x - nlast;
            if (fhi > flo) { if (nlast == F.G) weight_items(F, ap, flo, fhi, F.gw, F.NGW);
                             else if (q >= 0) weight_items(F, ap, flo, fhi, q * NWAVES + F.wave, (F.G - nlast) * NWAVES); }
        }
        if (pi + 1 < nprog) { XcdBarrier bl = bar; { GAS unsigned* bp = (GAS unsigned*)(ap->ws + WS_CTL) + CW_BAR; asm volatile("" : "+s"(bp), "+s"(bl.x)); bl.bar = (unsigned*)bp; }
            xcd_barrier(bl); }
    }
}

extern "C" void kernel_launch(void* const* d_in, const int* in_sizes, int n_in, void* d_out, int out_size, void* d_ws, size_t ws_size, hipStream_t stream) {
    static int grid = 0;
    if (grid == 0) {
        if (n_in != 32 || in_sizes[0] != NLAT * DM || out_size != NLAT * DM || ws_size < WS_END) {
            fprintf(stderr, "kernel_launch: unexpected shapes: n_in %d in0 %d out %d ws %zu (need %zu)\n", n_in, n_in > 0 ? in_sizes[0] : -1, out_size, ws_size, (size_t)WS_END); grid = -1; return; }
        int dev = 0, cus = 0, per_cu = 0;
        if (hipGetDevice(&dev) != hipSuccess || hipDeviceGetAttribute(&cus, hipDeviceAttributeMultiprocessorCount, dev) != hipSuccess) { grid = -1; return; }
        if (hipFuncSetAttribute((const void*)fwd_kernel, hipFuncAttributeMaxDynamicSharedMemorySize, LDS_BYTES) != hipSuccess) { fprintf(stderr, "kernel_launch: hipFuncSetAttribute failed\n"); grid = -1; return; }
        if (hipOccupancyMaxActiveBlocksPerMultiprocessor(&per_cu, (const void*)fwd_kernel, NTHREADS, LDS_BYTES) != hipSuccess || per_cu < 1) {
            fprintf(stderr, "kernel_launch: occupancy query reports %d blocks per CU\n", per_cu); (void)hipGetLastError(); grid = -1; return; }
        if (cus < 192 || cus % 8 != 0) { fprintf(stderr, "kernel_launch: built for >= 192 CUs in multiples of 8, got %d\n", cus); grid = -1; return; }
        grid = cus;
    }
    if (grid < 0) return;
    (void)hipMemsetAsync((char*)d_ws + WS_CTL, 0, CTL_ZERO_BYTES, stream);
    Args a{};
    for (int i = 0; i < 32; ++i) a.in[i] = (const float*)d_in[i];
    a.out = (float*)d_out; a.ws = (unsigned char*)d_ws;
#if MK_N_LAUNCHES == 1
    { int n = 0; for (int p = 0; p < N_PHASES; ++p) { if (p == 8 || p == 17) continue; a.prog[n++] = (unsigned char)p; if ((PROBE_DUP >> p) & 1u) a.prog[n++] = (unsigned char)(p | 32); }
      if (PROBE_MFMA) a.prog[n++] = 21;
      a.nprog = n; }
    hipLaunchKernelGGL(fwd_kernel, dim3(grid), dim3(NTHREADS), LDS_BYTES, stream, a);
#else
    for (int p = 0; p < N_PHASES; ++p) { a.nprog = 1; a.prog[0] = (unsigned char)p; hipLaunchKernelGGL(fwd_kernel, dim3(grid), dim3(NTHREADS), LDS_BYTES, stream, a); }
#endif
}
```

```cpp
#include <hip/hip_runtime.h>
#include <hip/hip_bf16.h>
#include <cstdio>
#include <cstdint>

#ifndef MK_N_LAUNCHES
#define MK_N_LAUNCHES 1
#endif

#ifndef PROBE_ABL
#define PROBE_ABL 0
#endif
#ifndef PROBE_MFMA
#define PROBE_MFMA 0
#endif
#ifndef PROBE_DUP
#define ATT0_STREAM 0
#define ATT1_STREAM 1
#ifndef ALG_G
#define ALG_G 4
#endif
#ifndef ALG_G8
#define ALG_G8 1
#endif
#ifndef ALG_A0
#define ALG_A0 0
#endif
#ifndef ALG_A1
#define ALG_A1 0
#endif
#define HOT_STR2(x) #x
#define HOT_STR(x) HOT_STR2(x)
#define HOT_ALIGN(n) asm volatile(".p2align 8\n\t.rept " HOT_STR(n) "\n\ts_nop 0\n\t.endr")
#define PROBE_BAR2 0
#define PROBE_DUP 0u
#endif

#define GAS __attribute__((address_space(1)))
#define LAS __attribute__((address_space(3)))
typedef unsigned short bf16_t;
typedef short bf16x8 __attribute__((ext_vector_type(8)));
typedef short s16x4 __attribute__((ext_vector_type(4)));
typedef float f32x2 __attribute__((ext_vector_type(2)));
typedef float f32x4 __attribute__((ext_vector_type(4)));
typedef float f32x16 __attribute__((ext_vector_type(16)));
typedef unsigned u32x2 __attribute__((ext_vector_type(2)));
typedef unsigned u32x4 __attribute__((ext_vector_type(4)));
typedef GAS unsigned gu32;
typedef int v8i32 __attribute__((ext_vector_type(8)));
typedef int v4i32 __attribute__((ext_vector_type(4)));

constexpr int DM = 1024, NB = 8, SEQ = 4096, CTX = 256;
constexpr int NLAT = NB * SEQ;
constexpr int NCTX = NB * CTX;
constexpr int MALL = NLAT + NCTX;
constexpr int NE = 16, FF = 1024;
constexpr int CAP_L = 512, CAP_C = 32;
constexpr int EROWS0 = NB * CAP_L + NB * CAP_C;
constexpr int EROWS1 = NB * CAP_L;
constexpr int NWIN = 3072, NQKV1 = 1536;
constexpr float NORM_EPS = 1e-6f;
constexpr float LAM_INIT = 0.2f;
constexpr int NWAVES = 8, NTHREADS = 512;

constexpr size_t KiB = 1024, MiB = 1024 * 1024;
constexpr size_t WS_CTL = 0, CTL_ZERO_BYTES = 1 * MiB;
constexpr int CW_BAR = 4096;
constexpr size_t WS_MOD = 64 * KiB;
constexpr size_t MOD_BYTES = 2 * 9 * 6144 * 4;
static_assert(WS_MOD + MOD_BYTES <= 640 * KiB, "mod");
constexpr size_t WS_ROPE = 1 * MiB;
constexpr size_t WS_PART = WS_ROPE + 16 * KiB;
constexpr size_t WS_AFF = WS_PART + (size_t)2 * 4 * 9 * 6144 * 4;
constexpr size_t WS_POS = WS_AFF + (size_t)MALL * 16 * 4;
constexpr size_t WS_IDX = WS_POS + (size_t)MALL * 16 * 4;
constexpr size_t WS_XB = (WS_IDX + (size_t)NE * EROWS0 * 4 + 4096 + 4095) / 4096 * 4096;
constexpr size_t WS_W = WS_XB + (size_t)MALL * DM * 2;
constexpr size_t W_IN = WS_W;
constexpr size_t W_OUT0 = W_IN + (size_t)NWIN * DM * 2;
constexpr size_t W_GU0 = W_OUT0 + (size_t)DM * DM * 2;
constexpr size_t W_D0 = W_GU0 + (size_t)NE * 2 * FF * DM;
constexpr size_t W_QKV = W_D0 + (size_t)NE * DM * FF;
constexpr size_t W_OUT1 = W_QKV + (size_t)NQKV1 * DM * 2;
constexpr size_t W_GU1 = W_OUT1 + (size_t)DM * DM * 2;
constexpr size_t W_D1 = W_GU1 + (size_t)NE * 2 * FF * DM;
constexpr size_t WS_ARENA = W_D1 + (size_t)NE * DM * FF;
constexpr size_t SZ_XN = (size_t)MALL * DM * 2;
constexpr size_t SZ_H5 = (size_t)MALL * 512 * 2;
constexpr size_t SZ_E = (size_t)NE * EROWS0 * DM * 2;
constexpr size_t A_XN = WS_ARENA;
constexpr size_t A_BG = A_XN + SZ_XN, A_CX = A_BG + SZ_H5, A_Q0 = A_CX + SZ_H5, A_K0 = A_Q0 + SZ_H5, A_V0 = A_K0 + SZ_H5;
constexpr size_t A_OH = A_V0 + SZ_H5;
constexpr size_t A_HS = A_XN + SZ_XN;
constexpr size_t A_ACT = A_HS + SZ_E;
constexpr size_t A_Q1 = A_XN + SZ_XN;
constexpr size_t A_K1 = A_Q1 + SZ_XN;
constexpr size_t A_V1 = A_K1 + (size_t)MALL * 256 * 2;
constexpr size_t WS_END = A_OH + SZ_XN + 1 * MiB;
static_assert(A_ACT + SZ_E / 2 <= WS_END && A_V1 + (size_t)MALL * 256 * 2 <= WS_END, "arena");
static_assert(WS_END <= 600000000ull, "workspace budget");

constexpr int RING_BYTES = 131072;
constexpr int MISC_OFF = RING_BYTES + 320;
constexpr int GT_OFF = RING_BYTES + 1024;
constexpr int LDS_BYTES = 147456;

#define RLX_AGENT __ATOMIC_RELAXED, __HIP_MEMORY_SCOPE_AGENT
#define LDS_WAIT() asm volatile("s_waitcnt lgkmcnt(0)" ::: "memory")
#define VM_WAIT() asm volatile("s_waitcnt vmcnt(0)" ::: "memory")

__device__ __forceinline__ unsigned f2bf(float f) { unsigned u = __builtin_bit_cast(unsigned, f); return (u + 0x7fffu + ((u >> 16) & 1u)) >> 16; }
__device__ __forceinline__ unsigned pk2(float lo, float hi) { return f2bf(lo) | (f2bf(hi) << 16); }
__device__ __forceinline__ unsigned cvt_pk_bf16(float lo, float hi) { unsigned r; asm volatile("v_cvt_pk_bf16_f32 %0, %1, %2" : "=v"(r) : "v"(lo), "v"(hi)); return r; }
__device__ __forceinline__ unsigned pk4_fp8(float a, float b, float c, float d) {
    a = fminf(fmaxf(a, -448.f), 448.f); b = fminf(fmaxf(b, -448.f), 448.f); c = fminf(fmaxf(c, -448.f), 448.f); d = fminf(fmaxf(d, -448.f), 448.f);
    int w = 0; w = __builtin_amdgcn_cvt_pk_fp8_f32(a, b, w, false); w = __builtin_amdgcn_cvt_pk_fp8_f32(c, d, w, true); return (unsigned)w;
}
__device__ __forceinline__ float bf_lo(unsigned w) { return __builtin_bit_cast(float, w << 16); }
__device__ __forceinline__ float bf_hi(unsigned w) { return __builtin_bit_cast(float, w & 0xffff0000u); }
template <int CTRL> __device__ __forceinline__ float dpp_f(float x) { return __builtin_bit_cast(float, __builtin_amdgcn_mov_dpp(__builtin_bit_cast(int, x), CTRL, 0xf, 0xf, true)); }
__device__ __forceinline__ float row16_sum(float v) { v += dpp_f<0xB1>(v); v += dpp_f<0x4E>(v); v += dpp_f<0x141>(v); v += dpp_f<0x128>(v); return v; }
__device__ __forceinline__ float xsum16(float v) { auto rr = __builtin_amdgcn_permlane16_swap(__float_as_uint(v), __float_as_uint(v), false, false); return __uint_as_float(rr[0]) + __uint_as_float(rr[1]); }
__device__ __forceinline__ float xsum32(float v) { auto rr = __builtin_amdgcn_permlane32_swap(__float_as_uint(v), __float_as_uint(v), false, false); return __uint_as_float(rr[0]) + __uint_as_float(rr[1]); }
__device__ __forceinline__ float xmax16(float v) { auto rr = __builtin_amdgcn_permlane16_swap(__float_as_uint(v), __float_as_uint(v), false, false); return fmaxf(__uint_as_float(rr[0]), __uint_as_float(rr[1])); }
__device__ __forceinline__ float xmax32(float v) { auto rr = __builtin_amdgcn_permlane32_swap(__float_as_uint(v), __float_as_uint(v), false, false); return fmaxf(__uint_as_float(rr[0]), __uint_as_float(rr[1])); }
__device__ __forceinline__ float wave_sum(float v) { v = row16_sum(v); v = xsum16(v); v = xsum32(v); return v; }

#define XB_TMO      128
#define XB_XCNT(j)  (256  + 64 * (j))
#define XB_XSUB(j)  (1280 + 64 * (j))
#define XB_XGEN(j)  (2304 + 64 * (j))
#define XB_TOP      3328
#define XB_TOPGEN   3392
#define XCD_BAR_WORDS 3456
#define XB_SPIN_CAP (1u << 20)
__device__ __forceinline__ unsigned xb_ld(unsigned* p)              { return __hip_atomic_load(p, __ATOMIC_RELAXED, __HIP_MEMORY_SCOPE_AGENT); }
__device__ __forceinline__ unsigned xb_add(unsigned* p, unsigned v) { return __hip_atomic_fetch_add(p, v, __ATOMIC_RELAXED, __HIP_MEMORY_SCOPE_AGENT); }
__device__ __forceinline__ unsigned xb_xcc_id() { return (unsigned)__builtin_amdgcn_s_getreg((3 << 11) | 20) & 0xFu; }
#define XB_SPIN(cond, bar) do { unsigned _sp = 0; while (cond) { __builtin_amdgcn_s_sleep(1); \
    if ((++_sp & 255u) == 0u) { if (xb_ld(&(bar)[XB_TMO])) break; if (_sp > XB_SPIN_CAP) { atomicAdd(&(bar)[XB_TMO], 1u); break; } } } } while (0)
struct XcdBarrier { unsigned* bar; unsigned x; volatile LAS unsigned* st; };
__device__ __forceinline__ XcdBarrier xcd_barrier_post(unsigned* bar, volatile LAS unsigned* st) {
    XcdBarrier b; b.bar = bar; b.x = xb_xcc_id(); b.st = st;
    if (threadIdx.x == 0) (void)xb_add(&bar[XB_XCNT(b.x)], 1u);
    return b;
}
__device__ __forceinline__ void xcd_barrier_complete(unsigned* bar, unsigned x, unsigned& nloc, unsigned& nx) {
    const unsigned G = gridDim.x * gridDim.y * gridDim.z;
    unsigned sum, cnt, mine, sp = 0u;
    for (;;) {
        sum = 0u; cnt = 0u; mine = 0u;
#pragma unroll
        for (unsigned j = 0; j < 16; ++j) { const unsigned c = xb_ld(&bar[XB_XCNT(j)]); sum += c; cnt += (c > 0u) ? 1u : 0u; mine = (j == x) ? c : mine; }
        if (sum == G) break;
        __builtin_amdgcn_s_sleep(1);
        if ((++sp & 255u) == 0u) { if (xb_ld(&bar[XB_TMO])) break; if (sp > XB_SPIN_CAP) { atomicAdd(&bar[XB_TMO], 1u); break; } }
    }
    nloc = mine > 0u ? mine : 1u; nx = cnt > 0u ? cnt : 1u;
}
__device__ __forceinline__ void xcd_barrier(const XcdBarrier& b) {
    asm volatile("s_waitcnt vmcnt(0)" ::: "memory");
    __syncthreads();
    if (threadIdx.x == 0) {
        unsigned* bar = b.bar;
        __builtin_amdgcn_s_waitcnt(0);
        unsigned nloc = b.st[0], nx = b.st[1];
        if (nloc == 0u) { xcd_barrier_complete(bar, b.x, nloc, nx); b.st[0] = nloc; b.st[1] = nx; }
        const unsigned old = xb_add(&bar[XB_XSUB(b.x)], 1u);
        const unsigned gen = old / nloc;
        if (old + 1u == (gen + 1u) * nloc) {
            __builtin_amdgcn_fence(__ATOMIC_RELEASE, "agent");
            asm volatile("s_waitcnt vmcnt(0)" ::: "memory");
            const unsigned og = xb_add(&bar[XB_TOP], 1u);
            const unsigned target = (og / nx + 1u) * nx;
            if (og + 1u != target) XB_SPIN((int)(xb_ld(&bar[XB_TOP]) - target) < 0, bar);
            (void)xb_add(&bar[XB_XGEN(b.x)], 1u);
            __builtin_amdgcn_fence(__ATOMIC_ACQUIRE, "agent");
            asm volatile("s_waitcnt vmcnt(0)" ::: "memory");
        } else {
            XB_SPIN(xb_ld(&bar[XB_XGEN(b.x)]) == gen, bar);
            __builtin_amdgcn_fence(__ATOMIC_ACQUIRE, "agent");
            asm volatile("s_waitcnt vmcnt(0)" ::: "memory");
        }
    }
    __syncthreads();
}

__device__ __forceinline__ int fresh_lane() { unsigned ones = ~0u; asm volatile("" : "+s"(ones)); return (int)__builtin_amdgcn_mbcnt_hi(ones, __builtin_amdgcn_mbcnt_lo(ones, 0u)); }
namespace pg8 {
constexpr int BM = 256, BK = 64, HALF = 128, HTB = HALF * BK * 2, NXCD = 8, WGM = 8;
__device__ __forceinline__ int lds_byte(int r, int c) { const int st = (r >> 4) * 2 + (c >> 5), rr = r & 15, cc = c & 31, ob = rr * 64 + cc * 2; return st * 1024 + (ob ^ (((ob >> 9) & 1) << 5)); }
__device__ __forceinline__ void stage_rc(int b, int& R, int& C) { const int st = b / 1024, sb = b % 1024, swz = sb ^ (((sb >> 9) & 1) << 5); R = (st >> 1) * 16 + swz / 64; C = (st & 1) * 32 + (swz % 64) / 2; }
__device__ __forceinline__ int perm32(int rho) { const int n = rho >> 4, i = rho & 15; return 8 * (i >> 2) + 4 * n + (i & 3); }

struct Unit { int pm, pn; const char* a; const char* b; };
struct Sched {
    const char* A; const char* B; int nM, nN, tpe, G, c, pitch, wgm; bool hot; const int* gidx;
    __device__ __forceinline__ bool next(int i, Unit& u) const {
        const int nwg = nM * nN; const long L = (long)i * G + c; if (L >= nwg) return false;
        int wgid = (int)L; { const int q = nwg / NXCD, r = nwg % NXCD, xcd = wgid % NXCD, off = wgid / NXCD; wgid = (xcd < r ? xcd * (q + 1) : r * (q + 1) + (xcd - r) * q) + off; }
        const int nig = wgm * nN, gid = wgid / nig, fm = gid * wgm, gsz = (nM - fm) < wgm ? (nM - fm) : wgm;
        u.pm = fm + ((wgid % nig) % gsz); u.pn = (wgid % nig) / gsz;
        const size_t tstep = (size_t)BM * pitch;
        u.a = gidx ? A : A + (size_t)u.pm * tstep; u.b = B + (size_t)((u.pm / tpe) * nN + u.pn) * tstep;
        if (hot) {
            if (PROBE_ABL != 13) u.a = A + (size_t)(c & 7) * tstep; if (PROBE_ABL != 12) u.b = B + (size_t)(c & 3) * tstep; }
        return true;
    }
};

enum EpiKind { EK_IN0 = 0, EK_OUT = 1, EK_GU = 2, EK_DOWN = 3, EK_QKV1 = 4, EK_NONE = 5 };
struct Epi {
    int kind, layer; bool f8out; float wsc; unsigned char* ws; const float* xin_lat; const float* xin_ctx;
    __device__ __forceinline__ int nstores(const Unit& u) const { return (kind == EK_GU || (kind == EK_IN0 && u.pn >= 2 && u.pn < 6)) ? 8 : 16; }
    __device__ __forceinline__ void store8(bf16_t* p, const f32x4 a, const f32x4 b) const {
        u32x4 w; w.x = cvt_pk_bf16(a[0], a[1]); w.y = cvt_pk_bf16(a[2], a[3]); w.z = cvt_pk_bf16(b[0], b[1]); w.w = cvt_pk_bf16(b[2], b[3]);
        *(u32x4*)p = w;
    }
    __device__ __forceinline__ void operator()(const f32x4 (&acc)[2][2][4][2], const Unit& u, int wr, int wc, int fr, int fq) const {
        if (kind == EK_NONE) {
#pragma unroll
            for (int ai = 0; ai < 2; ++ai)
#pragma unroll
                for (int bj = 0; bj < 2; ++bj)
#pragma unroll
                    for (int m = 0; m < 4; ++m) asm volatile("" :: "v"(acc[ai][bj][m][0]), "v"(acc[ai][bj][m][1]));
            return;
        }
        const int row0 = u.pm * BM + wr * 64 + fr;
        const int cw = wc * 32 + 8 * fq;
        if (kind == EK_OUT) {
            const bool lat = row0 < NLAT;
            const int col0 = u.pn * BM + cw;
            f32x4 gv[2][2];
            const int gb = lat ? (row0 >> 12) : 8;
#pragma unroll
            for (int bj = 0; bj < 2; ++bj)
#pragma unroll
                for (int n = 0; n < 2; ++n) gv[bj][n] = *(const f32x4*)((const float*)(ws + WS_MOD) + (size_t)(layer * 9 + gb) * 6144 + 2 * 1024 + col0 + bj * HALF + 4 * n);
            bf16_t* XB = (bf16_t*)(ws + WS_XB);
            const float* xi = lat ? xin_lat : xin_ctx - (size_t)NLAT * DM;
#pragma unroll
            for (int am = 0; am < 4; ++am) { const int ai = am >> 1, m0 = (am & 1) * 2;
                f32x4 r0[2][2], r1[2][2]; u32x4 rw[2][2];
#pragma unroll
                for (int mm = 0; mm < 2; ++mm) { const size_t off = (size_t)(row0 + ai * HALF + (m0 + mm) * 16) * DM + col0;
#pragma unroll
                    for (int bj = 0; bj < 2; ++bj) {
                        if (layer == 0) { r0[mm][bj] = *(const f32x4*)(xi + off + bj * HALF); r1[mm][bj] = *(const f32x4*)(xi + off + bj * HALF + 4); }
                        else rw[mm][bj] = *(const u32x4*)(XB + off + bj * HALF); } }
#pragma unroll
                for (int mm = 0; mm < 2; ++mm) { const int m = m0 + mm; const size_t off = (size_t)(row0 + ai * HALF + m * 16) * DM + col0;
#pragma unroll
                    for (int bj = 0; bj < 2; ++bj) { f32x4 b0, b1;
                        if (layer == 0) { b0 = r0[mm][bj]; b1 = r1[mm][bj]; }
                        else { const u32x4 w = rw[mm][bj]; b0 = (f32x4){bf_lo(w.x), bf_hi(w.x), bf_lo(w.y), bf_hi(w.y)}; b1 = (f32x4){bf_lo(w.z), bf_hi(w.z), bf_lo(w.w), bf_hi(w.w)}; }
                        store8(XB + off + bj * HALF, b0 + gv[bj][0] * acc[ai][bj][m][0], b1 + gv[bj][1] * acc[ai][bj][m][1]); } }
                asm volatile("" ::: "memory"); }
            return;
        }
        if (kind == EK_GU) {
#pragma unroll
            for (int ai = 0; ai < 2; ++ai)
#pragma unroll
                for (int m = 0; m < 4; ++m) { f32x4 v[2];
#pragma unroll
                    for (int n = 0; n < 2; ++n) { const f32x4 g = acc[ai][0][m][n] * wsc, up = acc[ai][1][m][n] * wsc;
#pragma unroll
                        for (int j = 0; j < 4; ++j) v[n][j] = g[j] * __builtin_amdgcn_rcpf(1.f + __expf(-g[j])) * up[j]; }
                    if (f8out) { u32x2 w; w.x = pk4_fp8(v[0][0], v[0][1], v[0][2], v[0][3]); w.y = pk4_fp8(v[1][0], v[1][1], v[1][2], v[1][3]);
                        *(u32x2*)((unsigned char*)(ws + A_ACT) + (size_t)(row0 + ai * HALF + m * 16) * FF + u.pn * HALF + cw) = w; }
                    else store8((bf16_t*)(ws + A_ACT) + (size_t)(row0 + ai * HALF + m * 16) * FF + u.pn * HALF + cw, v[0], v[1]); }
            return;
        }
        if (kind == EK_DOWN) {
#pragma unroll
            for (int ai = 0; ai < 2; ++ai)
#pragma unroll
                for (int m = 0; m < 4; ++m)
#pragma unroll
                    for (int bj = 0; bj < 2; ++bj)
                    { const f32x4 y0 = acc[ai][bj][m][0] * (wsc * 16.f), y1 = acc[ai][bj][m][1] * (wsc * 16.f);
                        u32x2 w; w.x = pk4_fp8(y0[0], y0[1], y0[2], y0[3]); w.y = pk4_fp8(y1[0], y1[1], y1[2], y1[3]);
                        *(u32x2*)((unsigned char*)(ws + A_HS) + (size_t)(row0 + ai * HALF + m * 16) * DM + u.pn * BM + bj * HALF + cw) = w; }
            return;
        }
        int mode; size_t doff; int ld, cb;
        if (kind == EK_IN0) {
            if (u.pn < 2)       { mode = 0; doff = A_BG; ld = 512; cb = u.pn * 256; }
            else if (u.pn < 6)  { mode = 1; doff = A_CX; ld = 512; cb = (u.pn - 2) * 128; }
            else if (u.pn < 8)  { mode = 2; doff = A_Q0; ld = 512; cb = (u.pn - 6) * 256; }
            else if (u.pn < 10) { mode = 2; doff = A_K0; ld = 512; cb = (u.pn - 8) * 256; }
            else                { mode = 0; doff = A_V0; ld = 512; cb = (u.pn - 10) * 256; }
        } else {
            if (u.pn < 4)       { mode = 2; doff = A_Q1; ld = 1024; cb = u.pn * 256; }
            else if (u.pn == 4) { mode = 2; doff = A_K1; ld = 256; cb = 0; }
            else                { mode = 0; doff = A_V1; ld = 256; cb = 0; }
        }
        bf16_t* dst = (bf16_t*)(ws + doff); const float* rope = (const float*)(ws + WS_ROPE);
        const float qs = ((kind == EK_IN0 && (u.pn == 6 || u.pn == 7)) || (kind == EK_QKV1 && u.pn < 4)) ? 0.125f * 1.4426950408889634f : 1.0f;
        if (mode == 2 && row0 >= NLAT) mode = 0;
        if (mode == 1) {
#pragma unroll
            for (int ai = 0; ai < 2; ++ai)
#pragma unroll
                for (int m = 0; m < 4; ++m)
                    store8(dst + (size_t)(row0 + ai * HALF + m * 16) * ld + cb + cw, acc[ai][0][m][0] * acc[ai][1][m][0], acc[ai][0][m][1] * acc[ai][1][m][1]);
        } else if (mode == 0) {
#pragma unroll
            for (int ai = 0; ai < 2; ++ai)
#pragma unroll
                for (int m = 0; m < 4; ++m)
#pragma unroll
                    for (int bj = 0; bj < 2; ++bj)
                        store8(dst + (size_t)(row0 + ai * HALF + m * 16) * ld + cb + bj * HALF + cw, acc[ai][bj][m][0] * qs, acc[ai][bj][m][1] * qs);
        } else {
            f32x4 csv[4], snv[4];
            const int t0 = row0 & (SEQ - 1);
            if (wc & 1) {
#pragma unroll
                for (int m = 0; m < 4; ++m) { const int pos = (t0 + m * 16) & 63; csv[m] = *(const f32x4*)(rope + pos * 16 + 4 * fq); snv[m] = *(const f32x4*)(rope + 1024 + pos * 16 + 4 * fq); }
            } else {
#pragma unroll
                for (int ai = 0; ai < 2; ++ai) { const int pos = ((t0 + ai * HALF) >> 6) & 63; csv[ai] = *(const f32x4*)(rope + pos * 16 + 4 * fq); snv[ai] = *(const f32x4*)(rope + 1024 + pos * 16 + 4 * fq); }
                csv[2] = csv[0]; snv[2] = snv[0]; csv[3] = csv[1]; snv[3] = snv[1];
            }
#pragma unroll
            for (int ai = 0; ai < 2; ++ai)
#pragma unroll
                for (int m = 0; m < 4; ++m) { const int row = row0 + ai * HALF + m * 16;
                    const f32x4 cs = ((wc & 1) ? csv[m] : csv[ai]) * qs, sn = ((wc & 1) ? snv[m] : snv[ai]) * qs;
#pragma unroll
                    for (int bj = 0; bj < 2; ++bj) { const f32x4 x1 = acc[ai][bj][m][0], x2 = acc[ai][bj][m][1];
                        store8(dst + (size_t)row * ld + cb + bj * HALF + cw, x1 * cs - x2 * sn, x2 * cs + x1 * sn); } }
        }
    }
};

__device__ __forceinline__ void gemm_phase(LAS unsigned char* lds, const int tid, const bool perm, const Sched& S, const Epi& E) {
    const int wid = __builtin_amdgcn_readfirstlane(tid >> 6), lane = tid & 63, wr = wid >> 2, wc = wid & 3, fr = lane & 15, fq = lane >> 4;
    constexpr int K = DM, nt = K / BK;
    unsigned voffB[2]; int sR[2], sC[2];
#pragma unroll
    for (int i = 0; i < 2; ++i) { int R, C; stage_rc(tid * 16 + i * 8192, R, C); const int Rb = perm ? ((R & ~31) + perm32(R & 31)) : R;
        sR[i] = R; sC[i] = C; voffB[i] = (unsigned)(Rb * K + C) * 2u; }
    const bool gather = S.gidx != nullptr;
    LAS unsigned* gtab = (LAS unsigned*)(lds + GT_OFF);
    if (gather) {
        Unit tu;
        for (int i = 0; S.next(i, tu); ++i) if (tid < 256) gtab[i * 256 + tid] = (unsigned)S.gidx[(tu.pm / S.tpe) * EROWS0 + (tu.pm % S.tpe) * 256 + tid] * (unsigned)(K * 2);
        __syncthreads();
    }
    unsigned gc[2][2], gn[2][2];
#define PG8_GOFF(dst, ord) do { const int t_ = wid * 64 + fresh_lane(); _Pragma("unroll") for (int i_ = 0; i_ < 2; ++i_) { int R_, C_; stage_rc(t_ * 16 + i_ * 8192, R_, C_); \
        _Pragma("unroll") for (int h_ = 0; h_ < 2; ++h_) dst[h_][i_] = gather ? gtab[(ord) * 256 + h_ * HALF + R_] + (unsigned)C_ * 2u : (unsigned)((h_ * HALF + R_) * K + C_) * 2u; } } while (0)
    constexpr size_t kstep = (size_t)(BK * 2);
    constexpr size_t hstep = (size_t)HALF * K * 2;
    const unsigned ldsw = (unsigned)wid * 1024u;
    const int aoff = lds_byte(wr * 64 + fr, fq * 8), boff = lds_byte(wc * 32 + fr, fq * 8);
#define PG8_SA(b, h) (((b) * 2 + (h)) * HTB)
#define PG8_SB(b, h) ((4 + (b) * 2 + (h)) * HTB)
#define PG8_STAGE(bufoff, gbase, voff) do { _Pragma("unroll") for (int _i = 0; _i < 2; ++_i) \
        __builtin_amdgcn_global_load_lds((const unsigned*)((const char*)(gbase) + (voff)[_i]), (LAS unsigned*)(lds + (bufoff) + ldsw + _i * 8192), 16, 0, 0); } while (0)
#define PG8_LDA(dst, b, h) do { _Pragma("unroll") for (int m = 0; m < 4; ++m) _Pragma("unroll") for (int k = 0; k < 2; ++k) dst[m][k] = *(const LAS bf16x8*)(lds + PG8_SA(b, h) + aoff + m * 2048 + k * 1024); } while (0)
#define PG8_LDB(dst, b, h) do { _Pragma("unroll") for (int n = 0; n < 2; ++n) _Pragma("unroll") for (int k = 0; k < 2; ++k) dst[n][k] = *(const LAS bf16x8*)(lds + PG8_SB(b, h) + boff + n * 2048 + k * 1024); } while (0)
#define PG8_MMA(ai, bj, At, Bt) do { __builtin_amdgcn_s_setprio(1); _Pragma("unroll") for (int m = 0; m < 4; ++m) _Pragma("unroll") for (int n = 0; n < 2; ++n) _Pragma("unroll") for (int k = 0; k < 2; ++k) \
        acc[ai][bj][m][n] = __builtin_amdgcn_mfma_f32_16x16x32_bf16(Bt[n][k], At[m][k], acc[ai][bj][m][n], 0, 0, 0); __builtin_amdgcn_s_setprio(0); } while (0)
#define PG8_WAIT_V(n) asm volatile("s_waitcnt vmcnt(" #n ")" ::: "memory")
#define PG8_WAIT_VE(n16, n8) do { if (fe) { if (ns == 16) asm volatile("s_waitcnt vmcnt(" #n16 ")" ::: "memory"); else asm volatile("s_waitcnt vmcnt(" #n8 ")" ::: "memory"); } else asm volatile("s_waitcnt vmcnt(8)" ::: "memory"); } while (0)
#define PG8_WAIT_L(n) asm volatile("s_waitcnt lgkmcnt(" #n ")" ::: "memory")
#define PG8_BAR __builtin_amdgcn_s_barrier()
#define PG8_SCHED __builtin_amdgcn_sched_barrier(0)
    Unit cur, nxt; int ui = 0; int ns = 16;
    if (!S.next(0, cur)) return;
    f32x4 acc[2][2][4][2];
#pragma unroll
    for (int a = 0; a < 2; ++a)
#pragma unroll
        for (int b = 0; b < 2; ++b)
#pragma unroll
            for (int m = 0; m < 4; ++m)
#pragma unroll
                for (int n = 0; n < 2; ++n) acc[a][b][m][n] = (f32x4){0.f, 0.f, 0.f, 0.f};
    bf16x8 At[4][2], B0[2][2], B1[2][2];
    const char* cA = cur.a; const char* cB = cur.b;
    PG8_GOFF(gc, 0);
    PG8_STAGE(PG8_SB(0, 0), cB, voffB); PG8_STAGE(PG8_SB(0, 1), cB + hstep, voffB); PG8_STAGE(PG8_SA(0, 0), cA, gc[0]); PG8_STAGE(PG8_SA(0, 1), cA, gc[1]);
    if (wr == 1) PG8_BAR;
    PG8_WAIT_V(2); PG8_BAR;
    PG8_STAGE(PG8_SB(1, 0), cB + kstep, voffB); PG8_STAGE(PG8_SA(1, 0), cA + kstep, gc[0]); PG8_STAGE(PG8_SB(1, 1), cB + hstep + kstep, voffB);
    PG8_WAIT_V(6); PG8_BAR;
    for (;;) {
        const bool has_next = S.next(ui + 1, nxt);
        const char* nA = has_next ? nxt.a : cA; const char* nB = has_next ? nxt.b : cB;
        if (has_next) PG8_GOFF(gn, ui + 1);
        else {
#pragma unroll
            for (int h_ = 0; h_ < 2; ++h_)
#pragma unroll
                for (int i_ = 0; i_ < 2; ++i_) gn[h_][i_] = gc[h_][i_]; }
        HOT_ALIGN(ALG_G);
        for (int t = 0; t < nt; t += 2) {
            const bool last = (t == nt - 2); const bool fe = (t == 0) && (ui > 0);
            const char* a1 = cA + (size_t)(t + 1) * kstep;
            const char* a2 = last ? nA : cA + (size_t)(t + 2) * kstep; const char* b2 = last ? nB : cB + (size_t)(t + 2) * kstep;
            const char* a3 = a2 + kstep; const char* b3 = b2 + kstep;
            unsigned g2[2][2];
#pragma unroll
            for (int h_ = 0; h_ < 2; ++h_)
#pragma unroll
                for (int i_ = 0; i_ < 2; ++i_) g2[h_][i_] = last ? gn[h_][i_] : gc[h_][i_];
            PG8_LDB(B0, 0, 0); PG8_LDB(B1, 0, 1); PG8_SCHED; PG8_LDA(At, 0, 0); PG8_STAGE(PG8_SA(1, 1), a1, gc[1]);
            PG8_WAIT_VE(18, 10); PG8_WAIT_L(0); PG8_BAR; PG8_MMA(0, 0, At, B0); PG8_MMA(0, 1, At, B1); PG8_BAR; PG8_SCHED;
            PG8_LDA(At, 0, 1); PG8_STAGE(PG8_SB(0, 0), b2, voffB); PG8_STAGE(PG8_SB(0, 1), b2 + hstep, voffB); PG8_STAGE(PG8_SA(0, 0), a2, g2[0]);
            PG8_WAIT_VE(24, 16); PG8_WAIT_L(0); PG8_BAR; PG8_MMA(1, 0, At, B0); PG8_MMA(1, 1, At, B1); PG8_BAR; PG8_SCHED;
            PG8_LDB(B0, 1, 0); PG8_LDB(B1, 1, 1); PG8_SCHED; PG8_LDA(At, 1, 0); PG8_STAGE(PG8_SA(0, 1), a2, g2[1]);
            PG8_WAIT_V(8); PG8_WAIT_L(0); PG8_BAR; PG8_MMA(0, 0, At, B0); PG8_MMA(0, 1, At, B1); PG8_BAR; PG8_SCHED;
            PG8_LDA(At, 1, 1); PG8_STAGE(PG8_SB(1, 0), b3, voffB); PG8_STAGE(PG8_SB(1, 1), b3 + hstep, voffB); PG8_STAGE(PG8_SA(1, 0), a3, g2[0]);
            PG8_WAIT_V(8); PG8_WAIT_L(0); PG8_BAR; PG8_MMA(1, 0, At, B0); PG8_MMA(1, 1, At, B1); PG8_BAR; PG8_SCHED;
        }
        if (wr == 0) PG8_BAR;
        PG8_WAIT_V(0);
        { int fr_ = fr, fq_ = fq; asm volatile("" : "+v"(fr_), "+v"(fq_));
          E(acc, cur, wr, wc, fr_, fq_); } ns = E.nstores(cur);
        if (!has_next) break;
#pragma unroll
        for (int a = 0; a < 2; ++a)
#pragma unroll
            for (int b = 0; b < 2; ++b)
#pragma unroll
                for (int m = 0; m < 4; ++m)
#pragma unroll
                    for (int n = 0; n < 2; ++n) acc[a][b][m][n] = (f32x4){0.f, 0.f, 0.f, 0.f};
        cur = nxt; cA = nA; cB = nB; ++ui;
#pragma unroll
        for (int h_ = 0; h_ < 2; ++h_)
#pragma unroll
            for (int i_ = 0; i_ < 2; ++i_) gc[h_][i_] = gn[h_][i_];
        if (wr == 1) PG8_BAR;
    }
    PG8_WAIT_V(0);
    PG8_BAR;
#undef PG8_GOFF
#undef PG8_SA
#undef PG8_SB
#undef PG8_STAGE
#undef PG8_LDA
#undef PG8_LDB
#undef PG8_MMA
#undef PG8_WAIT_V
#undef PG8_WAIT_VE
#undef PG8_WAIT_L
#undef PG8_BAR
#undef PG8_SCHED
}
__device__ __forceinline__ void gemm_phase8(LAS unsigned char* lds, const int tid, const bool perm, const Sched& S, const Epi& E) {
    const int wid = __builtin_amdgcn_readfirstlane(tid >> 6), lane = tid & 63, wr = wid >> 2, wc = wid & 3, fr = lane & 15, fq = lane >> 4;
    constexpr int K = DM, nt = K / 128, PITCH = K;
    unsigned voffB[2]; int sR[2], sC[2];
#pragma unroll
    for (int i = 0; i < 2; ++i) { const int X = tid * 16 + i * 8192, p = X >> 10, l = (X >> 4) & 63, fr_ = l >> 2, g_ = fr_ >> 2, cp = (l & 3) ^ (g_ ^ (g_ >> 1));
        const int R = (p >> 1) * 16 + fr_, C = ((p & 1) * 4 + cp) * 16; const int Rb = perm ? ((R & ~31) + perm32(R & 31)) : R;
        sR[i] = R; sC[i] = C; voffB[i] = (unsigned)(Rb * PITCH + C); }
    const bool gather = S.gidx != nullptr;
    LAS unsigned* gtab = (LAS unsigned*)(lds + GT_OFF);
    if (gather) {
        Unit tu;
        for (int i = 0; S.next(i, tu); ++i) if (tid < 256) gtab[i * 256 + tid] = (unsigned)S.gidx[(tu.pm / S.tpe) * EROWS0 + (tu.pm % S.tpe) * 256 + tid] * (unsigned)PITCH;
        __syncthreads();
    }
    unsigned gc[2][2], gn[2][2];
#define PG8_GOFF(dst, ord) do { const int t_ = wid * 64 + fresh_lane(); _Pragma("unroll") for (int i_ = 0; i_ < 2; ++i_) { const int X_ = t_ * 16 + i_ * 8192, p_ = X_ >> 10, l_ = (X_ >> 4) & 63, f_ = l_ >> 2, g_ = f_ >> 2; \
        const int R_ = (p_ >> 1) * 16 + f_, C_ = ((p_ & 1) * 4 + ((l_ & 3) ^ (g_ ^ (g_ >> 1)))) * 16; \
        _Pragma("unroll") for (int h_ = 0; h_ < 2; ++h_) dst[h_][i_] = gather ? gtab[(ord) * 256 + h_ * HALF + R_] + (unsigned)C_ : (unsigned)((h_ * HALF + R_) * PITCH + C_); } } while (0)
    constexpr size_t kstep = (size_t)(BK * 2);
    constexpr size_t hstep = (size_t)HALF * PITCH;
    const unsigned ldsw = (unsigned)wid * 1024u;
    int aoff[2], boff[2];
#pragma unroll
    for (int hh = 0; hh < 2; ++hh) { const int g_ = fr >> 2, ch = (((fq & 1) * 2 + hh) ^ (g_ ^ (g_ >> 1))); const int o_ = (fq >> 1) * 1024 + (4 * fr + ch) * 16;
        aoff[hh] = wr * 8192 + o_; boff[hh] = wc * 4096 + o_; }
#define PG8_SA(b, h) (((b) * 2 + (h)) * HTB)
#define PG8_SB(b, h) ((4 + (b) * 2 + (h)) * HTB)
#define PG8_STAGE(bufoff, gbase, voff) do { _Pragma("unroll") for (int _i = 0; _i < 2; ++_i) \
        __builtin_amdgcn_global_load_lds((const unsigned*)((const char*)(gbase) + (voff)[_i]), (LAS unsigned*)(lds + (bufoff) + ldsw + _i * 8192), 16, 0, 0); } while (0)
#define PG8_LDA(dst, b, h) do { _Pragma("unroll") for (int m = 0; m < 4; ++m) dst[m] = __builtin_shufflevector(*(const LAS v4i32*)(lds + PG8_SA(b, h) + aoff[0] + m * 2048), *(const LAS v4i32*)(lds + PG8_SA(b, h) + aoff[1] + m * 2048), 0, 1, 2, 3, 4, 5, 6, 7); } while (0)
#define PG8_LDB(dst, b, h) do { _Pragma("unroll") for (int n = 0; n < 2; ++n) dst[n] = __builtin_shufflevector(*(const LAS v4i32*)(lds + PG8_SB(b, h) + boff[0] + n * 2048), *(const LAS v4i32*)(lds + PG8_SB(b, h) + boff[1] + n * 2048), 0, 1, 2, 3, 4, 5, 6, 7); } while (0)
#define PG8_V8(x) (x)
#define PG8_MMA(ai, bj, At, Bt) do { __builtin_amdgcn_s_setprio(1); _Pragma("unroll") for (int m = 0; m < 4; ++m) _Pragma("unroll") for (int n = 0; n < 2; ++n) \
        asm volatile("v_mfma_f32_16x16x128_f8f6f4 %0, %1, %2, %0" : "+v"(acc[ai][bj][m][n]) : "v"(Bt[n]), "v"(At[m])); __builtin_amdgcn_s_setprio(0); } while (0)
#define PG8_WAIT_V(n) asm volatile("s_waitcnt vmcnt(" #n ")" ::: "memory")
#define PG8_WAIT_VE(n16, n8) do { if (fe) { if (ns == 16) asm volatile("s_waitcnt vmcnt(" #n16 ")" ::: "memory"); else asm volatile("s_waitcnt vmcnt(" #n8 ")" ::: "memory"); } else asm volatile("s_waitcnt vmcnt(8)" ::: "memory"); } while (0)
#define PG8_WAIT_L(n) asm volatile("s_waitcnt lgkmcnt(" #n ")" ::: "memory")
#define PG8_BAR __builtin_amdgcn_s_barrier()
#define PG8_SCHED __builtin_amdgcn_sched_barrier(0)
    Unit cur, nxt; int ui = 0; int ns = 16;
    if (!S.next(0, cur)) return;
    f32x4 acc[2][2][4][2];
#pragma unroll
    for (int a = 0; a < 2; ++a)
#pragma unroll
        for (int b = 0; b < 2; ++b)
#pragma unroll
            for (int m = 0; m < 4; ++m)
#pragma unroll
                for (int n = 0; n < 2; ++n) acc[a][b][m][n] = (f32x4){0.f, 0.f, 0.f, 0.f};
    v8i32 At[4], B0[2], B1[2];
    const char* cA = cur.a; const char* cB = cur.b;
    PG8_GOFF(gc, 0);
    PG8_STAGE(PG8_SB(0, 0), cB, voffB); PG8_STAGE(PG8_SB(0, 1), cB + hstep, voffB); PG8_STAGE(PG8_SA(0, 0), cA, gc[0]); PG8_STAGE(PG8_SA(0, 1), cA, gc[1]);
    if (wr == 1) PG8_BAR;
    PG8_WAIT_V(2); PG8_BAR;
    PG8_STAGE(PG8_SB(1, 0), cB + kstep, voffB); PG8_STAGE(PG8_SA(1, 0), cA + kstep, gc[0]); PG8_STAGE(PG8_SB(1, 1), cB + hstep + kstep, voffB);
    PG8_WAIT_V(6); PG8_BAR;
    for (;;) {
        const bool has_next = S.next(ui + 1, nxt);
        const char* nA = has_next ? nxt.a : cA; const char* nB = has_next ? nxt.b : cB;
        if (has_next) PG8_GOFF(gn, ui + 1);
        else {
#pragma unroll
            for (int h_ = 0; h_ < 2; ++h_)
#pragma unroll
                for (int i_ = 0; i_ < 2; ++i_) gn[h_][i_] = gc[h_][i_]; }
        HOT_ALIGN(ALG_G8);
#pragma unroll 1
        for (int t = 0; t < nt; t += 2) {
            const bool last = (t == nt - 2); const bool fe = (t == 0) && (ui > 0);
            const char* a1 = cA + (size_t)(t + 1) * kstep;
            const char* a2 = last ? nA : cA + (size_t)(t + 2) * kstep; const char* b2 = last ? nB : cB + (size_t)(t + 2) * kstep;
            const char* a3 = a2 + kstep; const char* b3 = b2 + kstep;
            unsigned g2[2][2];
#pragma unroll
            for (int h_ = 0; h_ < 2; ++h_)
#pragma unroll
                for (int i_ = 0; i_ < 2; ++i_) g2[h_][i_] = last ? gn[h_][i_] : gc[h_][i_];
            PG8_LDB(B0, 0, 0); PG8_LDB(B1, 0, 1); PG8_SCHED; PG8_LDA(At, 0, 0); PG8_STAGE(PG8_SA(1, 1), a1, gc[1]);
            PG8_WAIT_VE(18, 10); PG8_WAIT_L(0); PG8_BAR; PG8_MMA(0, 0, At, B0); PG8_MMA(0, 1, At, B1); PG8_BAR; PG8_SCHED;
            PG8_LDA(At, 0, 1); PG8_STAGE(PG8_SB(0, 0), b2, voffB); PG8_STAGE(PG8_SB(0, 1), b2 + hstep, voffB); PG8_STAGE(PG8_SA(0, 0), a2, g2[0]);
            PG8_WAIT_VE(24, 16); PG8_WAIT_L(0); PG8_BAR; PG8_MMA(1, 0, At, B0); PG8_MMA(1, 1, At, B1); PG8_BAR; PG8_SCHED;
            PG8_LDB(B0, 1, 0); PG8_LDB(B1, 1, 1); PG8_SCHED; PG8_LDA(At, 1, 0); PG8_STAGE(PG8_SA(0, 1), a2, g2[1]);
            PG8_WAIT_V(8); PG8_WAIT_L(0); PG8_BAR; PG8_MMA(0, 0, At, B0); PG8_MMA(0, 1, At, B1); PG8_BAR; PG8_SCHED;
            PG8_LDA(At, 1, 1); PG8_STAGE(PG8_SB(1, 0), b3, voffB); PG8_STAGE(PG8_SB(1, 1), b3 + hstep, voffB); PG8_STAGE(PG8_SA(1, 0), a3, g2[0]);
            PG8_WAIT_V(8); PG8_WAIT_L(0); PG8_BAR; PG8_MMA(1, 0, At, B0); PG8_MMA(1, 1, At, B1); PG8_BAR; PG8_SCHED;
        }
        if (wr == 0) PG8_BAR;
        asm volatile("s_nop 15\n\ts_nop 15" ::: "memory");
        PG8_WAIT_V(0);
        { int fr_ = fr, fq_ = fq; asm volatile("" : "+v"(fr_), "+v"(fq_));
          E(acc, cur, wr, wc, fr_, fq_); } ns = E.nstores(cur);
        if (!has_next) break;
#pragma unroll
        for (int a = 0; a < 2; ++a)
#pragma unroll
            for (int b = 0; b < 2; ++b)
#pragma unroll
                for (int m = 0; m < 4; ++m)
#pragma unroll
                    for (int n = 0; n < 2; ++n) acc[a][b][m][n] = (f32x4){0.f, 0.f, 0.f, 0.f};
        cur = nxt; cA = nA; cB = nB; ++ui;
#pragma unroll
        for (int h_ = 0; h_ < 2; ++h_)
#pragma unroll
            for (int i_ = 0; i_ < 2; ++i_) gc[h_][i_] = gn[h_][i_];
        if (wr == 1) PG8_BAR;
    }
    PG8_WAIT_V(0);
    PG8_BAR;
#undef PG8_GOFF
#undef PG8_V8
#undef PG8_SA
#undef PG8_SB
#undef PG8_STAGE
#undef PG8_LDA
#undef PG8_LDB
#undef PG8_MMA
#undef PG8_WAIT_V
#undef PG8_WAIT_VE
#undef PG8_WAIT_L
#undef PG8_BAR
#undef PG8_SCHED
}
}

namespace att {
constexpr int QBLK = 32, KVBLK = 64;
constexpr float SCALE = 0.125f;
constexpr float THR = 8.f;
constexpr float LOG2E = 1.4426950408889634f;
#define SBAR() __builtin_amdgcn_sched_barrier(0)
#define KSWZ(row, colB) ((row) * 128 + ((colB) ^ ((((row) >> 1) & 7) << 4)))
__device__ __forceinline__ int crow(int r, int hi) { return (r & 3) + 8 * (r >> 2) + 4 * hi; }
__device__ __forceinline__ unsigned cvtpk(float lo, float hi) { unsigned r; asm volatile("v_cvt_pk_bf16_f32 %0, %1, %2" : "=v"(r) : "v"(lo), "v"(hi)); return r; }

constexpr float THRL = 8.f;
template <bool NEGM = true>
__device__ __forceinline__ void partialSM(f32x16& p0, f32x16& p1, float& m_reg, f32x16& negm, float& alpha, const bool first) {
    float a = fmaxf(fmaxf(p0[0], p0[1]), p1[0]), b = fmaxf(fmaxf(p0[2], p0[3]), p1[1]); a = fmaxf(fmaxf(a, p1[2]), p1[3]);
#pragma unroll
    for (int r = 4; r < 16; r += 4) { a = fmaxf(fmaxf(a, p0[r]), p0[r + 1]); b = fmaxf(fmaxf(b, p0[r + 2]), p0[r + 3]); a = fmaxf(fmaxf(a, p1[r]), p1[r + 1]); b = fmaxf(fmaxf(b, p1[r + 2]), p1[r + 3]); }
    float pmax = fmaxf(a, b);
    { auto rr = __builtin_amdgcn_permlane32_swap(__float_as_uint(pmax), __float_as_uint(pmax), false, false);
      pmax = fmaxf(__uint_as_float(rr[0]), __uint_as_float(rr[1])); }
    if constexpr (!NEGM) pmax -= m_reg;
    alpha = 1.f;
    if (__builtin_expect(first || __any(pmax > THRL), 0)) {
        const float dl = first ? pmax : fmaxf(pmax, 0.f);
        m_reg += dl;
        if constexpr (NEGM) {
#pragma unroll
            for (int r = 0; r < 16; ++r) { p0[r] -= dl; p1[r] -= dl; }
#pragma unroll
            for (int r = 0; r < 16; ++r) negm[r] = -m_reg; }
        alpha = __builtin_amdgcn_exp2f(-dl);
    }
    if constexpr (!NEGM) {
#pragma unroll
        for (int r = 0; r < 16; ++r) { p0[r] -= m_reg; p1[r] -= m_reg; } }
#pragma unroll
    for (int r = 0; r < 16; ++r) p0[r] = __builtin_amdgcn_exp2f(p0[r]);
}
__device__ __forceinline__ void finishSM(f32x16& p0, f32x16& p1, float alpha, float& l_reg, bf16x8& pa0, bf16x8& pa1, bf16x8& pa2, bf16x8& pa3) {
#pragma unroll
    for (int r = 0; r < 16; ++r) p1[r] = __builtin_amdgcn_exp2f(p1[r]);
#define ADDF(d, a, b) asm("v_add_f32 %0, %1, %2" : "=v"(d) : "v"(a), "v"(b))
    float s0, s1, s2, s3;
    ADDF(s0, p0[0], p0[4]); ADDF(s1, p0[1], p0[5]); ADDF(s2, p0[2], p0[6]); ADDF(s3, p0[3], p0[7]);
#pragma unroll
    for (int r = 8; r < 16; r += 4) { ADDF(s0, s0, p0[r]); ADDF(s1, s1, p0[r + 1]); ADDF(s2, s2, p0[r + 2]); ADDF(s3, s3, p0[r + 3]); }
#pragma unroll
    for (int r = 0; r < 16; r += 4) { ADDF(s0, s0, p1[r]); ADDF(s1, s1, p1[r + 1]); ADDF(s2, s2, p1[r + 2]); ADDF(s3, s3, p1[r + 3]); }
    ADDF(s0, s0, s1); ADDF(s2, s2, s3);
    float ps; ADDF(ps, s0, s2);
#undef ADDF
    { auto rr = __builtin_amdgcn_permlane32_swap(__float_as_uint(ps), __float_as_uint(ps), false, false);
      ps = __uint_as_float(rr[0]) + __uint_as_float(rr[1]); }
    l_reg = l_reg * alpha + ps;
#define PK8(P, BASE, OUT) do { u32x4 w = {cvtpk(P[BASE + 0], P[BASE + 1]), cvtpk(P[BASE + 2], P[BASE + 3]), cvtpk(P[BASE + 4], P[BASE + 5]), cvtpk(P[BASE + 6], P[BASE + 7])}; OUT = __builtin_bit_cast(bf16x8, w); } while (0)
    PK8(p0, 0, pa0); PK8(p0, 8, pa1); PK8(p1, 0, pa2); PK8(p1, 8, pa3);
#undef PK8
}
__device__ __forceinline__ void qkt(f32x16& p0, f32x16& p1, const LAS char* Ks, const LAS char* qf, const f32x16& cinit, int r32, int hi) {
#pragma unroll
    for (int d0 = 0; d0 < 4; ++d0) { const int cb = (d0 * 16 + hi * 8) * 2;
        const bf16x8 q = *(const LAS bf16x8*)(qf + d0 * 1024);
        const bf16x8 b0 = *(const LAS bf16x8*)(Ks + KSWZ(r32, cb));
        const bf16x8 b1 = *(const LAS bf16x8*)(Ks + KSWZ(32 + r32, cb));
        if (d0 == 0) { p0 = __builtin_amdgcn_mfma_f32_32x32x16_bf16(b0, q, cinit, 0, 0, 0); p1 = __builtin_amdgcn_mfma_f32_32x32x16_bf16(b1, q, cinit, 0, 0, 0); }
        else { p0 = __builtin_amdgcn_mfma_f32_32x32x16_bf16(b0, q, p0, 0, 0, 0); p1 = __builtin_amdgcn_mfma_f32_32x32x16_bf16(b1, q, p1, 0, 0, 0); } }
}
__device__ __forceinline__ void qkt_r(f32x16& p0, f32x16& p1, const LAS char* Ks, const bf16x8* qr, const f32x16& cinit, int r32, int hi) {
#pragma unroll
    for (int d0 = 0; d0 < 4; ++d0) { const int cb = (d0 * 16 + hi * 8) * 2;
        const bf16x8 b0 = *(const LAS bf16x8*)(Ks + KSWZ(r32, cb));
        const bf16x8 b1 = *(const LAS bf16x8*)(Ks + KSWZ(32 + r32, cb));
        if (d0 == 0) { p0 = __builtin_amdgcn_mfma_f32_32x32x16_bf16(b0, qr[0], cinit, 0, 0, 0); p1 = __builtin_amdgcn_mfma_f32_32x32x16_bf16(b1, qr[0], cinit, 0, 0, 0); }
        else { p0 = __builtin_amdgcn_mfma_f32_32x32x16_bf16(b0, qr[d0], p0, 0, 0, 0); p1 = __builtin_amdgcn_mfma_f32_32x32x16_bf16(b1, qr[d0], p1, 0, 0, 0); } }
}
template <int NCB> __device__ __forceinline__ int v_st(int k, int c) { const int kk = k; return ((kk >> 3) * NCB + (c >> 5)) * 512 + ((kk & 7) * 32 + (c & 31)) * 2; }
__device__ __forceinline__ int v_rd_base(int lane) { return ((lane & 3) << 3) | (((lane >> 2) & 3) << 6) | (((lane >> 4) & 1) << 5) | (((lane >> 5) & 1) << 8); }
typedef short v4i16_t __attribute__((ext_vector_type(4)));
__device__ __forceinline__ s16x4 vtr(const LAS char* p) { return __builtin_bit_cast(s16x4, __builtin_amdgcn_ds_read_tr16_b64_v4i16((LAS v4i16_t*)p)); }
template <int NCB, int D0> __device__ __forceinline__ void pv_one(f32x16& od, const LAS char* vb, bf16x8 pa0, bf16x8 pa1, bf16x8 pa2, bf16x8 pa3) {
    constexpr int KS = NCB * 1024, HS = NCB * 512;
    const s16x4 l0 = vtr(vb + D0 * 512 + 0 * KS), h0 = vtr(vb + D0 * 512 + 0 * KS + HS), l1 = vtr(vb + D0 * 512 + 1 * KS), h1 = vtr(vb + D0 * 512 + 1 * KS + HS);
    const s16x4 l2 = vtr(vb + D0 * 512 + 2 * KS), h2 = vtr(vb + D0 * 512 + 2 * KS + HS), l3 = vtr(vb + D0 * 512 + 3 * KS), h3 = vtr(vb + D0 * 512 + 3 * KS + HS);
#define PK(L, H) (bf16x8){L[0], L[1], L[2], L[3], H[0], H[1], H[2], H[3]}
    od = __builtin_amdgcn_mfma_f32_32x32x16_bf16(pa0, PK(l0, h0), od, 0, 0, 0);
    od = __builtin_amdgcn_mfma_f32_32x32x16_bf16(pa1, PK(l1, h1), od, 0, 0, 0);
    od = __builtin_amdgcn_mfma_f32_32x32x16_bf16(pa2, PK(l2, h2), od, 0, 0, 0);
    od = __builtin_amdgcn_mfma_f32_32x32x16_bf16(pa3, PK(l3, h3), od, 0, 0, 0);
#undef PK
}
template <int NCB> __device__ __forceinline__ void pv_all(f32x16* o, const LAS char* vb, bf16x8 pa0, bf16x8 pa1, bf16x8 pa2, bf16x8 pa3) {
    pv_one<NCB, 0>(o[0], vb, pa0, pa1, pa2, pa3); pv_one<NCB, 1>(o[1], vb, pa0, pa1, pa2, pa3);
    if constexpr (NCB == 4) { pv_one<NCB, 2>(o[2], vb, pa0, pa1, pa2, pa3); pv_one<NCB, 3>(o[3], vb, pa0, pa1, pa2, pa3); }
}

struct UnitDesc {
    const bf16_t* Q; int ldq;
    const bf16_t* K; const bf16_t* V; int ldk, ldv;
    bf16_t* O; int ldo;
    int ctx_row0, lat_row0, lat_t0, NT;
    int q0; const float* sink;
};
template <int DV, bool SWA, int ABL = 0>
__device__ __forceinline__ void attn_unit(const UnitDesc& U, LAS char* lds, const int tid) {
    constexpr int NCB = DV / 32;
    constexpr int LDQ = SWA ? 1024 : 512, LDK = SWA ? 256 : 512, LDV = LDK, LDO = 1024;
    constexpr int SHM_V = KVBLK * DV * 2, SHM_K = KVBLK * 64 * 2;
    constexpr int NLD = (DV == 128) ? 3 : 2;
    const int wid = __builtin_amdgcn_readfirstlane(tid >> 6), lane = tid & 63, r32 = lane & 31, hi = lane >> 5;
    LAS char* V_lds = lds; LAS char* K_lds = lds + 3 * SHM_V;
    LAS float* ws = (LAS float*)(lds + 3 * SHM_V + 3 * SHM_K) + wid * 64; LAS float* li_l = ws; LAS float* al_l = ws + 32;
    float m_reg = 0.f, l_reg = 0; f32x16 o[NCB]; f32x16 negm = f32x16{};
#pragma unroll
    for (int d = 0; d < NCB; ++d) o[d] = f32x16{};
    const bf16_t* Qw = U.Q + (size_t)(wid * QBLK + r32) * LDQ + hi * 8;
    LAS char* qf = lds + 3 * SHM_V + 3 * SHM_K + 2048 + wid * 4096 + lane * 16;
#pragma unroll
    for (int d0 = 0; d0 < 4; ++d0) *(LAS bf16x8*)(qf + d0 * 1024) = *(const bf16x8*)(Qw + d0 * 16);
    const int kr = tid >> 3, kc = (tid & 7) * 8;
    const int sr = tid >> 4, sc = (tid & 15) * 8;
    const int kst = KSWZ(kr, kc * 2);
    const int vst0 = (DV == 128) ? v_st<NCB>(sr, sc) : v_st<NCB>(kr, kc), vst1 = (DV == 128) ? v_st<NCB>(32 + sr, sc) : 0;
    const LAS char* vrd = V_lds + v_rd_base(lane);
    bf16x8 svA0, svA1, skA;
    const bf16_t* kp = U.K + (size_t)(U.ctx_row0 + kr) * LDK + kc;
    const bf16_t* vp = (DV == 128) ? U.V + (size_t)(U.ctx_row0 + sr) * LDV + sc : U.V + (size_t)(U.ctx_row0 + kr) * LDV + kc;
    const int jump = (U.lat_row0 + 64 * U.lat_t0) - (U.ctx_row0 + 192);
#define SLOAD(S, t) do { \
        if constexpr (DV == 128) { sv##S##0 = *(const bf16x8*)(vp); sv##S##1 = *(const bf16x8*)(vp + (size_t)32 * LDV); } \
        else { sv##S##0 = *(const bf16x8*)(vp); } \
        sk##S = *(const bf16x8*)(kp); \
        { const int adv_ = ((t) == 3) ? jump : 64; kp += (ptrdiff_t)adv_ * LDK; vp += (ptrdiff_t)adv_ * LDV; } } while (0)
#define SWRITE(slot, S) do { *(LAS bf16x8*)(V_lds + (slot) * SHM_V + vst0) = sv##S##0; if constexpr (DV == 128) *(LAS bf16x8*)(V_lds + (slot) * SHM_V + vst1) = sv##S##1; \
        *(LAS bf16x8*)(K_lds + (slot) * SHM_K + kst) = sk##S; } while (0)
#define RESC(a) do { if (__any((a) < 1.f)) { if (hi == 0) al_l[r32] = (a); asm volatile("s_waitcnt lgkmcnt(0)" ::: "memory"); \
        _Pragma("unroll") for (int d = 0; d < NCB; ++d) _Pragma("unroll") for (int r = 0; r < 16; ++r) o[d][r] *= al_l[crow(r, hi)]; } } while (0)
    const int qs = U.q0 + wid * QBLK;
#define ACTIVE(t) (!SWA || (t) < 4 || (64 * (U.lat_t0 + (t) - 4) + 63 >= qs - 128 && 64 * (U.lat_t0 + (t) - 4) <= qs + 31 + 128))
#define MASK(P0, P1, t) do { if constexpr (SWA) { if ((t) >= 4 && !(64 * (U.lat_t0 + (t) - 4) >= qs + 31 - 128 && 64 * (U.lat_t0 + (t) - 4) + 63 <= qs + 128)) { const int kb_ = 64 * (U.lat_t0 + (t) - 4) - (qs + r32) + 4 * hi; \
        _Pragma("unroll") for (int r = 0; r < 16; ++r) { const int d0_ = kb_ + (r & 3) + 8 * (r >> 2); \
            if (d0_ > 128 || d0_ < -128) P0[r] = -1e30f; if (d0_ + 32 > 128 || d0_ + 32 < -128) P1[r] = -1e30f; } } } } while (0)
    f32x16 pA0, pA1, pB0, pB1; float alA = 1.f, alB = 1.f; bf16x8 pa0, pa1, pa2, pa3; const int NT = U.NT;
    bool actA = true, actB = true;
    int sp = 0, scur = 0, snx = 1;
#define ROT() do { sp = scur; scur = snx; snx = (snx == 2) ? 0 : snx + 1; } while (0)
#define STEP(t, C, P, LOADN, WRITEN) do { \
        act##C = ACTIVE(t); \
        SBAR(); if (act##C) { if constexpr (ABL != 4) qkt(p##C##0, p##C##1, K_lds + scur * SHM_K, qf, negm, r32, hi); else { asm volatile("" : "+v"(p##C##0), "+v"(p##C##1)); } MASK(p##C##0, p##C##1, t); } \
        if (act##P) { finishSM(p##P##0, p##P##1, al##P, l_reg, pa0, pa1, pa2, pa3); } SBAR(); \
        if (WRITEN && ABL != 1) { SWRITE(snx, A); } \
        if (LOADN && ABL != 1) SLOAD(A, (t) + 2); SBAR(); \
        if (act##P) { if constexpr (ABL != 3) { pv_all<NCB>(o, vrd + sp * SHM_V, pa0, pa1, pa2, pa3); } else { asm volatile("" :: "v"(pa0), "v"(pa1), "v"(pa2), "v"(pa3)); } } \
        if (act##C) { partialSM(p##C##0, p##C##1, m_reg, negm, al##C, false); } else al##C = 1.f; \
        if (act##C) RESC(al##C); \
        __syncthreads(); ROT(); } while (0)
    SLOAD(A, 0); asm volatile("s_waitcnt vmcnt(0)" ::: "memory"); SWRITE(0, A); SLOAD(A, 1); __syncthreads();
    qkt(pA0, pA1, K_lds, qf, negm, r32, hi); MASK(pA0, pA1, 0); partialSM(pA0, pA1, m_reg, negm, alA, true);
    SWRITE(1, A); SLOAD(A, 2); __syncthreads();
    sp = 0; scur = 1; snx = 2;
    for (int j = 1; j + 1 < NT; j += 2) {
        STEP(j, B, A, true, true);
        STEP(j + 1, A, B, (j + 3 < NT), true);
    }
    STEP(NT - 1, B, A, false, false);
    if (actB) { finishSM(pB0, pB1, alB, l_reg, pa0, pa1, pa2, pa3); SBAR(); pv_all<NCB>(o, vrd + sp * SHM_V, pa0, pa1, pa2, pa3); }
    if constexpr (SWA) l_reg += __builtin_amdgcn_exp2f(U.sink[0] * LOG2E - m_reg);
    if (hi == 0) li_l[r32] = l_reg; asm volatile("s_waitcnt lgkmcnt(0)" ::: "memory");
    float rli[16];
#pragma unroll
    for (int r = 0; r < 16; ++r) rli[r] = __builtin_amdgcn_rcpf(li_l[crow(r, hi)]);
    bf16_t* Ow = U.O + (size_t)(wid * QBLK) * LDO;
#pragma unroll
    for (int r = 0; r < 16; ++r) { const int orow = crow(r, hi);
#pragma unroll
        for (int d0 = 0; d0 < NCB; ++d0) Ow[(size_t)orow * LDO + d0 * 32 + r32] = (bf16_t)f2bf(o[d0][r] * rli[r]); }
    __syncthreads();
#undef SLOAD
#undef SWRITE
#undef RESC
#undef ACTIVE
#undef MASK
#undef ROT
#undef STEP
}
template <int DV, bool SWA>
__device__ __forceinline__ void attn_unit_pp(const UnitDesc& U, LAS char* lds, const int tid) {
    constexpr int NCB = DV / 32;
    constexpr int LDQ = SWA ? 1024 : 512, LDK = SWA ? 256 : 512, LDV = LDK, LDO = 1024;
    constexpr int SHM_V = KVBLK * DV * 2, SHM_K = KVBLK * 64 * 2;
    const int wid = __builtin_amdgcn_readfirstlane(tid >> 6), lane = tid & 63, r32 = lane & 31, hi = lane >> 5;
    const int wrow = SWA ? (wid & 1) * QBLK : wid * QBLK, wcol = SWA ? (wid >> 1) * 64 : 0;
    LAS char* V_lds = lds; LAS char* K_lds = lds + 5 * SHM_V;
    LAS float* ws = (LAS float*)(lds + 5 * SHM_V + 4 * SHM_K) + wid * 64; LAS float* li_l = ws; LAS float* al_l = ws + 32;
    constexpr bool NEGM = true;
    float m_reg = 0.f, l_reg = 0; f32x16 o[NCB]; f32x16 negm = f32x16{};
#pragma unroll
    for (int d = 0; d < NCB; ++d) o[d] = f32x16{};
    const bf16_t* Qw = U.Q + (size_t)(wrow + r32) * LDQ + wcol + hi * 8;
    bf16x8 qf[4];
#pragma unroll
    for (int d0 = 0; d0 < 4; ++d0) qf[d0] = *(const bf16x8*)(Qw + d0 * 16);
    const int krow = 8 * wid + (lane >> 3), klog = (lane & 7) ^ ((krow >> 1) & 7);
    const bf16_t* kp = U.K + (size_t)(U.ctx_row0 + krow) * LDK + klog * 8;
    const int vsub = 2 * wid + (lane >> 5), vkey = ((DV == 128) ? (vsub >> 2) : (vsub >> 1)) * 8 + ((lane >> 2) & 7), vcol = ((DV == 128) ? (vsub & 3) : (vsub & 1)) * 32 + (lane & 3) * 8;
    const bf16_t* vp = U.V + (size_t)(U.ctx_row0 + vkey) * LDV + vcol;
    const LAS char* vrd = V_lds + v_rd_base(lane);
    const int jump = (U.lat_row0 + 64 * U.lat_t0) - (U.ctx_row0 + 192);
#define DMA1(gp, la) asm volatile("s_mov_b32 m0, %1\n\ts_nop 0\n\tglobal_load_lds_dwordx4 %0, off" :: "v"(gp), "s"(la) : "memory", "m0")
#define DWAIT() asm volatile("s_waitcnt vmcnt(0)" ::: "memory")
    const unsigned kl0 = (unsigned)(unsigned long)(K_lds + wid * 1024), vl0 = (unsigned)(unsigned long)(V_lds + wid * 1024);
#define DMA(t, ks, vs) do { \
        DMA1(kp, kl0 + (ks) * SHM_K); \
        DMA1(vp, vl0 + (vs) * SHM_V); \
        if constexpr (DV == 128) DMA1(vp + (size_t)32 * LDV, vl0 + (vs) * SHM_V + 8 * 1024); \
        { const int adv_ = ((t) == 3) ? jump : 64; kp += (ptrdiff_t)adv_ * LDK; vp += (ptrdiff_t)adv_ * LDV; } } while (0)
#define RESC(a) do { if (__any((a) < 1.f)) { if (hi == 0) al_l[r32] = (a); asm volatile("s_waitcnt lgkmcnt(0)" ::: "memory"); \
        _Pragma("unroll") for (int d = 0; d < NCB; ++d) _Pragma("unroll") for (int r = 0; r < 16; ++r) o[d][r] *= al_l[crow(r, hi)]; } } while (0)
    const int qs = U.q0 + wrow;
#define ACTIVE(t) (!SWA || (t) < 4 || (64 * (U.lat_t0 + (t) - 4) + 63 >= qs - 128 && 64 * (U.lat_t0 + (t) - 4) <= qs + 31 + 128))
#define MASK(P0, P1, t) do { if constexpr (SWA) { if ((t) >= 4 && !(64 * (U.lat_t0 + (t) - 4) >= qs + 31 - 128 && 64 * (U.lat_t0 + (t) - 4) + 63 <= qs + 128)) { const int kb_ = 64 * (U.lat_t0 + (t) - 4) - (qs + r32) + 4 * hi; \
        _Pragma("unroll") for (int r = 0; r < 16; ++r) { const int d0_ = kb_ + (r & 3) + 8 * (r >> 2); \
            if (d0_ > 128 || d0_ < -128) P0[r] = -1e30f; if (d0_ + 32 > 128 || d0_ + 32 < -128) P1[r] = -1e30f; } } } } while (0)
    f32x16 pA0, pA1, pB0, pB1; float alA = 1.f, alB = 1.f; bf16x8 pa0, pa1, pa2, pa3; const int NT = U.NT;
    bool actA = true, actB = true;
    int v5 = 0;
#define INC5(x) ((x) == 4 ? 0 : (x) + 1)
#define STEP0(t, C, P) do { \
        act##C = ACTIVE(t); \
        SBAR(); if (act##C) { qkt_r(p##C##0, p##C##1, K_lds + ((t) & 3) * SHM_K, qf, negm, r32, hi); MASK(p##C##0, p##C##1, t); } \
        if (act##P) finishSM(p##P##0, p##P##1, al##P, l_reg, pa0, pa1, pa2, pa3); SBAR(); \
        if (act##P) pv_all<NCB>(o, vrd + v5 * SHM_V, pa0, pa1, pa2, pa3); \
        if (act##C) { partialSM<NEGM>(p##C##0, p##C##1, m_reg, negm, al##C, false); RESC(al##C); } else al##C = 1.f; \
        v5 = INC5(v5); } while (0)
    DMA(0, 0, 0); DWAIT(); __syncthreads();
    asm volatile("" : "+v"(qf[0]), "+v"(qf[1]), "+v"(qf[2]), "+v"(qf[3]));
    DMA(1, 1, 1); DMA(2, 2, 2);
    qkt_r(pA0, pA1, K_lds, qf, negm, r32, hi); MASK(pA0, pA1, 0);
    partialSM<NEGM>(pA0, pA1, m_reg, negm, alA, true);
    DWAIT(); __syncthreads();
    int vw = 3;
    HOT_ALIGN(ALG_A0);
    for (int j = 1; j + 1 < NT; j += 2) {
        if (j + 2 < NT) { DMA(j + 2, (j + 2) & 3, vw); vw = INC5(vw); }
        if (j + 3 < NT) { DMA(j + 3, (j + 3) & 3, vw); vw = INC5(vw); }
        STEP0(j, B, A); STEP0(j + 1, A, B);
        DWAIT(); __syncthreads();
    }
    if ((NT & 1) == 0) {
        STEP0(NT - 1, B, A);
        if (actB) { finishSM(pB0, pB1, alB, l_reg, pa0, pa1, pa2, pa3); SBAR(); pv_all<NCB>(o, vrd + v5 * SHM_V, pa0, pa1, pa2, pa3); }
    } else {
        if (actA) { finishSM(pA0, pA1, alA, l_reg, pa0, pa1, pa2, pa3); SBAR(); pv_all<NCB>(o, vrd + v5 * SHM_V, pa0, pa1, pa2, pa3); }
    }
    if constexpr (SWA) l_reg += __builtin_amdgcn_exp2f(U.sink[wid >> 1] * LOG2E - m_reg);
    if (hi == 0) li_l[r32] = l_reg; asm volatile("s_waitcnt lgkmcnt(0)" ::: "memory");
    float rli[16];
#pragma unroll
    for (int r = 0; r < 16; ++r) rli[r] = __builtin_amdgcn_rcpf(li_l[crow(r, hi)]);
    bf16_t* Ow = U.O + (size_t)wrow * LDO + wcol;
#pragma unroll
    for (int r = 0; r < 16; ++r) { const int orow = crow(r, hi);
#pragma unroll
        for (int d0 = 0; d0 < NCB; ++d0) Ow[(size_t)orow * LDO + d0 * 32 + r32] = (bf16_t)f2bf(o[d0][r] * rli[r]); }
    __syncthreads();
#undef DMA
#undef DMA1
#undef DWAIT
#undef RESC
#undef ACTIVE
#undef MASK
#undef INC5
#undef STEP0
}

template <int DV, bool SWA, class Gen>
__device__ __forceinline__ void attn_stream(const Gen& gen, const int nunits, LAS char* lds, const int tid) {
    constexpr int NCB = DV / 32;
    constexpr int LDQ = SWA ? 1024 : 512, LDK = SWA ? 256 : 512, LDV = LDK, LDO = 1024;
    constexpr int SHM_V = KVBLK * DV * 2, SHM_K = KVBLK * 64 * 2;
    static_assert(5 * SHM_V + 5 * SHM_K + 2048 <= RING_BYTES, "rings");
    if (nunits <= 0) return;
    const int wid = __builtin_amdgcn_readfirstlane(tid >> 6), lane = tid & 63, r32 = lane & 31, hi = lane >> 5;
    const int wrow = SWA ? (wid & 1) * QBLK : wid * QBLK, wcol = SWA ? (wid >> 1) * 64 : 0;
    LAS char* V_lds = lds; LAS char* K_lds = lds + 5 * SHM_V;
    LAS float* ws = (LAS float*)(lds + 5 * SHM_V + 5 * SHM_K) + wid * 64; LAS float* li_l = ws; LAS float* al_l = ws + 32;
    constexpr bool NEGM = true;
    const int krow = 8 * wid + (lane >> 3), klog = (lane & 7) ^ ((krow >> 1) & 7);
    const int vsub = 2 * wid + (lane >> 5), vkey = ((DV == 128) ? (vsub >> 2) : (vsub >> 1)) * 8 + ((lane >> 2) & 7), vcol = ((DV == 128) ? (vsub & 3) : (vsub & 1)) * 32 + (lane & 3) * 8;
    const LAS char* vrd = V_lds + v_rd_base(lane);
    const unsigned kl0 = (unsigned)(unsigned long)(K_lds + wid * 1024), vl0 = (unsigned)(unsigned long)(V_lds + wid * 1024);
    const bf16_t* kp; const bf16_t* vp; int jump; bf16x8 qf[4];
#define DMA1(gp, la) asm volatile("s_mov_b32 m0, %1\n\ts_nop 0\n\tglobal_load_lds_dwordx4 %0, off" :: "v"(gp), "s"(la) : "memory", "m0")
#define DWAIT() asm volatile("s_waitcnt vmcnt(0)" ::: "memory")
#define DMA(t, s) do { \
        DMA1(kp, kl0 + (s) * SHM_K); \
        DMA1(vp, vl0 + (s) * SHM_V); \
        if constexpr (DV == 128) DMA1(vp + (size_t)32 * LDV, vl0 + (s) * SHM_V + 8 * 1024); \
        { const int adv_ = ((t) == 3) ? jump : 64; kp += (ptrdiff_t)adv_ * LDK; vp += (ptrdiff_t)adv_ * LDV; } } while (0)
#define SETUP(UU) do { kp = (UU).K + (size_t)((UU).ctx_row0 + krow) * LDK + klog * 8; vp = (UU).V + (size_t)((UU).ctx_row0 + vkey) * LDV + vcol; \
        jump = ((UU).lat_row0 + 64 * (UU).lat_t0) - ((UU).ctx_row0 + 192); } while (0)
#define QLOAD(UU) do { const bf16_t* Qw_ = (UU).Q + (size_t)(wrow + r32) * LDQ + wcol + hi * 8; _Pragma("unroll") for (int d0 = 0; d0 < 4; ++d0) qf[d0] = *(const bf16x8*)(Qw_ + d0 * 16); } while (0)
#define INC5(x) ((x) == 4 ? 0 : (x) + 1)
#define RESC(a) do { if (__any((a) < 1.f)) { if (hi == 0) al_l[r32] = (a); asm volatile("s_waitcnt lgkmcnt(0)" ::: "memory"); \
        _Pragma("unroll") for (int d = 0; d < NCB; ++d) _Pragma("unroll") for (int r = 0; r < 16; ++r) o[d][r] *= al_l[crow(r, hi)]; } } while (0)
#define ACTIVE(t) (!SWA || (t) < 4 || (64 * (U.lat_t0 + (t) - 4) + 63 >= qs - 128 && 64 * (U.lat_t0 + (t) - 4) <= qs + 31 + 128))
#define MASK(P0, P1, t) do { if constexpr (SWA) { if ((t) >= 4 && !(64 * (U.lat_t0 + (t) - 4) >= qs + 31 - 128 && 64 * (U.lat_t0 + (t) - 4) + 63 <= qs + 128)) { const int kb_ = 64 * (U.lat_t0 + (t) - 4) - (qs + r32) + 4 * hi; \
        _Pragma("unroll") for (int r = 0; r < 16; ++r) { const int d0_ = kb_ + (r & 3) + 8 * (r >> 2); \
            if (d0_ > 128 || d0_ < -128) P0[r] = -1e30f; if (d0_ + 32 > 128 || d0_ + 32 < -128) P1[r] = -1e30f; } } } } while (0)
#define STEP0(t, C, P) do { \
        act##C = ACTIVE(t); \
        SBAR(); if (act##C) { qkt_r(p##C##0, p##C##1, K_lds + INC5(v5) * SHM_K, qf, negm, r32, hi); MASK(p##C##0, p##C##1, t); } \
        if (act##P) finishSM(p##P##0, p##P##1, al##P, l_reg, pa0, pa1, pa2, pa3); SBAR(); \
        if (act##P) pv_all<NCB>(o, vrd + v5 * SHM_V, pa0, pa1, pa2, pa3); \
        if (act##C) { partialSM<NEGM>(p##C##0, p##C##1, m_reg, negm, al##C, false); RESC(al##C); } else al##C = 1.f; \
        v5 = INC5(v5); } while (0)
    UnitDesc U, Un; float sink_n = 0.f;
    gen(0, Un); SETUP(Un); if constexpr (SWA) sink_n = Un.sink[wid >> 1]; QLOAD(Un);
    DMA(0, 0); DMA(1, 1); DMA(2, 2);
    DWAIT(); __syncthreads();
    asm volatile("" : "+v"(qf[0]), "+v"(qf[1]), "+v"(qf[2]), "+v"(qf[3]), "+v"(sink_n));
    int rb = 0;
    for (int ui = 0; ui < nunits; ++ui) {
        U = Un; const float sinkv = sink_n;
        const int NT = U.NT, qs = U.q0 + wrow;
        float m_reg = 0.f, l_reg = 0.f; f32x16 o[NCB]; f32x16 negm = f32x16{};
#pragma unroll
        for (int d = 0; d < NCB; ++d) o[d] = f32x16{};
        f32x16 pA0, pA1, pB0, pB1; float alA = 1.f, alB = 1.f; bf16x8 pa0, pa1, pa2, pa3;
        bool actA = true, actB = true;
        int v5 = rb;
        int vw = rb + 3 >= 5 ? rb - 2 : rb + 3;
        qkt_r(pA0, pA1, K_lds + rb * SHM_K, qf, negm, r32, hi); MASK(pA0, pA1, 0);
        partialSM<NEGM>(pA0, pA1, m_reg, negm, alA, true);
        HOT_ALIGN(ALG_A1);
        for (int j = 1; j + 1 < NT; j += 2) {
            if (j + 2 < NT) { DMA(j + 2, vw); vw = INC5(vw); }
            if (j + 3 < NT) { DMA(j + 3, vw); vw = INC5(vw); }
            STEP0(j, B, A); STEP0(j + 1, A, B);
            DWAIT(); __syncthreads();
        }
        const bool has_next = ui + 1 < nunits;
        const int rbn = vw;
        if (has_next) { gen(ui + 1, Un); SETUP(Un); DMA(0, vw); vw = INC5(vw); DMA(1, vw); vw = INC5(vw); DMA(2, vw); }
        const bool even = (NT & 1) == 0;
        if (even) STEP0(NT - 1, B, A);
        SBAR();
        if (has_next) { if constexpr (SWA) sink_n = Un.sink[wid >> 1]; QLOAD(Un); }
        if (even) { if (actB) { finishSM(pB0, pB1, alB, l_reg, pa0, pa1, pa2, pa3); SBAR(); pv_all<NCB>(o, vrd + v5 * SHM_V, pa0, pa1, pa2, pa3); } }
        else      { if (actA) { finishSM(pA0, pA1, alA, l_reg, pa0, pa1, pa2, pa3); SBAR(); pv_all<NCB>(o, vrd + v5 * SHM_V, pa0, pa1, pa2, pa3); } }
        SBAR();
        if constexpr (SWA) l_reg += __builtin_amdgcn_exp2f(sinkv * LOG2E - m_reg);
        if (hi == 0) li_l[r32] = l_reg; asm volatile("s_waitcnt lgkmcnt(0)" ::: "memory");
        float rli[16];
#pragma unroll
        for (int r = 0; r < 16; ++r) rli[r] = __builtin_amdgcn_rcpf(li_l[crow(r, hi)]);
        bf16_t* Ow = U.O + (size_t)wrow * LDO + wcol;
        asm volatile("" : "+v"(qf[0]), "+v"(qf[1]), "+v"(qf[2]), "+v"(qf[3]), "+v"(sink_n));
#pragma unroll
        for (int r = 0; r < 16; ++r) { const int orow = crow(r, hi);
#pragma unroll
            for (int d0 = 0; d0 < NCB; ++d0) Ow[(size_t)orow * LDO + d0 * 32 + r32] = (bf16_t)f2bf(o[d0][r] * rli[r]); }
        if (has_next) asm volatile("s_waitcnt lgkmcnt(0)\n\ts_barrier" ::: "memory");
        else __syncthreads();
        rb = rbn;
    }
#undef DMA
#undef DMA1
#undef DWAIT
#undef SETUP
#undef QLOAD
#undef RESC
#undef ACTIVE
#undef MASK
#undef INC5
#undef STEP0
}
#undef SBAR
#undef KSWZ
}

struct Args { const float* in[32]; float* out; unsigned char* ws; int nprog, pad; unsigned char prog[64]; };
struct ArgsD { const GAS float* in[32]; GAS float* out; GAS unsigned char* ws; int nprog, pad; unsigned char prog[64]; };
typedef const __attribute__((address_space(4))) ArgsD* ArgsP;
#define APIN(i) ((const float*)ap->in[i])
#define APOUT ((float*)ap->out)

struct Frame {
    LAS unsigned char* lds;
    int tid, lane, wave, vcu, G, gw, NGW;
    unsigned char* ws;
};

__device__ __forceinline__ int rope_src(int p) { return 16 * ((p >> 2) & 1) + 4 * (p >> 3) + (p & 3); }
__device__ __forceinline__ void transpose_item(const float* W, int N, bf16_t* WT, int src0, int dst_row0, int k0, bool perm, LAS float* scr, int lane) {
    float tv[32];
#pragma unroll
    for (int i = 0; i < 32; ++i) { const int kk = 2 * i + (lane >> 5); tv[i] = W[(size_t)(k0 + kk) * N + src0 + (lane & 31)]; }
#pragma unroll
    for (int i = 0; i < 32; ++i) { const int kk = 2 * i + (lane >> 5); scr[kk * 33 + (lane & 31)] = tv[i]; }
    LDS_WAIT(); asm volatile("" ::: "memory");
    const int c = lane & 7;
#pragma unroll
    for (int j = 0; j < 4; ++j) { const int n = (lane >> 3) + 8 * j; const int sn = perm ? rope_src(n) : n; const LAS float* s = scr + (8 * c) * 33 + sn;
        u32x4 o; o.x = pk2(s[0 * 33], s[1 * 33]); o.y = pk2(s[2 * 33], s[3 * 33]); o.z = pk2(s[4 * 33], s[5 * 33]); o.w = pk2(s[6 * 33], s[7 * 33]);
        *(u32x4*)(WT + (size_t)(dst_row0 + n) * DM + k0 + 8 * c) = o; }
    LDS_WAIT(); asm volatile("" ::: "memory");
}
__device__ __forceinline__ void transpose_item8(const float* W, int N, unsigned char* WT, int src0, int dst_row0, int k0, LAS float* scr, int lane) {
    float tv[32];
#pragma unroll
    for (int i = 0; i < 32; ++i) { const int kk = 2 * i + (lane >> 5); tv[i] = W[(size_t)(k0 + kk) * N + src0 + (lane & 31)]; }
#pragma unroll
    for (int i = 0; i < 32; ++i) { const int kk = 2 * i + (lane >> 5); scr[kk * 33 + (lane & 31)] = tv[i] * 32.f; }
    LDS_WAIT(); asm volatile("" ::: "memory");
    const int c = lane & 7;
#pragma unroll
    for (int j = 0; j < 4; ++j) { const int n = (lane >> 3) + 8 * j; const LAS float* s = scr + (8 * c) * 33 + n;
        u32x2 o; o.x = pk4_fp8(s[0 * 33], s[1 * 33], s[2 * 33], s[3 * 33]); o.y = pk4_fp8(s[4 * 33], s[5 * 33], s[6 * 33], s[7 * 33]);
        *(u32x2*)(WT + (size_t)(dst_row0 + n) * DM + k0 + 8 * c) = o; }
    LDS_WAIT(); asm volatile("" ::: "memory");
}
__device__ __forceinline__ float silu_f(float v) { return v / (1.f + __expf(-v)); }

namespace wc { constexpr int I_IN = 96 * 16, I_O = 32 * 16, I_GU = 16 * 64 * 16, I_D = 16 * 32 * 16, I_QKV = 48 * 16;
    constexpr int NITEMS = I_IN + I_O + I_GU + I_D + I_QKV + I_O + I_GU + I_D;
    constexpr int L0E = I_IN + I_O, L1 = L0E + I_GU + I_D;
    constexpr int F1_LO = L0E, F1_HI = F1_LO + 160 * 54, F2_HI = F1_HI + 224 * 54;
    constexpr int F3_LO = L1, F3_HI = F3_LO + 128 * 34, F4_HI = F3_HI + 192 * 34, F5_HI = F4_HI + 208 * 54;
    static_assert(F2_HI < L1 && F5_HI < NITEMS && F3_LO + I_QKV + I_O <= F3_HI, "filler slices");
}
__device__ __forceinline__ void weight_item(Frame& F, ArgsP ap, int it, LAS float* scr) {
    using namespace wc; unsigned char* ws = F.ws;
        int r = it;
        if (r < I_IN) { const int g = r / 16, kb = r % 16, r0 = 32 * g; int src0; bool perm = false;
            if (r0 < 512) src0 = r0;
            else if (r0 < 1536) { const int u = (r0 - 512) / 256, w = (r0 - 512) % 256; src0 = w < 128 ? 512 + u * 128 + w : 1024 + u * 128 + (w - 128); }
            else if (r0 < 2560) { src0 = r0; perm = true; }
            else src0 = r0;
            transpose_item(APIN(7), NWIN, (bf16_t*)(ws + W_IN), src0, r0, kb * 64, perm, scr, F.lane); return; }
        r -= I_IN;
        if (r < I_O) { const int g = r / 16, kb = r % 16; transpose_item(APIN(14), DM, (bf16_t*)(ws + W_OUT0), 32 * g, 32 * g, kb * 64, false, scr, F.lane); return; }
        r -= I_O;
        if (r < I_GU) { const int e = r / 1024, g = (r % 1024) / 16, kb = r % 16, r0 = 32 * g, u = r0 / 256, w = r0 % 256;
            const float* src = (w < 128 ? APIN(17) : APIN(18)) + (size_t)e * DM * FF;
            transpose_item8(src, FF, (unsigned char*)(ws + W_GU0) + (size_t)e * 2 * FF * DM, u * 128 + (w & 127), r0, kb * 64, scr, F.lane); return; }
        r -= I_GU;
        if (r < I_D) { const int e = r / 512, g = (r % 512) / 16, kb = r % 16;
            transpose_item8(APIN(19) + (size_t)e * FF * DM, DM, (unsigned char*)(ws + W_D0) + (size_t)e * DM * FF, 32 * g, 32 * g, kb * 64, scr, F.lane); return; }
        r -= I_D;
        if (r < I_QKV) { const int g = r / 16, kb = r % 16, r0 = 32 * g;
            transpose_item(APIN(23), NQKV1, (bf16_t*)(ws + W_QKV), r0, r0, kb * 64, r0 < 1280, scr, F.lane); return; }
        r -= I_QKV;
        if (r < I_O) { const int g = r / 16, kb = r % 16; transpose_item(APIN(25), DM, (bf16_t*)(ws + W_OUT1), 32 * g, 32 * g, kb * 64, false, scr, F.lane); return; }
        r -= I_O;
        if (r < I_GU) { const int e = r / 1024, g = (r % 1024) / 16, kb = r % 16, r0 = 32 * g, u = r0 / 256, w = r0 % 256;
            const float* src = (w < 128 ? APIN(28) : APIN(29)) + (size_t)e * DM * FF;
            transpose_item8(src, FF, (unsigned char*)(ws + W_GU1) + (size_t)e * 2 * FF * DM, u * 128 + (w & 127), r0, kb * 64, scr, F.lane); return; }
        r -= I_GU;
        { const int e = r / 512, g = (r % 512) / 16, kb = r % 16;
            transpose_item8(APIN(30) + (size_t)e * FF * DM, DM, (unsigned char*)(ws + W_D1) + (size_t)e * DM * FF, 32 * g, 32 * g, kb * 64, scr, F.lane); }
}
__device__ __forceinline__ void weight_items(Frame& F, ArgsP ap, int lo, int hi, int wv, int nw) {
    LAS float* scr = (LAS float*)(F.lds + F.wave * 16384);
    for (int it = lo + wv; it < hi; it += nw) weight_item(F, ap, it, scr);
}
__device__ __forceinline__ void p0_prologue(Frame& F, ArgsP ap, const bool rerun) {
    LAS float* scr = (LAS float*)(F.lds + F.wave * 16384);
    unsigned char* ws = F.ws;
    if (F.gw < 16) { const int pos = F.gw * 4 + (F.lane >> 4), f = F.lane & 15;
        const float inv = __builtin_amdgcn_exp2f(-(float)f * (13.287712379549449f / 16.f));
        const float ang = (float)pos * inv, rev = ang * 0.15915494309189535f;
        float* rp = (float*)(ws + WS_ROPE);
        rp[pos * 16 + f] = __builtin_amdgcn_cosf(rev); rp[1024 + pos * 16 + f] = __builtin_amdgcn_sinf(rev); }
    if (!rerun && F.vcu < 2 * 4 * 24) {
        const int it = F.vcu, layer = it / 96, r = it % 96, kq = r / 24, nb = r % 24;
        const float* W = APIN(layer ? 20 : 4);
        const int n0 = nb * 256 + 4 * F.lane, k0 = kq * 256 + F.wave * 32;
        f32x4 acc[9];
#pragma unroll
        for (int b = 0; b < 9; ++b) acc[b] = (f32x4){0.f, 0.f, 0.f, 0.f};
        float sv[9];
#pragma unroll
        for (int b = 0; b < 8; ++b) sv[b] = silu_f(APIN(1)[b * DM + k0 + (F.lane & 31)]);
        sv[8] = silu_f(APIN(3)[k0 + (F.lane & 31)]);
#pragma unroll 8
        for (int kk = 0; kk < 32; ++kk) { const f32x4 w = *(const f32x4*)(W + (size_t)(k0 + kk) * 6144 + n0);
#pragma unroll
            for (int b = 0; b < 9; ++b) { const float s = __builtin_bit_cast(float, __builtin_amdgcn_readlane(__builtin_bit_cast(int, sv[b]), kk)); acc[b] += w * s; } }
#pragma unroll
        for (int b = 0; b < 9; ++b) *(LAS f32x4*)(scr + b * 256 + 4 * F.lane) = acc[b];
        __syncthreads();
        float* part = (float*)(ws + WS_PART) + (size_t)(layer * 4 + kq) * 9 * 6144;
        for (int o = F.tid; o < 9 * 256; o += NTHREADS) { float s = 0.f;
#pragma unroll
            for (int w = 0; w < 8; ++w) s += ((LAS float*)(F.lds + w * 16384))[o];
            part[(o >> 8) * 6144 + nb * 256 + (o & 255)] = s; }
        __syncthreads();
    }
    weight_items(F, ap, 0, wc::L0E, F.gw, F.NGW);
    weight_items(F, ap, wc::F2_HI, wc::L1, F.gw, F.NGW);
    weight_items(F, ap, wc::F5_HI, wc::NITEMS, F.gw, F.NGW);
}

__device__ __forceinline__ void load_row(const float* p, int lane, f32x4 (&v)[4]) {
    const f32x4* r = (const f32x4*)p + lane;
#pragma unroll
    for (int j = 0; j < 4; ++j) v[j] = r[64 * j];
}
__device__ __forceinline__ void load_row_bf(const bf16_t* p, int lane, f32x4 (&v)[4]) {
    const u32x2* r = (const u32x2*)p + lane;
#pragma unroll
    for (int j = 0; j < 4; ++j) { const u32x2 w = r[64 * j]; v[j] = (f32x4){bf_lo(w.x), bf_hi(w.x), bf_lo(w.y), bf_hi(w.y)}; }
}
__device__ __forceinline__ void wave_range(int total, int gw, int ngw, int& r0, int& r1) { const int per = (total + ngw - 1) / ngw; r0 = gw * per; r1 = r0 + per < total ? r0 + per : total; }
__device__ __forceinline__ const float* xrow_ptr(const float* xlat, const float* xctx, int r) { return r < NLAT ? xlat + (size_t)r * DM : xctx + (size_t)(r - NLAT) * DM; }
__device__ __forceinline__ void load_mod(const float* gain, const float* shift, const float* scale, int lane, f32x4 (&ga)[4], f32x4 (&sh)[4]) {
#pragma unroll
    for (int j = 0; j < 4; ++j) { const f32x4 g = ((const f32x4*)gain)[lane + 64 * j], sc = ((const f32x4*)scale)[lane + 64 * j]; ga[j] = g * (sc + 1.0f); sh[j] = ((const f32x4*)shift)[lane + 64 * j]; }
}
__device__ __forceinline__ void modulate_row(f32x4 (&v)[4], const f32x4 (&ga)[4], const f32x4 (&sh)[4], int lane, bf16_t* orow) {
    float s = 0.f;
#pragma unroll
    for (int j = 0; j < 4; ++j) s += (v[j].x * v[j].x + v[j].y * v[j].y) + (v[j].z * v[j].z + v[j].w * v[j].w);
    const float rs = 1.f / sqrtf(wave_sum(s) * (1.f / DM) + NORM_EPS);
    u32x2* o8 = (u32x2*)orow + lane;
#pragma unroll
    for (int j = 0; j < 4; ++j) { v[j] = (v[j] * rs) * ga[j] + sh[j];
        u32x2 w; w.x = cvt_pk_bf16(v[j].x, v[j].y); w.y = cvt_pk_bf16(v[j].z, v[j].w); o8[64 * j] = w; }
}
__device__ __forceinline__ f32x4 mod_sum4(const float* part_layer, const float* bias, int b, int n) {
    f32x4 s = *(const f32x4*)(bias + n);
#pragma unroll
    for (int q = 0; q < 4; ++q) s += *(const f32x4*)(part_layer + (size_t)(q * 9 + b) * 6144 + n);
    return s;
}
__device__ __forceinline__ void norm1_phase(Frame& F, const float* xlat, const float* xctx, const float* gain, const float* bias0, const float* bias1) {
    bf16_t* XN = (bf16_t*)(F.ws + A_XN);
    const float* part = (const float*)(F.ws + WS_PART); float* mod = (float*)(F.ws + WS_MOD);
    for (int i = (F.gw * 64 + F.lane) * 4; i < 2 * 9 * 6144; i += F.NGW * 64 * 4) {
        const int layer = i / (9 * 6144), r = i % (9 * 6144), b = r / 6144, n = r % 6144;
        *(f32x4*)(mod + i) = mod_sum4(part + (size_t)layer * 4 * 9 * 6144, layer ? bias1 : bias0, b, n);
    }
    int r0, r1; wave_range(MALL, F.gw, F.NGW, r0, r1);
    f32x4 v[4], vn[4], ga[4], sh[4]; int cb = -1;
    if (r0 < r1) load_row(xrow_ptr(xlat, xctx, r0), F.lane, vn);
    for (int r = r0; r < r1; ++r) {
#pragma unroll
        for (int j = 0; j < 4; ++j) v[j] = vn[j];
        if (r + 1 < r1) load_row(xrow_ptr(xlat, xctx, r + 1), F.lane, vn);
        const int b = r < NLAT ? (r >> 12) : 8;
        if (b != cb) { cb = b;
#pragma unroll
            for (int j = 0; j < 4; ++j) { const int k = 4 * (F.lane + 64 * j); const f32x4 g = ((const f32x4*)gain)[F.lane + 64 * j];
                const f32x4 shv = mod_sum4(part, bias0, b, k), scv = mod_sum4(part, bias0, b, 1024 + k); ga[j] = g * (scv + 1.0f); sh[j] = shv; } }
        modulate_row(v, ga, sh, F.lane, XN + (size_t)r * DM);
    }
}
__device__ __forceinline__ void load_router(Frame& F, const float* Wr) {
    LAS float* Wt = (LAS float*)F.lds;
    for (int i = F.tid; i < DM * 4; i += NTHREADS) { const int k = i >> 2, e4 = (i & 3) * 4; const f32x4 w = *(const f32x4*)(Wr + k * 16 + e4);
        Wt[(e4 + 0) * DM + k] = w.x; Wt[(e4 + 1) * DM + k] = w.y; Wt[(e4 + 2) * DM + k] = w.z; Wt[(e4 + 3) * DM + k] = w.w; }
    __syncthreads();
}
__device__ __forceinline__ void router_dot2(const LAS char* Wl, const f32x4 (&va)[4], const f32x4 (&vb)[4], float (&la)[16], float (&lb)[16]) {
#pragma unroll
    for (int e = 0; e < 16; ++e) { f32x2 sa = {0.f, 0.f}, sb = {0.f, 0.f};
#pragma unroll
        for (int j = 0; j < 4; ++j) { const f32x4 w = *(const LAS f32x4*)(Wl + (e * DM + 256 * j) * 4);
            const f32x2 wl = {w.x, w.y}, wh = {w.z, w.w};
            sa = __builtin_elementwise_fma((f32x2){va[j].x, va[j].y}, wl, sa); sa = __builtin_elementwise_fma((f32x2){va[j].z, va[j].w}, wh, sa);
            sb = __builtin_elementwise_fma((f32x2){vb[j].x, vb[j].y}, wl, sb); sb = __builtin_elementwise_fma((f32x2){vb[j].z, vb[j].w}, wh, sb); }
        la[e] = sa.x + sa.y; lb[e] = sb.x + sb.y; if ((e & 1) == 1) __builtin_amdgcn_sched_barrier(0); }
}
__device__ __forceinline__ float router_softmax(const float (&lg)[16], int l) {
    float a8[8];
#pragma unroll
    for (int i = 0; i < 8; ++i) { auto rr = __builtin_amdgcn_permlane32_swap(__float_as_uint(lg[i]), __float_as_uint(lg[8 + i]), false, false); a8[i] = __uint_as_float(rr[0]) + __uint_as_float(rr[1]); }
    float a4[4];
#pragma unroll
    for (int i = 0; i < 4; ++i) { auto rr = __builtin_amdgcn_permlane16_swap(__float_as_uint(a8[i]), __float_as_uint(a8[4 + i]), false, false); a4[i] = __uint_as_float(rr[0]) + __uint_as_float(rr[1]); }
    float a2[2];
#pragma unroll
    for (int i = 0; i < 2; ++i) { const bool up = (l & 8) != 0; const float keep = up ? a4[2 + i] : a4[i], send = up ? a4[i] : a4[2 + i]; a2[i] = keep + dpp_f<0x128>(send); }
    float a1;
    { const bool up = (l & 4) != 0; const float keep = up ? a2[1] : a2[0], send = up ? a2[0] : a2[1]; a1 = keep + dpp_f<0x141>(send); }
    a1 += dpp_f<0x4E>(a1); a1 += dpp_f<0xB1>(a1);
    float mx = a1;
    mx = fmaxf(mx, dpp_f<0x141>(mx)); mx = fmaxf(mx, dpp_f<0x128>(mx)); mx = xmax16(mx); mx = xmax32(mx);
    const float ex = __expf(a1 - mx);
    float den = ex; den += dpp_f<0x141>(den); den += dpp_f<0x128>(den); den = xsum16(den); den = xsum32(den);
    return ex / den;
}
__device__ __forceinline__ void norm2_router_phase(Frame& F, int nrows, const float* gain, const float* mod, const float* Wr) {
    load_router(F, Wr);
    unsigned char* XN8 = (unsigned char*)(F.ws + A_XN); float* AFF = (float*)(F.ws + WS_AFF); const bf16_t* XB = (const bf16_t*)(F.ws + WS_XB);
    const int npairs = nrows >> 1;
    int p0, p1; wave_range(npairs, F.gw, F.NGW, p0, p1);
    f32x4 ga[4], sh[4]; int cb = -1;
    const int l = F.lane;
    u32x2 na[4], nb[4];
    if (p0 < p1) { const u32x2* ra = (const u32x2*)(XB + (size_t)(2 * p0) * DM) + l; const u32x2* rb = (const u32x2*)(XB + (size_t)(2 * p0 + 1) * DM) + l;
#pragma unroll
        for (int j = 0; j < 4; ++j) { na[j] = ra[64 * j]; nb[j] = rb[64 * j]; } }
    for (int p = p0; p < p1; ++p) {
        const int r = 2 * p;
        f32x4 va[4], vb[4];
#pragma unroll
        for (int j = 0; j < 4; ++j) { va[j] = (f32x4){bf_lo(na[j].x), bf_hi(na[j].x), bf_lo(na[j].y), bf_hi(na[j].y)}; vb[j] = (f32x4){bf_lo(nb[j].x), bf_hi(nb[j].x), bf_lo(nb[j].y), bf_hi(nb[j].y)}; }
        if (p + 1 < p1) { const u32x2* ra = (const u32x2*)(XB + (size_t)(r + 2) * DM) + l; const u32x2* rb = (const u32x2*)(XB + (size_t)(r + 3) * DM) + l;
#pragma unroll
            for (int j = 0; j < 4; ++j) { na[j] = ra[64 * j]; nb[j] = rb[64 * j]; } }
        const int b = r < NLAT ? (r >> 12) : 8;
        if (b != cb) { cb = b; load_mod(gain, mod + (size_t)b * 6144 + 3 * 1024, mod + (size_t)b * 6144 + 4 * 1024, l, ga, sh); }
        float s0 = 0.f, s1 = 0.f;
#pragma unroll
        for (int j = 0; j < 4; ++j) { s0 += (va[j].x * va[j].x + va[j].y * va[j].y) + (va[j].z * va[j].z + va[j].w * va[j].w); s1 += (vb[j].x * vb[j].x + vb[j].y * vb[j].y) + (vb[j].z * vb[j].z + vb[j].w * vb[j].w); }
        const float rs0 = 1.f / sqrtf(wave_sum(s0) * (1.f / DM) + NORM_EPS), rs1 = 1.f / sqrtf(wave_sum(s1) * (1.f / DM) + NORM_EPS);
        unsigned* oa = (unsigned*)(XN8 + (size_t)r * DM) + l; unsigned* ob = (unsigned*)(XN8 + (size_t)(r + 1) * DM) + l;
#pragma unroll
        for (int j = 0; j < 4; ++j) { va[j] = (va[j] * rs0) * ga[j] + sh[j]; vb[j] = (vb[j] * rs1) * ga[j] + sh[j];
            oa[64 * j] = pk4_fp8(va[j].x, va[j].y, va[j].z, va[j].w); ob[64 * j] = pk4_fp8(vb[j].x, vb[j].y, vb[j].z, vb[j].w); }
        int wofs = 16 * l; asm volatile("" : "+v"(wofs));
        float la[16], lb[16];
        router_dot2((const LAS char*)F.lds + wofs, va, vb, la, lb);
        const float pa_ = router_softmax(la, l), pb_ = router_softmax(lb, l);
        if ((l & 3) == 0) { AFF[(size_t)r * 16 + (l >> 2)] = pa_; AFF[(size_t)(r + 1) * 16 + (l >> 2)] = pb_; }
    }
    __syncthreads();
}

__device__ __forceinline__ void mix0_combine_phase(Frame& F, ArgsP ap) {
    const bf16_t* BG = (const bf16_t*)(F.ws + A_BG); const bf16_t* CX = (const bf16_t*)(F.ws + A_CX); const bf16_t* OH = (const bf16_t*)(F.ws + A_OH);
    bf16_t* AO = (bf16_t*)(F.ws + A_XN);
    float d1 = APIN(9)[F.lane] * APIN(10)[F.lane], d2 = APIN(11)[F.lane] * APIN(12)[F.lane];
    const float lam = __expf(wave_sum(d1)) - __expf(wave_sum(d2)) + LAM_INIT;
    const int l = F.lane;
    float cw0[8], cw1[8], cw2[8], sg[8];
#pragma unroll
    for (int i = 0; i < 8; ++i) { cw0[i] = APIN(8)[8 * l + i]; cw1[i] = APIN(8)[512 + 8 * l + i]; cw2[i] = APIN(8)[1024 + 8 * l + i]; sg[i] = APIN(13)[(l & 15) * 8 + i] * (1.f - LAM_INIT); }
    const int h = l >> 4, d0 = (l & 15) * 8;
    int r0, r1; wave_range(MALL, F.gw, F.NGW, r0, r1);
    if (r0 >= r1) return;
    const u32x4 zero = (u32x4){0u, 0u, 0u, 0u};
#define CXROW(r) (*(const u32x4*)(CX + (size_t)(r) * 512 + 8 * l))
    u32x4 c0 = r0 > 0 ? CXROW(r0 - 1) : zero, c1 = CXROW(r0), c2 = r0 + 1 < MALL ? CXROW(r0 + 1) : zero, c3;
    u32x4 bgn = *(const u32x4*)(BG + (size_t)r0 * 512 + 8 * l);
    u32x4 o1n = *(const u32x4*)(OH + (size_t)r0 * DM + (2 * h) * 128 + d0), o2n = *(const u32x4*)(OH + (size_t)r0 * DM + (2 * h + 1) * 128 + d0);
    for (int r = r0; r < r1; ++r) {
        const u32x4 bgv = bgn, o1 = o1n, o2 = o2n;
        c3 = r + 2 < MALL ? CXROW(r + 2) : zero;
        if (r + 1 < r1) { bgn = *(const u32x4*)(BG + (size_t)(r + 1) * 512 + 8 * l);
            o1n = *(const u32x4*)(OH + (size_t)(r + 1) * DM + (2 * h) * 128 + d0); o2n = *(const u32x4*)(OH + (size_t)(r + 1) * DM + (2 * h + 1) * 128 + d0); }
        const bool lat = r < NLAT; const int t = lat ? (r & (SEQ - 1)) : ((r - NLAT) & (CTX - 1)); const int tl = lat ? SEQ : CTX;
        const u32x4 ca = t > 0 ? c0 : zero, cc = t < tl - 1 ? c2 : zero;
        u32x4 ow;
#pragma unroll
        for (int i = 0; i < 4; ++i) {
            const float lo = bf_lo(bgv[i]) * (cw0[2 * i] * bf_lo(ca[i]) + cw1[2 * i] * bf_lo(c1[i]) + cw2[2 * i] * bf_lo(cc[i]));
            const float hi = bf_hi(bgv[i]) * (cw0[2 * i + 1] * bf_hi(ca[i]) + cw1[2 * i + 1] * bf_hi(c1[i]) + cw2[2 * i + 1] * bf_hi(cc[i]));
            ow[i] = cvt_pk_bf16(lo, hi); }
        *(u32x4*)(AO + (size_t)r * DM + 8 * l) = ow;
        c0 = c1; c1 = c2; c2 = c3;
        float ov[8]; float ss = 0.f;
#pragma unroll
        for (int i = 0; i < 4; ++i) { ov[2 * i] = bf_lo(o1[i]) - lam * bf_lo(o2[i]); ov[2 * i + 1] = bf_hi(o1[i]) - lam * bf_hi(o2[i]); ss += ov[2 * i] * ov[2 * i] + ov[2 * i + 1] * ov[2 * i + 1]; }
        ss = row16_sum(ss);
        const float rs = 1.f / sqrtf(ss * (1.f / 128.f) + NORM_EPS);
        u32x4 ow2;
#pragma unroll
        for (int i = 0; i < 4; ++i) ow2[i] = cvt_pk_bf16(ov[2 * i] * rs * sg[2 * i], ov[2 * i + 1] * rs * sg[2 * i + 1]);
        *(u32x4*)(AO + (size_t)r * DM + 512 + h * 128 + d0) = ow2;
    }
#undef CXROW
}

__device__ __forceinline__ unsigned block_excl_scan(unsigned v, LAS unsigned* sc, int tid, unsigned& total) {
    unsigned x = v;
    x += (unsigned)__builtin_amdgcn_update_dpp(0, (int)x, 0x111, 0xf, 0xf, true); x += (unsigned)__builtin_amdgcn_update_dpp(0, (int)x, 0x112, 0xf, 0xf, true);
    x += (unsigned)__builtin_amdgcn_update_dpp(0, (int)x, 0x114, 0xf, 0xf, true); x += (unsigned)__builtin_amdgcn_update_dpp(0, (int)x, 0x118, 0xf, 0xf, true);
    x += (unsigned)__builtin_amdgcn_update_dpp(0, (int)x, 0x142, 0xa, 0xf, false); x += (unsigned)__builtin_amdgcn_update_dpp(0, (int)x, 0x143, 0xc, 0xf, false);
    if ((tid & 63) == 63) sc[tid >> 6] = x;
    __syncthreads();
    unsigned base = 0, tot = 0;
#pragma unroll
    for (int w = 0; w < 8; ++w) { const unsigned s = sc[w]; if (w < (tid >> 6)) base += s; tot += s; }
    __syncthreads();
    total = tot;
    return base + x - v;
}
__device__ __forceinline__ void topk_list(Frame& F, int row0, int n, int e, int cap, int slot_row0) {
    LAS unsigned* sc = (LAS unsigned*)F.lds;
    LAS unsigned* cw = sc + 16;
    const float* AFF = (const float*)(F.ws + WS_AFF); int* POS = (int*)(F.ws + WS_POS); int* IDX = (int*)(F.ws + WS_IDX);
    const int tid = F.tid, wave = tid >> 6;
    const int per = 8; const int base = tid * per; const bool act = base < n;
    unsigned kk[8];
#pragma unroll
    for (int i = 0; i < per; ++i) kk[i] = act ? __builtin_bit_cast(unsigned, AFF[(size_t)(row0 + base + i) * 16 + e]) : 0u;
    unsigned T = 0; int it = 0;
    for (int bit = 30; bit >= 0; --bit, ++it) {
        const unsigned cand = T | (1u << bit);
        unsigned c = 0;
#pragma unroll
        for (int i = 0; i < per; ++i) c += (unsigned)__builtin_popcountll(__ballot(act && kk[i] >= cand));
        if ((tid & 63) == 0) cw[(it & 1) * 8 + wave] = c;
        __syncthreads();
        unsigned tot = 0;
#pragma unroll
        for (int w = 0; w < 8; ++w) tot += cw[(it & 1) * 8 + w];
        if (tot >= (unsigned)cap) T = cand;
    }
    __syncthreads();
    const unsigned prefix = T;
    unsigned ngt_l = 0, neq = 0;
#pragma unroll
    for (int i = 0; i < per; ++i) { ngt_l += (act && kk[i] > prefix) ? 1u : 0u; neq += (act && kk[i] == prefix) ? 1u : 0u; }
    unsigned ngt; (void)block_excl_scan(ngt_l, sc, tid, ngt);
    const unsigned krem = (unsigned)cap - ngt;
    unsigned tot; const unsigned eq_before = block_excl_scan(neq, sc, tid, tot);
    unsigned nsel = 0; unsigned selm = 0; unsigned eqc = eq_before;
#pragma unroll
    for (int i = 0; i < per; ++i) { bool s = false; if (act) { if (kk[i] > prefix) s = true; else if (kk[i] == prefix) { s = eqc < krem; ++eqc; } } if (s) { selm |= 1u << i; ++nsel; } }
    const unsigned sel_before = block_excl_scan(nsel, sc, tid, tot);
    unsigned slot = sel_before;
    if (act) {
#pragma unroll
        for (int i = 0; i < per; ++i) { const int row = row0 + base + i;
            if (selm & (1u << i)) { IDX[e * EROWS0 + slot_row0 + slot] = row; POS[(size_t)row * 16 + e] = slot_row0 + (int)slot; ++slot; }
            else POS[(size_t)row * 16 + e] = -1; }
    }
    __syncthreads();
}
__device__ __forceinline__ void topk_phase(Frame& F, bool with_ctx) {
    const int nl = with_ctx ? 256 : 128;
    for (int lid = F.vcu; lid < nl; lid += F.G) {
        if (lid < 128) { const int b = lid >> 4, e = lid & 15; topk_list(F, b * SEQ, SEQ, e, CAP_L, b * CAP_L); }
        else { const int b = (lid - 128) >> 4, e = lid & 15; topk_list(F, NLAT + b * CTX, CTX, e, CAP_C, NB * CAP_L + b * CAP_C); }
    }
}
__device__ __forceinline__ void gather_phase(Frame& F, int erows) {
    const int* IDX = (const int*)(F.ws + WS_IDX); const bf16_t* XN = (const bf16_t*)(F.ws + A_XN); bf16_t* HS = (bf16_t*)(F.ws + A_HS);
    const int total = NE * erows;
    int r0, r1; wave_range(total, F.gw, F.NGW, r0, r1);
    for (int base = r0; base < r1; base += 64) {
        const int n = r1 - base < 64 ? r1 - base : 64;
        int myidx = 0;
        if (F.lane < n) { const int i = base + F.lane; const int e = i / erows, s = i - e * erows; myidx = __hip_atomic_load(IDX + e * EROWS0 + s, RLX_AGENT); }
        for (int k = 0; k < n; k += 4) {
            u32x4 va[4], vb[4];
#pragma unroll
            for (int q = 0; q < 4; ++q) { const int kk = k + q < n ? k + q : n - 1; const int src = __builtin_amdgcn_readlane(myidx, kk);
                const u32x4* sp = (const u32x4*)(XN + (size_t)src * DM) + F.lane; va[q] = sp[0]; vb[q] = sp[64]; }
#pragma unroll
            for (int q = 0; q < 4; ++q) { if (k + q < n) { u32x4* dp = (u32x4*)(HS + (size_t)(base + k + q) * DM) + F.lane; dp[0] = va[q]; dp[64] = vb[q]; } }
        }
    }
}
__device__ __forceinline__ void moe_combine_phase(Frame& F, int nrows, int erows, const float* mod_cur, bool final_norm,
                                                  const float* gain_next, const float* mod_next, float* outp) {
    const float* AFF = (const float*)(F.ws + WS_AFF); const int* POS = (const int*)(F.ws + WS_POS); const unsigned char* Y = (const unsigned char*)(F.ws + A_HS);
    bf16_t* XN = (bf16_t*)(F.ws + A_XN); bf16_t* XB = (bf16_t*)(F.ws + WS_XB);
    int r0, r1; wave_range(nrows, F.gw, F.NGW, r0, r1);
    if (r0 >= r1) return;
    const int l = F.lane;
    f32x4 v[4], vn[4], ga[4], sh[4], g2[4]; int cb = -1; int pos_n = -1; float af_n = 0.f;
    load_row_bf(XB + (size_t)r0 * DM, l, vn);
    if (l < 16) { pos_n = POS[(size_t)r0 * 16 + l]; af_n = AFF[(size_t)r0 * 16 + l]; }
    for (int r = r0; r < r1; ++r) {
#pragma unroll
        for (int j = 0; j < 4; ++j) v[j] = vn[j];
        const int pos = pos_n; const float af = af_n;
        if (r + 1 < r1) { load_row_bf(XB + (size_t)(r + 1) * DM, l, vn); if (l < 16) { pos_n = POS[(size_t)(r + 1) * 16 + l]; af_n = AFF[(size_t)(r + 1) * 16 + l]; } }
        const int b = r < NLAT ? (r >> 12) : 8;
        if (b != cb) { cb = b;
#pragma unroll
            for (int j = 0; j < 4; ++j) g2[j] = ((const f32x4*)(mod_cur + (size_t)b * 6144 + 5 * 1024))[l + 64 * j];
            if (!final_norm) load_mod(gain_next, mod_next + (size_t)b * 6144, mod_next + (size_t)b * 6144 + 1024, l, ga, sh);
            else {
#pragma unroll
                for (int j = 0; j < 4; ++j) ga[j] = ((const f32x4*)gain_next)[l + 64 * j]; } }
        f32x4 acc[4];
#pragma unroll
        for (int j = 0; j < 4; ++j) acc[j] = (f32x4){0.f, 0.f, 0.f, 0.f};
        unsigned long long m = __ballot(pos >= 0);
        while (m) {
            const int e0 = __builtin_ctzll(m); m &= m - 1; const bool two = m != 0; const int e1 = two ? __builtin_ctzll(m) : e0; if (two) m &= m - 1;
            const int p0 = __builtin_amdgcn_readlane(pos, e0), p1 = __builtin_amdgcn_readlane(pos, e1);
            const float w0 = __builtin_bit_cast(float, __builtin_amdgcn_readlane(__builtin_bit_cast(int, af), e0));
            const float w1 = two ? __builtin_bit_cast(float, __builtin_amdgcn_readlane(__builtin_bit_cast(int, af), e1)) : 0.f;
            const unsigned* y0 = (const unsigned*)(Y + ((size_t)e0 * erows + p0) * DM) + l; const unsigned* y1 = (const unsigned*)(Y + ((size_t)e1 * erows + p1) * DM) + l;
            unsigned ya[4], yb[4];
#pragma unroll
            for (int j = 0; j < 4; ++j) { ya[j] = y0[64 * j]; yb[j] = y1[64 * j]; }
#pragma unroll
            for (int j = 0; j < 4; ++j) {
                const f32x2 a01 = __builtin_amdgcn_cvt_pk_f32_fp8((int)ya[j], false), a23 = __builtin_amdgcn_cvt_pk_f32_fp8((int)ya[j], true);
                const f32x2 b01 = __builtin_amdgcn_cvt_pk_f32_fp8((int)yb[j], false), b23 = __builtin_amdgcn_cvt_pk_f32_fp8((int)yb[j], true);
                acc[j].x += w0 * a01.x + w1 * b01.x; acc[j].y += w0 * a01.y + w1 * b01.y; acc[j].z += w0 * a23.x + w1 * b23.x; acc[j].w += w0 * a23.y + w1 * b23.y; }
        }
#pragma unroll
        for (int j = 0; j < 4; ++j) v[j] = v[j] + g2[j] * acc[j] * (1.f / 16.f);
        if (!final_norm) {
            u32x2* xo = (u32x2*)(XB + (size_t)r * DM) + l;
#pragma unroll
            for (int j = 0; j < 4; ++j) { u32x2 w; w.x = cvt_pk_bf16(v[j].x, v[j].y); w.y = cvt_pk_bf16(v[j].z, v[j].w); xo[64 * j] = w; }
            modulate_row(v, ga, sh, l, XN + (size_t)r * DM);
        } else {
            float s = 0.f;
#pragma unroll
            for (int j = 0; j < 4; ++j) s += (v[j].x * v[j].x + v[j].y * v[j].y) + (v[j].z * v[j].z + v[j].w * v[j].w);
            const float rs = 1.f / sqrtf(wave_sum(s) * (1.f / DM) + NORM_EPS);
            f32x4* xo = (f32x4*)(outp + (size_t)r * DM) + l;
#pragma unroll
            for (int j = 0; j < 4; ++j) xo[64 * j] = (v[j] * rs) * ga[j];
        }
    }
}

__device__ __forceinline__ void attn0_phase(Frame& F, const bool rerun) {
    const bf16_t* Q0 = (const bf16_t*)(F.ws + A_Q0); const bf16_t* K0 = (const bf16_t*)(F.ws + A_K0); const bf16_t* V0 = (const bf16_t*)(F.ws + A_V0);
    bf16_t* OH = (bf16_t*)(F.ws + A_OH);
    const int per = (1024 + F.G - 1) / F.G;
    const int u0 = F.vcu * per, nlat = u0 >= 1024 ? 0 : (u0 + per > 1024 ? 1024 - u0 : per), nctx = F.vcu < 64 ? 1 : 0, vcu = F.vcu;
    auto gen = [=](int i, att::UnitDesc& U) {
        int b, sh, qrow0;
        if (i < nlat) { const int u = u0 + i; b = u >> 7; sh = (u & 127) >> 4; const int qb = u & 15; qrow0 = b * SEQ + qb * 256; U.NT = 68; }
        else { b = vcu >> 3; sh = vcu & 7; qrow0 = NLAT + b * CTX; U.NT = 4; }
        U.Q = Q0 + (size_t)qrow0 * 512 + sh * 64; U.ldq = 512;
        U.K = K0 + sh * 64; U.V = V0 + (sh >> 1) * 128; U.ldk = 512; U.ldv = 512;
        U.O = OH + (size_t)qrow0 * DM + sh * 128; U.ldo = DM;
        U.ctx_row0 = NLAT + b * CTX; U.lat_row0 = b * SEQ; U.lat_t0 = 0; U.q0 = 0; U.sink = nullptr;
    };
#if ATT0_STREAM
    att::attn_stream<128, false>(gen, nlat + nctx, (LAS char*)F.lds, F.tid);
#else
    for (int i = 0; i < nlat + nctx; ++i) { att::UnitDesc U; gen(i, U); att::attn_unit_pp<128, false>(U, (LAS char*)F.lds, F.tid); }
#endif
}
__device__ __forceinline__ void attn1_phase(Frame& F, const float* sink) {
    const bf16_t* Q1 = (const bf16_t*)(F.ws + A_Q1); const bf16_t* K1 = (const bf16_t*)(F.ws + A_K1); const bf16_t* V1 = (const bf16_t*)(F.ws + A_V1);
    bf16_t* AO = (bf16_t*)(F.ws + A_XN);
    const int per = (2048 + F.G - 1) / F.G;
    const int u0 = F.vcu * per, n = u0 >= 2048 ? 0 : (u0 + per > 2048 ? 2048 - u0 : per);
    auto gen = [=](int i, att::UnitDesc& U) {
        const int u = u0 + i;
        const int b = u >> 8, kvh = (u & 255) >> 6, qb = u & 63, q0 = qb * 64, qrow0 = b * SEQ + q0;
        U.Q = Q1 + (size_t)qrow0 * DM + kvh * 256; U.ldq = DM;
        U.K = K1 + kvh * 64; U.V = V1 + kvh * 64; U.ldk = 256; U.ldv = 256;
        U.O = AO + (size_t)qrow0 * DM + kvh * 256; U.ldo = DM;
        const int lo = q0 - 128 < 0 ? 0 : q0 - 128, hi = q0 + 192 > SEQ ? SEQ : q0 + 192;
        U.ctx_row0 = NLAT + b * CTX; U.lat_row0 = b * SEQ; U.lat_t0 = lo >> 6; U.NT = 4 + ((hi - lo) >> 6);
        U.q0 = q0; U.sink = sink + kvh * 4;
    };
#if ATT1_STREAM
    att::attn_stream<64, true>(gen, n, (LAS char*)F.lds, F.tid);
#else
    for (int i = 0; i < n; ++i) { att::UnitDesc U; gen(i, U); att::attn_unit_pp<64, true>(U, (LAS char*)F.lds, F.tid); }
#endif
}

constexpr int N_PHASES = 21;
#ifndef PH_EN
#define PH_EN(p) ((p) != 8 && (p) != 17)
#endif
#ifndef GEMM_EN
#define GEMM_EN 1
#endif
__global__ void __launch_bounds__(NTHREADS, 2) fwd_kernel(Args args) {
    extern __shared__ __attribute__((aligned(16))) unsigned char lds_raw[];
    Frame F;
    F.lds = (LAS unsigned char*)lds_raw;
    F.tid = threadIdx.x; F.lane = F.tid & 63; F.wave = __builtin_amdgcn_readfirstlane(F.tid >> 6);
    F.G = gridDim.x; { const int bx = blockIdx.x; F.vcu = (F.G % 8 == 0) ? (bx % 8) * (F.G / 8) + bx / 8 : bx; }
    F.gw = F.vcu * NWAVES + F.wave; F.NGW = F.G * NWAVES;
    F.ws = args.ws;
    unsigned char* ws = args.ws;
    volatile LAS unsigned* MISC = (volatile LAS unsigned*)(F.lds + MISC_OFF);
    for (int u = F.tid; u < (LDS_BYTES - RING_BYTES) / 4; u += NTHREADS) ((LAS unsigned*)(F.lds + RING_BYTES))[u] = 0u;
    __syncthreads();
    const int nprog = args.nprog;
    XcdBarrier bar; bar.bar = (unsigned*)(ws + WS_CTL) + CW_BAR; bar.x = 0; bar.st = nullptr;
    if (nprog > 1) bar = xcd_barrier_post((unsigned*)(ws + WS_CTL) + CW_BAR, MISC + 8);

    const Frame F0 = F;
    for (int pi = 0; pi < nprog; ++pi) {
        F = F0; asm volatile("" : "+s"(F.wave), "+s"(F.vcu), "+s"(F.gw));
        { unsigned ones = ~0u; asm volatile("" : "+s"(ones));
          F.lane = (int)__builtin_amdgcn_mbcnt_hi(ones, __builtin_amdgcn_mbcnt_lo(ones, 0u)); F.tid = F.wave * 64 + F.lane; }
        ArgsP ap = (ArgsP)__builtin_amdgcn_kernarg_segment_ptr(); asm volatile("" : "+s"(ap));
        { GAS unsigned char* wsg = ap->ws; asm volatile("" : "+s"(wsg)); F.ws = (unsigned char*)wsg; }
        ws = F.ws;
        const int phx = ap->prog[pi], ph = phx & 31; const bool rerun = (phx & 32) != 0;
        const float* MOD0 = (const float*)(ws + WS_MOD); const float* MOD1 = MOD0 + 9 * 6144;
        bool is_gemm = false, is_gemm8 = false; bool perm = true; pg8::Sched S; pg8::Epi E;
        S.G = F.G; S.c = (int)blockIdx.x; S.tpe = 1 << 20; S.pitch = 2 * DM; S.wgm = 8; S.hot = false; S.gidx = nullptr; S.A = nullptr; S.B = nullptr; S.nM = 0; S.nN = 0;
        E.kind = 0; E.layer = 0; E.f8out = false; E.wsc = 1.f; E.ws = ws; E.xin_lat = nullptr; E.xin_ctx = nullptr;
        switch (ph) {
        case 0: if (!PH_EN(0)) break; p0_prologue(F, ap, rerun); break;
        case 1: if (!PH_EN(1)) break; norm1_phase(F, APIN(0), APIN(2), APIN(6), APIN(5), APIN(21)); break;
        case 2: if (!PH_EN(2)) break; is_gemm = true; S.A = (const char*)(ws + A_XN); S.B = (const char*)(ws + W_IN); S.nM = MALL / 256; S.nN = NWIN / 256; E.kind = pg8::EK_IN0; break;
        case 3: if (!PH_EN(3)) break; attn0_phase(F, rerun); break;
        case 4: if (!PH_EN(4)) break; mix0_combine_phase(F, ap); break;
        case 5: if (!PH_EN(5)) break; is_gemm = true; S.A = (const char*)(ws + A_XN); S.B = (const char*)(ws + W_OUT0); S.nM = MALL / 256; S.nN = DM / 256;
                E.kind = pg8::EK_OUT; E.layer = 0; E.xin_lat = APIN(0); E.xin_ctx = APIN(2); break;
        case 6: if (!PH_EN(6)) break; norm2_router_phase(F, MALL, APIN(15), MOD0, APIN(16)); break;
        case 7: if (!PH_EN(7)) break; topk_phase(F, true); break;
        case 8: if (!PH_EN(8)) break; gather_phase(F, EROWS0); break;
        case 9: if (!PH_EN(9)) break; is_gemm8 = true; S.pitch = DM; S.wgm = 4; E.wsc = 1.f / 32.f; E.f8out = true; S.A = (const char*)(ws + A_XN); S.gidx = (const int*)(ws + WS_IDX); S.B = (const char*)(ws + W_GU0); S.nM = NE * EROWS0 / 256; S.nN = 2 * FF / 256; S.tpe = EROWS0 / 256; E.kind = pg8::EK_GU; break;
        case 10: if (!PH_EN(10)) break; is_gemm8 = true; S.pitch = DM; E.wsc = 1.f / 32.f; S.A = (const char*)(ws + A_ACT); S.B = (const char*)(ws + W_D0); S.nM = NE * EROWS0 / 256; S.nN = DM / 256; S.tpe = EROWS0 / 256; E.kind = pg8::EK_DOWN; break;
        case 11: if (!PH_EN(11)) break; moe_combine_phase(F, MALL, EROWS0, MOD0, false, APIN(22), MOD1, nullptr); break;
        case 12: if (!PH_EN(12)) break; is_gemm = true; S.A = (const char*)(ws + A_XN); S.B = (const char*)(ws + W_QKV); S.nM = MALL / 256; S.nN = NQKV1 / 256; E.kind = pg8::EK_QKV1; break;
        case 13: if (!PH_EN(13)) break; attn1_phase(F, APIN(24)); break;
        case 14: if (!PH_EN(14)) break; is_gemm = true; S.A = (const char*)(ws + A_XN); S.B = (const char*)(ws + W_OUT1); S.nM = NLAT / 256; S.nN = DM / 256;
                E.kind = pg8::EK_OUT; E.layer = 1; break;
        case 15: if (!PH_EN(15)) break; norm2_router_phase(F, NLAT, APIN(26), MOD1, APIN(27)); break;
        case 16: if (!PH_EN(16)) break; topk_phase(F, false); break;
        case 17: if (!PH_EN(17)) break; gather_phase(F, EROWS1); break;
        case 18: if (!PH_EN(18)) break; is_gemm8 = true; S.pitch = DM; S.wgm = 4; E.wsc = 1.f / 32.f; E.f8out = true; S.A = (const char*)(ws + A_XN); S.gidx = (const int*)(ws + WS_IDX); S.B = (const char*)(ws + W_GU1); S.nM = NE * EROWS1 / 256; S.nN = 2 * FF / 256; S.tpe = EROWS1 / 256; E.kind = pg8::EK_GU; break;
        case 19: if (!PH_EN(19)) break; is_gemm8 = true; S.pitch = DM; E.wsc = 1.f / 32.f; S.A = (const char*)(ws + A_ACT); S.B = (const char*)(ws + W_D1); S.nM = NE * EROWS1 / 256; S.nN = DM / 256; S.tpe = EROWS1 / 256; E.kind = pg8::EK_DOWN; break;
        case 20: if (!PH_EN(20)) break; moe_combine_phase(F, NLAT, EROWS1, MOD1, true, APIN(31), nullptr, APOUT); break;
#if PROBE_MFMA
        case 21: {
            typedef int v8i_ __attribute__((ext_vector_type(8))); typedef int v6i_ __attribute__((ext_vector_type(6)));
            int z_ = F.lane; asm volatile("" : "+v"(z_));
#if PROBE_MFMA == 1 || PROBE_MFMA == 5
            bf16x8 OA, OB;
#pragma unroll
            for (int q = 0; q < 8; ++q) { OA[q] = (short)(z_ + q); OB[q] = (short)(z_ + 2 * q); }
#elif PROBE_MFMA == 4
            v6i_ OA, OB;
#pragma unroll
            for (int q = 0; q < 6; ++q) { OA[q] = z_ + q; OB[q] = z_ + 2 * q; }
#else
            v8i_ OA, OB;
#pragma unroll
            for (int q = 0; q < 8; ++q) { OA[q] = z_ + q; OB[q] = z_ + 2 * q; }
#endif
#if PROBE_MFMA == 3 || PROBE_MFMA == 5
            f32x16 c0 = f32x16{}, c1 = c0, c2 = c0, c3 = c0;
#else
            f32x4 c0 = {0, 0, 0, 0}, c1 = c0, c2 = c0, c3 = c0;
#endif
#if PROBE_MFMA == 1
#define MF_ "v_mfma_f32_16x16x32_bf16"
#define MS_ ""
#elif PROBE_MFMA == 2
#define MF_ "v_mfma_f32_16x16x128_f8f6f4"
#define MS_ ""
#elif PROBE_MFMA == 3
#define MF_ "v_mfma_f32_32x32x64_f8f6f4"
#define MS_ ""
#elif PROBE_MFMA == 4
#define MF_ "v_mfma_f32_16x16x128_f8f6f4"
#define MS_ " cbsz:2 blgp:2"
#else
#define MF_ "v_mfma_f32_32x32x16_bf16"
#define MS_ ""
#endif
            asm volatile("" : "+v"(OA), "+v"(OB));
            for (int i = 0; i < 2000; ++i)
                asm volatile(MF_ " %0, %4, %5, %0" MS_ "\n\t" MF_ " %1, %4, %5, %1" MS_ "\n\t" MF_ " %2, %4, %5, %2" MS_ "\n\t" MF_ " %3, %4, %5, %3" MS_ : "+v"(c0), "+v"(c1), "+v"(c2), "+v"(c3) : "v"(OA), "v"(OB));
            asm volatile("s_nop 15\n\ts_nop 15" ::: "memory");
            if (c0[0] + c1[0] + c2[0] + c3[0] == 123.456f) ((float*)(ws + A_OH + SZ_XN + 4096))[F.tid] = 1.f;
        } break;
#endif
        default: break;
        }
#if PROBE_ABL == 9 || PROBE_ABL >= 11
        if (rerun) { E.kind = pg8::EK_NONE; if (PROBE_ABL >= 11) S.hot = true; }
#endif
        if (GEMM_EN && is_gemm) pg8::gemm_phase(F.lds, F.tid, perm, S, E);
        if (GEMM_EN && is_gemm8) pg8::gemm_phase8(F.lds, F.tid, perm, S, E);
        if ((is_gemm || is_gemm8) && !rerun) {
            int flo = 0, fhi = 0;
            if (ph == 2) { flo = wc::F1_LO; fhi = wc::F1_HI; } else if (ph == 5) { flo = wc::F1_HI; fhi = wc::F2_HI; }
            else if (ph == 9) { flo = wc::F3_LO; fhi = wc::F3_HI; } else if (ph == 10) { flo = wc::F3_HI; fhi = wc::F4_HI; } else if (ph == 12) { flo = wc::F4_HI; fhi = wc::F5_HI; }
            const int nwg = S.nM * S.nN, rounds = (nwg + F.G - 1) / F.G, nlast = nwg - (rounds - 1) * F.G, q = (int)blockIdx.x - nlast;
            if (fhi > flo) { if (nlast == F.G) weight_items(F, ap, flo, fhi, F.gw, F.NGW);
                             else if (q >= 0) weight_items(F, ap, flo, fhi, q * NWAVES + F.wave, (F.G - nlast) * NWAVES); }
        }
        if (pi + 1 < nprog) { XcdBarrier bl = bar; { GAS unsigned* bp = (GAS unsigned*)(ap->ws + WS_CTL) + CW_BAR; asm volatile("" : "+s"(bp), "+s"(bl.x)); bl.bar = (unsigned*)bp; }
            xcd_barrier(bl);
#if PROBE_BAR2
            xcd_barrier(bl);
#endif
        }
    }
}

extern "C" void kernel_launch(void* const* d_in, const int* in_sizes, int n_in, void* d_out, int out_size, void* d_ws, size_t ws_size, hipStream_t stream) {
    static int grid = 0;
    if (grid == 0) {
        if (n_in != 32 || in_sizes[0] != NLAT * DM || out_size != NLAT * DM || ws_size < WS_END) {
            fprintf(stderr, "kernel_launch: unexpected shapes: n_in %d in0 %d out %d ws %zu (need %zu)\n", n_in, n_in > 0 ? in_sizes[0] : -1, out_size, ws_size, (size_t)WS_END); grid = -1; return; }
        int dev = 0, cus = 0, per_cu = 0;
        if (hipGetDevice(&dev) != hipSuccess || hipDeviceGetAttribute(&cus, hipDeviceAttributeMultiprocessorCount, dev) != hipSuccess) { grid = -1; return; }
        if (hipFuncSetAttribute((const void*)fwd_kernel, hipFuncAttributeMaxDynamicSharedMemorySize, LDS_BYTES) != hipSuccess) { fprintf(stderr, "kernel_launch: hipFuncSetAttribute failed\n"); grid = -1; return; }
        if (hipOccupancyMaxActiveBlocksPerMultiprocessor(&per_cu, (const void*)fwd_kernel, NTHREADS, LDS_BYTES) != hipSuccess || per_cu < 1) {
            fprintf(stderr, "kernel_launch: occupancy query reports %d blocks per CU\n", per_cu); (void)hipGetLastError(); grid = -1; return; }
        if (cus < 192 || cus % 8 != 0) { fprintf(stderr, "kernel_launch: built for >= 192 CUs in multiples of 8, got %d\n", cus); grid = -1; return; }
        grid = cus;
    }
    if (grid < 0) return;
    (void)hipMemsetAsync((char*)d_ws + WS_CTL, 0, CTL_ZERO_BYTES, stream);
    Args a{};
    for (int i = 0; i < 32; ++i) a.in[i] = (const float*)d_in[i];
    a.out = (float*)d_out; a.ws = (unsigned char*)d_ws;
#if MK_N_LAUNCHES == 1
    { int n = 0; for (int p = 0; p < N_PHASES; ++p) { if (p == 8 || p == 17) continue; a.prog[n++] = (unsigned char)p; if ((PROBE_DUP >> p) & 1u) a.prog[n++] = (unsigned char)(p | 32); }
      if (PROBE_MFMA) a.prog[n++] = 21;
      a.nprog = n; }
    hipLaunchKernelGGL(fwd_kernel, dim3(grid), dim3(NTHREADS), LDS_BYTES, stream, a);
#else
    for (int p = 0; p < N_PHASES; ++p) { a.nprog = 1; a.prog[0] = (unsigned char)p; hipLaunchKernelGGL(fwd_kernel, dim3(grid), dim3(NTHREADS), LDS_BYTES, stream, a); }
#endif
}
```

```cpp
#include <hip/hip_runtime.h>
#include <hip/hip_bf16.h>
#include <cstdio>
#include <cstdint>

#ifndef MK_N_LAUNCHES
#define MK_N_LAUNCHES 1
#endif

#ifndef PROBE_ABL
#define PROBE_ABL 0
#endif
#ifndef PROBE_MFMA
#define PROBE_MFMA 0
#endif
#ifndef PROBE_DUP
#define ATT0_PAIR 1
#define ATT0_PG 1
#define ATT0_STREAM 0
#define ATT1_STREAM 1
#ifndef ALG_G
#define ALG_G 4
#endif
#ifndef ALG_G8
#define ALG_G8 9
#endif
#ifndef ALG_A0
#define ALG_A0 0
#endif
#ifndef ALG_A1
#define ALG_A1 0
#endif
#define HOT_STR2(x) #x
#define HOT_STR(x) HOT_STR2(x)
#define HOT_ALIGN(n) asm volatile(".p2align 8\n\t.rept " HOT_STR(n) "\n\ts_nop 0\n\t.endr")
#define PROBE_BAR2 0
#define PROBE_DUP 0u
#endif

#define GAS __attribute__((address_space(1)))
#define LAS __attribute__((address_space(3)))
typedef unsigned short bf16_t;
typedef short bf16x8 __attribute__((ext_vector_type(8)));
typedef short s16x4 __attribute__((ext_vector_type(4)));
typedef float f32x2 __attribute__((ext_vector_type(2)));
typedef float f32x4 __attribute__((ext_vector_type(4)));
typedef float f32x16 __attribute__((ext_vector_type(16)));
typedef unsigned u32x2 __attribute__((ext_vector_type(2)));
typedef unsigned u32x4 __attribute__((ext_vector_type(4)));
typedef GAS unsigned gu32;
typedef int v8i32 __attribute__((ext_vector_type(8)));
typedef int v4i32 __attribute__((ext_vector_type(4)));

constexpr int DM = 1024, NB = 8, SEQ = 4096, CTX = 256;
constexpr int NLAT = NB * SEQ;
constexpr int NCTX = NB * CTX;
constexpr int MALL = NLAT + NCTX;
constexpr int NE = 16, FF = 1024;
constexpr int CAP_L = 512, CAP_C = 32;
constexpr int EROWS0 = NB * CAP_L + NB * CAP_C;
constexpr int EROWS1 = NB * CAP_L;
constexpr int NWIN = 3072, NQKV1 = 1536;
constexpr float NORM_EPS = 1e-6f;
constexpr float LAM_INIT = 0.2f;
constexpr int NWAVES = 8, NTHREADS = 512;

constexpr size_t KiB = 1024, MiB = 1024 * 1024;
constexpr size_t WS_CTL = 0, CTL_ZERO_BYTES = 1 * MiB;
constexpr int CW_BAR = 4096;
constexpr size_t WS_MOD = 64 * KiB;
constexpr size_t MOD_BYTES = 2 * 9 * 6144 * 4;
static_assert(WS_MOD + MOD_BYTES <= 640 * KiB, "mod");
constexpr size_t WS_ROPE = 1 * MiB;
constexpr size_t WS_PART = WS_ROPE + 16 * KiB;
constexpr size_t WS_AFF = WS_PART + (size_t)2 * 4 * 9 * 6144 * 4;
constexpr size_t WS_POS = WS_AFF + (size_t)MALL * 16 * 4;
constexpr size_t WS_IDX = WS_POS + (size_t)MALL * 16 * 4;
constexpr size_t WS_XB = (WS_IDX + (size_t)NE * EROWS0 * 4 + 4096 + 4095) / 4096 * 4096;
constexpr size_t WS_W = WS_XB + (size_t)MALL * DM * 2;
constexpr size_t W_IN = WS_W;
constexpr size_t W_OUT0 = W_IN + (size_t)NWIN * DM * 2;
constexpr size_t W_GU0 = W_OUT0 + (size_t)DM * DM * 2;
constexpr size_t W_D0 = W_GU0 + (size_t)NE * 2 * FF * DM;
constexpr size_t W_QKV = W_D0 + (size_t)NE * DM * FF;
constexpr size_t W_OUT1 = W_QKV + (size_t)NQKV1 * DM * 2;
constexpr size_t W_GU1 = W_OUT1 + (size_t)DM * DM * 2;
constexpr size_t W_D1 = W_GU1 + (size_t)NE * 2 * FF * DM;
constexpr size_t WS_ARENA = W_D1 + (size_t)NE * DM * FF;
constexpr size_t SZ_XN = (size_t)MALL * DM * 2;
constexpr size_t SZ_H5 = (size_t)MALL * 512 * 2;
constexpr size_t SZ_E = (size_t)NE * EROWS0 * DM * 2;
constexpr size_t A_XN = WS_ARENA;
constexpr size_t A_BG = A_XN + SZ_XN, A_CX = A_BG + SZ_H5, A_Q0 = A_CX + SZ_H5, A_K0 = A_Q0 + SZ_H5, A_V0 = A_K0 + SZ_H5;
constexpr size_t A_OH = A_V0 + SZ_H5;
constexpr size_t A_HS = A_XN + SZ_XN;
constexpr size_t A_ACT = A_HS + SZ_E;
constexpr size_t A_Q1 = A_XN + SZ_XN;
constexpr size_t A_K1 = A_Q1 + SZ_XN;
constexpr size_t A_V1 = A_K1 + (size_t)MALL * 256 * 2;
constexpr size_t WS_END = A_OH + SZ_XN + 1 * MiB;
static_assert(A_ACT + SZ_E / 2 <= WS_END && A_V1 + (size_t)MALL * 256 * 2 <= WS_END, "arena");
static_assert(WS_END <= 600000000ull, "workspace budget");

constexpr int RING_BYTES = 147456;
constexpr int MISC_OFF = RING_BYTES + 320;
constexpr int GT_OFF = RING_BYTES + 1024;
constexpr int LDS_BYTES = 163840;

#define RLX_AGENT __ATOMIC_RELAXED, __HIP_MEMORY_SCOPE_AGENT
#define LDS_WAIT() asm volatile("s_waitcnt lgkmcnt(0)" ::: "memory")
#define VM_WAIT() asm volatile("s_waitcnt vmcnt(0)" ::: "memory")

__device__ __forceinline__ unsigned f2bf(float f) { unsigned u = __builtin_bit_cast(unsigned, f); return (u + 0x7fffu + ((u >> 16) & 1u)) >> 16; }
__device__ __forceinline__ unsigned pk2(float lo, float hi) { return f2bf(lo) | (f2bf(hi) << 16); }
__device__ __forceinline__ unsigned cvt_pk_bf16(float lo, float hi) { unsigned r; asm volatile("v_cvt_pk_bf16_f32 %0, %1, %2" : "=v"(r) : "v"(lo), "v"(hi)); return r; }
__device__ __forceinline__ unsigned pk4_fp8(float a, float b, float c, float d) {
    a = fminf(fmaxf(a, -448.f), 448.f); b = fminf(fmaxf(b, -448.f), 448.f); c = fminf(fmaxf(c, -448.f), 448.f); d = fminf(fmaxf(d, -448.f), 448.f);
    int w = 0; w = __builtin_amdgcn_cvt_pk_fp8_f32(a, b, w, false); w = __builtin_amdgcn_cvt_pk_fp8_f32(c, d, w, true); return (unsigned)w;
}
__device__ __forceinline__ float bf_lo(unsigned w) { return __builtin_bit_cast(float, w << 16); }
__device__ __forceinline__ float bf_hi(unsigned w) { return __builtin_bit_cast(float, w & 0xffff0000u); }
template <int CTRL> __device__ __forceinline__ float dpp_f(float x) { return __builtin_bit_cast(float, __builtin_amdgcn_mov_dpp(__builtin_bit_cast(int, x), CTRL, 0xf, 0xf, true)); }
__device__ __forceinline__ float row16_sum(float v) { v += dpp_f<0xB1>(v); v += dpp_f<0x4E>(v); v += dpp_f<0x141>(v); v += dpp_f<0x128>(v); return v; }
__device__ __forceinline__ float xsum16(float v) { auto rr = __builtin_amdgcn_permlane16_swap(__float_as_uint(v), __float_as_uint(v), false, false); return __uint_as_float(rr[0]) + __uint_as_float(rr[1]); }
__device__ __forceinline__ float xsum32(float v) { auto rr = __builtin_amdgcn_permlane32_swap(__float_as_uint(v), __float_as_uint(v), false, false); return __uint_as_float(rr[0]) + __uint_as_float(rr[1]); }
__device__ __forceinline__ float xmax16(float v) { auto rr = __builtin_amdgcn_permlane16_swap(__float_as_uint(v), __float_as_uint(v), false, false); return fmaxf(__uint_as_float(rr[0]), __uint_as_float(rr[1])); }
__device__ __forceinline__ float xmax32(float v) { auto rr = __builtin_amdgcn_permlane32_swap(__float_as_uint(v), __float_as_uint(v), false, false); return fmaxf(__uint_as_float(rr[0]), __uint_as_float(rr[1])); }
__device__ __forceinline__ float wave_sum(float v) { v = row16_sum(v); v = xsum16(v); v = xsum32(v); return v; }

#define XB_TMO      128
#define XB_XCNT(j)  (256  + 64 * (j))
#define XB_XSUB(j)  (1280 + 64 * (j))
#define XB_XGEN(j)  (2304 + 64 * (j))
#define XB_TOP      3328
#define XB_TOPGEN   3392
#define XCD_BAR_WORDS 3456
#define XB_SPIN_CAP (1u << 20)
__device__ __forceinline__ unsigned xb_ld(unsigned* p)              { return __hip_atomic_load(p, __ATOMIC_RELAXED, __HIP_MEMORY_SCOPE_AGENT); }
__device__ __forceinline__ unsigned xb_add(unsigned* p, unsigned v) { return __hip_atomic_fetch_add(p, v, __ATOMIC_RELAXED, __HIP_MEMORY_SCOPE_AGENT); }
__device__ __forceinline__ unsigned xb_xcc_id() { return (unsigned)__builtin_amdgcn_s_getreg((3 << 11) | 20) & 0xFu; }
#define XB_SPIN(cond, bar) do { unsigned _sp = 0; while (cond) { __builtin_amdgcn_s_sleep(1); \
    if ((++_sp & 255u) == 0u) { if (xb_ld(&(bar)[XB_TMO])) break; if (_sp > XB_SPIN_CAP) { atomicAdd(&(bar)[XB_TMO], 1u); break; } } } } while (0)
struct XcdBarrier { unsigned* bar; unsigned x; volatile LAS unsigned* st; };
__device__ __forceinline__ XcdBarrier xcd_barrier_post(unsigned* bar, volatile LAS unsigned* st) {
    XcdBarrier b; b.bar = bar; b.x = xb_xcc_id(); b.st = st;
    if (threadIdx.x == 0) (void)xb_add(&bar[XB_XCNT(b.x)], 1u);
    return b;
}
__device__ __forceinline__ void xcd_barrier_complete(unsigned* bar, unsigned x, unsigned& nloc, unsigned& nx) {
    const unsigned G = gridDim.x * gridDim.y * gridDim.z;
    unsigned sum, cnt, mine, sp = 0u;
    for (;;) {
        sum = 0u; cnt = 0u; mine = 0u;
#pragma unroll
        for (unsigned j = 0; j < 16; ++j) { const unsigned c = xb_ld(&bar[XB_XCNT(j)]); sum += c; cnt += (c > 0u) ? 1u : 0u; mine = (j == x) ? c : mine; }
        if (sum == G) break;
        __builtin_amdgcn_s_sleep(1);
        if ((++sp & 255u) == 0u) { if (xb_ld(&bar[XB_TMO])) break; if (sp > XB_SPIN_CAP) { atomicAdd(&bar[XB_TMO], 1u); break; } }
    }
    nloc = mine > 0u ? mine : 1u; nx = cnt > 0u ? cnt : 1u;
}
__device__ __forceinline__ void xcd_barrier(const XcdBarrier& b) {
    asm volatile("s_waitcnt vmcnt(0)" ::: "memory");
    __syncthreads();
    if (threadIdx.x == 0) {
        unsigned* bar = b.bar;
        __builtin_amdgcn_s_waitcnt(0);
        unsigned nloc = b.st[0], nx = b.st[1];
        if (nloc == 0u) { xcd_barrier_complete(bar, b.x, nloc, nx); b.st[0] = nloc; b.st[1] = nx; }
        const unsigned old = xb_add(&bar[XB_XSUB(b.x)], 1u);
        const unsigned gen = old / nloc;
        if (old + 1u == (gen + 1u) * nloc) {
            __builtin_amdgcn_fence(__ATOMIC_RELEASE, "agent");
            asm volatile("s_waitcnt vmcnt(0)" ::: "memory");
            const unsigned og = xb_add(&bar[XB_TOP], 1u);
            const unsigned target = (og / nx + 1u) * nx;
            if (og + 1u != target) XB_SPIN((int)(xb_ld(&bar[XB_TOP]) - target) < 0, bar);
            (void)xb_add(&bar[XB_XGEN(b.x)], 1u);
            __builtin_amdgcn_fence(__ATOMIC_ACQUIRE, "agent");
            asm volatile("s_waitcnt vmcnt(0)" ::: "memory");
        } else {
            XB_SPIN(xb_ld(&bar[XB_XGEN(b.x)]) == gen, bar);
            __builtin_amdgcn_fence(__ATOMIC_ACQUIRE, "agent");
            asm volatile("s_waitcnt vmcnt(0)" ::: "memory");
        }
    }
    __syncthreads();
}

__device__ __forceinline__ int fresh_lane() { unsigned ones = ~0u; asm volatile("" : "+s"(ones)); return (int)__builtin_amdgcn_mbcnt_hi(ones, __builtin_amdgcn_mbcnt_lo(ones, 0u)); }
namespace pg8 {
constexpr int BM = 256, BK = 64, HALF = 128, HTB = HALF * BK * 2, NXCD = 8, WGM = 8;
__device__ __forceinline__ int lds_byte(int r, int c) { const int st = (r >> 4) * 2 + (c >> 5), rr = r & 15, cc = c & 31, ob = rr * 64 + cc * 2; return st * 1024 + (ob ^ (((ob >> 9) & 1) << 5)); }
__device__ __forceinline__ void stage_rc(int b, int& R, int& C) { const int st = b / 1024, sb = b % 1024, swz = sb ^ (((sb >> 9) & 1) << 5); R = (st >> 1) * 16 + swz / 64; C = (st & 1) * 32 + (swz % 64) / 2; }
__device__ __forceinline__ int perm32(int rho) { const int n = rho >> 4, i = rho & 15; return 8 * (i >> 2) + 4 * n + (i & 3); }

struct Unit { int pm, pn; const char* a; const char* b; };
struct Sched {
    const char* A; const char* B; int nM, nN, tpe, G, c, pitch, wgm; bool hot; const int* gidx;
    __device__ __forceinline__ bool next(int i, Unit& u) const {
        const int nwg = nM * nN; const long L = (long)i * G + c; if (L >= nwg) return false;
        int wgid = (int)L; { const int q = nwg / NXCD, r = nwg % NXCD, xcd = wgid % NXCD, off = wgid / NXCD; wgid = (xcd < r ? xcd * (q + 1) : r * (q + 1) + (xcd - r) * q) + off; }
        const int nig = wgm * nN, gid = wgid / nig, fm = gid * wgm, gsz = (nM - fm) < wgm ? (nM - fm) : wgm;
        u.pm = fm + ((wgid % nig) % gsz); u.pn = (wgid % nig) / gsz;
        const size_t tstep = (size_t)BM * pitch;
        u.a = gidx ? A : A + (size_t)u.pm * tstep; u.b = B + (size_t)((u.pm / tpe) * nN + u.pn) * tstep;
        if (hot) {
            if (PROBE_ABL != 13) u.a = A + (size_t)(c & 7) * tstep; if (PROBE_ABL != 12) u.b = B + (size_t)(c & 3) * tstep; }
        return true;
    }
};

enum EpiKind { EK_IN0 = 0, EK_OUT = 1, EK_GU = 2, EK_DOWN = 3, EK_QKV1 = 4, EK_NONE = 5 };
struct Epi {
    int kind, layer; bool f8out; float wsc; unsigned char* ws; const float* xin_lat; const float* xin_ctx;
    __device__ __forceinline__ int nstores(const Unit& u) const { return (kind == EK_GU || (kind == EK_IN0 && u.pn >= 2 && u.pn < 6)) ? 8 : 16; }
    __device__ __forceinline__ void store8(bf16_t* p, const f32x4 a, const f32x4 b) const {
        u32x4 w; w.x = cvt_pk_bf16(a[0], a[1]); w.y = cvt_pk_bf16(a[2], a[3]); w.z = cvt_pk_bf16(b[0], b[1]); w.w = cvt_pk_bf16(b[2], b[3]);
        *(u32x4*)p = w;
    }
    __device__ __forceinline__ void operator()(const f32x4 (&acc)[2][2][4][2], const Unit& u, int wr, int wc, int fr, int fq) const {
        if (kind == EK_NONE) {
#pragma unroll
            for (int ai = 0; ai < 2; ++ai)
#pragma unroll
                for (int bj = 0; bj < 2; ++bj)
#pragma unroll
                    for (int m = 0; m < 4; ++m) asm volatile("" :: "v"(acc[ai][bj][m][0]), "v"(acc[ai][bj][m][1]));
            return;
        }
        const int row0 = u.pm * BM + wr * 64 + fr;
        const int cw = wc * 32 + 8 * fq;
        if (kind == EK_OUT) {
            const bool lat = row0 < NLAT;
            const int col0 = u.pn * BM + cw;
            f32x4 gv[2][2];
            const int gb = lat ? (row0 >> 12) : 8;
#pragma unroll
            for (int bj = 0; bj < 2; ++bj)
#pragma unroll
                for (int n = 0; n < 2; ++n) gv[bj][n] = *(const f32x4*)((const float*)(ws + WS_MOD) + (size_t)(layer * 9 + gb) * 6144 + 2 * 1024 + col0 + bj * HALF + 4 * n);
            bf16_t* XB = (bf16_t*)(ws + WS_XB);
            const float* xi = lat ? xin_lat : xin_ctx - (size_t)NLAT * DM;
#pragma unroll
            for (int am = 0; am < 4; ++am) { const int ai = am >> 1, m0 = (am & 1) * 2;
                f32x4 r0[2][2], r1[2][2]; u32x4 rw[2][2];
#pragma unroll
                for (int mm = 0; mm < 2; ++mm) { const size_t off = (size_t)(row0 + ai * HALF + (m0 + mm) * 16) * DM + col0;
#pragma unroll
                    for (int bj = 0; bj < 2; ++bj) {
                        if (layer == 0) { r0[mm][bj] = __builtin_nontemporal_load((const f32x4*)(xi + off + bj * HALF)); r1[mm][bj] = __builtin_nontemporal_load((const f32x4*)(xi + off + bj * HALF + 4)); }
                        else rw[mm][bj] = *(const u32x4*)(XB + off + bj * HALF); } }
#pragma unroll
                for (int mm = 0; mm < 2; ++mm) { const int m = m0 + mm; const size_t off = (size_t)(row0 + ai * HALF + m * 16) * DM + col0;
#pragma unroll
                    for (int bj = 0; bj < 2; ++bj) { f32x4 b0, b1;
                        if (layer == 0) { b0 = r0[mm][bj]; b1 = r1[mm][bj]; }
                        else { const u32x4 w = rw[mm][bj]; b0 = (f32x4){bf_lo(w.x), bf_hi(w.x), bf_lo(w.y), bf_hi(w.y)}; b1 = (f32x4){bf_lo(w.z), bf_hi(w.z), bf_lo(w.w), bf_hi(w.w)}; }
                        store8(XB + off + bj * HALF, b0 + gv[bj][0] * acc[ai][bj][m][0], b1 + gv[bj][1] * acc[ai][bj][m][1]); } }
                asm volatile("" ::: "memory"); }
            return;
        }
        if (kind == EK_GU) {
#pragma unroll
            for (int ai = 0; ai < 2; ++ai)
#pragma unroll
                for (int m = 0; m < 4; ++m) { f32x4 v[2];
#pragma unroll
                    for (int n = 0; n < 2; ++n) { const f32x4 g = acc[ai][0][m][n] * wsc, up = acc[ai][1][m][n] * wsc;
#pragma unroll
                        for (int j = 0; j < 4; ++j) v[n][j] = g[j] * __builtin_amdgcn_rcpf(1.f + __expf(-g[j])) * up[j]; }
                    if (f8out) { u32x2 w; w.x = pk4_fp8(v[0][0], v[0][1], v[0][2], v[0][3]); w.y = pk4_fp8(v[1][0], v[1][1], v[1][2], v[1][3]);
                        *(u32x2*)((unsigned char*)(ws + A_ACT) + (size_t)(row0 + ai * HALF + m * 16) * FF + u.pn * HALF + cw) = w; }
                    else store8((bf16_t*)(ws + A_ACT) + (size_t)(row0 + ai * HALF + m * 16) * FF + u.pn * HALF + cw, v[0], v[1]); }
            return;
        }
        if (kind == EK_DOWN) {
#pragma unroll
            for (int ai = 0; ai < 2; ++ai)
#pragma unroll
                for (int m = 0; m < 4; ++m)
#pragma unroll
                    for (int bj = 0; bj < 2; ++bj)
                    { const f32x4 y0 = acc[ai][bj][m][0] * (wsc * 16.f), y1 = acc[ai][bj][m][1] * (wsc * 16.f);
                        u32x2 w; w.x = pk4_fp8(y0[0], y0[1], y0[2], y0[3]); w.y = pk4_fp8(y1[0], y1[1], y1[2], y1[3]);
                        *(u32x2*)((unsigned char*)(ws + A_HS) + (size_t)(row0 + ai * HALF + m * 16) * DM + u.pn * BM + bj * HALF + cw) = w; }
            return;
        }
        int mode; size_t doff; int ld, cb;
        if (kind == EK_IN0) {
            if (u.pn < 2)       { mode = 0; doff = A_BG; ld = 512; cb = u.pn * 256; }
            else if (u.pn < 6)  { mode = 1; doff = A_CX; ld = 512; cb = (u.pn - 2) * 128; }
            else if (u.pn < 8)  { mode = 2; doff = A_Q0; ld = 512; cb = (u.pn - 6) * 256; }
            else if (u.pn < 10) { mode = 2; doff = A_K0; ld = 512; cb = (u.pn - 8) * 256; }
            else                { mode = 0; doff = A_V0; ld = 512; cb = (u.pn - 10) * 256; }
        } else {
            if (u.pn < 4)       { mode = 2; doff = A_Q1; ld = 1024; cb = u.pn * 256; }
            else if (u.pn == 4) { mode = 2; doff = A_K1; ld = 256; cb = 0; }
            else                { mode = 0; doff = A_V1; ld = 256; cb = 0; }
        }
        bf16_t* dst = (bf16_t*)(ws + doff); const float* rope = (const float*)(ws + WS_ROPE);
        const float qs = ((kind == EK_IN0 && (u.pn == 6 || u.pn == 7)) || (kind == EK_QKV1 && u.pn < 4)) ? 0.125f * 1.4426950408889634f : 1.0f;
        if (mode == 2 && row0 >= NLAT) mode = 0;
        if (mode == 1) {
#pragma unroll
            for (int ai = 0; ai < 2; ++ai)
#pragma unroll
                for (int m = 0; m < 4; ++m)
                    store8(dst + (size_t)(row0 + ai * HALF + m * 16) * ld + cb + cw, acc[ai][0][m][0] * acc[ai][1][m][0], acc[ai][0][m][1] * acc[ai][1][m][1]);
        } else if (mode == 0) {
#pragma unroll
            for (int ai = 0; ai < 2; ++ai)
#pragma unroll
                for (int m = 0; m < 4; ++m)
#pragma unroll
                    for (int bj = 0; bj < 2; ++bj)
                        store8(dst + (size_t)(row0 + ai * HALF + m * 16) * ld + cb + bj * HALF + cw, acc[ai][bj][m][0] * qs, acc[ai][bj][m][1] * qs);
        } else {
            f32x4 csv[4], snv[4];
            const int t0 = row0 & (SEQ - 1);
            if (wc & 1) {
#pragma unroll
                for (int m = 0; m < 4; ++m) { const int pos = (t0 + m * 16) & 63; csv[m] = *(const f32x4*)(rope + pos * 16 + 4 * fq); snv[m] = *(const f32x4*)(rope + 1024 + pos * 16 + 4 * fq); }
            } else {
#pragma unroll
                for (int ai = 0; ai < 2; ++ai) { const int pos = ((t0 + ai * HALF) >> 6) & 63; csv[ai] = *(const f32x4*)(rope + pos * 16 + 4 * fq); snv[ai] = *(const f32x4*)(rope + 1024 + pos * 16 + 4 * fq); }
                csv[2] = csv[0]; snv[2] = snv[0]; csv[3] = csv[1]; snv[3] = snv[1];
            }
#pragma unroll
            for (int ai = 0; ai < 2; ++ai)
#pragma unroll
                for (int m = 0; m < 4; ++m) { const int row = row0 + ai * HALF + m * 16;
                    const f32x4 cs = ((wc & 1) ? csv[m] : csv[ai]) * qs, sn = ((wc & 1) ? snv[m] : snv[ai]) * qs;
#pragma unroll
                    for (int bj = 0; bj < 2; ++bj) { const f32x4 x1 = acc[ai][bj][m][0], x2 = acc[ai][bj][m][1];
                        store8(dst + (size_t)row * ld + cb + bj * HALF + cw, x1 * cs - x2 * sn, x2 * cs + x1 * sn); } }
        }
    }
};

__device__ __forceinline__ void gemm_phase(LAS unsigned char* lds, const int tid, const bool perm, const Sched& S, const Epi& E) {
    const int wid = __builtin_amdgcn_readfirstlane(tid >> 6), lane = tid & 63, wr = wid >> 2, wc = wid & 3, fr = lane & 15, fq = lane >> 4;
    constexpr int K = DM, nt = K / BK;
    unsigned voffB[2]; int sR[2], sC[2];
#pragma unroll
    for (int i = 0; i < 2; ++i) { int R, C; stage_rc(tid * 16 + i * 8192, R, C); const int Rb = perm ? ((R & ~31) + perm32(R & 31)) : R;
        sR[i] = R; sC[i] = C; voffB[i] = (unsigned)(Rb * K + C) * 2u; }
    const bool gather = S.gidx != nullptr;
    LAS unsigned* gtab = (LAS unsigned*)(lds + GT_OFF);
    if (gather) {
        Unit tu;
        for (int i = 0; S.next(i, tu); ++i) if (tid < 256) gtab[i * 256 + tid] = (unsigned)S.gidx[(tu.pm / S.tpe) * EROWS0 + (tu.pm % S.tpe) * 256 + tid] * (unsigned)(K * 2);
        __syncthreads();
    }
    unsigned gc[2][2], gn[2][2];
#define PG8_GOFF(dst, ord) do { const int t_ = wid * 64 + fresh_lane(); _Pragma("unroll") for (int i_ = 0; i_ < 2; ++i_) { int R_, C_; stage_rc(t_ * 16 + i_ * 8192, R_, C_); \
        _Pragma("unroll") for (int h_ = 0; h_ < 2; ++h_) dst[h_][i_] = gather ? gtab[(ord) * 256 + h_ * HALF + R_] + (unsigned)C_ * 2u : (unsigned)((h_ * HALF + R_) * K + C_) * 2u; } } while (0)
    constexpr size_t kstep = (size_t)(BK * 2);
    constexpr size_t hstep = (size_t)HALF * K * 2;
    const unsigned ldsw = (unsigned)wid * 1024u;
    const int aoff = lds_byte(wr * 64 + fr, fq * 8), boff = lds_byte(wc * 32 + fr, fq * 8);
#define PG8_SA(b, h) (((b) * 2 + (h)) * HTB)
#define PG8_SB(b, h) ((4 + (b) * 2 + (h)) * HTB)
#define PG8_STAGE(bufoff, gbase, voff) do { _Pragma("unroll") for (int _i = 0; _i < 2; ++_i) \
        __builtin_amdgcn_global_load_lds((const unsigned*)((const char*)(gbase) + (voff)[_i]), (LAS unsigned*)(lds + (bufoff) + ldsw + _i * 8192), 16, 0, 0); } while (0)
#define PG8_LDA(dst, b, h) do { _Pragma("unroll") for (int m = 0; m < 4; ++m) _Pragma("unroll") for (int k = 0; k < 2; ++k) dst[m][k] = *(const LAS bf16x8*)(lds + PG8_SA(b, h) + aoff + m * 2048 + k * 1024); } while (0)
#define PG8_LDB(dst, b, h) do { _Pragma("unroll") for (int n = 0; n < 2; ++n) _Pragma("unroll") for (int k = 0; k < 2; ++k) dst[n][k] = *(const LAS bf16x8*)(lds + PG8_SB(b, h) + boff + n * 2048 + k * 1024); } while (0)
#define PG8_MMA(ai, bj, At, Bt) do { __builtin_amdgcn_s_setprio(1); _Pragma("unroll") for (int m = 0; m < 4; ++m) _Pragma("unroll") for (int n = 0; n < 2; ++n) _Pragma("unroll") for (int k = 0; k < 2; ++k) \
        acc[ai][bj][m][n] = __builtin_amdgcn_mfma_f32_16x16x32_bf16(Bt[n][k], At[m][k], acc[ai][bj][m][n], 0, 0, 0); __builtin_amdgcn_s_setprio(0); } while (0)
#define PG8_WAIT_V(n) asm volatile("s_waitcnt vmcnt(" #n ")" ::: "memory")
#define PG8_WAIT_VE(n16, n8) do { if (fe) { if (ns == 16) asm volatile("s_waitcnt vmcnt(" #n16 ")" ::: "memory"); else asm volatile("s_waitcnt vmcnt(" #n8 ")" ::: "memory"); } else asm volatile("s_waitcnt vmcnt(8)" ::: "memory"); } while (0)
#define PG8_WAIT_L(n) asm volatile("s_waitcnt lgkmcnt(" #n ")" ::: "memory")
#define PG8_BAR __builtin_amdgcn_s_barrier()
#define PG8_SCHED __builtin_amdgcn_sched_barrier(0)
    Unit cur, nxt; int ui = 0; int ns = 16;
    if (!S.next(0, cur)) return;
    f32x4 acc[2][2][4][2];
#pragma unroll
    for (int a = 0; a < 2; ++a)
#pragma unroll
        for (int b = 0; b < 2; ++b)
#pragma unroll
            for (int m = 0; m < 4; ++m)
#pragma unroll
                for (int n = 0; n < 2; ++n) acc[a][b][m][n] = (f32x4){0.f, 0.f, 0.f, 0.f};
    bf16x8 At[4][2], B0[2][2], B1[2][2];
    const char* cA = cur.a; const char* cB = cur.b;
    PG8_GOFF(gc, 0);
    PG8_STAGE(PG8_SB(0, 0), cB, voffB); PG8_STAGE(PG8_SB(0, 1), cB + hstep, voffB); PG8_STAGE(PG8_SA(0, 0), cA, gc[0]); PG8_STAGE(PG8_SA(0, 1), cA, gc[1]);
    if (wr == 1) PG8_BAR;
    PG8_WAIT_V(2); PG8_BAR;
    PG8_STAGE(PG8_SB(1, 0), cB + kstep, voffB); PG8_STAGE(PG8_SA(1, 0), cA + kstep, gc[0]); PG8_STAGE(PG8_SB(1, 1), cB + hstep + kstep, voffB);
    PG8_WAIT_V(6); PG8_BAR;
    for (;;) {
        const bool has_next = S.next(ui + 1, nxt);
        const char* nA = has_next ? nxt.a : cA; const char* nB = has_next ? nxt.b : cB;
        if (has_next) PG8_GOFF(gn, ui + 1);
        else {
#pragma unroll
            for (int h_ = 0; h_ < 2; ++h_)
#pragma unroll
                for (int i_ = 0; i_ < 2; ++i_) gn[h_][i_] = gc[h_][i_]; }
        HOT_ALIGN(ALG_G);
        for (int t = 0; t < nt; t += 2) {
            const bool last = (t == nt - 2); const bool fe = (t == 0) && (ui > 0);
            const char* a1 = cA + (size_t)(t + 1) * kstep;
            const char* a2 = last ? nA : cA + (size_t)(t + 2) * kstep; const char* b2 = last ? nB : cB + (size_t)(t + 2) * kstep;
            const char* a3 = a2 + kstep; const char* b3 = b2 + kstep;
            unsigned g2[2][2];
#pragma unroll
            for (int h_ = 0; h_ < 2; ++h_)
#pragma unroll
                for (int i_ = 0; i_ < 2; ++i_) g2[h_][i_] = last ? gn[h_][i_] : gc[h_][i_];
            PG8_LDB(B0, 0, 0); PG8_LDB(B1, 0, 1); PG8_SCHED; PG8_LDA(At, 0, 0); PG8_STAGE(PG8_SA(1, 1), a1, gc[1]);
            PG8_WAIT_VE(18, 10); PG8_WAIT_L(0); PG8_BAR; PG8_MMA(0, 0, At, B0); PG8_MMA(0, 1, At, B1); PG8_BAR; PG8_SCHED;
            PG8_LDA(At, 0, 1); PG8_STAGE(PG8_SB(0, 0), b2, voffB); PG8_STAGE(PG8_SB(0, 1), b2 + hstep, voffB); PG8_STAGE(PG8_SA(0, 0), a2, g2[0]);
            PG8_WAIT_VE(24, 16); PG8_WAIT_L(0); PG8_BAR; PG8_MMA(1, 0, At, B0); PG8_MMA(1, 1, At, B1); PG8_BAR; PG8_SCHED;
            PG8_LDB(B0, 1, 0); PG8_LDB(B1, 1, 1); PG8_SCHED; PG8_LDA(At, 1, 0); PG8_STAGE(PG8_SA(0, 1), a2, g2[1]);
            PG8_WAIT_V(8); PG8_WAIT_L(0); PG8_BAR; PG8_MMA(0, 0, At, B0); PG8_MMA(0, 1, At, B1); PG8_BAR; PG8_SCHED;
            PG8_LDA(At, 1, 1); PG8_STAGE(PG8_SB(1, 0), b3, voffB); PG8_STAGE(PG8_SB(1, 1), b3 + hstep, voffB); PG8_STAGE(PG8_SA(1, 0), a3, g2[0]);
            PG8_WAIT_V(8); PG8_WAIT_L(0); PG8_BAR; PG8_MMA(1, 0, At, B0); PG8_MMA(1, 1, At, B1); PG8_BAR; PG8_SCHED;
        }
        if (wr == 0) PG8_BAR;
        PG8_WAIT_V(0);
        { int fr_ = fr, fq_ = fq; asm volatile("" : "+v"(fr_), "+v"(fq_));
          E(acc, cur, wr, wc, fr_, fq_); } ns = E.nstores(cur);
        if (!has_next) break;
#pragma unroll
        for (int a = 0; a < 2; ++a)
#pragma unroll
            for (int b = 0; b < 2; ++b)
#pragma unroll
                for (int m = 0; m < 4; ++m)
#pragma unroll
                    for (int n = 0; n < 2; ++n) acc[a][b][m][n] = (f32x4){0.f, 0.f, 0.f, 0.f};
        cur = nxt; cA = nA; cB = nB; ++ui;
#pragma unroll
        for (int h_ = 0; h_ < 2; ++h_)
#pragma unroll
            for (int i_ = 0; i_ < 2; ++i_) gc[h_][i_] = gn[h_][i_];
        if (wr == 1) PG8_BAR;
    }
    PG8_WAIT_V(0);
    PG8_BAR;
#undef PG8_GOFF
#undef PG8_SA
#undef PG8_SB
#undef PG8_STAGE
#undef PG8_LDA
#undef PG8_LDB
#undef PG8_MMA
#undef PG8_WAIT_V
#undef PG8_WAIT_VE
#undef PG8_WAIT_L
#undef PG8_BAR
#undef PG8_SCHED
}
__device__ __forceinline__ void gemm_phase8(LAS unsigned char* lds, const int tid, const bool perm, const Sched& S, const Epi& E) {
    const int wid = __builtin_amdgcn_readfirstlane(tid >> 6), lane = tid & 63, wr = wid >> 2, wc = wid & 3, fr = lane & 15, fq = lane >> 4;
    constexpr int K = DM, nt = K / 128, PITCH = K;
    unsigned voffB[2]; int sR[2], sC[2];
#pragma unroll
    for (int i = 0; i < 2; ++i) { const int X = tid * 16 + i * 8192, p = X >> 10, l = (X >> 4) & 63, fr_ = l >> 2, g_ = fr_ >> 2, cp = (l & 3) ^ (g_ ^ (g_ >> 1));
        const int R = (p >> 1) * 16 + fr_, C = ((p & 1) * 4 + cp) * 16; const int Rb = perm ? ((R & ~31) + perm32(R & 31)) : R;
        sR[i] = R; sC[i] = C; voffB[i] = (unsigned)(Rb * PITCH + C); }
    const bool gather = S.gidx != nullptr;
    LAS unsigned* gtab = (LAS unsigned*)(lds + GT_OFF);
    if (gather) {
        Unit tu;
        for (int i = 0; S.next(i, tu); ++i) if (tid < 256) gtab[i * 256 + tid] = (unsigned)S.gidx[(tu.pm / S.tpe) * EROWS0 + (tu.pm % S.tpe) * 256 + tid] * (unsigned)PITCH;
        __syncthreads();
    }
    unsigned gc[2][2], gn[2][2];
#define PG8_GOFF(dst, ord) do { const int t_ = wid * 64 + fresh_lane(); _Pragma("unroll") for (int i_ = 0; i_ < 2; ++i_) { const int X_ = t_ * 16 + i_ * 8192, p_ = X_ >> 10, l_ = (X_ >> 4) & 63, f_ = l_ >> 2, g_ = f_ >> 2; \
        const int R_ = (p_ >> 1) * 16 + f_, C_ = ((p_ & 1) * 4 + ((l_ & 3) ^ (g_ ^ (g_ >> 1)))) * 16; \
        _Pragma("unroll") for (int h_ = 0; h_ < 2; ++h_) dst[h_][i_] = gather ? gtab[(ord) * 256 + h_ * HALF + R_] + (unsigned)C_ : (unsigned)((h_ * HALF + R_) * PITCH + C_); } } while (0)
    constexpr size_t kstep = (size_t)(BK * 2);
    constexpr size_t hstep = (size_t)HALF * PITCH;
    const unsigned ldsw = (unsigned)wid * 1024u;
    int aoff[2], boff[2];
#pragma unroll
    for (int hh = 0; hh < 2; ++hh) { const int g_ = fr >> 2, ch = (((fq & 1) * 2 + hh) ^ (g_ ^ (g_ >> 1))); const int o_ = (fq >> 1) * 1024 + (4 * fr + ch) * 16;
        aoff[hh] = wr * 8192 + o_; boff[hh] = wc * 4096 + o_; }
#define PG8_SA(b, h) (((b) * 2 + (h)) * HTB)
#define PG8_SB(b, h) ((4 + (b) * 2 + (h)) * HTB)
#define PG8_STAGE(bufoff, gbase, voff) do { _Pragma("unroll") for (int _i = 0; _i < 2; ++_i) \
        __builtin_amdgcn_global_load_lds((const unsigned*)((const char*)(gbase) + (voff)[_i]), (LAS unsigned*)(lds + (bufoff) + ldsw + _i * 8192), 16, 0, 0); } while (0)
#define PG8_LDA(dst, b, h) do { _Pragma("unroll") for (int m = 0; m < 4; ++m) dst[m] = __builtin_shufflevector(*(const LAS v4i32*)(lds + PG8_SA(b, h) + aoff[0] + m * 2048), *(const LAS v4i32*)(lds + PG8_SA(b, h) + aoff[1] + m * 2048), 0, 1, 2, 3, 4, 5, 6, 7); } while (0)
#define PG8_LDB(dst, b, h) do { _Pragma("unroll") for (int n = 0; n < 2; ++n) dst[n] = __builtin_shufflevector(*(const LAS v4i32*)(lds + PG8_SB(b, h) + boff[0] + n * 2048), *(const LAS v4i32*)(lds + PG8_SB(b, h) + boff[1] + n * 2048), 0, 1, 2, 3, 4, 5, 6, 7); } while (0)
#define PG8_V8(x) (x)
#define PG8_MMA(ai, bj, At, Bt) do { __builtin_amdgcn_s_setprio(1); _Pragma("unroll") for (int m = 0; m < 4; ++m) _Pragma("unroll") for (int n = 0; n < 2; ++n) \
        asm volatile("v_mfma_f32_16x16x128_f8f6f4 %0, %1, %2, %0" : "+v"(acc[ai][bj][m][n]) : "v"(Bt[n]), "v"(At[m])); __builtin_amdgcn_s_setprio(0); } while (0)
#define PG8_WAIT_V(n) asm volatile("s_waitcnt vmcnt(" #n ")" ::: "memory")
#define PG8_WAIT_VE(n16, n8) do { if (fe) { if (ns == 16) asm volatile("s_waitcnt vmcnt(" #n16 ")" ::: "memory"); else asm volatile("s_waitcnt vmcnt(" #n8 ")" ::: "memory"); } else asm volatile("s_waitcnt vmcnt(8)" ::: "memory"); } while (0)
#define PG8_WAIT_L(n) asm volatile("s_waitcnt lgkmcnt(" #n ")" ::: "memory")
#define PG8_BAR __builtin_amdgcn_s_barrier()
#define PG8_SCHED __builtin_amdgcn_sched_barrier(0)
    Unit cur, nxt; int ui = 0; int ns = 16;
    if (!S.next(0, cur)) return;
    f32x4 acc[2][2][4][2];
#pragma unroll
    for (int a = 0; a < 2; ++a)
#pragma unroll
        for (int b = 0; b < 2; ++b)
#pragma unroll
            for (int m = 0; m < 4; ++m)
#pragma unroll
                for (int n = 0; n < 2; ++n) acc[a][b][m][n] = (f32x4){0.f, 0.f, 0.f, 0.f};
    v8i32 At[4], B0[2], B1[2];
    const char* cA = cur.a; const char* cB = cur.b;
    PG8_GOFF(gc, 0);
    PG8_STAGE(PG8_SB(0, 0), cB, voffB); PG8_STAGE(PG8_SB(0, 1), cB + hstep, voffB); PG8_STAGE(PG8_SA(0, 0), cA, gc[0]); PG8_STAGE(PG8_SA(0, 1), cA, gc[1]);
    if (wr == 1) PG8_BAR;
    PG8_WAIT_V(2); PG8_BAR;
    PG8_STAGE(PG8_SB(1, 0), cB + kstep, voffB); PG8_STAGE(PG8_SA(1, 0), cA + kstep, gc[0]); PG8_STAGE(PG8_SB(1, 1), cB + hstep + kstep, voffB);
    PG8_WAIT_V(6); PG8_BAR;
    for (;;) {
        const bool has_next = S.next(ui + 1, nxt);
        const char* nA = has_next ? nxt.a : cA; const char* nB = has_next ? nxt.b : cB;
        if (has_next) PG8_GOFF(gn, ui + 1);
        else {
#pragma unroll
            for (int h_ = 0; h_ < 2; ++h_)
#pragma unroll
                for (int i_ = 0; i_ < 2; ++i_) gn[h_][i_] = gc[h_][i_]; }
        HOT_ALIGN(ALG_G8);
#pragma unroll 1
        for (int t = 0; t < nt; t += 2) {
            const bool last = (t == nt - 2); const bool fe = (t == 0) && (ui > 0);
            const char* a1 = cA + (size_t)(t + 1) * kstep;
            const char* a2 = last ? nA : cA + (size_t)(t + 2) * kstep; const char* b2 = last ? nB : cB + (size_t)(t + 2) * kstep;
            const char* a3 = a2 + kstep; const char* b3 = b2 + kstep;
            unsigned g2[2][2];
#pragma unroll
            for (int h_ = 0; h_ < 2; ++h_)
#pragma unroll
                for (int i_ = 0; i_ < 2; ++i_) g2[h_][i_] = last ? gn[h_][i_] : gc[h_][i_];
            PG8_LDB(B0, 0, 0); PG8_LDB(B1, 0, 1); PG8_SCHED; PG8_LDA(At, 0, 0); PG8_STAGE(PG8_SA(1, 1), a1, gc[1]);
            PG8_WAIT_VE(18, 10); PG8_WAIT_L(0); PG8_BAR; PG8_MMA(0, 0, At, B0); PG8_MMA(0, 1, At, B1); PG8_BAR; PG8_SCHED;
            PG8_LDA(At, 0, 1); PG8_STAGE(PG8_SB(0, 0), b2, voffB); PG8_STAGE(PG8_SB(0, 1), b2 + hstep, voffB); PG8_STAGE(PG8_SA(0, 0), a2, g2[0]);
            PG8_WAIT_VE(24, 16); PG8_WAIT_L(0); PG8_BAR; PG8_MMA(1, 0, At, B0); PG8_MMA(1, 1, At, B1); PG8_BAR; PG8_SCHED;
            PG8_LDB(B0, 1, 0); PG8_LDB(B1, 1, 1); PG8_SCHED; PG8_LDA(At, 1, 0); PG8_STAGE(PG8_SA(0, 1), a2, g2[1]);
            PG8_WAIT_V(8); PG8_WAIT_L(0); PG8_BAR; PG8_MMA(0, 0, At, B0); PG8_MMA(0, 1, At, B1); PG8_BAR; PG8_SCHED;
            PG8_LDA(At, 1, 1); PG8_STAGE(PG8_SB(1, 0), b3, voffB); PG8_STAGE(PG8_SB(1, 1), b3 + hstep, voffB); PG8_STAGE(PG8_SA(1, 0), a3, g2[0]);
            PG8_WAIT_V(8); PG8_WAIT_L(0); PG8_BAR; PG8_MMA(1, 0, At, B0); PG8_MMA(1, 1, At, B1); PG8_BAR; PG8_SCHED;
        }
        if (wr == 0) PG8_BAR;
        asm volatile("s_nop 15\n\ts_nop 15" ::: "memory");
        PG8_WAIT_V(0);
        { int fr_ = fr, fq_ = fq; asm volatile("" : "+v"(fr_), "+v"(fq_));
          E(acc, cur, wr, wc, fr_, fq_); } ns = E.nstores(cur);
        if (!has_next) break;
#pragma unroll
        for (int a = 0; a < 2; ++a)
#pragma unroll
            for (int b = 0; b < 2; ++b)
#pragma unroll
                for (int m = 0; m < 4; ++m)
#pragma unroll
                    for (int n = 0; n < 2; ++n) acc[a][b][m][n] = (f32x4){0.f, 0.f, 0.f, 0.f};
        cur = nxt; cA = nA; cB = nB; ++ui;
#pragma unroll
        for (int h_ = 0; h_ < 2; ++h_)
#pragma unroll
            for (int i_ = 0; i_ < 2; ++i_) gc[h_][i_] = gn[h_][i_];
        if (wr == 1) PG8_BAR;
    }
    PG8_WAIT_V(0);
    PG8_BAR;
#undef PG8_GOFF
#undef PG8_V8
#undef PG8_SA
#undef PG8_SB
#undef PG8_STAGE
#undef PG8_LDA
#undef PG8_LDB
#undef PG8_MMA
#undef PG8_WAIT_V
#undef PG8_WAIT_VE
#undef PG8_WAIT_L
#undef PG8_BAR
#undef PG8_SCHED
}
}

namespace att {
constexpr int QBLK = 32, KVBLK = 64;
constexpr float SCALE = 0.125f;
constexpr float THR = 8.f;
constexpr float LOG2E = 1.4426950408889634f;
#define SBAR() __builtin_amdgcn_sched_barrier(0)
#define KSWZ(row, colB) ((row) * 128 + ((colB) ^ ((((row) >> 1) & 7) << 4)))
__device__ __forceinline__ int crow(int r, int hi) { return (r & 3) + 8 * (r >> 2) + 4 * hi; }
__device__ __forceinline__ unsigned cvtpk(float lo, float hi) { unsigned r; asm volatile("v_cvt_pk_bf16_f32 %0, %1, %2" : "=v"(r) : "v"(lo), "v"(hi)); return r; }

constexpr float THRL = 8.f;
template <bool NEGM = true>
__device__ __forceinline__ void partialSM(f32x16& p0, f32x16& p1, float& m_reg, f32x16& negm, float& alpha, const bool first) {
    float a = fmaxf(fmaxf(p0[0], p0[1]), p1[0]), b = fmaxf(fmaxf(p0[2], p0[3]), p1[1]); a = fmaxf(fmaxf(a, p1[2]), p1[3]);
#pragma unroll
    for (int r = 4; r < 16; r += 4) { a = fmaxf(fmaxf(a, p0[r]), p0[r + 1]); b = fmaxf(fmaxf(b, p0[r + 2]), p0[r + 3]); a = fmaxf(fmaxf(a, p1[r]), p1[r + 1]); b = fmaxf(fmaxf(b, p1[r + 2]), p1[r + 3]); }
    float pmax = fmaxf(a, b);
    { auto rr = __builtin_amdgcn_permlane32_swap(__float_as_uint(pmax), __float_as_uint(pmax), false, false);
      pmax = fmaxf(__uint_as_float(rr[0]), __uint_as_float(rr[1])); }
    if constexpr (!NEGM) pmax -= m_reg;
    alpha = 1.f;
    if (__builtin_expect(first || __any(pmax > THRL), 0)) {
        const float dl = first ? pmax : fmaxf(pmax, 0.f);
        m_reg += dl;
        if constexpr (NEGM) {
#pragma unroll
            for (int r = 0; r < 16; ++r) { p0[r] -= dl; p1[r] -= dl; }
#pragma unroll
            for (int r = 0; r < 16; ++r) negm[r] = -m_reg; }
        alpha = __builtin_amdgcn_exp2f(-dl);
    }
    if constexpr (!NEGM) {
#pragma unroll
        for (int r = 0; r < 16; ++r) { p0[r] -= m_reg; p1[r] -= m_reg; } }
#pragma unroll
    for (int r = 0; r < 16; ++r) p0[r] = __builtin_amdgcn_exp2f(p0[r]);
    asm volatile("s_nop 0" : "+v"(p0));
}
__device__ __forceinline__ void finishSM(f32x16& p0, f32x16& p1, float alpha, float& l_reg, bf16x8& pa0, bf16x8& pa1, bf16x8& pa2, bf16x8& pa3) {
#pragma unroll
    for (int r = 0; r < 16; ++r) p1[r] = __builtin_amdgcn_exp2f(p1[r]);
    asm volatile("s_nop 0" : "+v"(p1));
#define ADDF(d, a, b) asm("v_add_f32 %0, %1, %2" : "=v"(d) : "v"(a), "v"(b))
    float s0, s1, s2, s3;
    ADDF(s0, p0[0], p0[4]); ADDF(s1, p0[1], p0[5]); ADDF(s2, p0[2], p0[6]); ADDF(s3, p0[3], p0[7]);
#pragma unroll
    for (int r = 8; r < 16; r += 4) { ADDF(s0, s0, p0[r]); ADDF(s1, s1, p0[r + 1]); ADDF(s2, s2, p0[r + 2]); ADDF(s3, s3, p0[r + 3]); }
#pragma unroll
    for (int r = 0; r < 16; r += 4) { ADDF(s0, s0, p1[r]); ADDF(s1, s1, p1[r + 1]); ADDF(s2, s2, p1[r + 2]); ADDF(s3, s3, p1[r + 3]); }
    ADDF(s0, s0, s1); ADDF(s2, s2, s3);
    float ps; ADDF(ps, s0, s2);
#undef ADDF
    { auto rr = __builtin_amdgcn_permlane32_swap(__float_as_uint(ps), __float_as_uint(ps), false, false);
      ps = __uint_as_float(rr[0]) + __uint_as_float(rr[1]); }
    l_reg = l_reg * alpha + ps;
#define PK8(P, BASE, OUT) do { u32x4 w = {cvtpk(P[BASE + 0], P[BASE + 1]), cvtpk(P[BASE + 2], P[BASE + 3]), cvtpk(P[BASE + 4], P[BASE + 5]), cvtpk(P[BASE + 6], P[BASE + 7])}; OUT = __builtin_bit_cast(bf16x8, w); } while (0)
    PK8(p0, 0, pa0); PK8(p0, 8, pa1); PK8(p1, 0, pa2); PK8(p1, 8, pa3);
#undef PK8
}
__device__ __forceinline__ void qkt(f32x16& p0, f32x16& p1, const LAS char* Ks, const LAS char* qf, const f32x16& cinit, int r32, int hi) {
#pragma unroll
    for (int d0 = 0; d0 < 4; ++d0) { const int cb = (d0 * 16 + hi * 8) * 2;
        const bf16x8 q = *(const LAS bf16x8*)(qf + d0 * 1024);
        const bf16x8 b0 = *(const LAS bf16x8*)(Ks + KSWZ(r32, cb));
        const bf16x8 b1 = *(const LAS bf16x8*)(Ks + KSWZ(32 + r32, cb));
        if (d0 == 0) { p0 = __builtin_amdgcn_mfma_f32_32x32x16_bf16(b0, q, cinit, 0, 0, 0); p1 = __builtin_amdgcn_mfma_f32_32x32x16_bf16(b1, q, cinit, 0, 0, 0); }
        else { p0 = __builtin_amdgcn_mfma_f32_32x32x16_bf16(b0, q, p0, 0, 0, 0); p1 = __builtin_amdgcn_mfma_f32_32x32x16_bf16(b1, q, p1, 0, 0, 0); } }
}
__device__ __forceinline__ void qkt_r(f32x16& p0, f32x16& p1, const LAS char* Ks, const bf16x8* qr, const f32x16& cinit, int r32, int hi) {
#pragma unroll
    for (int d0 = 0; d0 < 4; ++d0) { const int cb = (d0 * 16 + hi * 8) * 2;
        const bf16x8 b0 = *(const LAS bf16x8*)(Ks + KSWZ(r32, cb));
        const bf16x8 b1 = *(const LAS bf16x8*)(Ks + KSWZ(32 + r32, cb));
        if (d0 == 0) { p0 = __builtin_amdgcn_mfma_f32_32x32x16_bf16(b0, qr[0], cinit, 0, 0, 0); p1 = __builtin_amdgcn_mfma_f32_32x32x16_bf16(b1, qr[0], cinit, 0, 0, 0); }
        else { p0 = __builtin_amdgcn_mfma_f32_32x32x16_bf16(b0, qr[d0], p0, 0, 0, 0); p1 = __builtin_amdgcn_mfma_f32_32x32x16_bf16(b1, qr[d0], p1, 0, 0, 0); } }
}
template <int NCB> __device__ __forceinline__ int v_st(int k, int c) { const int kk = k; return ((kk >> 3) * NCB + (c >> 5)) * 512 + ((kk & 7) * 32 + (c & 31)) * 2; }
__device__ __forceinline__ int v_rd_base(int lane) { return ((lane & 3) << 3) | (((lane >> 2) & 3) << 6) | (((lane >> 4) & 1) << 5) | (((lane >> 5) & 1) << 8); }
typedef short v4i16_t __attribute__((ext_vector_type(4)));
__device__ __forceinline__ s16x4 vtr(const LAS char* p) { return __builtin_bit_cast(s16x4, __builtin_amdgcn_ds_read_tr16_b64_v4i16((LAS v4i16_t*)p)); }
template <int NCB, int D0> __device__ __forceinline__ void pv_one(f32x16& od, const LAS char* vb, bf16x8 pa0, bf16x8 pa1, bf16x8 pa2, bf16x8 pa3) {
    constexpr int KS = NCB * 1024, HS = NCB * 512;
    const s16x4 l0 = vtr(vb + D0 * 512 + 0 * KS), h0 = vtr(vb + D0 * 512 + 0 * KS + HS), l1 = vtr(vb + D0 * 512 + 1 * KS), h1 = vtr(vb + D0 * 512 + 1 * KS + HS);
    const s16x4 l2 = vtr(vb + D0 * 512 + 2 * KS), h2 = vtr(vb + D0 * 512 + 2 * KS + HS), l3 = vtr(vb + D0 * 512 + 3 * KS), h3 = vtr(vb + D0 * 512 + 3 * KS + HS);
#define PK(L, H) (bf16x8){L[0], L[1], L[2], L[3], H[0], H[1], H[2], H[3]}
    od = __builtin_amdgcn_mfma_f32_32x32x16_bf16(pa0, PK(l0, h0), od, 0, 0, 0);
    od = __builtin_amdgcn_mfma_f32_32x32x16_bf16(pa1, PK(l1, h1), od, 0, 0, 0);
    od = __builtin_amdgcn_mfma_f32_32x32x16_bf16(pa2, PK(l2, h2), od, 0, 0, 0);
    od = __builtin_amdgcn_mfma_f32_32x32x16_bf16(pa3, PK(l3, h3), od, 0, 0, 0);
#undef PK
}
template <int NCB> __device__ __forceinline__ void pv_all(f32x16* o, const LAS char* vb, bf16x8 pa0, bf16x8 pa1, bf16x8 pa2, bf16x8 pa3) {
    pv_one<NCB, 0>(o[0], vb, pa0, pa1, pa2, pa3); pv_one<NCB, 1>(o[1], vb, pa0, pa1, pa2, pa3);
    if constexpr (NCB == 4) { pv_one<NCB, 2>(o[2], vb, pa0, pa1, pa2, pa3); pv_one<NCB, 3>(o[3], vb, pa0, pa1, pa2, pa3); }
}

struct UnitDesc {
    const bf16_t* Q; int ldq;
    const bf16_t* K; const bf16_t* V; int ldk, ldv;
    bf16_t* O; int ldo;
    int ctx_row0, lat_row0, lat_t0, NT;
    int q0; const float* sink;
};
template <int DV, bool SWA, int ABL = 0>
__device__ __forceinline__ void attn_unit(const UnitDesc& U, LAS char* lds, const int tid) {
    constexpr int NCB = DV / 32;
    constexpr int LDQ = SWA ? 1024 : 512, LDK = SWA ? 256 : 512, LDV = LDK, LDO = 1024;
    constexpr int SHM_V = KVBLK * DV * 2, SHM_K = KVBLK * 64 * 2;
    constexpr int NLD = (DV == 128) ? 3 : 2;
    const int wid = __builtin_amdgcn_readfirstlane(tid >> 6), lane = tid & 63, r32 = lane & 31, hi = lane >> 5;
    LAS char* V_lds = lds; LAS char* K_lds = lds + 3 * SHM_V;
    LAS float* ws = (LAS float*)(lds + 3 * SHM_V + 3 * SHM_K) + wid * 64; LAS float* li_l = ws; LAS float* al_l = ws + 32;
    float m_reg = 0.f, l_reg = 0; f32x16 o[NCB]; f32x16 negm = f32x16{};
#pragma unroll
    for (int d = 0; d < NCB; ++d) o[d] = f32x16{};
    const bf16_t* Qw = U.Q + (size_t)(wid * QBLK + r32) * LDQ + hi * 8;
    LAS char* qf = lds + 3 * SHM_V + 3 * SHM_K + 2048 + wid * 4096 + lane * 16;
#pragma unroll
    for (int d0 = 0; d0 < 4; ++d0) *(LAS bf16x8*)(qf + d0 * 1024) = *(const bf16x8*)(Qw + d0 * 16);
    const int kr = tid >> 3, kc = (tid & 7) * 8;
    const int sr = tid >> 4, sc = (tid & 15) * 8;
    const int kst = KSWZ(kr, kc * 2);
    const int vst0 = (DV == 128) ? v_st<NCB>(sr, sc) : v_st<NCB>(kr, kc), vst1 = (DV == 128) ? v_st<NCB>(32 + sr, sc) : 0;
    const LAS char* vrd = V_lds + v_rd_base(lane);
    bf16x8 svA0, svA1, skA;
    const bf16_t* kp = U.K + (size_t)(U.ctx_row0 + kr) * LDK + kc;
    const bf16_t* vp = (DV == 128) ? U.V + (size_t)(U.ctx_row0 + sr) * LDV + sc : U.V + (size_t)(U.ctx_row0 + kr) * LDV + kc;
    const int jump = (U.lat_row0 + 64 * U.lat_t0) - (U.ctx_row0 + 192);
#define SLOAD(S, t) do { \
        if constexpr (DV == 128) { sv##S##0 = *(const bf16x8*)(vp); sv##S##1 = *(const bf16x8*)(vp + (size_t)32 * LDV); } \
        else { sv##S##0 = *(const bf16x8*)(vp); } \
        sk##S = *(const bf16x8*)(kp); \
        { const int adv_ = ((t) == 3) ? jump : 64; kp += (ptrdiff_t)adv_ * LDK; vp += (ptrdiff_t)adv_ * LDV; } } while (0)
#define SWRITE(slot, S) do { *(LAS bf16x8*)(V_lds + (slot) * SHM_V + vst0) = sv##S##0; if constexpr (DV == 128) *(LAS bf16x8*)(V_lds + (slot) * SHM_V + vst1) = sv##S##1; \
        *(LAS bf16x8*)(K_lds + (slot) * SHM_K + kst) = sk##S; } while (0)
#define RESC(a) do { if (__any((a) < 1.f)) { if (hi == 0) al_l[r32] = (a); asm volatile("s_waitcnt lgkmcnt(0)" ::: "memory"); \
        _Pragma("unroll") for (int d = 0; d < NCB; ++d) _Pragma("unroll") for (int r = 0; r < 16; ++r) o[d][r] *= al_l[crow(r, hi)]; } } while (0)
    const int qs = U.q0 + wid * QBLK;
#define ACTIVE(t) (!SWA || (t) < 4 || (64 * (U.lat_t0 + (t) - 4) + 63 >= qs - 128 && 64 * (U.lat_t0 + (t) - 4) <= qs + 31 + 128))
#define MASK(P0, P1, t) do { if constexpr (SWA) { if ((t) >= 4 && !(64 * (U.lat_t0 + (t) - 4) >= qs + 31 - 128 && 64 * (U.lat_t0 + (t) - 4) + 63 <= qs + 128)) { const int kb_ = 64 * (U.lat_t0 + (t) - 4) - (qs + r32) + 4 * hi; \
        _Pragma("unroll") for (int r = 0; r < 16; ++r) { const int d0_ = kb_ + (r & 3) + 8 * (r >> 2); \
            if (d0_ > 128 || d0_ < -128) P0[r] = -1e30f; if (d0_ + 32 > 128 || d0_ + 32 < -128) P1[r] = -1e30f; } } } } while (0)
    f32x16 pA0, pA1, pB0, pB1; float alA = 1.f, alB = 1.f; bf16x8 pa0, pa1, pa2, pa3; const int NT = U.NT;
    bool actA = true, actB = true;
    int sp = 0, scur = 0, snx = 1;
#define ROT() do { sp = scur; scur = snx; snx = (snx == 2) ? 0 : snx + 1; } while (0)
#define STEP(t, C, P, LOADN, WRITEN) do { \
        act##C = ACTIVE(t); \
        SBAR(); if (act##C) { if constexpr (ABL != 4) qkt(p##C##0, p##C##1, K_lds + scur * SHM_K, qf, negm, r32, hi); else { asm volatile("" : "+v"(p##C##0), "+v"(p##C##1)); } MASK(p##C##0, p##C##1, t); } \
        if (act##P) { finishSM(p##P##0, p##P##1, al##P, l_reg, pa0, pa1, pa2, pa3); } SBAR(); \
        if (WRITEN && ABL != 1) { SWRITE(snx, A); } \
        if (LOADN && ABL != 1) SLOAD(A, (t) + 2); SBAR(); \
        if (act##P) { if constexpr (ABL != 3) { pv_all<NCB>(o, vrd + sp * SHM_V, pa0, pa1, pa2, pa3); } else { asm volatile("" :: "v"(pa0), "v"(pa1), "v"(pa2), "v"(pa3)); } } \
        if (act##C) { partialSM(p##C##0, p##C##1, m_reg, negm, al##C, false); } else al##C = 1.f; \
        if (act##C) RESC(al##C); \
        __syncthreads(); ROT(); } while (0)
    SLOAD(A, 0); asm volatile("s_waitcnt vmcnt(0)" ::: "memory"); SWRITE(0, A); SLOAD(A, 1); __syncthreads();
    qkt(pA0, pA1, K_lds, qf, negm, r32, hi); MASK(pA0, pA1, 0); partialSM(pA0, pA1, m_reg, negm, alA, true);
    SWRITE(1, A); SLOAD(A, 2); __syncthreads();
    sp = 0; scur = 1; snx = 2;
    for (int j = 1; j + 1 < NT; j += 2) {
        STEP(j, B, A, true, true);
        STEP(j + 1, A, B, (j + 3 < NT), true);
    }
    STEP(NT - 1, B, A, false, false);
    if (actB) { finishSM(pB0, pB1, alB, l_reg, pa0, pa1, pa2, pa3); SBAR(); pv_all<NCB>(o, vrd + sp * SHM_V, pa0, pa1, pa2, pa3); }
    if constexpr (SWA) l_reg += __builtin_amdgcn_exp2f(U.sink[0] * LOG2E - m_reg);
    if (hi == 0) li_l[r32] = l_reg; asm volatile("s_waitcnt lgkmcnt(0)" ::: "memory");
    float rli[16];
#pragma unroll
    for (int r = 0; r < 16; ++r) rli[r] = __builtin_amdgcn_rcpf(li_l[crow(r, hi)]);
    bf16_t* Ow = U.O + (size_t)(wid * QBLK) * LDO;
#pragma unroll
    for (int r = 0; r < 16; ++r) { const int orow = crow(r, hi);
#pragma unroll
        for (int d0 = 0; d0 < NCB; ++d0) Ow[(size_t)orow * LDO + d0 * 32 + r32] = (bf16_t)f2bf(o[d0][r] * rli[r]); }
    __syncthreads();
#undef SLOAD
#undef SWRITE
#undef RESC
#undef ACTIVE
#undef MASK
#undef ROT
#undef STEP
}
template <int DV, bool SWA>
__device__ __forceinline__ void attn_unit_pp(const UnitDesc& U, LAS char* lds, const int tid) {
    constexpr int NCB = DV / 32;
    constexpr int LDQ = SWA ? 1024 : 512, LDK = SWA ? 256 : 512, LDV = LDK, LDO = 1024;
    constexpr int SHM_V = KVBLK * DV * 2, SHM_K = KVBLK * 64 * 2;
    const int wid = __builtin_amdgcn_readfirstlane(tid >> 6), lane = tid & 63, r32 = lane & 31, hi = lane >> 5;
    const int wrow = SWA ? (wid & 1) * QBLK : wid * QBLK, wcol = SWA ? (wid >> 1) * 64 : 0;
    LAS char* V_lds = lds; LAS char* K_lds = lds + 5 * SHM_V;
    LAS float* ws = (LAS float*)(lds + 5 * SHM_V + 4 * SHM_K) + wid * 64; LAS float* li_l = ws; LAS float* al_l = ws + 32;
    constexpr bool NEGM = true;
    float m_reg = 0.f, l_reg = 0; f32x16 o[NCB]; f32x16 negm = f32x16{};
#pragma unroll
    for (int d = 0; d < NCB; ++d) o[d] = f32x16{};
    const bf16_t* Qw = U.Q + (size_t)(wrow + r32) * LDQ + wcol + hi * 8;
    bf16x8 qf[4];
#pragma unroll
    for (int d0 = 0; d0 < 4; ++d0) qf[d0] = *(const bf16x8*)(Qw + d0 * 16);
    const int krow = 8 * wid + (lane >> 3), klog = (lane & 7) ^ ((krow >> 1) & 7);
    const bf16_t* kp = U.K + (size_t)(U.ctx_row0 + krow) * LDK + klog * 8;
    const int vsub = 2 * wid + (lane >> 5), vkey = ((DV == 128) ? (vsub >> 2) : (vsub >> 1)) * 8 + ((lane >> 2) & 7), vcol = ((DV == 128) ? (vsub & 3) : (vsub & 1)) * 32 + (lane & 3) * 8;
    const bf16_t* vp = U.V + (size_t)(U.ctx_row0 + vkey) * LDV + vcol;
    const LAS char* vrd = V_lds + v_rd_base(lane);
    const int jump = (U.lat_row0 + 64 * U.lat_t0) - (U.ctx_row0 + 192);
#define DMA1(gp, la) asm volatile("s_mov_b32 m0, %1\n\ts_nop 0\n\tglobal_load_lds_dwordx4 %0, off" :: "v"(gp), "s"(la) : "memory", "m0")
#define DWAIT() asm volatile("s_waitcnt vmcnt(0)" ::: "memory")
    const unsigned kl0 = (unsigned)(unsigned long)(K_lds + wid * 1024), vl0 = (unsigned)(unsigned long)(V_lds + wid * 1024);
#define DMA(t, ks, vs) do { \
        DMA1(kp, kl0 + (ks) * SHM_K); \
        DMA1(vp, vl0 + (vs) * SHM_V); \
        if constexpr (DV == 128) DMA1(vp + (size_t)32 * LDV, vl0 + (vs) * SHM_V + 8 * 1024); \
        { const int adv_ = ((t) == 3) ? jump : 64; kp += (ptrdiff_t)adv_ * LDK; vp += (ptrdiff_t)adv_ * LDV; } } while (0)
#define RESC(a) do { if (__any((a) < 1.f)) { if (hi == 0) al_l[r32] = (a); asm volatile("s_waitcnt lgkmcnt(0)" ::: "memory"); \
        _Pragma("unroll") for (int d = 0; d < NCB; ++d) _Pragma("unroll") for (int r = 0; r < 16; ++r) o[d][r] *= al_l[crow(r, hi)]; } } while (0)
    const int qs = U.q0 + wrow;
#define ACTIVE(t) (!SWA || (t) < 4 || (64 * (U.lat_t0 + (t) - 4) + 63 >= qs - 128 && 64 * (U.lat_t0 + (t) - 4) <= qs + 31 + 128))
#define MASK(P0, P1, t) do { if constexpr (SWA) { if ((t) >= 4 && !(64 * (U.lat_t0 + (t) - 4) >= qs + 31 - 128 && 64 * (U.lat_t0 + (t) - 4) + 63 <= qs + 128)) { const int kb_ = 64 * (U.lat_t0 + (t) - 4) - (qs + r32) + 4 * hi; \
        _Pragma("unroll") for (int r = 0; r < 16; ++r) { const int d0_ = kb_ + (r & 3) + 8 * (r >> 2); \
            if (d0_ > 128 || d0_ < -128) P0[r] = -1e30f; if (d0_ + 32 > 128 || d0_ + 32 < -128) P1[r] = -1e30f; } } } } while (0)
    f32x16 pA0, pA1, pB0, pB1; float alA = 1.f, alB = 1.f; bf16x8 pa0, pa1, pa2, pa3; const int NT = U.NT;
    bool actA = true, actB = true;
    int v5 = 0;
#define INC5(x) ((x) == 4 ? 0 : (x) + 1)
#define STEP0(t, C, P) do { \
        act##C = ACTIVE(t); \
        SBAR(); if (act##C) { qkt_r(p##C##0, p##C##1, K_lds + ((t) & 3) * SHM_K, qf, negm, r32, hi); MASK(p##C##0, p##C##1, t); } \
        if (act##P) finishSM(p##P##0, p##P##1, al##P, l_reg, pa0, pa1, pa2, pa3); SBAR(); \
        if (act##P) pv_all<NCB>(o, vrd + v5 * SHM_V, pa0, pa1, pa2, pa3); \
        if (act##C) { partialSM<NEGM>(p##C##0, p##C##1, m_reg, negm, al##C, false); RESC(al##C); } else al##C = 1.f; \
        v5 = INC5(v5); } while (0)
    DMA(0, 0, 0); DWAIT(); __syncthreads();
    asm volatile("" : "+v"(qf[0]), "+v"(qf[1]), "+v"(qf[2]), "+v"(qf[3]));
    DMA(1, 1, 1); DMA(2, 2, 2);
    qkt_r(pA0, pA1, K_lds, qf, negm, r32, hi); MASK(pA0, pA1, 0);
    partialSM<NEGM>(pA0, pA1, m_reg, negm, alA, true);
    DWAIT(); __syncthreads();
    int vw = 3;
    HOT_ALIGN(ALG_A0);
    for (int j = 1; j + 1 < NT; j += 2) {
        if (j + 2 < NT) { DMA(j + 2, (j + 2) & 3, vw); vw = INC5(vw); }
        if (j + 3 < NT) { DMA(j + 3, (j + 3) & 3, vw); vw = INC5(vw); }
        STEP0(j, B, A); STEP0(j + 1, A, B);
        DWAIT(); __syncthreads();
    }
    if ((NT & 1) == 0) {
        STEP0(NT - 1, B, A);
        if (actB) { finishSM(pB0, pB1, alB, l_reg, pa0, pa1, pa2, pa3); SBAR(); pv_all<NCB>(o, vrd + v5 * SHM_V, pa0, pa1, pa2, pa3); }
    } else {
        if (actA) { finishSM(pA0, pA1, alA, l_reg, pa0, pa1, pa2, pa3); SBAR(); pv_all<NCB>(o, vrd + v5 * SHM_V, pa0, pa1, pa2, pa3); }
    }
    if constexpr (SWA) l_reg += __builtin_amdgcn_exp2f(U.sink[wid >> 1] * LOG2E - m_reg);
    if (hi == 0) li_l[r32] = l_reg; asm volatile("s_waitcnt lgkmcnt(0)" ::: "memory");
    float rli[16];
#pragma unroll
    for (int r = 0; r < 16; ++r) rli[r] = __builtin_amdgcn_rcpf(li_l[crow(r, hi)]);
    bf16_t* Ow = U.O + (size_t)wrow * LDO + wcol;
#pragma unroll
    for (int r = 0; r < 16; ++r) { const int orow = crow(r, hi);
#pragma unroll
        for (int d0 = 0; d0 < NCB; ++d0) Ow[(size_t)orow * LDO + d0 * 32 + r32] = (bf16_t)f2bf(o[d0][r] * rli[r]); }
    __syncthreads();
#undef DMA
#undef DMA1
#undef DWAIT
#undef RESC
#undef ACTIVE
#undef MASK
#undef INC5
#undef STEP0
}

template <int NCB, int D0> __device__ __forceinline__ void pv_one_t(f32x16& od, const LAS char* vb, bf16x8 pa0, bf16x8 pa1, bf16x8 pa2, bf16x8 pa3) {
    constexpr int KS = NCB * 1024, HS = NCB * 512;
    const s16x4 l0 = vtr(vb + D0 * 512 + 0 * KS), h0 = vtr(vb + D0 * 512 + 0 * KS + HS), l1 = vtr(vb + D0 * 512 + 1 * KS), h1 = vtr(vb + D0 * 512 + 1 * KS + HS);
    const s16x4 l2 = vtr(vb + D0 * 512 + 2 * KS), h2 = vtr(vb + D0 * 512 + 2 * KS + HS), l3 = vtr(vb + D0 * 512 + 3 * KS), h3 = vtr(vb + D0 * 512 + 3 * KS + HS);
#define PK(L, H) (bf16x8){L[0], L[1], L[2], L[3], H[0], H[1], H[2], H[3]}
    od = __builtin_amdgcn_mfma_f32_32x32x16_bf16(PK(l0, h0), pa0, od, 0, 0, 0);
    od = __builtin_amdgcn_mfma_f32_32x32x16_bf16(PK(l1, h1), pa1, od, 0, 0, 0);
    od = __builtin_amdgcn_mfma_f32_32x32x16_bf16(PK(l2, h2), pa2, od, 0, 0, 0);
    od = __builtin_amdgcn_mfma_f32_32x32x16_bf16(PK(l3, h3), pa3, od, 0, 0, 0);
#undef PK
}
template <int NCB> __device__ __forceinline__ void pv_all_t(f32x16* o, const LAS char* vb, bf16x8 pa0, bf16x8 pa1, bf16x8 pa2, bf16x8 pa3) {
    pv_one_t<NCB, 0>(o[0], vb, pa0, pa1, pa2, pa3); pv_one_t<NCB, 1>(o[1], vb, pa0, pa1, pa2, pa3);
    if constexpr (NCB == 4) { pv_one_t<NCB, 2>(o[2], vb, pa0, pa1, pa2, pa3); pv_one_t<NCB, 3>(o[3], vb, pa0, pa1, pa2, pa3); }
}
__device__ __forceinline__ void pv_mm_t(f32x16& od, const s16x4 (&f)[8], bf16x8 pa0, bf16x8 pa1, bf16x8 pa2, bf16x8 pa3) {
#define PK(L, H) (bf16x8){L[0], L[1], L[2], L[3], H[0], H[1], H[2], H[3]}
    od = __builtin_amdgcn_mfma_f32_32x32x16_bf16(PK(f[0], f[1]), pa0, od, 0, 0, 0);
    od = __builtin_amdgcn_mfma_f32_32x32x16_bf16(PK(f[2], f[3]), pa1, od, 0, 0, 0);
    od = __builtin_amdgcn_mfma_f32_32x32x16_bf16(PK(f[4], f[5]), pa2, od, 0, 0, 0);
    od = __builtin_amdgcn_mfma_f32_32x32x16_bf16(PK(f[6], f[7]), pa3, od, 0, 0, 0);
#undef PK
}
__device__ __forceinline__ unsigned cvtpk_n(float lo, float hi) { unsigned r; asm volatile("v_cvt_pk_bf16_f32 %0, %1, %2\n\ts_nop 1" : "=v"(r) : "v"(lo), "v"(hi)); return r; }
template <int NCB> __device__ __forceinline__ void store_rows_t(const f32x16* o, const float rl, bf16_t* orow, const int hi) {
#pragma unroll
    for (int d = 0; d < NCB; ++d)
#pragma unroll
        for (int k = 0; k < 4; k += 2) {
            unsigned ax = cvtpk_n(o[d][4 * k + 0] * rl, o[d][4 * k + 1] * rl), ay = cvtpk_n(o[d][4 * k + 2] * rl, o[d][4 * k + 3] * rl);
            unsigned bx = cvtpk_n(o[d][4 * k + 4] * rl, o[d][4 * k + 5] * rl), by = cvtpk_n(o[d][4 * k + 6] * rl, o[d][4 * k + 7] * rl);
            { auto r = __builtin_amdgcn_permlane32_swap(ax, bx, false, false); ax = r[0]; bx = r[1]; }
            { auto r = __builtin_amdgcn_permlane32_swap(ay, by, false, false); ay = r[0]; by = r[1]; }
            *(u32x4*)(orow + d * 32 + 8 * k + (hi ? 8 : 0)) = (u32x4){ax, ay, bx, by};
        }
}
template <int NCB, int D0> __device__ __forceinline__ void pv_ld(const LAS char* vb, s16x4 (&f)[8]) {
    constexpr int KS = NCB * 1024, HS = NCB * 512;
#pragma unroll
    for (int s = 0; s < 4; ++s) { f[2 * s] = vtr(vb + D0 * 512 + s * KS); f[2 * s + 1] = vtr(vb + D0 * 512 + s * KS + HS); }
}
__device__ __forceinline__ void pv_mm(f32x16& od, const s16x4 (&f)[8], bf16x8 pa0, bf16x8 pa1, bf16x8 pa2, bf16x8 pa3) {
#define PK(L, H) (bf16x8){L[0], L[1], L[2], L[3], H[0], H[1], H[2], H[3]}
    od = __builtin_amdgcn_mfma_f32_32x32x16_bf16(pa0, PK(f[0], f[1]), od, 0, 0, 0);
    od = __builtin_amdgcn_mfma_f32_32x32x16_bf16(pa1, PK(f[2], f[3]), od, 0, 0, 0);
    od = __builtin_amdgcn_mfma_f32_32x32x16_bf16(pa2, PK(f[4], f[5]), od, 0, 0, 0);
    od = __builtin_amdgcn_mfma_f32_32x32x16_bf16(pa3, PK(f[6], f[7]), od, 0, 0, 0);
#undef PK
}
template <int DV, bool SWA>
__device__ __forceinline__ void attn_unit_pg(const UnitDesc& U, LAS char* lds, const int tid) {
    constexpr int NCB = DV / 32, NP = DV == 128 ? 3 : 2;
    constexpr int LDQ = SWA ? 1024 : 512, LDK = SWA ? 256 : 512, LDV = LDK, LDO = 1024;
    constexpr int SHM_V = KVBLK * DV * 2, SHM_K = KVBLK * 64 * 2;
    const int wid = __builtin_amdgcn_readfirstlane(tid >> 6), lane = tid & 63, r32 = lane & 31, hi = lane >> 5;
    const int wrow = SWA ? (wid & 1) * QBLK : wid * QBLK, wcol = SWA ? (wid >> 1) * 64 : 0;
    const int grp = wid >> 2;
    LAS char* V_lds = lds; LAS char* K_lds = lds + 5 * SHM_V;
    LAS float* ws = (LAS float*)(lds + 5 * SHM_V + 4 * SHM_K) + wid * 64; LAS float* li_l = ws; LAS float* al_l = ws + 32;
    constexpr bool NEGM = true;
    float m_reg = 0.f, l_reg = 0; f32x16 o[NCB]; f32x16 negm = f32x16{};
#pragma unroll
    for (int d = 0; d < NCB; ++d) o[d] = f32x16{};
    const bf16_t* Qw = U.Q + (size_t)(wrow + r32) * LDQ + wcol + hi * 8;
    bf16x8 qf[4];
#pragma unroll
    for (int d0 = 0; d0 < 4; ++d0) qf[d0] = *(const bf16x8*)(Qw + d0 * 16);
    const int krow = 8 * wid + (lane >> 3), klog = (lane & 7) ^ ((krow >> 1) & 7);
    const bf16_t* kp = U.K + (size_t)(U.ctx_row0 + krow) * LDK + klog * 8;
    const int vsub = 2 * wid + (lane >> 5), vkey = ((DV == 128) ? (vsub >> 2) : (vsub >> 1)) * 8 + ((lane >> 2) & 7), vcol = ((DV == 128) ? (vsub & 3) : (vsub & 1)) * 32 + (lane & 3) * 8;
    const bf16_t* vp = U.V + (size_t)(U.ctx_row0 + vkey) * LDV + vcol;
    const LAS char* vrd = V_lds + v_rd_base(lane);
    const int jump = (U.lat_row0 + 64 * U.lat_t0) - (U.ctx_row0 + 192);
#define DMA1(gp, la) asm volatile("s_mov_b32 m0, %1\n\ts_nop 0\n\tglobal_load_lds_dwordx4 %0, off" :: "v"(gp), "s"(la) : "memory", "m0")
    const unsigned kl0 = (unsigned)(unsigned long)(K_lds + wid * 1024), vl0 = (unsigned)(unsigned long)(V_lds + wid * 1024);
#define DMA(t, ks, vs) do { \
        DMA1(kp, kl0 + (ks) * SHM_K); \
        DMA1(vp, vl0 + (vs) * SHM_V); \
        if constexpr (DV == 128) DMA1(vp + (size_t)32 * LDV, vl0 + (vs) * SHM_V + 8 * 1024); \
        { const int adv_ = ((t) == 3) ? jump : 64; kp += (ptrdiff_t)adv_ * LDK; vp += (ptrdiff_t)adv_ * LDV; } } while (0)
#define RESC(a) do { if (__any((a) < 1.f)) { _Pragma("unroll") for (int d = 0; d < NCB; ++d) _Pragma("unroll") for (int r = 0; r < 16; ++r) o[d][r] *= (a); } } while (0)
    const int qs = U.q0 + wrow;
#define ACTIVE(t) (!SWA || (t) < 4 || (64 * (U.lat_t0 + (t) - 4) + 63 >= qs - 128 && 64 * (U.lat_t0 + (t) - 4) <= qs + 31 + 128))
#define MASK(P0, P1, t) do { if constexpr (SWA) { if ((t) >= 4 && !(64 * (U.lat_t0 + (t) - 4) >= qs + 31 - 128 && 64 * (U.lat_t0 + (t) - 4) + 63 <= qs + 128)) { const int kb_ = 64 * (U.lat_t0 + (t) - 4) - (qs + r32) + 4 * hi; \
        _Pragma("unroll") for (int r = 0; r < 16; ++r) { const int d0_ = kb_ + (r & 3) + 8 * (r >> 2); \
            if (d0_ > 128 || d0_ < -128) P0[r] = -1e30f; if (d0_ + 32 > 128 || d0_ + 32 < -128) P1[r] = -1e30f; } } } } while (0)
#define INC5(x) ((x) == 4 ? 0 : (x) + 1)
#define BAR() asm volatile("s_barrier" ::: "memory")
#define BARW(t) do { if ((t) + 4 < NT) asm volatile("s_waitcnt vmcnt(%0)\n\ts_barrier" :: "n"(NP) : "memory"); else asm volatile("s_waitcnt vmcnt(0)\n\ts_barrier" ::: "memory"); } while (0)
    f32x16 p0, p1; float alpha = 1.f; bf16x8 pa0, pa1, pa2, pa3; const int NT = U.NT;
    bf16x8 kf[4], kg[4];
    s16x4 va[8], vb2[8], vc[8], vd[8];
    static_assert(!SWA, "the ping-pong body is written for dense units (every tile active, no mask)");
    bool actn = false, actq = false, actp = false;
    int vr = 0, vw = 4;
#define KLOAD(t) do { const LAS char* Ks_ = K_lds + ((t) & 3) * SHM_K; \
        _Pragma("unroll") for (int d0 = 0; d0 < 4; ++d0) { const int cb_ = (d0 * 16 + hi * 8) * 2; kf[2 * d0] = *(const LAS bf16x8*)(Ks_ + KSWZ(r32, cb_)); kf[2 * d0 + 1] = *(const LAS bf16x8*)(Ks_ + KSWZ(32 + r32, cb_)); } } while (0)
#define KLOADH(t, h, KF) do { const LAS char* Ks_ = K_lds + ((t) & 3) * SHM_K; \
        _Pragma("unroll") for (int d_ = 0; d_ < 2; ++d_) { const int cb_ = ((2 * (h) + d_) * 16 + hi * 8) * 2; KF[2 * d_] = *(const LAS bf16x8*)(Ks_ + KSWZ(r32, cb_)); KF[2 * d_ + 1] = *(const LAS bf16x8*)(Ks_ + KSWZ(32 + r32, cb_)); } } while (0)
#define SEG_M(t, HQ, HP) do { SBAR(); __builtin_amdgcn_s_setprio(2);        \
        if ((t) >= 0 && (t) + 4 < NT) { DMA((t) + 4, ((t) + 4) & 3, vw); vw = INC5(vw); } \
        const LAS char* vb_ = vrd + vr * SHM_V; \
        SBAR(); \
        if constexpr (HQ) { KLOADH((t) + 1, 0, kf); KLOADH((t) + 1, 1, kg); } \
        if constexpr (HP && NCB == 4) { pv_ld<NCB, 2>(vb_, vc); pv_ld<NCB, 3>(vb_, vd); } \
        if constexpr (HP) { pv_mm_t(o[0], va, pa0, pa1, pa2, pa3); pv_mm_t(o[1], vb2, pa0, pa1, pa2, pa3); } \
        if constexpr (HQ) { \
            asm("v_mfma_f32_32x32x16_bf16 %0, %1, %2, %3" : "=&v"(p0) : "v"(kf[0]), "v"(qf[0]), "v"(negm)); \
            asm("v_mfma_f32_32x32x16_bf16 %0, %1, %2, %3" : "=&v"(p1) : "v"(kf[1]), "v"(qf[0]), "v"(negm)); \
            p0 = __builtin_amdgcn_mfma_f32_32x32x16_bf16(kf[2], qf[1], p0, 0, 0, 0); p1 = __builtin_amdgcn_mfma_f32_32x32x16_bf16(kf[3], qf[1], p1, 0, 0, 0); \
            p0 = __builtin_amdgcn_mfma_f32_32x32x16_bf16(kg[0], qf[2], p0, 0, 0, 0); p1 = __builtin_amdgcn_mfma_f32_32x32x16_bf16(kg[1], qf[2], p1, 0, 0, 0); \
            p0 = __builtin_amdgcn_mfma_f32_32x32x16_bf16(kg[2], qf[3], p0, 0, 0, 0); p1 = __builtin_amdgcn_mfma_f32_32x32x16_bf16(kg[3], qf[3], p1, 0, 0, 0); } \
        if constexpr (HP && NCB == 4) { pv_mm_t(o[2], vc, pa0, pa1, pa2, pa3); pv_mm_t(o[3], vd, pa0, pa1, pa2, pa3); } \
        if constexpr (HQ) { const LAS char* vn_ = vrd + (HP ? INC5(vr) : vr) * SHM_V; pv_ld<NCB, 0>(vn_, va); pv_ld<NCB, 1>(vn_, vb2); }        \
        if constexpr (HQ && HP) { \
            _Pragma("unroll") for (int g_ = 0; g_ < 20; ++g_) { __builtin_amdgcn_sched_group_barrier(0x008, 1, 0); __builtin_amdgcn_sched_group_barrier(0x100, 2, 0); } \
            __builtin_amdgcn_sched_group_barrier(0x008, 4, 0); } \
        actq = HQ; \
        if constexpr (HP) vr = INC5(vr); \
        __builtin_amdgcn_s_setprio(0); SBAR(); } while (0)
#define SEG_V(t, first) do { SBAR(); \
        if (actq) { partialSM<NEGM>(p0, p1, m_reg, negm, alpha, first); if (first) alpha = 1.f; else RESC(alpha); finishSM(p0, p1, alpha, l_reg, pa0, pa1, pa2, pa3); } \
        actp = actq; SBAR(); } while (0)
    DMA(0, 0, 0); DMA(1, 1, 1); DMA(2, 2, 2); DMA(3, 3, 3);
    asm volatile("s_waitcnt vmcnt(0)" ::: "memory"); __syncthreads();
    asm volatile("" : "+v"(qf[0]), "+v"(qf[1]), "+v"(qf[2]), "+v"(qf[3]));
    if (grp) BAR();
    SEG_M(-1, true, false); BAR();
    SEG_V(0, true); BAR();
    for (int t = 0; t + 1 < NT; ++t) {
        SEG_M(t, true, true); BARW(t);
        SEG_V(t + 1, false); BAR();
    }
    SEG_M(NT - 1, false, true); BARW(NT - 1);
    if (!grp) BAR();
    if constexpr (SWA) l_reg += __builtin_amdgcn_exp2f(U.sink[wid >> 1] * LOG2E - m_reg);
    store_rows_t<NCB>(o, __builtin_amdgcn_rcpf(l_reg), U.O + (size_t)(wrow + r32) * LDO + wcol, hi);
    __syncthreads();
#undef DMA
#undef DMA1
#undef RESC
#undef ACTIVE
#undef MASK
#undef INC5
#undef BAR
#undef BARW
#undef KLOAD
#undef SEG_M
#undef KLOADH
#undef SEG_V
}

__device__ __forceinline__ void attn_unit_pair(const UnitDesc& U, const float lam, const float* sgp, LAS char* lds, const int tid) {
    constexpr int DV = 128; constexpr bool SWA = false;
    constexpr int NCB = DV / 32, NP = 4;
    constexpr int LDQ = SWA ? 1024 : 512, LDK = SWA ? 256 : 512, LDV = LDK, LDO = 1024;
    constexpr int SHM_V = KVBLK * DV * 2, SHM_K = 2 * KVBLK * 64 * 2;
    const int wid = __builtin_amdgcn_readfirstlane(tid >> 6), lane = tid & 63, r32 = lane & 31, hi = lane >> 5;
    const int grp = wid >> 2;
    const int wrow = (wid & 3) * QBLK, wcol = grp * 64;
    LAS char* V_lds = lds; LAS char* K_lds = lds + 5 * SHM_V;
    static_assert(5 * SHM_V + 4 * SHM_K <= RING_BYTES, "rings");
    constexpr bool NEGM = true;
    float m_reg = 0.f, l_reg = 0; f32x16 o[NCB]; f32x16 negm = f32x16{};
#pragma unroll
    for (int d = 0; d < NCB; ++d) o[d] = f32x16{};
    const bf16_t* Qw = U.Q + (size_t)(wrow + r32) * LDQ + wcol + hi * 8;
    bf16x8 qf[4];
#pragma unroll
    for (int d0 = 0; d0 < 4; ++d0) qf[d0] = *(const bf16x8*)(Qw + d0 * 16);
    const int krow = 8 * wid + (lane >> 3), klog = (lane & 7) ^ ((krow >> 1) & 7);
    const int vsub = 2 * wid + (lane >> 5), vkey = (vsub >> 2) * 8 + ((lane >> 2) & 7), vcol = (vsub & 3) * 32 + (lane & 3) * 8;
    const unsigned kvoff = (unsigned)(krow * LDK + klog * 8) * 2u, vvoff = (unsigned)(vkey * LDV + vcol) * 2u;
    const __amdgpu_buffer_rsrc_t srdK = __builtin_amdgcn_make_buffer_rsrc((void*)U.K, (short)0, (int)((size_t)(MALL - 1) * LDK * 2 + 256), 0x00020000);
    const __amdgpu_buffer_rsrc_t srdV = __builtin_amdgcn_make_buffer_rsrc((void*)U.V, (short)0, (int)((size_t)(MALL - 1) * LDV * 2 + 256), 0x00020000);
    unsigned soff = (unsigned)U.ctx_row0 * (unsigned)(LDK * 2);
    const LAS char* vrd = V_lds + v_rd_base(lane);
    const unsigned sjump = (unsigned)((U.lat_row0 + 64 * U.lat_t0) - (U.ctx_row0 + 192)) * (unsigned)(LDK * 2);
#define DMA1(vo, srd, so, la, IMM) asm volatile("s_mov_b32 m0, %0\n\ts_nop 0\n\tbuffer_load_dwordx4 %1, %2, %3 offen offset:" #IMM " lds" :: "s"(la), "v"(vo), "s"(srd), "s"(so) : "m0", "memory")
    const unsigned kl0 = (unsigned)(unsigned long)(K_lds + wid * 1024), vl0 = (unsigned)(unsigned long)(V_lds + wid * 1024);
#define DMA(t, ks, vs) do { \
        DMA1(kvoff, srdK, soff, kl0 + (ks) * SHM_K, 0); \
        DMA1(kvoff, srdK, soff + 128u, kl0 + (ks) * SHM_K + 8 * 1024, 0);        \
        DMA1(vvoff, srdV, soff, vl0 + (vs) * SHM_V, 0); \
        DMA1(vvoff, srdV, soff + 32u * LDV * 2u, vl0 + (vs) * SHM_V + 8 * 1024, 0); \
        soff += ((t) == 3) ? sjump : 64u * LDK * 2u; } while (0)
#define RESC(a) do { if (__any((a) < 1.f)) { _Pragma("unroll") for (int d = 0; d < NCB; ++d) _Pragma("unroll") for (int r = 0; r < 16; ++r) o[d][r] *= (a); } } while (0)
    const int qs = U.q0 + wrow;
#define ACTIVE(t) (!SWA || (t) < 4 || (64 * (U.lat_t0 + (t) - 4) + 63 >= qs - 128 && 64 * (U.lat_t0 + (t) - 4) <= qs + 31 + 128))
#define MASK(P0, P1, t) do { if constexpr (SWA) { if ((t) >= 4 && !(64 * (U.lat_t0 + (t) - 4) >= qs + 31 - 128 && 64 * (U.lat_t0 + (t) - 4) + 63 <= qs + 128)) { const int kb_ = 64 * (U.lat_t0 + (t) - 4) - (qs + r32) + 4 * hi; \
        _Pragma("unroll") for (int r = 0; r < 16; ++r) { const int d0_ = kb_ + (r & 3) + 8 * (r >> 2); \
            if (d0_ > 128 || d0_ < -128) P0[r] = -1e30f; if (d0_ + 32 > 128 || d0_ + 32 < -128) P1[r] = -1e30f; } } } } while (0)
#define INC5(x) ((x) == 4 ? 0 : (x) + 1)
#define BAR() asm volatile("s_barrier" ::: "memory")
#define BARW(t) do { if ((t) + 4 < NT) asm volatile("s_waitcnt vmcnt(%0)\n\ts_barrier" :: "n"(NP) : "memory"); else asm volatile("s_waitcnt vmcnt(0)\n\ts_barrier" ::: "memory"); } while (0)
    f32x16 p0, p1; float alpha = 1.f; bf16x8 pa0, pa1, pa2, pa3; const int NT = U.NT;
    bf16x8 kf[4], kg[4];
    s16x4 va[8], vb2[8], vc[8], vd[8];
    static_assert(!SWA, "the ping-pong body is written for dense units (every tile active, no mask)");
    bool actn = false, actq = false, actp = false;
    int vr = 0, vw = 4;
#define KLOAD(t) do { const LAS char* Ks_ = K_lds + ((t) & 3) * SHM_K; \
        _Pragma("unroll") for (int d0 = 0; d0 < 4; ++d0) { const int cb_ = (d0 * 16 + hi * 8) * 2; kf[2 * d0] = *(const LAS bf16x8*)(Ks_ + KSWZ(r32, cb_)); kf[2 * d0 + 1] = *(const LAS bf16x8*)(Ks_ + KSWZ(32 + r32, cb_)); } } while (0)
#define KLOADH(t, h, KF) do { const LAS char* Ks_ = K_lds + ((t) & 3) * SHM_K + grp * 8192; \
        _Pragma("unroll") for (int d_ = 0; d_ < 2; ++d_) { const int cb_ = ((2 * (h) + d_) * 16 + hi * 8) * 2; KF[2 * d_] = *(const LAS bf16x8*)(Ks_ + KSWZ(r32, cb_)); KF[2 * d_ + 1] = *(const LAS bf16x8*)(Ks_ + KSWZ(32 + r32, cb_)); } } while (0)
#define SEG_M(t, HQ, HP) do { SBAR(); __builtin_amdgcn_s_setprio(2);        \
        if ((t) >= 0 && (t) + 4 < NT) { DMA((t) + 4, ((t) + 4) & 3, vw); vw = INC5(vw); } \
        const LAS char* vb_ = vrd + vr * SHM_V; \
        SBAR(); \
        if constexpr (HQ) { KLOADH((t) + 1, 0, kf); KLOADH((t) + 1, 1, kg); } \
        if constexpr (HP && NCB == 4) { pv_ld<NCB, 2>(vb_, vc); pv_ld<NCB, 3>(vb_, vd); } \
        if constexpr (HP) { pv_mm_t(o[0], va, pa0, pa1, pa2, pa3); pv_mm_t(o[1], vb2, pa0, pa1, pa2, pa3); } \
        if constexpr (HQ) { \
            asm("v_mfma_f32_32x32x16_bf16 %0, %1, %2, %3" : "=&v"(p0) : "v"(kf[0]), "v"(qf[0]), "v"(negm)); \
            asm("v_mfma_f32_32x32x16_bf16 %0, %1, %2, %3" : "=&v"(p1) : "v"(kf[1]), "v"(qf[0]), "v"(negm)); \
            p0 = __builtin_amdgcn_mfma_f32_32x32x16_bf16(kf[2], qf[1], p0, 0, 0, 0); p1 = __builtin_amdgcn_mfma_f32_32x32x16_bf16(kf[3], qf[1], p1, 0, 0, 0); \
            p0 = __builtin_amdgcn_mfma_f32_32x32x16_bf16(kg[0], qf[2], p0, 0, 0, 0); p1 = __builtin_amdgcn_mfma_f32_32x32x16_bf16(kg[1], qf[2], p1, 0, 0, 0); \
            p0 = __builtin_amdgcn_mfma_f32_32x32x16_bf16(kg[2], qf[3], p0, 0, 0, 0); p1 = __builtin_amdgcn_mfma_f32_32x32x16_bf16(kg[3], qf[3], p1, 0, 0, 0); } \
        if constexpr (HP && NCB == 4) { pv_mm_t(o[2], vc, pa0, pa1, pa2, pa3); pv_mm_t(o[3], vd, pa0, pa1, pa2, pa3); } \
        if constexpr (HQ) { const LAS char* vn_ = vrd + (HP ? INC5(vr) : vr) * SHM_V; pv_ld<NCB, 0>(vn_, va); pv_ld<NCB, 1>(vn_, vb2); }        \
        if constexpr (HQ && HP) { \
            _Pragma("unroll") for (int g_ = 0; g_ < 20; ++g_) { __builtin_amdgcn_sched_group_barrier(0x008, 1, 0); __builtin_amdgcn_sched_group_barrier(0x100, 2, 0); } \
            __builtin_amdgcn_sched_group_barrier(0x008, 4, 0); } \
        actq = HQ; \
        if constexpr (HP) vr = INC5(vr); \
        __builtin_amdgcn_s_setprio(0); SBAR(); } while (0)
#define SEG_V(t, first) do { SBAR(); \
        if (actq) { partialSM<NEGM>(p0, p1, m_reg, negm, alpha, first); if (first) alpha = 1.f; else RESC(alpha); finishSM(p0, p1, alpha, l_reg, pa0, pa1, pa2, pa3); } \
        actp = actq; SBAR(); } while (0)
    DMA(0, 0, 0); DMA(1, 1, 1); DMA(2, 2, 2); DMA(3, 3, 3);
    asm volatile("s_waitcnt vmcnt(0)" ::: "memory"); __syncthreads();
    asm volatile("" : "+v"(qf[0]), "+v"(qf[1]), "+v"(qf[2]), "+v"(qf[3]));
    if (grp) BAR();
    SEG_M(-1, true, false); BAR();
    SEG_V(0, true); BAR();
    for (int t = 0; t + 1 < NT; ++t) {
        SEG_M(t, true, true); BARW(t);
        SEG_V(t + 1, false); BAR();
    }
    SEG_M(NT - 1, false, true); BARW(NT - 1);
    if (!grp) BAR();
    { const float rl = __builtin_amdgcn_rcpf(l_reg);
#pragma unroll
      for (int d = 0; d < NCB; ++d)
#pragma unroll
          for (int r = 0; r < 16; ++r) o[d][r] *= rl; }
    LAS char* xb = lds + (wid & 3) * 16384 + lane * 16;
    if (grp) {
#pragma unroll
        for (int d = 0; d < NCB; ++d)
#pragma unroll
            for (int k = 0; k < 4; ++k) *(LAS f32x4*)(xb + (d * 4 + k) * 1024) = (f32x4){o[d][4 * k], o[d][4 * k + 1], o[d][4 * k + 2], o[d][4 * k + 3]};
    }
    __syncthreads();
    if (!grp) {
        float ss = 0.f;
#pragma unroll
        for (int d = 0; d < NCB; ++d)
#pragma unroll
            for (int k = 0; k < 4; ++k) { const f32x4 od = *(const LAS f32x4*)(xb + (d * 4 + k) * 1024);
#pragma unroll
                for (int j = 0; j < 4; ++j) { const float v = o[d][4 * k + j] - lam * od[j]; o[d][4 * k + j] = v; ss += v * v; } }
        { auto rr = __builtin_amdgcn_permlane32_swap(__float_as_uint(ss), __float_as_uint(ss), false, false); ss = __uint_as_float(rr[0]) + __uint_as_float(rr[1]); }
        const float rs = (1.f - LAM_INIT) / sqrtf(ss * (1.f / 128.f) + NORM_EPS);
#pragma unroll
        for (int d = 0; d < NCB; ++d)
#pragma unroll
            for (int k = 0; k < 4; ++k) { const f32x4 gq = *(const f32x4*)(sgp + d * 32 + 8 * k + 4 * hi);
#pragma unroll
                for (int j = 0; j < 4; ++j) o[d][4 * k + j] *= rs * gq[j]; }
        store_rows_t<NCB>(o, 1.f, U.O + (size_t)(wrow + r32) * LDO, hi);
    }
    __syncthreads();
#undef DMA
#undef DMA1
#undef RESC
#undef ACTIVE
#undef MASK
#undef INC5
#undef BAR
#undef BARW
#undef KLOAD
#undef SEG_M
#undef KLOADH
#undef SEG_V
}

template <int DV, bool SWA, class Gen>
__device__ __forceinline__ void attn_stream(const Gen& gen, const int nunits, LAS char* lds, const int tid) {
    constexpr int NCB = DV / 32;
    constexpr int LDQ = SWA ? 1024 : 512, LDK = SWA ? 256 : 512, LDV = LDK, LDO = 1024;
    constexpr int SHM_V = KVBLK * DV * 2, SHM_K = KVBLK * 64 * 2;
    static_assert(5 * SHM_V + 5 * SHM_K + 2048 <= RING_BYTES, "rings");
    if (nunits <= 0) return;
    const int wid = __builtin_amdgcn_readfirstlane(tid >> 6), lane = tid & 63, r32 = lane & 31, hi = lane >> 5;
    const int wrow = SWA ? (wid & 1) * QBLK : wid * QBLK, wcol = SWA ? (wid >> 1) * 64 : 0;
    LAS char* V_lds = lds; LAS char* K_lds = lds + 5 * SHM_V;
    LAS float* ws = (LAS float*)(lds + 5 * SHM_V + 5 * SHM_K) + wid * 64; LAS float* li_l = ws; LAS float* al_l = ws + 32;
    constexpr bool NEGM = true;
    const int krow = 8 * wid + (lane >> 3), klog = (lane & 7) ^ ((krow >> 1) & 7);
    const int vsub = 2 * wid + (lane >> 5), vkey = ((DV == 128) ? (vsub >> 2) : (vsub >> 1)) * 8 + ((lane >> 2) & 7), vcol = ((DV == 128) ? (vsub & 3) : (vsub & 1)) * 32 + (lane & 3) * 8;
    const LAS char* vrd = V_lds + v_rd_base(lane);
    const unsigned kl0 = (unsigned)(unsigned long)(K_lds + wid * 1024), vl0 = (unsigned)(unsigned long)(V_lds + wid * 1024);
    const bf16_t* kp; const bf16_t* vp; int jump; bf16x8 qf[4];
#define DMA1(gp, la) asm volatile("s_mov_b32 m0, %1\n\ts_nop 0\n\tglobal_load_lds_dwordx4 %0, off" :: "v"(gp), "s"(la) : "memory", "m0")
#define DWAIT() asm volatile("s_waitcnt vmcnt(0)" ::: "memory")
#define DMA(t, s) do { \
        DMA1(kp, kl0 + (s) * SHM_K); \
        DMA1(vp, vl0 + (s) * SHM_V); \
        if constexpr (DV == 128) DMA1(vp + (size_t)32 * LDV, vl0 + (s) * SHM_V + 8 * 1024); \
        { const int adv_ = ((t) == 3) ? jump : 64; kp += (ptrdiff_t)adv_ * LDK; vp += (ptrdiff_t)adv_ * LDV; } } while (0)
#define SETUP(UU) do { kp = (UU).K + (size_t)((UU).ctx_row0 + krow) * LDK + klog * 8; vp = (UU).V + (size_t)((UU).ctx_row0 + vkey) * LDV + vcol; \
        jump = ((UU).lat_row0 + 64 * (UU).lat_t0) - ((UU).ctx_row0 + 192); } while (0)
#define QLOAD(UU) do { const bf16_t* Qw_ = (UU).Q + (size_t)(wrow + r32) * LDQ + wcol + hi * 8; _Pragma("unroll") for (int d0 = 0; d0 < 4; ++d0) qf[d0] = *(const bf16x8*)(Qw_ + d0 * 16); } while (0)
#define INC5(x) ((x) == 4 ? 0 : (x) + 1)
#define RESC(a) do { if (__any((a) < 1.f)) { _Pragma("unroll") for (int d = 0; d < NCB; ++d) _Pragma("unroll") for (int r = 0; r < 16; ++r) o[d][r] *= (a); } } while (0)
#define ACTIVE(t) (!SWA || (t) < 4 || (64 * (U.lat_t0 + (t) - 4) + 63 >= qs - 128 && 64 * (U.lat_t0 + (t) - 4) <= qs + 31 + 128))
#define MASK(P0, P1, t) do { if constexpr (SWA) { if ((t) >= 4 && !(64 * (U.lat_t0 + (t) - 4) >= qs + 31 - 128 && 64 * (U.lat_t0 + (t) - 4) + 63 <= qs + 128)) { const int kb_ = 64 * (U.lat_t0 + (t) - 4) - (qs + r32) + 4 * hi; \
        _Pragma("unroll") for (int r = 0; r < 16; ++r) { const int d0_ = kb_ + (r & 3) + 8 * (r >> 2); \
            if (d0_ > 128 || d0_ < -128) P0[r] = -1e30f; if (d0_ + 32 > 128 || d0_ + 32 < -128) P1[r] = -1e30f; } } } } while (0)
#define STEP0(t, C, P) do { \
        act##C = ACTIVE(t); \
        SBAR(); if (act##C) { qkt_r(p##C##0, p##C##1, K_lds + INC5(v5) * SHM_K, qf, negm, r32, hi); MASK(p##C##0, p##C##1, t); } \
        if (act##P) finishSM(p##P##0, p##P##1, al##P, l_reg, pa0, pa1, pa2, pa3); SBAR(); \
        if (act##P) pv_all_t<NCB>(o, vrd + v5 * SHM_V, pa0, pa1, pa2, pa3); \
        if (act##C) { partialSM<NEGM>(p##C##0, p##C##1, m_reg, negm, al##C, false); RESC(al##C); } else al##C = 1.f; \
        v5 = INC5(v5); } while (0)
    UnitDesc U, Un; float sink_n = 0.f;
    gen(0, Un); SETUP(Un); if constexpr (SWA) sink_n = Un.sink[wid >> 1]; QLOAD(Un);
    DMA(0, 0); DMA(1, 1); DMA(2, 2);
    DWAIT(); __syncthreads();
    asm volatile("" : "+v"(qf[0]), "+v"(qf[1]), "+v"(qf[2]), "+v"(qf[3]), "+v"(sink_n));
    int rb = 0;
    for (int ui = 0; ui < nunits; ++ui) {
        U = Un; const float sinkv = sink_n;
        const int NT = U.NT, qs = U.q0 + wrow;
        float m_reg = 0.f, l_reg = 0.f; f32x16 o[NCB]; f32x16 negm = f32x16{};
#pragma unroll
        for (int d = 0; d < NCB; ++d) o[d] = f32x16{};
        f32x16 pA0, pA1, pB0, pB1; float alA = 1.f, alB = 1.f; bf16x8 pa0, pa1, pa2, pa3;
        bool actA = true, actB = true;
        int v5 = rb;
        int vw = rb + 3 >= 5 ? rb - 2 : rb + 3;
        qkt_r(pA0, pA1, K_lds + rb * SHM_K, qf, negm, r32, hi); MASK(pA0, pA1, 0);
        partialSM<NEGM>(pA0, pA1, m_reg, negm, alA, true);
        HOT_ALIGN(ALG_A1);
        for (int j = 1; j + 1 < NT; j += 2) {
            if (j + 2 < NT) { DMA(j + 2, vw); vw = INC5(vw); }
            if (j + 3 < NT) { DMA(j + 3, vw); vw = INC5(vw); }
            STEP0(j, B, A); STEP0(j + 1, A, B);
            DWAIT(); __syncthreads();
        }
        const bool has_next = ui + 1 < nunits;
        const int rbn = vw;
        if (has_next) { gen(ui + 1, Un); SETUP(Un); DMA(0, vw); vw = INC5(vw); DMA(1, vw); vw = INC5(vw); DMA(2, vw); }
        const bool even = (NT & 1) == 0;
        if (even) STEP0(NT - 1, B, A);
        SBAR();
        if (has_next) { if constexpr (SWA) sink_n = Un.sink[wid >> 1]; QLOAD(Un); }
        if (even) { if (actB) { finishSM(pB0, pB1, alB, l_reg, pa0, pa1, pa2, pa3); SBAR(); pv_all_t<NCB>(o, vrd + v5 * SHM_V, pa0, pa1, pa2, pa3); } }
        else      { if (actA) { finishSM(pA0, pA1, alA, l_reg, pa0, pa1, pa2, pa3); SBAR(); pv_all_t<NCB>(o, vrd + v5 * SHM_V, pa0, pa1, pa2, pa3); } }
        SBAR();
        if constexpr (SWA) l_reg += __builtin_amdgcn_exp2f(sinkv * LOG2E - m_reg);
        asm volatile("" : "+v"(qf[0]), "+v"(qf[1]), "+v"(qf[2]), "+v"(qf[3]), "+v"(sink_n));
        store_rows_t<NCB>(o, __builtin_amdgcn_rcpf(l_reg), U.O + (size_t)(wrow + r32) * LDO + wcol, hi);
        if (has_next) asm volatile("s_waitcnt lgkmcnt(0)\n\ts_barrier" ::: "memory");
        else __syncthreads();
        rb = rbn;
    }
#undef DMA
#undef DMA1
#undef DWAIT
#undef SETUP
#undef QLOAD
#undef RESC
#undef ACTIVE
#undef MASK
#undef INC5
#undef STEP0
}
#undef SBAR
#undef KSWZ
}

struct Args { const float* in[32]; float* out; unsigned char* ws; int nprog, pad; unsigned char prog[64]; };
struct ArgsD { const GAS float* in[32]; GAS float* out; GAS unsigned char* ws; int nprog, pad; unsigned char prog[64]; };
typedef const __attribute__((address_space(4))) ArgsD* ArgsP;
#define APIN(i) ((const float*)ap->in[i])
#define APOUT ((float*)ap->out)

struct Frame {
    LAS unsigned char* lds;
    int tid, lane, wave, vcu, G, gw, NGW;
    unsigned char* ws;
};

__device__ __forceinline__ int rope_src(int p) { return 16 * ((p >> 2) & 1) + 4 * (p >> 3) + (p & 3); }
__device__ __forceinline__ void transpose_item(const float* W, int N, bf16_t* WT, int src0, int dst_row0, int k0, bool perm, LAS float* scr, int lane) {
    float tv[32];
#pragma unroll
    for (int i = 0; i < 32; ++i) { const int kk = 2 * i + (lane >> 5); tv[i] = __builtin_nontemporal_load(W + (size_t)(k0 + kk) * N + src0 + (lane & 31)); }
#pragma unroll
    for (int i = 0; i < 32; ++i) { const int kk = 2 * i + (lane >> 5); scr[kk * 33 + (lane & 31)] = tv[i]; }
    LDS_WAIT(); asm volatile("" ::: "memory");
    const int c = lane & 7;
#pragma unroll
    for (int j = 0; j < 4; ++j) { const int n = (lane >> 3) + 8 * j; const int sn = perm ? rope_src(n) : n; const LAS float* s = scr + (8 * c) * 33 + sn;
        u32x4 o; o.x = pk2(s[0 * 33], s[1 * 33]); o.y = pk2(s[2 * 33], s[3 * 33]); o.z = pk2(s[4 * 33], s[5 * 33]); o.w = pk2(s[6 * 33], s[7 * 33]);
        *(u32x4*)(WT + (size_t)(dst_row0 + n) * DM + k0 + 8 * c) = o; }
    LDS_WAIT(); asm volatile("" ::: "memory");
}
__device__ __forceinline__ void transpose_item8(const float* W, int N, unsigned char* WT, int src0, int dst_row0, int k0, LAS float* scr, int lane) {
    float tv[32];
#pragma unroll
    for (int i = 0; i < 32; ++i) { const int kk = 2 * i + (lane >> 5); tv[i] = __builtin_nontemporal_load(W + (size_t)(k0 + kk) * N + src0 + (lane & 31)); }
#pragma unroll
    for (int i = 0; i < 32; ++i) { const int kk = 2 * i + (lane >> 5); scr[kk * 33 + (lane & 31)] = tv[i] * 32.f; }
    LDS_WAIT(); asm volatile("" ::: "memory");
    const int c = lane & 7;
#pragma unroll
    for (int j = 0; j < 4; ++j) { const int n = (lane >> 3) + 8 * j; const LAS float* s = scr + (8 * c) * 33 + n;
        u32x2 o; o.x = pk4_fp8(s[0 * 33], s[1 * 33], s[2 * 33], s[3 * 33]); o.y = pk4_fp8(s[4 * 33], s[5 * 33], s[6 * 33], s[7 * 33]);
        *(u32x2*)(WT + (size_t)(dst_row0 + n) * DM + k0 + 8 * c) = o; }
    LDS_WAIT(); asm volatile("" ::: "memory");
}
__device__ __forceinline__ float silu_f(float v) { return v / (1.f + __expf(-v)); }

namespace wc { constexpr int I_IN = 96 * 16, I_O = 32 * 16, I_GU = 16 * 64 * 16, I_D = 16 * 32 * 16, I_QKV = 48 * 16;
    constexpr int NITEMS = I_IN + I_O + I_GU + I_D + I_QKV + I_O + I_GU + I_D;
    constexpr int L0E = I_IN + I_O, L1 = L0E + I_GU + I_D;
    constexpr int F1_LO = L0E, F1_HI = F1_LO + 160 * 54, F2_HI = F1_HI + 224 * 54;
    constexpr int F3_LO = L1, F3_HI = F3_LO + 128 * 34, F4_HI = F3_HI + 192 * 34, F5_HI = F4_HI + 208 * 54;
    static_assert(F2_HI < L1 && F5_HI < NITEMS && F3_LO + I_QKV + I_O <= F3_HI, "filler slices");
}
__device__ __forceinline__ void weight_item(Frame& F, ArgsP ap, int it, LAS float* scr) {
    using namespace wc; unsigned char* ws = F.ws;
        int r = it;
        if (r < I_IN) { const int g = r / 16, kb = r % 16, r0 = 32 * g; int src0; bool perm = false;
            if (r0 < 512) src0 = r0;
            else if (r0 < 1536) { const int u = (r0 - 512) / 256, w = (r0 - 512) % 256; src0 = w < 128 ? 512 + u * 128 + w : 1024 + u * 128 + (w - 128); }
            else if (r0 < 2560) { src0 = r0; perm = true; }
            else src0 = r0;
            transpose_item(APIN(7), NWIN, (bf16_t*)(ws + W_IN), src0, r0, kb * 64, perm, scr, F.lane); return; }
        r -= I_IN;
        if (r < I_O) { const int g = r / 16, kb = r % 16; transpose_item(APIN(14), DM, (bf16_t*)(ws + W_OUT0), 32 * g, 32 * g, kb * 64, false, scr, F.lane); return; }
        r -= I_O;
        if (r < I_GU) { const int e = r / 1024, g = (r % 1024) / 16, kb = r % 16, r0 = 32 * g, u = r0 / 256, w = r0 % 256;
            const float* src = (w < 128 ? APIN(17) : APIN(18)) + (size_t)e * DM * FF;
            transpose_item8(src, FF, (unsigned char*)(ws + W_GU0) + (size_t)e * 2 * FF * DM, u * 128 + (w & 127), r0, kb * 64, scr, F.lane); return; }
        r -= I_GU;
        if (r < I_D) { const int e = r / 512, g = (r % 512) / 16, kb = r % 16;
            transpose_item8(APIN(19) + (size_t)e * FF * DM, DM, (unsigned char*)(ws + W_D0) + (size_t)e * DM * FF, 32 * g, 32 * g, kb * 64, scr, F.lane); return; }
        r -= I_D;
        if (r < I_QKV) { const int g = r / 16, kb = r % 16, r0 = 32 * g;
            transpose_item(APIN(23), NQKV1, (bf16_t*)(ws + W_QKV), r0, r0, kb * 64, r0 < 1280, scr, F.lane); return; }
        r -= I_QKV;
        if (r < I_O) { const int g = r / 16, kb = r % 16; transpose_item(APIN(25), DM, (bf16_t*)(ws + W_OUT1), 32 * g, 32 * g, kb * 64, false, scr, F.lane); return; }
        r -= I_O;
        if (r < I_GU) { const int e = r / 1024, g = (r % 1024) / 16, kb = r % 16, r0 = 32 * g, u = r0 / 256, w = r0 % 256;
            const float* src = (w < 128 ? APIN(28) : APIN(29)) + (size_t)e * DM * FF;
            transpose_item8(src, FF, (unsigned char*)(ws + W_GU1) + (size_t)e * 2 * FF * DM, u * 128 + (w & 127), r0, kb * 64, scr, F.lane); return; }
        r -= I_GU;
        { const int e = r / 512, g = (r % 512) / 16, kb = r % 16;
            transpose_item8(APIN(30) + (size_t)e * FF * DM, DM, (unsigned char*)(ws + W_D1) + (size_t)e * DM * FF, 32 * g, 32 * g, kb * 64, scr, F.lane); }
}
__device__ __forceinline__ void weight_items(Frame& F, ArgsP ap, int lo, int hi, int wv, int nw) {
    LAS float* scr = (LAS float*)(F.lds + F.wave * 16384);
    for (int it = lo + wv; it < hi; it += nw) weight_item(F, ap, it, scr);
}
__device__ __forceinline__ void p0_prologue(Frame& F, ArgsP ap, const bool rerun) {
    LAS float* scr = (LAS float*)(F.lds + F.wave * 16384);
    unsigned char* ws = F.ws;
    if (F.gw < 16) { const int pos = F.gw * 4 + (F.lane >> 4), f = F.lane & 15;
        const float inv = __builtin_amdgcn_exp2f(-(float)f * (13.287712379549449f / 16.f));
        const float ang = (float)pos * inv, rev = ang * 0.15915494309189535f;
        float* rp = (float*)(ws + WS_ROPE);
        rp[pos * 16 + f] = __builtin_amdgcn_cosf(rev); rp[1024 + pos * 16 + f] = __builtin_amdgcn_sinf(rev); }
    if (!rerun && F.vcu < 2 * 4 * 24) {
        const int it = F.vcu, layer = it / 96, r = it % 96, kq = r / 24, nb = r % 24;
        const float* W = APIN(layer ? 20 : 4);
        const int n0 = nb * 256 + 4 * F.lane, k0 = kq * 256 + F.wave * 32;
        f32x4 acc[9];
#pragma unroll
        for (int b = 0; b < 9; ++b) acc[b] = (f32x4){0.f, 0.f, 0.f, 0.f};
        float sv[9];
#pragma unroll
        for (int b = 0; b < 8; ++b) sv[b] = silu_f(APIN(1)[b * DM + k0 + (F.lane & 31)]);
        sv[8] = silu_f(APIN(3)[k0 + (F.lane & 31)]);
#pragma unroll 8
        for (int kk = 0; kk < 32; ++kk) { const f32x4 w = __builtin_nontemporal_load((const f32x4*)(W + (size_t)(k0 + kk) * 6144 + n0));
#pragma unroll
            for (int b = 0; b < 9; ++b) { const float s = __builtin_bit_cast(float, __builtin_amdgcn_readlane(__builtin_bit_cast(int, sv[b]), kk)); acc[b] += w * s; } }
#pragma unroll
        for (int b = 0; b < 9; ++b) *(LAS f32x4*)(scr + b * 256 + 4 * F.lane) = acc[b];
        __syncthreads();
        float* part = (float*)(ws + WS_PART) + (size_t)(layer * 4 + kq) * 9 * 6144;
        for (int o = F.tid; o < 9 * 256; o += NTHREADS) { float s = 0.f;
#pragma unroll
            for (int w = 0; w < 8; ++w) s += ((LAS float*)(F.lds + w * 16384))[o];
            part[(o >> 8) * 6144 + nb * 256 + (o & 255)] = s; }
        __syncthreads();
    }
    weight_items(F, ap, 0, wc::L0E, F.gw, F.NGW);
}

__device__ __forceinline__ void load_row(const float* p, int lane, f32x4 (&v)[4]) {
    const f32x4* r = (const f32x4*)p + lane;
#pragma unroll
    for (int j = 0; j < 4; ++j) v[j] = __builtin_nontemporal_load(r + 64 * j);
}
__device__ __forceinline__ void load_row_bf(const bf16_t* p, int lane, f32x4 (&v)[4]) {
    const u32x2* r = (const u32x2*)p + lane;
#pragma unroll
    for (int j = 0; j < 4; ++j) { const u32x2 w = r[64 * j]; v[j] = (f32x4){bf_lo(w.x), bf_hi(w.x), bf_lo(w.y), bf_hi(w.y)}; }
}
__device__ __forceinline__ void wave_range(int total, int gw, int ngw, int& r0, int& r1) { const int per = (total + ngw - 1) / ngw; r0 = gw * per; r1 = r0 + per < total ? r0 + per : total; }
__device__ __forceinline__ const float* xrow_ptr(const float* xlat, const float* xctx, int r) { return r < NLAT ? xlat + (size_t)r * DM : xctx + (size_t)(r - NLAT) * DM; }
__device__ __forceinline__ void load_mod(const float* gain, const float* shift, const float* scale, int lane, f32x4 (&ga)[4], f32x4 (&sh)[4]) {
#pragma unroll
    for (int j = 0; j < 4; ++j) { const f32x4 g = ((const f32x4*)gain)[lane + 64 * j], sc = ((const f32x4*)scale)[lane + 64 * j]; ga[j] = g * (sc + 1.0f); sh[j] = ((const f32x4*)shift)[lane + 64 * j]; }
}
__device__ __forceinline__ void modulate_row(f32x4 (&v)[4], const f32x4 (&ga)[4], const f32x4 (&sh)[4], int lane, bf16_t* orow) {
    float s = 0.f;
#pragma unroll
    for (int j = 0; j < 4; ++j) s += (v[j].x * v[j].x + v[j].y * v[j].y) + (v[j].z * v[j].z + v[j].w * v[j].w);
    const float rs = 1.f / sqrtf(wave_sum(s) * (1.f / DM) + NORM_EPS);
    u32x2* o8 = (u32x2*)orow + lane;
#pragma unroll
    for (int j = 0; j < 4; ++j) { v[j] = (v[j] * rs) * ga[j] + sh[j];
        u32x2 w; w.x = cvt_pk_bf16(v[j].x, v[j].y); w.y = cvt_pk_bf16(v[j].z, v[j].w); o8[64 * j] = w; }
}
__device__ __forceinline__ f32x4 mod_sum4(const float* part_layer, const float* bias, int b, int n) {
    f32x4 s = *(const f32x4*)(bias + n);
#pragma unroll
    for (int q = 0; q < 4; ++q) s += *(const f32x4*)(part_layer + (size_t)(q * 9 + b) * 6144 + n);
    return s;
}
__device__ __forceinline__ void norm1_phase(Frame& F, const float* xlat, const float* xctx, const float* gain, const float* bias0, const float* bias1) {
    bf16_t* XN = (bf16_t*)(F.ws + A_XN);
    const float* part = (const float*)(F.ws + WS_PART); float* mod = (float*)(F.ws + WS_MOD);
    for (int i = (F.gw * 64 + F.lane) * 4; i < 2 * 9 * 6144; i += F.NGW * 64 * 4) {
        const int layer = i / (9 * 6144), r = i % (9 * 6144), b = r / 6144, n = r % 6144;
        *(f32x4*)(mod + i) = mod_sum4(part + (size_t)layer * 4 * 9 * 6144, layer ? bias1 : bias0, b, n);
    }
    int r0, r1; wave_range(MALL, F.gw, F.NGW, r0, r1);
    f32x4 v[4], vn[4], ga[4], sh[4]; int cb = -1;
    if (r0 < r1) load_row(xrow_ptr(xlat, xctx, r0), F.lane, vn);
    for (int r = r0; r < r1; ++r) {
#pragma unroll
        for (int j = 0; j < 4; ++j) v[j] = vn[j];
        if (r + 1 < r1) load_row(xrow_ptr(xlat, xctx, r + 1), F.lane, vn);
        const int b = r < NLAT ? (r >> 12) : 8;
        if (b != cb) { cb = b;
#pragma unroll
            for (int j = 0; j < 4; ++j) { const int k = 4 * (F.lane + 64 * j); const f32x4 g = ((const f32x4*)gain)[F.lane + 64 * j];
                const f32x4 shv = mod_sum4(part, bias0, b, k), scv = mod_sum4(part, bias0, b, 1024 + k); ga[j] = g * (scv + 1.0f); sh[j] = shv; } }
        modulate_row(v, ga, sh, F.lane, XN + (size_t)r * DM);
    }
}
__device__ __forceinline__ void load_router(Frame& F, const float* Wr) {
    LAS float* Wt = (LAS float*)F.lds;
    for (int i = F.tid; i < DM * 4; i += NTHREADS) { const int k = i >> 2, e4 = (i & 3) * 4; const f32x4 w = *(const f32x4*)(Wr + k * 16 + e4);
        Wt[(e4 + 0) * DM + k] = w.x; Wt[(e4 + 1) * DM + k] = w.y; Wt[(e4 + 2) * DM + k] = w.z; Wt[(e4 + 3) * DM + k] = w.w; }
    __syncthreads();
}
__device__ __forceinline__ void router_dot2(const LAS char* Wl, const f32x4 (&va)[4], const f32x4 (&vb)[4], float (&la)[16], float (&lb)[16]) {
#pragma unroll
    for (int e = 0; e < 16; ++e) { f32x2 sa = {0.f, 0.f}, sb = {0.f, 0.f};
#pragma unroll
        for (int j = 0; j < 4; ++j) { const f32x4 w = *(const LAS f32x4*)(Wl + (e * DM + 256 * j) * 4);
            const f32x2 wl = {w.x, w.y}, wh = {w.z, w.w};
            sa = __builtin_elementwise_fma((f32x2){va[j].x, va[j].y}, wl, sa); sa = __builtin_elementwise_fma((f32x2){va[j].z, va[j].w}, wh, sa);
            sb = __builtin_elementwise_fma((f32x2){vb[j].x, vb[j].y}, wl, sb); sb = __builtin_elementwise_fma((f32x2){vb[j].z, vb[j].w}, wh, sb); }
        la[e] = sa.x + sa.y; lb[e] = sb.x + sb.y; if ((e & 1) == 1) __builtin_amdgcn_sched_barrier(0); }
}
__device__ __forceinline__ float router_softmax(const float (&lg)[16], int l) {
    float a8[8];
#pragma unroll
    for (int i = 0; i < 8; ++i) { auto rr = __builtin_amdgcn_permlane32_swap(__float_as_uint(lg[i]), __float_as_uint(lg[8 + i]), false, false); a8[i] = __uint_as_float(rr[0]) + __uint_as_float(rr[1]); }
    float a4[4];
#pragma unroll
    for (int i = 0; i < 4; ++i) { auto rr = __builtin_amdgcn_permlane16_swap(__float_as_uint(a8[i]), __float_as_uint(a8[4 + i]), false, false); a4[i] = __uint_as_float(rr[0]) + __uint_as_float(rr[1]); }
    float a2[2];
#pragma unroll
    for (int i = 0; i < 2; ++i) { const bool up = (l & 8) != 0; const float keep = up ? a4[2 + i] : a4[i], send = up ? a4[i] : a4[2 + i]; a2[i] = keep + dpp_f<0x128>(send); }
    float a1;
    { const bool up = (l & 4) != 0; const float keep = up ? a2[1] : a2[0], send = up ? a2[0] : a2[1]; a1 = keep + dpp_f<0x141>(send); }
    a1 += dpp_f<0x4E>(a1); a1 += dpp_f<0xB1>(a1);
    float mx = a1;
    mx = fmaxf(mx, dpp_f<0x141>(mx)); mx = fmaxf(mx, dpp_f<0x128>(mx)); mx = xmax16(mx); mx = xmax32(mx);
    const float ex = __expf(a1 - mx);
    float den = ex; den += dpp_f<0x141>(den); den += dpp_f<0x128>(den); den = xsum16(den); den = xsum32(den);
    return ex / den;
}
__device__ __forceinline__ void norm2_router_phase(Frame& F, int nrows, const float* gain, const float* mod, const float* Wr) {
    load_router(F, Wr);
    unsigned char* XN8 = (unsigned char*)(F.ws + A_XN); float* AFF = (float*)(F.ws + WS_AFF); const bf16_t* XB = (const bf16_t*)(F.ws + WS_XB);
    const int npairs = nrows >> 1;
    int p0, p1; wave_range(npairs, F.gw, F.NGW, p0, p1);
    f32x4 ga[4], sh[4]; int cb = -1;
    const int l = F.lane;
    u32x2 na[4], nb[4];
    if (p0 < p1) { const u32x2* ra = (const u32x2*)(XB + (size_t)(2 * p0) * DM) + l; const u32x2* rb = (const u32x2*)(XB + (size_t)(2 * p0 + 1) * DM) + l;
#pragma unroll
        for (int j = 0; j < 4; ++j) { na[j] = ra[64 * j]; nb[j] = rb[64 * j]; } }
    for (int p = p0; p < p1; ++p) {
        const int r = 2 * p;
        f32x4 va[4], vb[4];
#pragma unroll
        for (int j = 0; j < 4; ++j) { va[j] = (f32x4){bf_lo(na[j].x), bf_hi(na[j].x), bf_lo(na[j].y), bf_hi(na[j].y)}; vb[j] = (f32x4){bf_lo(nb[j].x), bf_hi(nb[j].x), bf_lo(nb[j].y), bf_hi(nb[j].y)}; }
        if (p + 1 < p1) { const u32x2* ra = (const u32x2*)(XB + (size_t)(r + 2) * DM) + l; const u32x2* rb = (const u32x2*)(XB + (size_t)(r + 3) * DM) + l;
#pragma unroll
            for (int j = 0; j < 4; ++j) { na[j] = ra[64 * j]; nb[j] = rb[64 * j]; } }
        const int b = r < NLAT ? (r >> 12) : 8;
        if (b != cb) { cb = b; load_mod(gain, mod + (size_t)b * 6144 + 3 * 1024, mod + (size_t)b * 6144 + 4 * 1024, l, ga, sh); }
        float s0 = 0.f, s1 = 0.f;
#pragma unroll
        for (int j = 0; j < 4; ++j) { s0 += (va[j].x * va[j].x + va[j].y * va[j].y) + (va[j].z * va[j].z + va[j].w * va[j].w); s1 += (vb[j].x * vb[j].x + vb[j].y * vb[j].y) + (vb[j].z * vb[j].z + vb[j].w * vb[j].w); }
        const float rs0 = 1.f / sqrtf(wave_sum(s0) * (1.f / DM) + NORM_EPS), rs1 = 1.f / sqrtf(wave_sum(s1) * (1.f / DM) + NORM_EPS);
        unsigned* oa = (unsigned*)(XN8 + (size_t)r * DM) + l; unsigned* ob = (unsigned*)(XN8 + (size_t)(r + 1) * DM) + l;
#pragma unroll
        for (int j = 0; j < 4; ++j) { va[j] = (va[j] * rs0) * ga[j] + sh[j]; vb[j] = (vb[j] * rs1) * ga[j] + sh[j];
            oa[64 * j] = pk4_fp8(va[j].x, va[j].y, va[j].z, va[j].w); ob[64 * j] = pk4_fp8(vb[j].x, vb[j].y, vb[j].z, vb[j].w); }
        int wofs = 16 * l; asm volatile("" : "+v"(wofs));
        float la[16], lb[16];
        router_dot2((const LAS char*)F.lds + wofs, va, vb, la, lb);
        const float pa_ = router_softmax(la, l), pb_ = router_softmax(lb, l);
        if ((l & 3) == 0) { AFF[(size_t)r * 16 + (l >> 2)] = pa_; AFF[(size_t)(r + 1) * 16 + (l >> 2)] = pb_; }
    }
    __syncthreads();
}

__device__ __forceinline__ void mix0_combine_phase(Frame& F, ArgsP ap) {
    const bf16_t* BG = (const bf16_t*)(F.ws + A_BG); const bf16_t* CX = (const bf16_t*)(F.ws + A_CX); const bf16_t* OH = (const bf16_t*)(F.ws + A_OH);
    bf16_t* AO = (bf16_t*)(F.ws + A_XN);
    float d1 = APIN(9)[F.lane] * APIN(10)[F.lane], d2 = APIN(11)[F.lane] * APIN(12)[F.lane];
    const float lam = __expf(wave_sum(d1)) - __expf(wave_sum(d2)) + LAM_INIT;
    const int l = F.lane;
    float cw0[8], cw1[8], cw2[8], sg[8];
#pragma unroll
    for (int i = 0; i < 8; ++i) { cw0[i] = APIN(8)[8 * l + i]; cw1[i] = APIN(8)[512 + 8 * l + i]; cw2[i] = APIN(8)[1024 + 8 * l + i]; sg[i] = APIN(13)[(l & 15) * 8 + i] * (1.f - LAM_INIT); }
    const int h = l >> 4, d0 = (l & 15) * 8;
    int r0, r1; wave_range(MALL, F.gw, F.NGW, r0, r1);
    if (r0 >= r1) return;
    const u32x4 zero = (u32x4){0u, 0u, 0u, 0u};
#define CXROW(r) __builtin_nontemporal_load((const u32x4*)(CX + (size_t)(r) * 512 + 8 * l))
    u32x4 c0 = r0 > 0 ? CXROW(r0 - 1) : zero, c1 = CXROW(r0), c2 = r0 + 1 < MALL ? CXROW(r0 + 1) : zero, c3;
    u32x4 bgn = __builtin_nontemporal_load((const u32x4*)(BG + (size_t)r0 * 512 + 8 * l));
    u32x4 o1n = zero, o2n = zero;
    if (!ATT0_PAIR) { o1n = *(const u32x4*)(OH + (size_t)r0 * DM + (2 * h) * 128 + d0); o2n = *(const u32x4*)(OH + (size_t)r0 * DM + (2 * h + 1) * 128 + d0); }
    for (int r = r0; r < r1; ++r) {
        const u32x4 bgv = bgn, o1 = o1n, o2 = o2n;
        c3 = r + 2 < MALL ? CXROW(r + 2) : zero;
        if (r + 1 < r1) { bgn = __builtin_nontemporal_load((const u32x4*)(BG + (size_t)(r + 1) * 512 + 8 * l));
            if (!ATT0_PAIR) { o1n = *(const u32x4*)(OH + (size_t)(r + 1) * DM + (2 * h) * 128 + d0); o2n = *(const u32x4*)(OH + (size_t)(r + 1) * DM + (2 * h + 1) * 128 + d0); } }
        const bool lat = r < NLAT; const int t = lat ? (r & (SEQ - 1)) : ((r - NLAT) & (CTX - 1)); const int tl = lat ? SEQ : CTX;
        const u32x4 ca = t > 0 ? c0 : zero, cc = t < tl - 1 ? c2 : zero;
        u32x4 ow;
#pragma unroll
        for (int i = 0; i < 4; ++i) {
            const float lo = bf_lo(bgv[i]) * (cw0[2 * i] * bf_lo(ca[i]) + cw1[2 * i] * bf_lo(c1[i]) + cw2[2 * i] * bf_lo(cc[i]));
            const float hi = bf_hi(bgv[i]) * (cw0[2 * i + 1] * bf_hi(ca[i]) + cw1[2 * i + 1] * bf_hi(c1[i]) + cw2[2 * i + 1] * bf_hi(cc[i]));
            ow[i] = cvt_pk_bf16(lo, hi); }
        *(u32x4*)(AO + (size_t)r * DM + 8 * l) = ow;
        c0 = c1; c1 = c2; c2 = c3;
        if (ATT0_PAIR) continue;
        float ov[8]; float ss = 0.f;
#pragma unroll
        for (int i = 0; i < 4; ++i) { ov[2 * i] = bf_lo(o1[i]) - lam * bf_lo(o2[i]); ov[2 * i + 1] = bf_hi(o1[i]) - lam * bf_hi(o2[i]); ss += ov[2 * i] * ov[2 * i] + ov[2 * i + 1] * ov[2 * i + 1]; }
        ss = row16_sum(ss);
        const float rs = 1.f / sqrtf(ss * (1.f / 128.f) + NORM_EPS);
        u32x4 ow2;
#pragma unroll
        for (int i = 0; i < 4; ++i) ow2[i] = cvt_pk_bf16(ov[2 * i] * rs * sg[2 * i], ov[2 * i + 1] * rs * sg[2 * i + 1]);
        *(u32x4*)(AO + (size_t)r * DM + 512 + h * 128 + d0) = ow2;
    }
#undef CXROW
}

__device__ __forceinline__ unsigned block_excl_scan(unsigned v, LAS unsigned* sc, int tid, unsigned& total) {
    unsigned x = v;
    x += (unsigned)__builtin_amdgcn_update_dpp(0, (int)x, 0x111, 0xf, 0xf, true); x += (unsigned)__builtin_amdgcn_update_dpp(0, (int)x, 0x112, 0xf, 0xf, true);
    x += (unsigned)__builtin_amdgcn_update_dpp(0, (int)x, 0x114, 0xf, 0xf, true); x += (unsigned)__builtin_amdgcn_update_dpp(0, (int)x, 0x118, 0xf, 0xf, true);
    x += (unsigned)__builtin_amdgcn_update_dpp(0, (int)x, 0x142, 0xa, 0xf, false); x += (unsigned)__builtin_amdgcn_update_dpp(0, (int)x, 0x143, 0xc, 0xf, false);
    if ((tid & 63) == 63) sc[tid >> 6] = x;
    __syncthreads();
    unsigned base = 0, tot = 0;
#pragma unroll
    for (int w = 0; w < 8; ++w) { const unsigned s = sc[w]; if (w < (tid >> 6)) base += s; tot += s; }
    __syncthreads();
    total = tot;
    return base + x - v;
}
__device__ __forceinline__ void topk_list(Frame& F, int row0, int n, int e, int cap, int slot_row0) {
    LAS unsigned* sc = (LAS unsigned*)F.lds;
    LAS unsigned* cw = sc + 16;
    const float* AFF = (const float*)(F.ws + WS_AFF); int* POS = (int*)(F.ws + WS_POS); int* IDX = (int*)(F.ws + WS_IDX);
    const int tid = F.tid, wave = tid >> 6;
    const int per = 8; const int base = tid * per; const bool act = base < n;
    unsigned kk[8];
#pragma unroll
    for (int i = 0; i < per; ++i) kk[i] = act ? __builtin_bit_cast(unsigned, AFF[(size_t)(row0 + base + i) * 16 + e]) : 0u;
    unsigned T = 0; int it = 0;
    {
        const unsigned cand = 1u << 30;
        unsigned c = 0;
#pragma unroll
        for (int i = 0; i < per; ++i) c += (unsigned)__builtin_popcountll(__ballot(act && kk[i] >= cand));
        if ((tid & 63) == 0) cw[wave] = c;
        __syncthreads();
        unsigned tot = 0;
#pragma unroll
        for (int w = 0; w < 8; ++w) tot += cw[w];
        if (tot >= (unsigned)cap) T = cand;
        it = 1;
    }
    for (int bit = 29; bit >= 1; bit -= 2, ++it) {
        const unsigned c1 = T | (1u << bit), c2 = T | (1u << (bit - 1)), c3 = c1 | c2;
        unsigned n1 = 0, n2 = 0, n3 = 0;
#pragma unroll
        for (int i = 0; i < per; ++i) { n1 += (unsigned)__builtin_popcountll(__ballot(act && kk[i] >= c1)); n2 += (unsigned)__builtin_popcountll(__ballot(act && kk[i] >= c2)); n3 += (unsigned)__builtin_popcountll(__ballot(act && kk[i] >= c3)); }
        LAS unsigned* cb = cw + (it & 1) * 24;
        if ((tid & 63) == 0) { cb[wave] = n1; cb[8 + wave] = n2; cb[16 + wave] = n3; }
        __syncthreads();
        unsigned t1 = 0, t2 = 0, t3 = 0;
#pragma unroll
        for (int w = 0; w < 8; ++w) { t1 += cb[w]; t2 += cb[8 + w]; t3 += cb[16 + w]; }
        if (t3 >= (unsigned)cap) T = c3; else if (t1 >= (unsigned)cap) T = c1; else if (t2 >= (unsigned)cap) T = c2;
    }
    __syncthreads();
    const unsigned prefix = T;
    unsigned ngt_l = 0, neq = 0;
#pragma unroll
    for (int i = 0; i < per; ++i) { ngt_l += (act && kk[i] > prefix) ? 1u : 0u; neq += (act && kk[i] == prefix) ? 1u : 0u; }
    unsigned ngt; (void)block_excl_scan(ngt_l, sc, tid, ngt);
    const unsigned krem = (unsigned)cap - ngt;
    unsigned tot; const unsigned eq_before = block_excl_scan(neq, sc, tid, tot);
    unsigned nsel = 0; unsigned selm = 0; unsigned eqc = eq_before;
#pragma unroll
    for (int i = 0; i < per; ++i) { bool s = false; if (act) { if (kk[i] > prefix) s = true; else if (kk[i] == prefix) { s = eqc < krem; ++eqc; } } if (s) { selm |= 1u << i; ++nsel; } }
    const unsigned sel_before = block_excl_scan(nsel, sc, tid, tot);
    unsigned slot = sel_before;
    if (act) {
#pragma unroll
        for (int i = 0; i < per; ++i) { const int row = row0 + base + i;
            if (selm & (1u << i)) { IDX[e * EROWS0 + slot_row0 + slot] = row; POS[(size_t)row * 16 + e] = slot_row0 + (int)slot; ++slot; }
            else POS[(size_t)row * 16 + e] = -1; }
    }
    __syncthreads();
}
__device__ __forceinline__ void topk_phase(Frame& F, bool with_ctx) {
    const int nl = with_ctx ? 256 : 128;
    for (int lid = F.vcu; lid < nl; lid += F.G) {
        if (lid < 128) { const int b = lid >> 4, e = lid & 15; topk_list(F, b * SEQ, SEQ, e, CAP_L, b * CAP_L); }
        else { const int b = (lid - 128) >> 4, e = lid & 15; topk_list(F, NLAT + b * CTX, CTX, e, CAP_C, NB * CAP_L + b * CAP_C); }
    }
}
__device__ __forceinline__ void gather_phase(Frame& F, int erows) {
    const int* IDX = (const int*)(F.ws + WS_IDX); const bf16_t* XN = (const bf16_t*)(F.ws + A_XN); bf16_t* HS = (bf16_t*)(F.ws + A_HS);
    const int total = NE * erows;
    int r0, r1; wave_range(total, F.gw, F.NGW, r0, r1);
    for (int base = r0; base < r1; base += 64) {
        const int n = r1 - base < 64 ? r1 - base : 64;
        int myidx = 0;
        if (F.lane < n) { const int i = base + F.lane; const int e = i / erows, s = i - e * erows; myidx = __hip_atomic_load(IDX + e * EROWS0 + s, RLX_AGENT); }
        for (int k = 0; k < n; k += 4) {
            u32x4 va[4], vb[4];
#pragma unroll
            for (int q = 0; q < 4; ++q) { const int kk = k + q < n ? k + q : n - 1; const int src = __builtin_amdgcn_readlane(myidx, kk);
                const u32x4* sp = (const u32x4*)(XN + (size_t)src * DM) + F.lane; va[q] = sp[0]; vb[q] = sp[64]; }
#pragma unroll
            for (int q = 0; q < 4; ++q) { if (k + q < n) { u32x4* dp = (u32x4*)(HS + (size_t)(base + k + q) * DM) + F.lane; dp[0] = va[q]; dp[64] = vb[q]; } }
        }
    }
}
__device__ __forceinline__ void moe_combine_phase(Frame& F, int nrows, int erows, const float* mod_cur, bool final_norm,
                                                  const float* gain_next, const float* mod_next, float* outp) {
    const float* AFF = (const float*)(F.ws + WS_AFF); const int* POS = (const int*)(F.ws + WS_POS); const unsigned char* Y = (const unsigned char*)(F.ws + A_HS);
    bf16_t* XN = (bf16_t*)(F.ws + A_XN); bf16_t* XB = (bf16_t*)(F.ws + WS_XB);
    int r0, r1; wave_range(nrows, F.gw, F.NGW, r0, r1);
    if (r0 >= r1) return;
    const int l = F.lane;
    constexpr int NB = 4;
    f32x4 v[4], ga[4], sh[4], g2[4]; int cb = -1;
    int pos_b[NB]; float af_b[NB];
#pragma unroll
    for (int k = 0; k < NB; ++k) { pos_b[k] = -1; af_b[k] = 0.f; if (r0 + k < r1 && l < 16) { pos_b[k] = POS[(size_t)(r0 + k) * 16 + l]; af_b[k] = AFF[(size_t)(r0 + k) * 16 + l]; } }
    for (int rb = r0; rb < r1; rb += NB) {
        u32x2 xw[NB][4]; unsigned yab[NB][4], ybb[NB][4];
#pragma unroll
        for (int k = 0; k < NB; ++k) if (rb + k < r1) {
            const u32x2* xr = (const u32x2*)(XB + (size_t)(rb + k) * DM) + l;
#pragma unroll
            for (int j = 0; j < 4; ++j) xw[k][j] = xr[64 * j];
            unsigned long long mm_ = __ballot(pos_b[k] >= 0);
            if (mm_) { const int e0_ = __builtin_ctzll(mm_); mm_ &= mm_ - 1; const int e1_ = mm_ ? __builtin_ctzll(mm_) : e0_;
                const int p0_ = __builtin_amdgcn_readlane(pos_b[k], e0_), p1_ = __builtin_amdgcn_readlane(pos_b[k], e1_);
                const unsigned* y0_ = (const unsigned*)(Y + ((size_t)e0_ * erows + p0_) * DM) + l; const unsigned* y1_ = (const unsigned*)(Y + ((size_t)e1_ * erows + p1_) * DM) + l;
#pragma unroll
                for (int j = 0; j < 4; ++j) { yab[k][j] = y0_[64 * j]; ybb[k][j] = y1_[64 * j]; } }
        }
        int pos_n[NB]; float af_n[NB];
#pragma unroll
        for (int k = 0; k < NB; ++k) { pos_n[k] = -1; af_n[k] = 0.f; if (rb + NB + k < r1 && l < 16) { pos_n[k] = POS[(size_t)(rb + NB + k) * 16 + l]; af_n[k] = AFF[(size_t)(rb + NB + k) * 16 + l]; } }
#pragma unroll
        for (int k = 0; k < NB; ++k) if (rb + k < r1) {
        const int r = rb + k; const int pos = pos_b[k]; const float af = af_b[k];
#pragma unroll
        for (int j = 0; j < 4; ++j) v[j] = (f32x4){bf_lo(xw[k][j].x), bf_hi(xw[k][j].x), bf_lo(xw[k][j].y), bf_hi(xw[k][j].y)};
        const int b = r < NLAT ? (r >> 12) : 8;
        if (b != cb) { cb = b;
#pragma unroll
            for (int j = 0; j < 4; ++j) g2[j] = ((const f32x4*)(mod_cur + (size_t)b * 6144 + 5 * 1024))[l + 64 * j];
            if (!final_norm) load_mod(gain_next, mod_next + (size_t)b * 6144, mod_next + (size_t)b * 6144 + 1024, l, ga, sh);
            else {
#pragma unroll
                for (int j = 0; j < 4; ++j) ga[j] = ((const f32x4*)gain_next)[l + 64 * j]; } }
        f32x4 acc[4];
#pragma unroll
        for (int j = 0; j < 4; ++j) acc[j] = (f32x4){0.f, 0.f, 0.f, 0.f};
        unsigned long long m = __ballot(pos >= 0); bool firstpair = true;
        while (m) {
            const int e0 = __builtin_ctzll(m); m &= m - 1; const bool two = m != 0; const int e1 = two ? __builtin_ctzll(m) : e0; if (two) m &= m - 1;
            const int p0 = __builtin_amdgcn_readlane(pos, e0), p1 = __builtin_amdgcn_readlane(pos, e1);
            const float w0 = __builtin_bit_cast(float, __builtin_amdgcn_readlane(__builtin_bit_cast(int, af), e0));
            const float w1 = two ? __builtin_bit_cast(float, __builtin_amdgcn_readlane(__builtin_bit_cast(int, af), e1)) : 0.f;
            const unsigned* y0 = (const unsigned*)(Y + ((size_t)e0 * erows + p0) * DM) + l; const unsigned* y1 = (const unsigned*)(Y + ((size_t)e1 * erows + p1) * DM) + l;
            unsigned ya[4], yb[4];
            if (firstpair) {
#pragma unroll
                for (int j = 0; j < 4; ++j) { ya[j] = yab[k][j]; yb[j] = ybb[k][j]; } }
            else {
#pragma unroll
                for (int j = 0; j < 4; ++j) { ya[j] = y0[64 * j]; yb[j] = y1[64 * j]; } }
            firstpair = false;
#pragma unroll
            for (int j = 0; j < 4; ++j) {
                const f32x2 a01 = __builtin_amdgcn_cvt_pk_f32_fp8((int)ya[j], false), a23 = __builtin_amdgcn_cvt_pk_f32_fp8((int)ya[j], true);
                const f32x2 b01 = __builtin_amdgcn_cvt_pk_f32_fp8((int)yb[j], false), b23 = __builtin_amdgcn_cvt_pk_f32_fp8((int)yb[j], true);
                acc[j].x += w0 * a01.x + w1 * b01.x; acc[j].y += w0 * a01.y + w1 * b01.y; acc[j].z += w0 * a23.x + w1 * b23.x; acc[j].w += w0 * a23.y + w1 * b23.y; }
        }
#pragma unroll
        for (int j = 0; j < 4; ++j) v[j] = v[j] + g2[j] * acc[j] * (1.f / 16.f);
        if (!final_norm) {
            u32x2* xo = (u32x2*)(XB + (size_t)r * DM) + l;
#pragma unroll
            for (int j = 0; j < 4; ++j) { u32x2 w; w.x = cvt_pk_bf16(v[j].x, v[j].y); w.y = cvt_pk_bf16(v[j].z, v[j].w); xo[64 * j] = w; }
            modulate_row(v, ga, sh, l, XN + (size_t)r * DM);
        } else {
            float s = 0.f;
#pragma unroll
            for (int j = 0; j < 4; ++j) s += (v[j].x * v[j].x + v[j].y * v[j].y) + (v[j].z * v[j].z + v[j].w * v[j].w);
            const float rs = 1.f / sqrtf(wave_sum(s) * (1.f / DM) + NORM_EPS);
            f32x4* xo = (f32x4*)(outp + (size_t)r * DM) + l;
#pragma unroll
            for (int j = 0; j < 4; ++j) xo[64 * j] = (v[j] * rs) * ga[j];
        }
        }
#pragma unroll
        for (int k = 0; k < NB; ++k) { pos_b[k] = pos_n[k]; af_b[k] = af_n[k]; }
    }
}

#if ATT0_PAIR
__device__ __forceinline__ void attn0_phase(Frame& F, const bool rerun, ArgsP ap) {
    const bf16_t* Q0 = (const bf16_t*)(F.ws + A_Q0); const bf16_t* K0 = (const bf16_t*)(F.ws + A_K0); const bf16_t* V0 = (const bf16_t*)(F.ws + A_V0);
    bf16_t* AO = (bf16_t*)(F.ws + A_XN);
    const float d1 = APIN(9)[F.lane] * APIN(10)[F.lane], d2 = APIN(11)[F.lane] * APIN(12)[F.lane];
    const float lam = __expf(wave_sum(d1)) - __expf(wave_sum(d2)) + LAM_INIT;
    const float* sgp = APIN(13);
    const int per = (1024 + F.G - 1) / F.G;
    const int u0 = F.vcu * per, nlat = u0 >= 1024 ? 0 : (u0 + per > 1024 ? 1024 - u0 : per), nctx = F.vcu < 64 ? 1 : 0;
    const bool conv_first = (F.vcu & 1) == 0;
    for (int pass = 0; pass < 2; ++pass) {
    if ((pass == 0) == conv_first) { mix0_combine_phase(F, ap); __syncthreads(); continue; }
    for (int i = 0; i < nlat + nctx; ++i) {
        att::UnitDesc U; int b, h, qrow0;
        if (i < nlat) { const int u = u0 + i; b = u >> 7; h = (u >> 5) & 3; qrow0 = b * SEQ + (u & 31) * 128; U.NT = 68; }
        else { const int c = F.vcu; b = c >> 3; h = (c & 7) >> 1; qrow0 = NLAT + b * CTX + (c & 1) * 128; U.NT = 4; }
        U.Q = Q0 + (size_t)qrow0 * 512 + h * 128; U.ldq = 512;
        U.K = K0 + h * 128; U.V = V0 + h * 128; U.ldk = 512; U.ldv = 512;
        U.O = AO + (size_t)qrow0 * DM + 512 + h * 128; U.ldo = DM;
        U.ctx_row0 = NLAT + b * CTX; U.lat_row0 = b * SEQ; U.lat_t0 = 0; U.q0 = 0; U.sink = nullptr;
        att::attn_unit_pair(U, lam, sgp, (LAS char*)F.lds, F.tid);
    }
    }
}
#else
__device__ __forceinline__ void attn0_phase(Frame& F, const bool rerun, ArgsP ap) {
    const bf16_t* Q0 = (const bf16_t*)(F.ws + A_Q0); const bf16_t* K0 = (const bf16_t*)(F.ws + A_K0); const bf16_t* V0 = (const bf16_t*)(F.ws + A_V0);
    bf16_t* OH = (bf16_t*)(F.ws + A_OH);
    const int per = (1024 + F.G - 1) / F.G;
    const int u0 = F.vcu * per, nlat = u0 >= 1024 ? 0 : (u0 + per > 1024 ? 1024 - u0 : per), nctx = F.vcu < 64 ? 1 : 0, vcu = F.vcu;
    auto gen = [=](int i, att::UnitDesc& U) {
        int b, sh, qrow0;
        if (i < nlat) { const int u = u0 + i; b = u >> 7; sh = (u & 127) >> 4; const int qb = u & 15; qrow0 = b * SEQ + qb * 256; U.NT = 68; }
        else { b = vcu >> 3; sh = vcu & 7; qrow0 = NLAT + b * CTX; U.NT = 4; }
        U.Q = Q0 + (size_t)qrow0 * 512 + sh * 64; U.ldq = 512;
        U.K = K0 + sh * 64; U.V = V0 + (sh >> 1) * 128; U.ldk = 512; U.ldv = 512;
        U.O = OH + (size_t)qrow0 * DM + sh * 128; U.ldo = DM;
        U.ctx_row0 = NLAT + b * CTX; U.lat_row0 = b * SEQ; U.lat_t0 = 0; U.q0 = 0; U.sink = nullptr;
    };
#if ATT0_STREAM
    att::attn_stream<128, false>(gen, nlat + nctx, (LAS char*)F.lds, F.tid);
#else
    for (int i = 0; i < nlat + nctx; ++i) { att::UnitDesc U; gen(i, U);
#if ATT0_PG
        att::attn_unit_pg<128, false>(U, (LAS char*)F.lds, F.tid);
#else
        att::attn_unit_pp<128, false>(U, (LAS char*)F.lds, F.tid);
#endif
    }
#endif
}
#endif
__device__ __forceinline__ void attn1_phase(Frame& F, const float* sink) {
    const bf16_t* Q1 = (const bf16_t*)(F.ws + A_Q1); const bf16_t* K1 = (const bf16_t*)(F.ws + A_K1); const bf16_t* V1 = (const bf16_t*)(F.ws + A_V1);
    bf16_t* AO = (bf16_t*)(F.ws + A_XN);
    const int per = (2048 + F.G - 1) / F.G;
    const int u0 = F.vcu * per, n = u0 >= 2048 ? 0 : (u0 + per > 2048 ? 2048 - u0 : per);
    auto gen = [=](int i, att::UnitDesc& U) {
        const int u = u0 + i;
        const int b = u >> 8, kvh = (u & 255) >> 6, qb = u & 63, q0 = qb * 64, qrow0 = b * SEQ + q0;
        U.Q = Q1 + (size_t)qrow0 * DM + kvh * 256; U.ldq = DM;
        U.K = K1 + kvh * 64; U.V = V1 + kvh * 64; U.ldk = 256; U.ldv = 256;
        U.O = AO + (size_t)qrow0 * DM + kvh * 256; U.ldo = DM;
        const int lo = q0 - 128 < 0 ? 0 : q0 - 128, hi = q0 + 192 > SEQ ? SEQ : q0 + 192;
        U.ctx_row0 = NLAT + b * CTX; U.lat_row0 = b * SEQ; U.lat_t0 = lo >> 6; U.NT = 4 + ((hi - lo) >> 6);
        U.q0 = q0; U.sink = sink + kvh * 4;
    };
#if ATT1_STREAM
    att::attn_stream<64, true>(gen, n, (LAS char*)F.lds, F.tid);
#else
    for (int i = 0; i < n; ++i) { att::UnitDesc U; gen(i, U); att::attn_unit_pp<64, true>(U, (LAS char*)F.lds, F.tid); }
#endif
}

constexpr int N_PHASES = 21;
#ifndef PH_EN
#define PH_EN(p) ((p) != 8 && (p) != 17 && (!ATT0_PAIR || (p) != 4))
#endif
#ifndef GEMM_EN
#define GEMM_EN 1
#endif
__global__ void __launch_bounds__(NTHREADS, 2) fwd_kernel(Args args) {
    extern __shared__ __attribute__((aligned(16))) unsigned char lds_raw[];
    Frame F;
    F.lds = (LAS unsigned char*)lds_raw;
    F.tid = threadIdx.x; F.lane = F.tid & 63; F.wave = __builtin_amdgcn_readfirstlane(F.tid >> 6);
    F.G = gridDim.x; { const int bx = blockIdx.x; F.vcu = (F.G % 8 == 0) ? (bx % 8) * (F.G / 8) + bx / 8 : bx; }
    F.gw = F.vcu * NWAVES + F.wave; F.NGW = F.G * NWAVES;
    F.ws = args.ws;
    unsigned char* ws = args.ws;
    volatile LAS unsigned* MISC = (volatile LAS unsigned*)(F.lds + MISC_OFF);
    for (int u = F.tid; u < (LDS_BYTES - RING_BYTES) / 4; u += NTHREADS) ((LAS unsigned*)(F.lds + RING_BYTES))[u] = 0u;
    __syncthreads();
    const int nprog = args.nprog;
    XcdBarrier bar; bar.bar = (unsigned*)(ws + WS_CTL) + CW_BAR; bar.x = 0; bar.st = nullptr;
    if (nprog > 1) bar = xcd_barrier_post((unsigned*)(ws + WS_CTL) + CW_BAR, MISC + 8);

    const Frame F0 = F;
    for (int pi = 0; pi < nprog; ++pi) {
        F = F0; asm volatile("" : "+s"(F.wave), "+s"(F.vcu), "+s"(F.gw));
        { unsigned ones = ~0u; asm volatile("" : "+s"(ones));
          F.lane = (int)__builtin_amdgcn_mbcnt_hi(ones, __builtin_amdgcn_mbcnt_lo(ones, 0u)); F.tid = F.wave * 64 + F.lane; }
        ArgsP ap = (ArgsP)__builtin_amdgcn_kernarg_segment_ptr(); asm volatile("" : "+s"(ap));
        { GAS unsigned char* wsg = ap->ws; asm volatile("" : "+s"(wsg)); F.ws = (unsigned char*)wsg; }
        ws = F.ws;
        const int phx = ap->prog[pi], ph = phx & 31; const bool rerun = (phx & 32) != 0;
        const float* MOD0 = (const float*)(ws + WS_MOD); const float* MOD1 = MOD0 + 9 * 6144;
        bool is_gemm = false, is_gemm8 = false; bool perm = true; pg8::Sched S; pg8::Epi E;
        S.G = F.G; S.c = (int)blockIdx.x; S.tpe = 1 << 20; S.pitch = 2 * DM; S.wgm = 8; S.hot = false; S.gidx = nullptr; S.A = nullptr; S.B = nullptr; S.nM = 0; S.nN = 0;
        E.kind = 0; E.layer = 0; E.f8out = false; E.wsc = 1.f; E.ws = ws; E.xin_lat = nullptr; E.xin_ctx = nullptr;
        switch (ph) {
        case 0: if (!PH_EN(0)) break; p0_prologue(F, ap, rerun); break;
        case 1: if (!PH_EN(1)) break; norm1_phase(F, APIN(0), APIN(2), APIN(6), APIN(5), APIN(21)); break;
        case 2: if (!PH_EN(2)) break; is_gemm = true; S.A = (const char*)(ws + A_XN); S.B = (const char*)(ws + W_IN); S.nM = MALL / 256; S.nN = NWIN / 256; E.kind = pg8::EK_IN0; break;
        case 3: if (!PH_EN(3)) break; attn0_phase(F, rerun, ap); break;
        case 4: if (!PH_EN(4)) break; mix0_combine_phase(F, ap); break;
        case 5: if (!PH_EN(5)) break; is_gemm = true; S.A = (const char*)(ws + A_XN); S.B = (const char*)(ws + W_OUT0); S.nM = MALL / 256; S.nN = DM / 256;
                E.kind = pg8::EK_OUT; E.layer = 0; E.xin_lat = APIN(0); E.xin_ctx = APIN(2); break;
        case 6: if (!PH_EN(6)) break; norm2_router_phase(F, MALL, APIN(15), MOD0, APIN(16)); break;
        case 7: if (!PH_EN(7)) break; topk_phase(F, true); break;
        case 8: if (!PH_EN(8)) break; gather_phase(F, EROWS0); break;
        case 9: if (!PH_EN(9)) break; is_gemm8 = true; S.pitch = DM; S.wgm = 4; E.wsc = 1.f / 32.f; E.f8out = true; S.A = (const char*)(ws + A_XN); S.gidx = (const int*)(ws + WS_IDX); S.B = (const char*)(ws + W_GU0); S.nM = NE * EROWS0 / 256; S.nN = 2 * FF / 256; S.tpe = EROWS0 / 256; E.kind = pg8::EK_GU; break;
        case 10: if (!PH_EN(10)) break; is_gemm8 = true; S.pitch = DM; E.wsc = 1.f / 32.f; S.A = (const char*)(ws + A_ACT); S.B = (const char*)(ws + W_D0); S.nM = NE * EROWS0 / 256; S.nN = DM / 256; S.tpe = EROWS0 / 256; E.kind = pg8::EK_DOWN; break;
        case 11: if (!PH_EN(11)) break; moe_combine_phase(F, MALL, EROWS0, MOD0, false, APIN(22), MOD1, nullptr); break;
        case 12: if (!PH_EN(12)) break; is_gemm = true; S.A = (const char*)(ws + A_XN); S.B = (const char*)(ws + W_QKV); S.nM = MALL / 256; S.nN = NQKV1 / 256; E.kind = pg8::EK_QKV1; break;
        case 13: if (!PH_EN(13)) break; attn1_phase(F, APIN(24)); break;
        case 14: if (!PH_EN(14)) break; is_gemm = true; S.A = (const char*)(ws + A_XN); S.B = (const char*)(ws + W_OUT1); S.nM = NLAT / 256; S.nN = DM / 256;
                E.kind = pg8::EK_OUT; E.layer = 1; break;
        case 15: if (!PH_EN(15)) break; norm2_router_phase(F, NLAT, APIN(26), MOD1, APIN(27)); break;
        case 16: if (!PH_EN(16)) break; topk_phase(F, false); break;
        case 17: if (!PH_EN(17)) break; gather_phase(F, EROWS1); break;
        case 18: if (!PH_EN(18)) break; is_gemm8 = true; S.pitch = DM; S.wgm = 4; E.wsc = 1.f / 32.f; E.f8out = true; S.A = (const char*)(ws + A_XN); S.gidx = (const int*)(ws + WS_IDX); S.B = (const char*)(ws + W_GU1); S.nM = NE * EROWS1 / 256; S.nN = 2 * FF / 256; S.tpe = EROWS1 / 256; E.kind = pg8::EK_GU; break;
        case 19: if (!PH_EN(19)) break; is_gemm8 = true; S.pitch = DM; E.wsc = 1.f / 32.f; S.A = (const char*)(ws + A_ACT); S.B = (const char*)(ws + W_D1); S.nM = NE * EROWS1 / 256; S.nN = DM / 256; S.tpe = EROWS1 / 256; E.kind = pg8::EK_DOWN; break;
        case 20: if (!PH_EN(20)) break; moe_combine_phase(F, NLAT, EROWS1, MOD1, true, APIN(31), nullptr, APOUT); break;
#if PROBE_MFMA
        case 21: {
            typedef int v8i_ __attribute__((ext_vector_type(8))); typedef int v6i_ __attribute__((ext_vector_type(6)));
            int z_ = F.lane; asm volatile("" : "+v"(z_));
#if PROBE_MFMA == 1 || PROBE_MFMA == 5
            bf16x8 OA, OB;
#pragma unroll
            for (int q = 0; q < 8; ++q) { OA[q] = (short)(z_ + q); OB[q] = (short)(z_ + 2 * q); }
#elif PROBE_MFMA == 4
            v6i_ OA, OB;
#pragma unroll
            for (int q = 0; q < 6; ++q) { OA[q] = z_ + q; OB[q] = z_ + 2 * q; }
#else
            v8i_ OA, OB;
#pragma unroll
            for (int q = 0; q < 8; ++q) { OA[q] = z_ + q; OB[q] = z_ + 2 * q; }
#endif
#if PROBE_MFMA == 3 || PROBE_MFMA == 5
            f32x16 c0 = f32x16{}, c1 = c0, c2 = c0, c3 = c0;
#else
            f32x4 c0 = {0, 0, 0, 0}, c1 = c0, c2 = c0, c3 = c0;
#endif
#if PROBE_MFMA == 1
#define MF_ "v_mfma_f32_16x16x32_bf16"
#define MS_ ""
#elif PROBE_MFMA == 2
#define MF_ "v_mfma_f32_16x16x128_f8f6f4"
#define MS_ ""
#elif PROBE_MFMA == 3
#define MF_ "v_mfma_f32_32x32x64_f8f6f4"
#define MS_ ""
#elif PROBE_MFMA == 4
#define MF_ "v_mfma_f32_16x16x128_f8f6f4"
#define MS_ " cbsz:2 blgp:2"
#else
#define MF_ "v_mfma_f32_32x32x16_bf16"
#define MS_ ""
#endif
            asm volatile("" : "+v"(OA), "+v"(OB));
            for (int i = 0; i < 2000; ++i)
                asm volatile(MF_ " %0, %4, %5, %0" MS_ "\n\t" MF_ " %1, %4, %5, %1" MS_ "\n\t" MF_ " %2, %4, %5, %2" MS_ "\n\t" MF_ " %3, %4, %5, %3" MS_ : "+v"(c0), "+v"(c1), "+v"(c2), "+v"(c3) : "v"(OA), "v"(OB));
            asm volatile("s_nop 15\n\ts_nop 15" ::: "memory");
            if (c0[0] + c1[0] + c2[0] + c3[0] == 123.456f) ((float*)(ws + A_OH + SZ_XN + 4096))[F.tid] = 1.f;
        } break;
#endif
        default: break;
        }
#if PROBE_ABL == 9 || PROBE_ABL >= 11
        if (rerun) { E.kind = pg8::EK_NONE; if (PROBE_ABL >= 11) S.hot = true; }
#endif
        if (!rerun) {
            if (ph == 3)  { const int q = F.vcu - 64;  if (q >= 0) weight_items(F, ap, wc::F2_HI, wc::L1, q * NWAVES + F.wave, (F.G - 64) * NWAVES); }
            if (ph == 16) { const int q = F.vcu - 128; if (q >= 0) weight_items(F, ap, wc::F5_HI, wc::NITEMS, q * NWAVES + F.wave, (F.G - 128) * NWAVES); }
        }
        if (GEMM_EN && is_gemm) pg8::gemm_phase(F.lds, F.tid, perm, S, E);
        if (GEMM_EN && is_gemm8) pg8::gemm_phase8(F.lds, F.tid, perm, S, E);
        if ((is_gemm || is_gemm8) && !rerun) {
            int flo = 0, fhi = 0;
            if (ph == 2) { flo = wc::F1_LO; fhi = wc::F1_HI; } else if (ph == 5) { flo = wc::F1_HI; fhi = wc::F2_HI; }
            else if (ph == 9) { flo = wc::F3_LO; fhi = wc::F3_HI; } else if (ph == 10) { flo = wc::F3_HI; fhi = wc::F4_HI; } else if (ph == 12) { flo = wc::F4_HI; fhi = wc::F5_HI; }
            const int nwg = S.nM * S.nN, rounds = (nwg + F.G - 1) / F.G, nlast = nwg - (rounds - 1) * F.G, q = (int)blockIdx.x - nlast;
            if (fhi > flo) { if (nlast == F.G) weight_items(F, ap, flo, fhi, F.gw, F.NGW);
                             else if (q >= 0) weight_items(F, ap, flo, fhi, q * NWAVES + F.wave, (F.G - nlast) * NWAVES); }
        }
        if (pi + 1 < nprog) { XcdBarrier bl = bar; { GAS unsigned* bp = (GAS unsigned*)(ap->ws + WS_CTL) + CW_BAR; asm volatile("" : "+s"(bp), "+s"(bl.x)); bl.bar = (unsigned*)bp; }
            xcd_barrier(bl);
#if PROBE_BAR2
            xcd_barrier(bl);
#endif
        }
    }
}

extern "C" void kernel_launch(void* const* d_in, const int* in_sizes, int n_in, void* d_out, int out_size, void* d_ws, size_t ws_size, hipStream_t stream) {
    static int grid = 0;
    if (grid == 0) {
        if (n_in != 32 || in_sizes[0] != NLAT * DM || out_size != NLAT * DM || ws_size < WS_END) {
            fprintf(stderr, "kernel_launch: unexpected shapes: n_in %d in0 %d out %d ws %zu (need %zu)\n", n_in, n_in > 0 ? in_sizes[0] : -1, out_size, ws_size, (size_t)WS_END); grid = -1; return; }
        int dev = 0, cus = 0, per_cu = 0;
        if (hipGetDevice(&dev) != hipSuccess || hipDeviceGetAttribute(&cus, hipDeviceAttributeMultiprocessorCount, dev) != hipSuccess) { grid = -1; return; }
        if (hipFuncSetAttribute((const void*)fwd_kernel, hipFuncAttributeMaxDynamicSharedMemorySize, LDS_BYTES) != hipSuccess) { fprintf(stderr, "kernel_launch: hipFuncSetAttribute failed\n"); grid = -1; return; }
        if (hipOccupancyMaxActiveBlocksPerMultiprocessor(&per_cu, (const void*)fwd_kernel, NTHREADS, LDS_BYTES) != hipSuccess || per_cu < 1) {
            fprintf(stderr, "kernel_launch: occupancy query reports %d blocks per CU\n", per_cu); (void)hipGetLastError(); grid = -1; return; }
        if (cus < 192 || cus % 8 != 0) { fprintf(stderr, "kernel_launch: built for >= 192 CUs in multiples of 8, got %d\n", cus); grid = -1; return; }
        grid = cus;
    }
    if (grid < 0) return;
    (void)hipMemsetAsync((char*)d_ws + WS_CTL, 0, CTL_ZERO_BYTES, stream);
    Args a{};
    for (int i = 0; i < 32; ++i) a.in[i] = (const float*)d_in[i];
    a.out = (float*)d_out; a.ws = (unsigned char*)d_ws;
#if MK_N_LAUNCHES == 1
    { int n = 0; for (int p = 0; p < N_PHASES; ++p) { if (p == 8 || p == 17 || (ATT0_PAIR && p == 4)) continue; a.prog[n++] = (unsigned char)p; if ((PROBE_DUP >> p) & 1u) a.prog[n++] = (unsigned char)(p | 32); }
      if (PROBE_MFMA) a.prog[n++] = 21;
      a.nprog = n; }
    hipLaunchKernelGGL(fwd_kernel, dim3(grid), dim3(NTHREADS), LDS_BYTES, stream, a);
#else
    for (int p = 0; p < N_PHASES; ++p) { a.nprog = 1; a.prog[0] = (unsigned char)p; hipLaunchKernelGGL(fwd_kernel, dim3(grid), dim3(NTHREADS), LDS_BYTES, stream, a); }
#endif
}
```
